# Optimizing an MI355X kernel written in HIP

```python
import jax, jax.numpy as jnp
from jax import lax
import numpy as np

D_MODEL = 1024
BATCH = 4
SEQ = 8192
DEPTH = 2

HEAD_DIM = 64
POOL_WINDOWS = (2, 4, 8, 16)
POOL_WIDTH = D_MODEL // 4
POOL_GROUP = POOL_WIDTH // len(POOL_WINDOWS)
DIL_PAIRS = ((128, 1), (512, 4), (2048, 16))
DIL_HEADS_PER_GROUP = D_MODEL // 512
DIL_HEADS = DIL_HEADS_PER_GROUP * len(DIL_PAIRS)
DIL_WIDTH = DIL_HEADS * HEAD_DIM
DIL_BLOCK = 64
WIN_Q_HEADS = DIL_HEADS
WIN_KV_HEADS = WIN_Q_HEADS // 3
WIN_GROUP = WIN_Q_HEADS // WIN_KV_HEADS
WIN_RADIUS = 128
WIN_BLOCK = 128
WIN_Q_WIDTH = WIN_Q_HEADS * HEAD_DIM
WIN_KV_WIDTH = WIN_KV_HEADS * HEAD_DIM
MIX_WIDTH = POOL_WIDTH + DIL_WIDTH + WIN_Q_WIDTH
IN_WIDTH = POOL_WIDTH + 3 * DIL_WIDTH + WIN_Q_WIDTH + 2 * WIN_KV_WIDTH
N_ATTN_HEADS = DIL_HEADS + WIN_Q_HEADS
D_FF = -(-8 * D_MODEL // (3 * 256)) * 256
N_MOD = 6
EPS = 1e-6
NEG = -1e30

kernel_name = "hybrid_pool_dilated_swa_encoder"


def rmsnorm(x, g):
    xf = x.astype(jnp.float32)
    y = xf * lax.rsqrt(jnp.mean(xf * xf, axis=-1, keepdims=True) + EPS)
    return (y * g.astype(jnp.float32)).astype(x.dtype)


def alibi_slopes():
    i = jnp.arange(1, N_ATTN_HEADS + 1, dtype=jnp.float32)
    return jnp.exp2(-8.0 * i / N_ATTN_HEADS)


def banded_attention(q, k, v, radius, block, slopes, dist_scale, sink):
    N, L, Hk, G, D = q.shape
    nb = -(-L // block)
    Lp = nb * block
    W = block + 2 * radius
    q = jnp.pad(q, ((0, 0), (0, Lp - L), (0, 0), (0, 0), (0, 0)))
    kpad = ((0, 0), (radius, Lp - L + radius), (0, 0), (0, 0))
    k = jnp.pad(k, kpad)
    v = jnp.pad(v, kpad)
    idx = (jnp.arange(nb) * block)[:, None] + jnp.arange(W)[None, :]
    kb = k[:, idx]
    vb = v[:, idx]
    qb = q.reshape(N, nb, block, Hk, G, D)
    s = jnp.einsum('nbqhgd,nbkhd->nbhgqk', qb, kb).astype(jnp.float32) * (D ** -0.5)
    rel = jnp.arange(W)[None, :] - radius - jnp.arange(block)[:, None]
    dist = jnp.abs(rel)
    key_pos = idx - radius
    valid = (dist <= radius)[None] & ((key_pos >= 0) & (key_pos < L))[:, None, :]
    bias = -(slopes.astype(jnp.float32) * dist_scale)[:, :, None, None] * dist.astype(jnp.float32)
    s = jnp.where(valid[None, :, None, None], s + bias[None, None], NEG)
    m = jnp.max(s, axis=-1)
    if sink is not None:
        sk = sink.astype(jnp.float32)[None, None, :, :, None]
        m = jnp.maximum(m, sk)
    e = jnp.exp(s - m[..., None])
    denom = jnp.sum(e, axis=-1)
    if sink is not None:
        denom = denom + jnp.exp(sk - m)
    p = e / denom[..., None]
    lse = m + jnp.log(denom)
    out = jnp.einsum('nbhgqk,nbkhd->nbqhgd', p.astype(v.dtype), vb)
    out = out.reshape(N, Lp, Hk, G, D)[:, :L]
    lse = lse.transpose(0, 1, 4, 2, 3).reshape(N, Lp, Hk, G)[:, :L]
    return out, lse


def multiscale_pool(u, w_pool, scale):
    B, S, C = u.shape
    uf = u.astype(jnp.float32)
    cs = jnp.pad(jnp.cumsum(uf, axis=1), ((0, 0), (1, 0), (0, 0)))
    t = jnp.arange(S)
    outs = []
    for g, w in enumerate(POOL_WINDOWS):
        r = w // 2
        lo = jnp.clip(t - r, 0, S)
        hi = jnp.clip(t + r + 1, 0, S)
        sl = slice(g * POOL_GROUP, (g + 1) * POOL_GROUP)
        csg = cs[..., sl]
        mean = (csg[:, hi] - csg[:, lo]) / (hi - lo).astype(jnp.float32)[None, :, None]
        outs.append(mean - uf[..., sl])
    pooled = jnp.stack(outs, axis=2).astype(u.dtype)
    y = jnp.einsum('bsgc,gcd->bsgd', pooled, w_pool).reshape(B, S, C)
    return y * scale


def dilated_attention(q, k, v, slopes):
    B, S, H, D = q.shape
    hg = DIL_HEADS_PER_GROUP
    outs, lses = [], []
    for g, (w, d) in enumerate(DIL_PAIRS):
        hs = slice(g * hg, (g + 1) * hg)

        def to_res(t):
            return t[:, :, hs].reshape(B, S // d, d, hg, D).transpose(0, 2, 1, 3, 4).reshape(B * d, S // d, hg, D)

        o, lse = banded_attention(to_res(q)[:, :, :, None, :], to_res(k), to_res(v),
                                  w // (2 * d), DIL_BLOCK, slopes[hs][:, None], d, None)
        outs.append(o.reshape(B, d, S // d, hg, D).transpose(0, 2, 1, 3, 4).reshape(B, S, hg, D))
        lses.append(lse.reshape(B, d, S // d, hg).transpose(0, 2, 1, 3).reshape(B, S, hg))
    alpha = jax.nn.softmax(jnp.stack(lses, axis=0), axis=0)
    y = jnp.concatenate([alpha[g][..., None].astype(outs[g].dtype) * outs[g]
                         for g in range(len(DIL_PAIRS))], axis=2)
    return y.reshape(B, S, DIL_WIDTH)


def windowed_gqa(q, k, v, slopes, sink):
    B, S, _ = q.shape
    qh = q.reshape(B, S, WIN_KV_HEADS, WIN_GROUP, HEAD_DIM)
    kh = k.reshape(B, S, WIN_KV_HEADS, HEAD_DIM)
    vh = v.reshape(B, S, WIN_KV_HEADS, HEAD_DIM)
    o, _ = banded_attention(qh, kh, vh, WIN_RADIUS, WIN_BLOCK,
                            slopes.reshape(WIN_KV_HEADS, WIN_GROUP), 1,
                            sink.reshape(WIN_KV_HEADS, WIN_GROUP))
    return o.reshape(B, S, WIN_Q_WIDTH)


def setup_inputs(seed: int = 0) -> dict:
    key = jax.random.key(seed)
    ks = jax.random.split(key, 16)
    f32 = jnp.float32
    nrm = lambda k, shape, s: jax.random.normal(k, shape, f32) * s
    return {
        "x": nrm(ks[0], (BATCH, SEQ, D_MODEL), 1.0),
        "c": nrm(ks[1], (BATCH, D_MODEL), 1.0),
        "norm1_g": 1.0 + nrm(ks[2], (DEPTH, D_MODEL), 0.1),
        "norm2_g": 1.0 + nrm(ks[3], (DEPTH, D_MODEL), 0.1),
        "w_ada": nrm(ks[4], (DEPTH, D_MODEL, N_MOD * D_MODEL), 0.5 * D_MODEL ** -0.5),
        "b_ada": nrm(ks[5], (DEPTH, N_MOD * D_MODEL), 0.02),
        "w_in": nrm(ks[6], (DEPTH, D_MODEL, IN_WIDTH), D_MODEL ** -0.5),
        "w_pool": nrm(ks[7], (DEPTH, len(POOL_WINDOWS), POOL_GROUP, POOL_GROUP), POOL_GROUP ** -0.5),
        "pool_scale": 1.0 + nrm(ks[8], (DEPTH, POOL_WIDTH), 0.1),
        "sink_logit": nrm(ks[9], (DEPTH, WIN_Q_HEADS), 1.0),
        "w_out": nrm(ks[10], (DEPTH, MIX_WIDTH, D_MODEL), MIX_WIDTH ** -0.5),
        "w_gate": nrm(ks[11], (DEPTH, D_MODEL, D_FF), D_MODEL ** -0.5),
        "w_up": nrm(ks[12], (DEPTH, D_MODEL, D_FF), D_MODEL ** -0.5),
        "w_down": nrm(ks[13], (DEPTH, D_FF, D_MODEL), D_FF ** -0.5),
        "final_g": 1.0 + nrm(ks[14], (D_MODEL,), 0.1),
    }


def reference(x, c, norm1_g, norm2_g, w_ada, b_ada, w_in, w_pool, pool_scale, sink_logit,
              w_out, w_gate, w_up, w_down, final_g):
    slopes = alibi_slopes()
    slopes_win = slopes[:WIN_Q_HEADS]
    slopes_dil = slopes[WIN_Q_HEADS:].astype(jnp.float32)
    o_q_b = POOL_WIDTH
    o_k_b = o_q_b + DIL_WIDTH
    o_v_b = o_k_b + DIL_WIDTH
    o_q_c = o_v_b + DIL_WIDTH
    o_k_c = o_q_c + WIN_Q_WIDTH
    o_v_c = o_k_c + WIN_KV_WIDTH
    B, S, _ = x.shape
    c_act = jax.nn.silu(c)
    for l in range(DEPTH):
        mod = (c_act @ w_ada[l] + b_ada[l])[:, None, :]
        sh1, sc1, g1, sh2, sc2, g2 = jnp.split(mod, N_MOD, axis=-1)
        h = rmsnorm(x, norm1_g[l]) * (1.0 + sc1) + sh1
        z = h @ w_in[l]
        y_a = multiscale_pool(z[..., :o_q_b], w_pool[l], pool_scale[l])
        qb = z[..., o_q_b:o_k_b].reshape(B, S, DIL_HEADS, HEAD_DIM)
        kb = z[..., o_k_b:o_v_b].reshape(B, S, DIL_HEADS, HEAD_DIM)
        vb = z[..., o_v_b:o_q_c].reshape(B, S, DIL_HEADS, HEAD_DIM)
        y_b = dilated_attention(qb, kb, vb, slopes_dil)
        y_c = windowed_gqa(z[..., o_q_c:o_k_c], z[..., o_k_c:o_v_c], z[..., o_v_c:],
                           slopes_win, sink_logit[l])
        mix = jnp.concatenate([y_a, y_b, y_c], axis=-1) @ w_out[l]
        x = x + g1 * mix
        h = rmsnorm(x, norm2_g[l]) * (1.0 + sc2) + sh2
        ffn = (jax.nn.silu(h @ w_gate[l]) * (h @ w_up[l])) @ w_down[l]
        x = x + g2 * ffn
    return rmsnorm(x, final_g)
```

```cpp
#include <hip/hip_runtime.h>
#include <cstdio>
#include <cstdint>
namespace pg8 {
#define PG8_LAS __attribute__((address_space(3)))
typedef unsigned short bf16_t;
typedef short bf16x8 __attribute__((ext_vector_type(8)));
typedef float f32x4 __attribute__((ext_vector_type(4)));
typedef unsigned u32x4 __attribute__((ext_vector_type(4)));
constexpr int BM = 256, BK = 64, HALF = 128, HTB = HALF * BK * 2  , STAGE_BYTES = 8 * HTB, NXCD = 8, WGM = 8;

__host__ __device__ __forceinline__ int lds_byte(int r, int c) { const int st = (r >> 4) * 2 + (c >> 5), rr = r & 15, cc = c & 31, ob = rr * 64 + cc * 2; return st * 1024 + (ob ^ (((ob >> 9) & 1) << 5)); }
__host__ __device__ __forceinline__ void stage_rc(int b, int& R, int& C) { const int st = b / 1024, sb = b % 1024, swz = sb ^ (((sb >> 9) & 1) << 5); R = (st >> 1) * 16 + swz / 64; C = (st & 1) * 32 + (swz % 64) / 2; }
__host__ __device__ __forceinline__ int perm32(int rho) { const int n = rho >> 4, i = rho & 15; return 8 * (i >> 2) + 4 * n + (i & 3); }

struct Unit { int pm, pn; };
struct Gemm { const bf16_t* A; const bf16_t* Bt; int M, N, K; };

struct StaticOrder {
    int nM, nN, nwg, G, c;
    __host__ __device__ void init(int M, int N, int G_, int c_) { nM = M / BM; nN = N / BM; nwg = nM * nN; G = G_; c = c_; }
    __host__ __device__ bool next(int i, Unit& u) const {
        const long L = (long)i * G + c; if (L >= nwg) return false;
        int wgid = (int)L; { const int q = nwg / NXCD, r = nwg % NXCD, xcd = wgid % NXCD, off = wgid / NXCD; wgid = (xcd < r ? xcd * (q + 1) : r * (q + 1) + (xcd - r) * q) + off; }
        const int nig = WGM * nN, gid = wgid / nig, fm = gid * WGM, gsz = (nM - fm) < WGM ? (nM - fm) : WGM;
        u.pm = fm + ((wgid % nig) % gsz); u.pn = (wgid % nig) / gsz; return true;
    }
    __device__ __forceinline__ void a_ready(const Unit&) const {}
    __device__ __forceinline__ void done(const Unit&) const {}
};

__device__ __forceinline__ unsigned cvt_pk_bf16(float lo, float hi) { unsigned r; asm volatile("v_cvt_pk_bf16_f32 %0, %1, %2" : "=v"(r) : "v"(lo), "v"(hi)); return r; }
struct EpiBf16 {
    static constexpr bool PERM = true, AFTER_DRAIN = false;
    bf16_t* O; int ldc;
    __device__ __forceinline__ void operator()(const f32x4 (&acc)[2][2][4][2], const Unit& u, int wr, int wc, int fr, int fq) const {
        const int row0 = u.pm * BM + wr * 64 + fr, col0 = u.pn * BM + wc * 32 + 8 * fq;
#pragma unroll
        for (int ai = 0; ai < 2; ++ai)
#pragma unroll
            for (int m = 0; m < 4; ++m) { bf16_t* rowp = O + (size_t)(row0 + ai * HALF + m * 16) * ldc + col0;
#pragma unroll
                for (int bj = 0; bj < 2; ++bj) { const f32x4 v0 = acc[ai][bj][m][0], v1 = acc[ai][bj][m][1];
                    u32x4 w; w.x = cvt_pk_bf16(v0[0], v0[1]); w.y = cvt_pk_bf16(v0[2], v0[3]); w.z = cvt_pk_bf16(v1[0], v1[1]); w.w = cvt_pk_bf16(v1[2], v1[3]);
                    *(u32x4*)(rowp + bj * HALF) = w; } }
    }
};
struct EpiGateRes {
    static constexpr bool PERM = false, AFTER_DRAIN = false;
    const float* base; float* out; const float* gate; int ldc; int gate_stride;
    __device__ __forceinline__ void operator()(const f32x4 (&acc)[2][2][4][2], const Unit& u, int wr, int wc, int fr, int fq) const {
        const int row0 = u.pm * BM + wr * 64 + fr, col0 = u.pn * BM + wc * 32 + 4 * fq;
        const float* gp = gate + (size_t)(u.pm >> 5) * gate_stride + col0;
        f32x4 gv[2][2];
#pragma unroll
        for (int bj = 0; bj < 2; ++bj)
#pragma unroll
            for (int n = 0; n < 2; ++n) gv[bj][n] = *(const f32x4*)(gp + bj * HALF + n * 16);
#pragma unroll
        for (int ai = 0; ai < 2; ++ai)
#pragma unroll
            for (int m = 0; m < 4; ++m) { const size_t off = (size_t)(row0 + ai * HALF + m * 16) * ldc + col0;
#pragma unroll
                for (int bj = 0; bj < 2; ++bj)
#pragma unroll
                    for (int n = 0; n < 2; ++n) { const f32x4 bs = *(const f32x4*)(base + off + bj * HALF + n * 16);
                        *(f32x4*)(out + off + bj * HALF + n * 16) = bs + gv[bj][n] * acc[ai][bj][m][n]; }
                if (m & 1) asm volatile("" ::: "memory"); }
    }
};
struct EpiSwiGLU {
    static constexpr bool PERM = true, AFTER_DRAIN = false;
    bf16_t* O; int ldc;
    static __device__ __forceinline__ float silu_mul(float g, float u) { return g * u * __builtin_amdgcn_rcpf(1.0f + __builtin_amdgcn_exp2f(-1.4426950408889634f * g)); }
    __device__ __forceinline__ void operator()(const f32x4 (&acc)[2][2][4][2], const Unit& u, int wr, int wc, int fr, int fq) const {
        const int row0 = u.pm * BM + wr * 64 + fr, col0 = u.pn * HALF + wc * 32 + 8 * fq;
#pragma unroll
        for (int ai = 0; ai < 2; ++ai)
#pragma unroll
            for (int m = 0; m < 4; ++m) { bf16_t* rowp = O + (size_t)(row0 + ai * HALF + m * 16) * ldc + col0;
                const f32x4 g0 = acc[ai][0][m][0], g1 = acc[ai][0][m][1], u0 = acc[ai][1][m][0], u1 = acc[ai][1][m][1];
                u32x4 w; w.x = cvt_pk_bf16(silu_mul(g0[0], u0[0]), silu_mul(g0[1], u0[1])); w.y = cvt_pk_bf16(silu_mul(g0[2], u0[2]), silu_mul(g0[3], u0[3]));
                w.z = cvt_pk_bf16(silu_mul(g1[0], u1[0]), silu_mul(g1[1], u1[1])); w.w = cvt_pk_bf16(silu_mul(g1[2], u1[2]), silu_mul(g1[3], u1[3]));
                *(u32x4*)rowp = w; }
    }
};

template <class Epi, class Sched, bool ALIGN_EPI = false, bool SP2 = false>
__device__ __forceinline__ void gemm_phase(PG8_LAS unsigned char* lds, const Gemm g, const Sched& S, const Epi& E) {
    int tid_ = threadIdx.x; asm volatile("" : "+v"(tid_));
    const int tid = tid_, wid = __builtin_amdgcn_readfirstlane(tid >> 6), lane = tid & 63, wr = wid >> 2, wc = wid & 3, fr = lane & 15, fq = lane >> 4;
    const int K = g.K, nt = K / BK;
    unsigned voffA[2], voffB[2];
#pragma unroll
    for (int i = 0; i < 2; ++i) { int R, C; stage_rc(tid * 16 + i * 8192, R, C); const int Rb = Epi::PERM ? ((R & ~31) + perm32(R & 31)) : R;
        voffA[i] = (unsigned)(R * K + C) * 2u; voffB[i] = (unsigned)(Rb * K + C) * 2u; }
    const size_t kstep = (size_t)(BK * 2);
    const size_t hstep = (size_t)HALF * K * 2;
    const size_t tstep = 2 * hstep;
    const unsigned ldsw = (unsigned)wid * 1024u;
    const int aoff = lds_byte(wr * 64 + fr, fq * 8), boff = lds_byte(wc * 32 + fr, fq * 8);
#define PG8_SA(b, h) (((b) * 2 + (h)) * HTB)
#define PG8_SB(b, h) ((4 + (b) * 2 + (h)) * HTB)
#define PG8_STAGE(bufoff, gbase, voff) do { _Pragma("unroll") for (int _i = 0; _i < 2; ++_i) \
        __builtin_amdgcn_global_load_lds((const unsigned*)((const char*)(gbase) + (voff)[_i]), (PG8_LAS unsigned*)(lds + (bufoff) + ldsw + _i * 8192), 16, 0, 0); } while (0)
#define PG8_LDA(dst, b, h) do { _Pragma("unroll") for (int m = 0; m < 4; ++m) _Pragma("unroll") for (int k = 0; k < 2; ++k) dst[m][k] = *(const PG8_LAS bf16x8*)(lds + PG8_SA(b, h) + aoff + m * 2048 + k * 1024); } while (0)
#define PG8_LDB(dst, b, h) do { _Pragma("unroll") for (int n = 0; n < 2; ++n) _Pragma("unroll") for (int k = 0; k < 2; ++k) dst[n][k] = *(const PG8_LAS bf16x8*)(lds + PG8_SB(b, h) + boff + n * 2048 + k * 1024); } while (0)
#define PG8_MMA(ai, bj, At, Bt) do { __builtin_amdgcn_s_setprio(1); _Pragma("unroll") for (int m = 0; m < 4; ++m) _Pragma("unroll") for (int n = 0; n < 2; ++n) _Pragma("unroll") for (int k = 0; k < 2; ++k) \
        acc[ai][bj][m][n] = __builtin_amdgcn_mfma_f32_16x16x32_bf16(Bt[n][k], At[m][k], acc[ai][bj][m][n], 0, 0, 0); __builtin_amdgcn_s_setprio(0); } while (0)
#define PG8_WAIT_V(n) asm volatile("s_waitcnt vmcnt(" #n ")" ::: "memory")
#define PG8_WAIT_L(n) asm volatile("s_waitcnt lgkmcnt(" #n ")" ::: "memory")
#define PG8_BAR __builtin_amdgcn_s_barrier()
#define PG8_SCHED __builtin_amdgcn_sched_barrier(0)
    Unit cur, nxt; int ui = 0;
    if (!S.next(0, cur)) return;
    f32x4 acc[2][2][4][2];
#pragma unroll
    for (int a = 0; a < 2; ++a)
#pragma unroll
        for (int b = 0; b < 2; ++b)
#pragma unroll
            for (int m = 0; m < 4; ++m)
#pragma unroll
                for (int n = 0; n < 2; ++n) acc[a][b][m][n] = (f32x4){0.f, 0.f, 0.f, 0.f};
    bf16x8 At[4][2], B0[2][2], B1[2][2];
    const char* cA = (const char*)g.A + (size_t)cur.pm * tstep; const char* cB = (const char*)g.Bt + (size_t)cur.pn * tstep;
    S.a_ready(cur);
    if constexpr (SP2) {
        PG8_STAGE(PG8_SB(0, 0), cB, voffB); PG8_STAGE(PG8_SB(0, 1), cB + hstep, voffB); PG8_STAGE(PG8_SA(0, 0), cA, voffA); PG8_STAGE(PG8_SA(0, 1), cA + hstep, voffA);
        if (wr == 1) PG8_BAR;
        PG8_WAIT_V(2); PG8_BAR;
        PG8_STAGE(PG8_SB(1, 0), cB + kstep, voffB); PG8_STAGE(PG8_SA(1, 0), cA + kstep, voffA); PG8_STAGE(PG8_SB(1, 1), cB + hstep + kstep, voffB);
        PG8_WAIT_V(6); PG8_BAR;
    } else {
        PG8_STAGE(PG8_SB(0, 0), cB, voffB); PG8_STAGE(PG8_SA(0, 0), cA, voffA); PG8_STAGE(PG8_SB(0, 1), cB + hstep, voffB); PG8_STAGE(PG8_SA(0, 1), cA + hstep, voffA);
        if (wr == 1) PG8_BAR;
        PG8_WAIT_V(4); PG8_BAR;
        PG8_STAGE(PG8_SB(1, 0), cB + kstep, voffB); PG8_STAGE(PG8_SA(1, 0), cA + kstep, voffA); PG8_STAGE(PG8_SB(1, 1), cB + hstep + kstep, voffB);
        PG8_WAIT_V(6); PG8_BAR;
    }
    for (;;) {
        const bool has_next = S.next(ui + 1, nxt);
        const char* nA = has_next ? (const char*)g.A + (size_t)nxt.pm * tstep : cA; const char* nB = has_next ? (const char*)g.Bt + (size_t)nxt.pn * tstep : cB;
        for (int t = 0; t < nt; t += 2) {
            const bool last = (t == nt - 2);
            const char* a1 = cA + (size_t)(t + 1) * kstep;
            const char* a2 = last ? nA : cA + (size_t)(t + 2) * kstep; const char* b2 = last ? nB : cB + (size_t)(t + 2) * kstep;
            const char* a3 = a2 + kstep; const char* b3 = b2 + kstep;
            if (last && has_next) S.a_ready(nxt);
            if constexpr (SP2) {
            PG8_LDB(B0, 0, 0); PG8_LDB(B1, 0, 1); PG8_SCHED; PG8_LDA(At, 0, 0); PG8_STAGE(PG8_SA(1, 1), a1 + hstep, voffA);
            PG8_WAIT_V(8); PG8_WAIT_L(0); PG8_BAR; PG8_MMA(0, 0, At, B0); PG8_MMA(0, 1, At, B1); PG8_BAR; PG8_SCHED;
            PG8_LDA(At, 0, 1); PG8_STAGE(PG8_SB(0, 0), b2, voffB); PG8_STAGE(PG8_SB(0, 1), b2 + hstep, voffB); PG8_STAGE(PG8_SA(0, 0), a2, voffA);
            PG8_WAIT_V(8); PG8_WAIT_L(0); PG8_BAR; PG8_MMA(1, 0, At, B0); PG8_MMA(1, 1, At, B1); PG8_BAR; PG8_SCHED;
            PG8_LDB(B0, 1, 0); PG8_LDB(B1, 1, 1); PG8_SCHED; PG8_LDA(At, 1, 0); PG8_STAGE(PG8_SA(0, 1), a2 + hstep, voffA);
            PG8_WAIT_V(8); PG8_WAIT_L(0); PG8_BAR; PG8_MMA(0, 0, At, B0); PG8_MMA(0, 1, At, B1); PG8_BAR; PG8_SCHED;
            PG8_LDA(At, 1, 1); PG8_STAGE(PG8_SB(1, 0), b3, voffB); PG8_STAGE(PG8_SB(1, 1), b3 + hstep, voffB); PG8_STAGE(PG8_SA(1, 0), a3, voffA);
            PG8_WAIT_V(8); PG8_WAIT_L(0); PG8_BAR; PG8_MMA(1, 0, At, B0); PG8_MMA(1, 1, At, B1); PG8_BAR; PG8_SCHED;
            } else {
            PG8_LDB(B0, 0, 0); PG8_SCHED; PG8_LDA(At, 0, 0); PG8_STAGE(PG8_SA(1, 1), a1 + hstep, voffA);
            PG8_WAIT_L(8); PG8_BAR; PG8_WAIT_L(0); PG8_MMA(0, 0, At, B0); PG8_BAR; PG8_SCHED;
            PG8_LDB(B1, 0, 1); PG8_STAGE(PG8_SB(0, 0), b2, voffB);
            PG8_BAR; PG8_WAIT_L(0); PG8_MMA(0, 1, At, B1); PG8_BAR;
            PG8_LDA(At, 0, 1); PG8_STAGE(PG8_SA(0, 0), a2, voffA);
            PG8_BAR; PG8_WAIT_L(0); PG8_MMA(1, 0, At, B0); PG8_BAR; PG8_SCHED;
            PG8_STAGE(PG8_SB(0, 1), b2 + hstep, voffB);
            PG8_WAIT_V(6); PG8_BAR; PG8_MMA(1, 1, At, B1); PG8_BAR;
            PG8_LDB(B0, 1, 0); PG8_SCHED; PG8_LDA(At, 1, 0); PG8_STAGE(PG8_SA(0, 1), a2 + hstep, voffA);
            PG8_WAIT_L(8); PG8_BAR; PG8_WAIT_L(0); PG8_MMA(0, 0, At, B0); PG8_BAR; PG8_SCHED;
            PG8_LDB(B1, 1, 1); PG8_STAGE(PG8_SB(1, 0), b3, voffB);
            PG8_BAR; PG8_WAIT_L(0); PG8_MMA(0, 1, At, B1); PG8_BAR;
            PG8_LDA(At, 1, 1); PG8_STAGE(PG8_SA(1, 0), a3, voffA);
            PG8_BAR; PG8_WAIT_L(0); PG8_MMA(1, 0, At, B0); PG8_BAR; PG8_SCHED;
            PG8_STAGE(PG8_SB(1, 1), b3 + hstep, voffB);
            PG8_WAIT_V(6); PG8_BAR; PG8_MMA(1, 1, At, B1); PG8_BAR;
            }
        }
        if constexpr (ALIGN_EPI) { if (wr == 0) PG8_BAR; }
        if constexpr (!Epi::AFTER_DRAIN) { E(acc, cur, wr, wc, fr, fq); S.done(cur); }
        if (!has_next) break;
#pragma unroll
        for (int a = 0; a < 2; ++a)
#pragma unroll
            for (int b = 0; b < 2; ++b)
#pragma unroll
                for (int m = 0; m < 4; ++m)
#pragma unroll
                    for (int n = 0; n < 2; ++n) acc[a][b][m][n] = (f32x4){0.f, 0.f, 0.f, 0.f};
        cur = nxt; cA = nA; cB = nB; ++ui;
        if constexpr (ALIGN_EPI) { if (wr == 1) PG8_BAR; }
    }
    PG8_WAIT_V(0);
    if constexpr (!ALIGN_EPI) { if (wr == 0) PG8_BAR; }
    PG8_BAR;
    if constexpr (Epi::AFTER_DRAIN) { E.fused(acc, cur, wr, wc, fr, fq, lds, wid, lane); S.done(cur); }
#undef PG8_SA
#undef PG8_SB
#undef PG8_STAGE
#undef PG8_LDA
#undef PG8_LDB
#undef PG8_MMA
#undef PG8_WAIT_V
#undef PG8_WAIT_L
#undef PG8_BAR
#undef PG8_SCHED
}
}
#define GAS __attribute__((address_space(1)))
#define LAS __attribute__((address_space(3)))
typedef unsigned short bf16;
typedef unsigned v4u __attribute__((ext_vector_type(4)));
typedef float f32x4 __attribute__((ext_vector_type(4)));
typedef short bf16x8 __attribute__((ext_vector_type(8)));
typedef GAS unsigned gu32;
typedef GAS unsigned long long gu64;
#define RLX_AGENT __ATOMIC_RELAXED, __HIP_MEMORY_SCOPE_AGENT
#define LDS_WAIT() asm volatile("s_waitcnt lgkmcnt(0)" ::: "memory")
#define VM_WAIT() asm volatile("s_waitcnt vmcnt(0)" ::: "memory")
__device__ __forceinline__ unsigned long long rt() { return __builtin_amdgcn_s_memrealtime(); }
__device__ __forceinline__ unsigned f2bf(float f) { unsigned u = __builtin_bit_cast(unsigned, f); return (u + 0x7fffu + ((u >> 16) & 1u)) >> 16; }
__device__ __forceinline__ unsigned pk2(float lo, float hi) { return f2bf(lo) | (f2bf(hi) << 16); }

#define XB_TMO      128
#define XB_XCNT(j)  (256  + 64 * (j))
#define XB_XSUB(j)  (1280 + 64 * (j))
#define XB_XGEN(j)  (2304 + 64 * (j))
#define XB_TOP      3328
#define XB_TOPGEN   3392
#define XCD_BAR_WORDS 3456
#define XB_SPIN_CAP (1u << 18)

__device__ __forceinline__ unsigned xb_ld(unsigned* p)              { return __hip_atomic_load(p, __ATOMIC_RELAXED, __HIP_MEMORY_SCOPE_AGENT); }
__device__ __forceinline__ unsigned xb_add(unsigned* p, unsigned v) { return __hip_atomic_fetch_add(p, v, __ATOMIC_RELAXED, __HIP_MEMORY_SCOPE_AGENT); }
__device__ __forceinline__ unsigned xb_xcc_id() { return (unsigned)__builtin_amdgcn_s_getreg((3 << 11) | 20) & 0xFu; }
#define XB_SPIN(cond, bar) do { unsigned _sp = 0; while (cond) { __builtin_amdgcn_s_sleep(1); \
    if ((++_sp & 255u) == 0u) { if (xb_ld(&(bar)[XB_TMO])) break; if (_sp > XB_SPIN_CAP) { atomicAdd(&(bar)[XB_TMO], 1u); break; } } } } while (0)

struct XcdBarrier {
    unsigned* bar; unsigned x;
    volatile LAS unsigned* st;
};

__device__ __forceinline__ XcdBarrier xcd_barrier_post(unsigned* bar, volatile LAS unsigned* st) {
    XcdBarrier b; b.bar = bar; b.x = xb_xcc_id(); b.st = st;
    if (threadIdx.x == 0) (void)xb_add(&bar[XB_XCNT(b.x)], 1u);
    return b;
}
__device__ __forceinline__ void xcd_barrier_complete(unsigned* bar, unsigned x, unsigned& nloc, unsigned& nx) {
    const unsigned G = gridDim.x * gridDim.y * gridDim.z;
    unsigned sum, cnt, mine, sp = 0u;
    for (;;) {
        sum = 0u; cnt = 0u; mine = 0u;
#pragma unroll
        for (unsigned j = 0; j < 16; ++j) { const unsigned c = xb_ld(&bar[XB_XCNT(j)]); sum += c; cnt += (c > 0u) ? 1u : 0u; mine = (j == x) ? c : mine; }
        if (sum == G) break;
        __builtin_amdgcn_s_sleep(1);
        if ((++sp & 255u) == 0u) { if (xb_ld(&bar[XB_TMO])) break; if (sp > XB_SPIN_CAP) { atomicAdd(&bar[XB_TMO], 1u); break; } }
    }
    nloc = mine > 0u ? mine : 1u; nx = cnt > 0u ? cnt : 1u;
}

__device__ __forceinline__ void xcd_barrier(const XcdBarrier& b) {
    asm volatile("s_waitcnt vmcnt(0)" ::: "memory");
    __syncthreads();
    if (threadIdx.x == 0) {
        unsigned* bar = b.bar;
        __builtin_amdgcn_s_waitcnt(0);
        unsigned nloc = b.st[0], nx = b.st[1];
        if (nloc == 0u) { xcd_barrier_complete(bar, b.x, nloc, nx); b.st[0] = nloc; b.st[1] = nx; }
        const unsigned old = xb_add(&bar[XB_XSUB(b.x)], 1u);
        const unsigned gen = old / nloc;
        if (old + 1u == (gen + 1u) * nloc) {
            __builtin_amdgcn_fence(__ATOMIC_RELEASE, "agent");
            asm volatile("s_waitcnt vmcnt(0)" ::: "memory");
            const unsigned og = xb_add(&bar[XB_TOP], 1u);
            const unsigned tg = og / nx;
            if (og + 1u == (tg + 1u) * nx) xb_add(&bar[XB_TOPGEN], 1u);
            else XB_SPIN(xb_ld(&bar[XB_TOPGEN]) == tg, bar);
            __builtin_amdgcn_fence(__ATOMIC_ACQUIRE, "agent");
            xb_add(&bar[XB_XGEN(b.x)], 1u);
            asm volatile("s_waitcnt vmcnt(0)" ::: "memory");
        } else {
            XB_SPIN(xb_ld(&bar[XB_XGEN(b.x)]) == gen, bar);
            __builtin_amdgcn_fence(__ATOMIC_ACQUIRE, "agent");
            asm volatile("s_waitcnt vmcnt(0)" ::: "memory");
        }
    }
    __syncthreads();
}

constexpr int NWAVES = 8;
constexpr int BATCH = 4, SEQ = 8192, D = 1024, M = BATCH * SEQ, DEPTH = 2;
constexpr int INW = 2048, DFF = 2816, NMOD = 6;
constexpr int O_U = 0, O_QB = 256, O_KB = 640, O_VB = 1024, O_QC = 1408, O_KC = 1792, O_VC = 1920;
constexpr float RMS_EPS = 1e-6f;
constexpr float LOG2E = 1.4426950408889634f;
constexpr float QSCALE = 0.125f * LOG2E;

constexpr size_t MiB = 1u << 20;
constexpr size_t WS_CTL = 0, CTL_ZERO_BYTES = 65536;
constexpr size_t WS_MOD = 1 * MiB;
constexpr size_t WS_W = 2 * MiB, W_LAYER = 24 * MiB;
constexpr size_t W_IN = 0, W_OUT = 4 * MiB, W_GU = 6 * MiB, W_DN = 17 * MiB, W_PT = 23 * MiB;
constexpr size_t WS_H = 50 * MiB;
constexpr size_t WS_Z = 114 * MiB;
constexpr size_t WS_MIX = 242 * MiB;
constexpr size_t WS_HID = 114 * MiB;
constexpr size_t WS_XS = 306 * MiB;
constexpr size_t WS_END = 434 * MiB;
static_assert(WS_HID + (size_t)M * DFF * 2 <= WS_XS && WS_MIX + (size_t)M * D * 2 <= WS_XS && WS_Z + (size_t)M * INW * 2 <= WS_MIX && WS_H + (size_t)M * D * 2 <= WS_Z, "ws map");
constexpr int CW_TMO = 0, CW_CODE = 1, CW_BAR = 4096, CW_QUEUE = 8192;

constexpr int RING_OFF = 0, RING_BYTES = 131072;
constexpr int LDSCTL_OFF = RING_BYTES, MISC_OFF = LDSCTL_OFF + 320;
constexpr int LDS_BYTES = 147456;

constexpr int PH_PRO = 0, PH_PER_LAYER = 7, PH_FINAL = 1 + DEPTH * PH_PER_LAYER, NPHASES = PH_FINAL + 1;
#ifndef MK_ONE_LAUNCH
#define MK_ONE_LAUNCH 0
#endif

struct Frame {
    LAS unsigned char* lds;
    volatile LAS unsigned* MISC;
    gu32* ctl;
    int tid, lane, wave, G, vcu;
};

__device__ __forceinline__ float wave_sum(float v) {
#pragma unroll
    for (int o = 1; o < 64; o <<= 1) v += __shfl_xor(v, o);
    return v;
}
__device__ __forceinline__ float bf2f(unsigned short b) { return __uint_as_float((unsigned)b << 16); }

__device__ __forceinline__ void tr_item(const float* W, int N, int k0, int n0, bf16* WT, int ldt, int drow0, float scale, LAS float* scr, int lane) {
#pragma unroll 8
    for (int i = 0; i < 32; ++i) { const int kk = 2 * i + (lane >> 5); scr[kk * 33 + (lane & 31)] = W[(size_t)(k0 + kk) * N + n0 + (lane & 31)]; }
    LDS_WAIT(); asm volatile("" ::: "memory");
    const int c = lane & 7;
#pragma unroll
    for (int j = 0; j < 4; ++j) { const int n = (lane >> 3) + 8 * j; const LAS float* s = scr + (8 * c) * 33 + n;
        v4u o; o.x = pk2(s[0 * 33] * scale, s[1 * 33] * scale); o.y = pk2(s[2 * 33] * scale, s[3 * 33] * scale); o.z = pk2(s[4 * 33] * scale, s[5 * 33] * scale); o.w = pk2(s[6 * 33] * scale, s[7 * 33] * scale);
        *(GAS v4u*)(WT + (size_t)(drow0 + n) * ldt + k0 + 8 * c) = o; }
    LDS_WAIT(); asm volatile("" ::: "memory");
}
constexpr int TI_IN = 16 * 64, TI_OUT = 16 * 32, TI_G = 16 * 88, TI_DN = 44 * 32, TI_P = 8, TI_LAYER = TI_IN + TI_OUT + 2 * TI_G + TI_DN + TI_P;
__device__ __forceinline__ void weight_item(const float* const* in, unsigned char* ws, int it, LAS float* scr, int lane) {
    const int l = it / TI_LAYER; int r = it % TI_LAYER;
    unsigned char* wl = ws + WS_W + (size_t)l * W_LAYER;
    if (r < TI_IN) { const int kb = r / 64, n0 = 32 * (r % 64); const bool isq = (n0 >= O_QB && n0 < O_KB) || (n0 >= O_QC && n0 < O_KC);
        tr_item(in[6] + (size_t)l * D * INW, INW, 64 * kb, n0, (bf16*)(wl + W_IN), D, n0, isq ? QSCALE : 1.0f, scr, lane); return; }
    r -= TI_IN;
    if (r < TI_OUT) { const int kb = r / 32, n0 = 32 * (r % 32); tr_item(in[10] + (size_t)l * D * D, D, 64 * kb, n0, (bf16*)(wl + W_OUT), D, n0, 1.0f, scr, lane); return; }
    r -= TI_OUT;
    if (r < 2 * TI_G) { const int up = r >= TI_G; if (up) r -= TI_G; const int kb = r / 88, n0 = 32 * (r % 88);
        tr_item(in[up ? 12 : 11] + (size_t)l * D * DFF, DFF, 64 * kb, n0, (bf16*)(wl + W_GU), D, 256 * (n0 >> 7) + 128 * up + (n0 & 127), 1.0f, scr, lane); return; }
    r -= 2 * TI_G;
    if (r < TI_DN) { const int kb = r / 32, n0 = 32 * (r % 32); tr_item(in[13] + (size_t)l * DFF * D, D, 64 * kb, n0, (bf16*)(wl + W_DN), DFF, n0, 1.0f, scr, lane); return; }
    r -= TI_DN;
    { const int g = r >> 1, n0 = 32 * (r & 1); tr_item(in[7] + (size_t)l * 16384 + g * 4096, 64, 0, n0, (bf16*)(wl + W_PT) + g * 4096, 64, n0, 1.0f, scr, lane); }
}
__device__ __forceinline__ void ada_item(Frame& F, const float* const* in, unsigned char* ws, int item) {
    LAS float* cact = (LAS float*)(F.lds);
    LAS float* red = (LAS float*)(F.lds + 16384);
    const int l = item / 96, cb = item % 96;
    const float* c = in[1];
    for (int i = F.tid; i < BATCH * D; i += NWAVES * 64) { const int b = i >> 10, k = i & 1023; const float v = c[i]; cact[k * 4 + b] = v / (1.0f + __expf(-v)); }
    __syncthreads();
    const float* W = in[4] + (size_t)l * D * (NMOD * D) + 64 * cb + F.lane;
    float a0 = 0.f, a1 = 0.f, a2 = 0.f, a3 = 0.f;
    const int kbeg = 128 * F.wave;
#pragma unroll 16
    for (int kk = 0; kk < 128; ++kk) { const float wv = W[(size_t)(kbeg + kk) * (NMOD * D)]; const f32x4 ca = *(const LAS f32x4*)(cact + (kbeg + kk) * 4);
        a0 += ca.x * wv; a1 += ca.y * wv; a2 += ca.z * wv; a3 += ca.w * wv; }
    red[(F.wave * 4 + 0) * 64 + F.lane] = a0; red[(F.wave * 4 + 1) * 64 + F.lane] = a1; red[(F.wave * 4 + 2) * 64 + F.lane] = a2; red[(F.wave * 4 + 3) * 64 + F.lane] = a3;
    __syncthreads();
    if (F.wave < 4) { float s = in[5][(size_t)l * NMOD * D + 64 * cb + F.lane];
#pragma unroll
        for (int w = 0; w < 8; ++w) s += red[(w * 4 + F.wave) * 64 + F.lane];
        ((float*)(ws + WS_MOD))[((size_t)l * BATCH + F.wave) * (NMOD * D) + 64 * cb + F.lane] = s; }
    __syncthreads();
}
__device__ __forceinline__ void p_prologue(Frame& F, const float* const* in, unsigned char* ws) {
    for (int item = blockIdx.x; item < DEPTH * 96; item += F.G) ada_item(F, in, ws, item);
    LAS float* scr = (LAS float*)(F.lds + RING_OFF + F.wave * 16384);
    const int gw = blockIdx.x * NWAVES + F.wave, NGW = F.G * NWAVES;
    for (int it = gw; it < DEPTH * TI_LAYER; it += NGW) weight_item(in, ws, it, scr, F.lane);
}

__device__ __forceinline__ void p_norm_mod(Frame& F, const float* xin, bf16* hout, const float* gvec, const float* modl, int sh_off, int sc_off) {
    const int NGW = F.G * NWAVES, gw = blockIdx.x * NWAVES + F.wave, rpw = M / NGW;
    const int row0 = gw * rpw, b = row0 / SEQ;
    const float* mb = modl + (size_t)b * (NMOD * D);
    f32x4 Gv[4], Sv[4];
#pragma unroll
    for (int j = 0; j < 4; ++j) { const int cidx = 4 * F.lane + 256 * j; const f32x4 g = *(const f32x4*)(gvec + cidx), sc = *(const f32x4*)(mb + sc_off + cidx); Gv[j] = g * (sc + 1.0f); Sv[j] = *(const f32x4*)(mb + sh_off + cidx); }
    for (int rr = 0; rr < rpw; ++rr) {
        const size_t row = (size_t)(row0 + rr);
        const GAS f32x4* xr = (const GAS f32x4*)(xin + row * D) + F.lane;
        f32x4 v[4]; float s = 0.f;
#pragma unroll
        for (int j = 0; j < 4; ++j) { v[j] = xr[64 * j]; s += (v[j].x * v[j].x + v[j].y * v[j].y) + (v[j].z * v[j].z + v[j].w * v[j].w); }
        const float rstd = 1.0f / sqrtf(wave_sum(s) * (1.0f / D) + RMS_EPS);
        GAS unsigned long long* o8 = (GAS unsigned long long*)(hout + row * D) + F.lane;
#pragma unroll
        for (int j = 0; j < 4; ++j) { const f32x4 o = v[j] * rstd * Gv[j] + Sv[j]; o8[64 * j] = (unsigned long long)pk2(o.x, o.y) | ((unsigned long long)pk2(o.z, o.w) << 32); }
    }
}
__device__ __forceinline__ void p_norm_final(Frame& F, const float* xin, float* out, const float* gvec) {
    const int NGW = F.G * NWAVES, gw = blockIdx.x * NWAVES + F.wave, rpw = M / NGW;
    const int row0 = gw * rpw;
    f32x4 Gv[4];
#pragma unroll
    for (int j = 0; j < 4; ++j) Gv[j] = *(const f32x4*)(gvec + 4 * F.lane + 256 * j);
    for (int rr = 0; rr < rpw; ++rr) {
        const size_t row = (size_t)(row0 + rr);
        const GAS f32x4* xr = (const GAS f32x4*)(xin + row * D) + F.lane;
        f32x4 v[4]; float s = 0.f;
#pragma unroll
        for (int j = 0; j < 4; ++j) { v[j] = xr[64 * j]; s += (v[j].x * v[j].x + v[j].y * v[j].y) + (v[j].z * v[j].z + v[j].w * v[j].w); }
        const float rstd = 1.0f / sqrtf(wave_sum(s) * (1.0f / D) + RMS_EPS);
        GAS f32x4* o = (GAS f32x4*)(out + row * D) + F.lane;
#pragma unroll
        for (int j = 0; j < 4; ++j) o[64 * j] = v[j] * rstd * Gv[j];
    }
}

namespace mx {
typedef short bf16x8 __attribute__((ext_vector_type(8)));
typedef short s16x4 __attribute__((ext_vector_type(4)));
typedef float f32x16 __attribute__((ext_vector_type(16)));
typedef unsigned u32x4 __attribute__((ext_vector_type(4)));
typedef unsigned u32x2 __attribute__((ext_vector_type(2)));
typedef float f32x2_t __attribute__((ext_vector_type(2))); typedef __bf16 bf16x2_t __attribute__((ext_vector_type(2)));
__device__ __forceinline__ unsigned cvtpk(float lo, float hi) { f32x2_t v = {lo, hi}; bf16x2_t b = __builtin_convertvector(v, bf16x2_t); return __builtin_bit_cast(unsigned, b); }
__device__ __forceinline__ float hswap_max(float v) { auto rr = __builtin_amdgcn_permlane32_swap(__float_as_uint(v), __float_as_uint(v), false, false); return fmaxf(__uint_as_float(rr[0]), __uint_as_float(rr[1])); }
__device__ __forceinline__ float hswap_sum(float v) { auto rr = __builtin_amdgcn_permlane32_swap(__float_as_uint(v), __float_as_uint(v), false, false); return __uint_as_float(rr[0]) + __uint_as_float(rr[1]); }
__device__ __forceinline__ s16x4 vtr(const LAS char* p) { return __builtin_bit_cast(s16x4, __builtin_amdgcn_ds_read_tr16_b64_v4i16((LAS s16x4*)p)); }

__device__ __forceinline__ void score_tile(f32x16& t, const bf16x8 (&kf)[4], const bf16x8 (&qf)[4], float rel, float slope2, float Rf) {
    f32x16 s = {0.f, 0.f, 0.f, 0.f, 0.f, 0.f, 0.f, 0.f, 0.f, 0.f, 0.f, 0.f, 0.f, 0.f, 0.f, 0.f};
#pragma unroll
    for (int i = 0; i < 4; ++i) s = __builtin_amdgcn_mfma_f32_32x32x16_bf16(kf[i], qf[i], s, 0, 0, 0);
#pragma unroll
    for (int r = 0; r < 16; ++r) { const float ad = __builtin_fabsf(rel - (float)((r & 3) + 8 * (r >> 2))); const float v = __builtin_fmaf(-ad, slope2, s[r]); t[r] = ad > Rf ? -INFINITY : v; }
}
__device__ __forceinline__ float tile_max(const f32x16& t) {
    float a = fmaxf(fmaxf(t[0], t[1]), fmaxf(t[2], t[3])), b = fmaxf(fmaxf(t[4], t[5]), fmaxf(t[6], t[7])), c = fmaxf(fmaxf(t[8], t[9]), fmaxf(t[10], t[11])), d = fmaxf(fmaxf(t[12], t[13]), fmaxf(t[14], t[15]));
    return hswap_max(fmaxf(fmaxf(a, b), fmaxf(c, d)));
}
__device__ __forceinline__ void load_frag4(bf16x8 (&f)[4], const bf16* rowp, int hi) {
#pragma unroll
    for (int i = 0; i < 4; ++i) f[i] = *(const bf16x8*)(rowp + 16 * i + 8 * hi);
}
__device__ __forceinline__ void stage_v(LAS char* vb, const bf16* vrow0, long rs, int lane) {
#pragma unroll
    for (int i = 0; i < 4; ++i) { const int key = 8 * i + (lane >> 3), c = lane & 7;
        const u32x4 v = *(const u32x4*)(vrow0 + (long)key * rs + 8 * c);
        *(LAS u32x4*)(vb + (c >> 2) * 2048 + (key >> 4) * 1024 + (key & 15) * 64 + (c & 3) * 16) = v; }
}
__device__ __forceinline__ void load_vfrags(bf16x8 (&vf)[2][2], const LAS char* vaddr) {
#pragma unroll
    for (int d0 = 0; d0 < 2; ++d0)
#pragma unroll
        for (int ks = 0; ks < 2; ++ks) { const s16x4 lo = vtr(vaddr + d0 * 2048 + ks * 1024), hh = vtr(vaddr + d0 * 2048 + ks * 1024 + 512);
            vf[d0][ks] = (bf16x8){lo[0], lo[1], lo[2], lo[3], hh[0], hh[1], hh[2], hh[3]}; }
}
__device__ __forceinline__ void pv_tile(f32x16 (&o)[2], const bf16x8 (&vf)[2][2], const f32x16& p) {
    u32x4 w0, w1;
    w0.x = cvtpk(p[0], p[1]); w0.y = cvtpk(p[2], p[3]); w0.z = cvtpk(p[4], p[5]); w0.w = cvtpk(p[6], p[7]);
    w1.x = cvtpk(p[8], p[9]); w1.y = cvtpk(p[10], p[11]); w1.z = cvtpk(p[12], p[13]); w1.w = cvtpk(p[14], p[15]);
    const bf16x8 pa0 = __builtin_bit_cast(bf16x8, w0), pa1 = __builtin_bit_cast(bf16x8, w1);
#pragma unroll
    for (int d0 = 0; d0 < 2; ++d0) { o[d0] = __builtin_amdgcn_mfma_f32_32x32x16_bf16(vf[d0][0], pa0, o[d0], 0, 0, 0); o[d0] = __builtin_amdgcn_mfma_f32_32x32x16_bf16(vf[d0][1], pa1, o[d0], 0, 0, 0); }
}
__device__ __forceinline__ void store_o(bf16* orow, const f32x16 (&o)[2], float scale, int hi) {
#pragma unroll
    for (int d0 = 0; d0 < 2; ++d0)
#pragma unroll
        for (int g = 0; g < 4; ++g) { u32x2 w; w.x = cvtpk(o[d0][4 * g] * scale, o[d0][4 * g + 1] * scale); w.y = cvtpk(o[d0][4 * g + 2] * scale, o[d0][4 * g + 3] * scale);
            *(u32x2*)(orow + 32 * d0 + 8 * g + 4 * hi) = w; }
}
__device__ __forceinline__ float alibi_slope(int k  ) { return __builtin_amdgcn_exp2f(-8.0f * (float)(k + 1) / 12.0f); }

__device__ __forceinline__ float b_pass1(const bf16* zb, long rs, int N, int n0, int qcol, int kcol, float slope2, int lane) {
    const int q = lane & 31, hi = lane >> 5;
    bf16x8 qf[4]; load_frag4(qf, zb + (long)(n0 + q) * rs + qcol, hi);
    float m = -1e30f, l = 0.f;
    for (int kt = -2; kt <= 2; ++kt) { const int k0 = n0 + 32 * kt; if (k0 < 0 || k0 >= N) continue;
        bf16x8 kf[4]; load_frag4(kf, zb + (long)(k0 + q) * rs + kcol, hi);
        f32x16 t; score_tile(t, kf, qf, (float)(q - 32 * kt - 4 * hi), slope2, 64.0f);
        const float mn = fmaxf(m, tile_max(t)); float ps = 0.f;
#pragma unroll
        for (int r = 0; r < 16; ++r) ps += __builtin_amdgcn_exp2f(t[r] - mn);
        l = l * __builtin_amdgcn_exp2f(m - mn) + ps; m = mn; }
    return m + __builtin_amdgcn_logf(hswap_sum(l));
}
__device__ __forceinline__ void b_pass2(f32x16 (&o)[2], const bf16* zb, long rs, int N, int n0, int qcol, int kcol, int vcol, float slope2, float L, LAS char* vb, int lane) {
    const int q = lane & 31, hi = lane >> 5;
    bf16x8 qf[4]; load_frag4(qf, zb + (long)(n0 + q) * rs + qcol, hi);
    const LAS char* vaddr = vb + (4 * hi + ((lane & 15) >> 2)) * 64 + ((lane >> 4) & 1) * 32 + (lane & 3) * 8;
    for (int kt = -2; kt <= 2; ++kt) { const int k0 = n0 + 32 * kt; if (k0 < 0 || k0 >= N) continue;
        bf16x8 kf[4]; load_frag4(kf, zb + (long)(k0 + q) * rs + kcol, hi);
        stage_v(vb, zb + (long)k0 * rs + vcol, rs, lane);
        f32x16 t; score_tile(t, kf, qf, (float)(q - 32 * kt - 4 * hi), slope2, 64.0f);
#pragma unroll
        for (int r = 0; r < 16; ++r) t[r] = __builtin_amdgcn_exp2f(t[r] - L);
        bf16x8 vf[2][2]; load_vfrags(vf, vaddr);
        pv_tile(o, vf, t); }
}
__device__ __forceinline__ void b_unit(const bf16* Z, bf16* MIX, int u, LAS char* lds, int wave, int lane) {
    const int b = u >> 5, c = (u >> 1) & 15, j = u & 1;
    LAS float* lseb = (LAS float*)(lds + 131072 + 1024);
    LAS char* vb = lds + wave * 16384;
    const int q = lane & 31, hi = lane >> 5;
#pragma unroll 1
    for (int pass = 0; pass < 2; ++pass) {
#pragma unroll 1
        for (int it = 0; it < 6; ++it) {
            const int qi = wave + 8 * it, g = qi >> 4, i = qi & 15, lg = 2 * g, d = 1 << lg;
            const int r = i >> (4 - lg), isub = i & ((16 >> lg) - 1), n0 = ((512 * c) >> lg) + 32 * isub, N = SEQ >> lg;
            const int head = 2 * g + j; const float slope2 = alibi_slope(6 + head) * (float)d * LOG2E;
            const bf16* zb = Z + ((size_t)b * SEQ + r) * INW; const long rs = (long)d * INW;
            const int tl = (32 * isub + q) * d + r;
            if (pass == 0) { const float lse = b_pass1(zb, rs, N, n0, O_QB + 64 * head, O_KB + 64 * head, slope2, lane); if (hi == 0) lseb[g * 512 + tl] = lse; }
            else { const float l0 = lseb[tl], l1 = lseb[512 + tl], l2 = lseb[1024 + tl]; const float mm = fmaxf(l0, fmaxf(l1, l2));
                const float L = mm + __builtin_amdgcn_logf(__builtin_amdgcn_exp2f(l0 - mm) + __builtin_amdgcn_exp2f(l1 - mm) + __builtin_amdgcn_exp2f(l2 - mm));
                f32x16 o[2]; o[0] = (f32x16){0.f, 0.f, 0.f, 0.f, 0.f, 0.f, 0.f, 0.f, 0.f, 0.f, 0.f, 0.f, 0.f, 0.f, 0.f, 0.f}; o[1] = o[0];
                b_pass2(o, zb, rs, N, n0, O_QB + 64 * head, O_KB + 64 * head, O_VB + 64 * head, slope2, L, vb, lane);
                store_o(MIX + ((size_t)b * SEQ + (size_t)(n0 + q) * d + r) * D + 256 + 64 * head, o, 1.0f, hi); }
        }
        __syncthreads();
    }
}
__device__ __forceinline__ void c_item(const bf16* Z, bf16* MIX, const float* sink, int item, LAS char* vb, int lane) {
    const int b = item >> 9, kvh = (item >> 8) & 1, n0 = 32 * (item & 255);
    const int q = lane & 31, hi = lane >> 5;
    const bf16* zb = Z + (size_t)b * SEQ * INW; const long rs = INW;
    f32x16 o[3][2]; float m[3], l[3], slope2[3];
    LAS char* qlds = vb + 4096 + lane * 16;
#pragma unroll
    for (int hh = 0; hh < 3; ++hh) { const int head = 3 * kvh + hh; bf16x8 qf[4]; load_frag4(qf, zb + (long)(n0 + q) * rs + O_QC + 64 * head, hi);
#pragma unroll
        for (int i = 0; i < 4; ++i) *(LAS bf16x8*)(qlds + (4 * hh + i) * 1024) = qf[i];
        o[hh][0] = (f32x16){0.f, 0.f, 0.f, 0.f, 0.f, 0.f, 0.f, 0.f, 0.f, 0.f, 0.f, 0.f, 0.f, 0.f, 0.f, 0.f}; o[hh][1] = o[hh][0];
        m[hh] = sink[head] * LOG2E; l[hh] = hi ? 0.f : 1.0f; slope2[hh] = alibi_slope(head) * LOG2E; }
    const LAS char* vaddr = vb + (4 * hi + ((lane & 15) >> 2)) * 64 + ((lane >> 4) & 1) * 32 + (lane & 3) * 8;
#pragma unroll 1
    for (int kt = -4; kt <= 4; ++kt) { const int k0 = n0 + 32 * kt; if (k0 < 0 || k0 >= SEQ) continue;
        bf16x8 kf[4]; load_frag4(kf, zb + (long)(k0 + q) * rs + O_KC + 64 * kvh, hi);
        stage_v(vb, zb + (long)k0 * rs + O_VC + 64 * kvh, rs, lane);
        bf16x8 vf[2][2]; load_vfrags(vf, vaddr);
        const float rel = (float)(q - 32 * kt - 4 * hi);
#pragma unroll
        for (int hh = 0; hh < 3; ++hh) {
            bf16x8 qf[4];
#pragma unroll
            for (int i = 0; i < 4; ++i) qf[i] = *(const LAS bf16x8*)(qlds + (4 * hh + i) * 1024);
            f32x16 t; score_tile(t, kf, qf, rel, slope2[hh], 128.0f);
            const float mn = fmaxf(m[hh], tile_max(t)), f = __builtin_amdgcn_exp2f(m[hh] - mn); float ps = 0.f;
#pragma unroll
            for (int r = 0; r < 16; ++r) { t[r] = __builtin_amdgcn_exp2f(t[r] - mn); ps += t[r]; }
            l[hh] = l[hh] * f + ps; m[hh] = mn;
#pragma unroll
            for (int r = 0; r < 16; ++r) { o[hh][0][r] *= f; o[hh][1][r] *= f; }
            pv_tile(o[hh], vf, t); }
    }
#pragma unroll
    for (int hh = 0; hh < 3; ++hh) { const float inv = 1.0f / hswap_sum(l[hh]);
        store_o(MIX + ((size_t)b * SEQ + n0 + q) * D + 640 + 64 * (3 * kvh + hh), o[hh], inv, hi); }
}
__device__ __forceinline__ void pool_item(const bf16* Z, bf16* MIX, const bf16* wpt, const float* pscale, int item, int lane) {
    const int row0 = 16 * item, b = row0 / SEQ, t0 = row0 % SEQ;
    const int tok = t0 + (lane & 15), kq = lane >> 4;
    const bf16* zb = Z + (size_t)b * SEQ * INW;
#pragma unroll 1
    for (int g = 0; g < 4; ++g) { const int r = 1 << g;
        int lo = tok - r, hi2 = tok + r + 1; lo = lo < 0 ? 0 : lo; hi2 = hi2 > SEQ ? SEQ : hi2; const float inv = 1.0f / (float)(hi2 - lo);
        f32x4 acc[4];
#pragma unroll
        for (int dt = 0; dt < 4; ++dt) acc[dt] = (f32x4){0.f, 0.f, 0.f, 0.f};
#pragma unroll 1
        for (int kb = 0; kb < 2; ++kb) { const int ch0 = g * 64 + kb * 32 + 8 * kq;
            float s[8];
#pragma unroll
            for (int e = 0; e < 8; ++e) s[e] = 0.f;
#pragma unroll 1
            for (int base = -r; base <= r; base += 4) {
                bf16x8 v[4]; float w[4];
#pragma unroll
                for (int i = 0; i < 4; ++i) { const int dt2 = base + i, tt = tok + dt2; const bool ok = dt2 <= r && tt >= 0 && tt < SEQ; const int tc = ok ? tt : tok;
                    v[i] = *(const bf16x8*)(zb + (size_t)tc * INW + ch0); w[i] = ok ? 1.0f : 0.0f; }
#pragma unroll
                for (int i = 0; i < 4; ++i)
#pragma unroll
                    for (int e = 0; e < 8; ++e) s[e] += w[i] * bf2f((unsigned short)v[i][e]); }
            const bf16x8 uc = *(const bf16x8*)(zb + (size_t)tok * INW + ch0);
            u32x4 pw; float pe[8];
#pragma unroll
            for (int e = 0; e < 8; ++e) pe[e] = s[e] * inv - bf2f((unsigned short)uc[e]);
            pw.x = cvtpk(pe[0], pe[1]); pw.y = cvtpk(pe[2], pe[3]); pw.z = cvtpk(pe[4], pe[5]); pw.w = cvtpk(pe[6], pe[7]);
            const bf16x8 bfrag = __builtin_bit_cast(bf16x8, pw);
#pragma unroll
            for (int dt = 0; dt < 4; ++dt) { const bf16x8 afrag = *(const bf16x8*)(wpt + (size_t)(g * 64 + dt * 16 + (lane & 15)) * 64 + kb * 32 + 8 * kq);
                acc[dt] = __builtin_amdgcn_mfma_f32_16x16x32_bf16(afrag, bfrag, acc[dt], 0, 0, 0); } }
#pragma unroll
        for (int dt = 0; dt < 4; ++dt) { const int dcol = g * 64 + dt * 16 + 4 * kq; const f32x4 sc = *(const f32x4*)(pscale + dcol);
            u32x2 w; w.x = cvtpk(acc[dt][0] * sc.x, acc[dt][1] * sc.y); w.y = cvtpk(acc[dt][2] * sc.z, acc[dt][3] * sc.w);
            *(u32x2*)(MIX + (size_t)(row0 + (lane & 15)) * D + dcol) = w; }
    }
}
constexpr int N_C_ITEMS = BATCH * 2 * (SEQ / 32), N_P_ITEMS = M / 16;
}

__device__ __forceinline__ void p_mixers(Frame& F, const float* const* in, unsigned char* ws, int l) {
    const bf16* Z = (const bf16*)(ws + WS_Z); bf16* MIX = (bf16*)(ws + WS_MIX);
    LAS char* lds = (LAS char*)F.lds;
    if (blockIdx.x < 128) { const int u = (blockIdx.x & 7) * 16 + (blockIdx.x >> 3); mx::b_unit(Z, MIX, u, lds, F.wave, F.lane); }
    gu32* qctr = F.ctl + CW_QUEUE + 64 * l;
    const bf16* wpt = (const bf16*)(ws + WS_W + (size_t)l * W_LAYER + W_PT);
    const float* sink = in[9] + 6 * l; const float* pscale = in[8] + 256 * l;
    for (;;) {
        unsigned it = 0; if (F.lane == 0) it = __hip_atomic_fetch_add(qctr, 1u, RLX_AGENT);
        it = (unsigned)__builtin_amdgcn_readfirstlane(it);
        if (it >= (unsigned)(mx::N_C_ITEMS + mx::N_P_ITEMS)) break;
        if (it < (unsigned)mx::N_C_ITEMS) mx::c_item(Z, MIX, sink, (int)it, lds + F.wave * 16384, F.lane);
        else mx::pool_item(Z, MIX, wpt, pscale, (int)it - mx::N_C_ITEMS, F.lane);
    }
}

struct Args { const float* in[15]; float* out; unsigned char* ws; int ph_lo, ph_hi, li, pad; };
__global__ void __launch_bounds__(NWAVES * 64, 2) mk_fwd(Args args) {
    extern __shared__ __attribute__((aligned(16))) unsigned char lds[];
    Frame F;
    F.lds = (LAS unsigned char*)lds;
    F.MISC = (volatile LAS unsigned*)(F.lds + MISC_OFF);
    F.tid = threadIdx.x; F.lane = F.tid & 63; F.wave = __builtin_amdgcn_readfirstlane(F.tid >> 6);
    F.G = gridDim.x; { const int bx = blockIdx.x; F.vcu = (F.G % 8 == 0) ? (bx % 8) * (F.G / 8) + bx / 8 : bx; }
    unsigned char* ws = args.ws;
    F.ctl = (gu32*)(ws + WS_CTL);
    for (int u = F.tid; u < (LDS_BYTES - LDSCTL_OFF) / 4; u += NWAVES * 64) ((LAS unsigned*)(F.lds + LDSCTL_OFF))[u] = 0u;
    __syncthreads();
    XcdBarrier bar; bar.bar = (unsigned*)(F.ctl + CW_BAR); bar.x = 0; bar.st = nullptr;
    const int lo = args.ph_lo, hi = args.ph_hi;
    if (hi - lo > 1) bar = xcd_barrier_post((unsigned*)(F.ctl + CW_BAR), F.MISC + 8);
    const float* const* in = args.in;
    float* XS = (float*)(ws + WS_XS);
    bf16* H = (bf16*)(ws + WS_H);
    const float* MOD = (const float*)(ws + WS_MOD);

#pragma unroll 1
    for (int ph = lo; ph < hi; ++ph) {
        { int t_ = threadIdx.x; asm volatile("" : "+v"(t_)); F.tid = t_; F.lane = t_ & 63; F.wave = __builtin_amdgcn_readfirstlane(t_ >> 6); }
        if (ph == PH_PRO) p_prologue(F, in, ws);
        else if (ph == PH_FINAL) p_norm_final(F, XS, args.out, in[14]);
        else {
            const int l = (ph - 1) / PH_PER_LAYER, k = (ph - 1) % PH_PER_LAYER;
            unsigned char* wl = ws + WS_W + (size_t)l * W_LAYER;
            const float* modl = MOD + (size_t)l * BATCH * NMOD * D;
            if (k == 0) p_norm_mod(F, l == 0 ? in[0] : XS, H, in[2] + l * D, modl, 0 * D, 1 * D);
            else if (k == 1) { pg8::Gemm g{H, (const bf16*)(wl + W_IN), M, INW, D}; pg8::StaticOrder S; S.init(M, INW, F.G, (int)blockIdx.x);
                pg8::EpiBf16 E{(bf16*)(ws + WS_Z), INW};
                pg8::gemm_phase<pg8::EpiBf16, pg8::StaticOrder, true, true>(F.lds + RING_OFF, g, S, E); }
            else if (k == 2) p_mixers(F, in, ws, l);
            else if (k == 3 || k == 6) { const bool dn = (k == 6);
                pg8::Gemm g{(const bf16*)(ws + (dn ? WS_HID : WS_MIX)), (const bf16*)(wl + (dn ? W_DN : W_OUT)), M, D, dn ? DFF : D}; pg8::StaticOrder S; S.init(M, D, F.G, (int)blockIdx.x);
                pg8::EpiGateRes E{(!dn && l == 0) ? in[0] : XS, XS, modl + (dn ? 5 : 2) * D, D, NMOD * D};
                pg8::gemm_phase<pg8::EpiGateRes, pg8::StaticOrder, true, true>(F.lds + RING_OFF, g, S, E); }
            else if (k == 4) p_norm_mod(F, XS, H, in[3] + l * D, modl, 3 * D, 4 * D);
            else if (k == 5) { pg8::Gemm g{H, (const bf16*)(wl + W_GU), M, 2 * DFF, D}; pg8::StaticOrder S; S.init(M, 2 * DFF, F.G, (int)blockIdx.x);
                pg8::EpiSwiGLU E{(bf16*)(ws + WS_HID), DFF};
                pg8::gemm_phase<pg8::EpiSwiGLU, pg8::StaticOrder, true, true>(F.lds + RING_OFF, g, S, E); }
        }
        if (ph + 1 < hi) xcd_barrier(bar);
    }
}

extern "C" void kernel_launch(void* const* d_in, const int* in_sizes, int n_in, void* d_out, int out_size, void* d_ws, size_t ws_size, hipStream_t stream) {
    static int grid = 0;
    if (grid == 0) {
        if (n_in != 15 || in_sizes[0] != M * D || out_size != M * D || ws_size < WS_END) { fprintf(stderr, "kernel_launch: unexpected shapes (n_in %d, in0 %d, out %d, ws %zu); nothing launched\n", n_in, n_in > 0 ? in_sizes[0] : -1, out_size, ws_size); grid = -1; return; }
        int dev = 0, cus = 0, per_cu = 0;
        if (hipGetDevice(&dev) != hipSuccess || hipDeviceGetAttribute(&cus, hipDeviceAttributeMultiprocessorCount, dev) != hipSuccess) { grid = -1; return; }
        if (hipFuncSetAttribute((const void*)mk_fwd, hipFuncAttributeMaxDynamicSharedMemorySize, LDS_BYTES) != hipSuccess) { fprintf(stderr, "kernel_launch: hipFuncSetAttribute failed\n"); grid = -1; return; }
        if (hipOccupancyMaxActiveBlocksPerMultiprocessor(&per_cu, (const void*)mk_fwd, NWAVES * 64, LDS_BYTES) != hipSuccess || per_cu < 1) fprintf(stderr, "kernel_launch: occupancy query reports %d blocks per CU\n", per_cu);
        (void)hipGetLastError();
        grid = cus;
        if (grid != 256) fprintf(stderr, "kernel_launch: %d CUs; this kernel is laid out for 256\n", grid);
    }
    if (grid < 0) return;
    if (hipMemsetAsync((char*)d_ws + WS_CTL, 0, CTL_ZERO_BYTES, stream) != hipSuccess) return;
    Args a{};
    for (int i = 0; i < 15; ++i) a.in[i] = (const float*)d_in[i];
    a.out = (float*)d_out; a.ws = (unsigned char*)d_ws;
#if MK_ONE_LAUNCH
    a.ph_lo = 0; a.ph_hi = NPHASES; a.li = 0;
    hipLaunchKernelGGL(mk_fwd, dim3(grid), dim3(NWAVES * 64), LDS_BYTES, stream, a);
#else
    for (int ph = 0; ph < NPHASES; ++ph) { a.ph_lo = ph; a.ph_hi = ph + 1; a.li = ph; hipLaunchKernelGGL(mk_fwd, dim3(grid), dim3(NWAVES * 64), LDS_BYTES, stream, a); }
#endif
}
```

```cpp
#include <hip/hip_runtime.h>
#include <cstdio>
#include <cstdint>
namespace pg8 {
#define PG8_LAS __attribute__((address_space(3)))
typedef unsigned short bf16_t;
typedef short bf16x8 __attribute__((ext_vector_type(8)));
typedef float f32x4 __attribute__((ext_vector_type(4)));
typedef unsigned u32x4 __attribute__((ext_vector_type(4)));
constexpr int BM = 256, BK = 64, HALF = 128, HTB = HALF * BK * 2  , STAGE_BYTES = 8 * HTB, NXCD = 8, WGM = 8;

__host__ __device__ __forceinline__ int lds_byte(int r, int c) { const int st = (r >> 4) * 2 + (c >> 5), rr = r & 15, cc = c & 31, ob = rr * 64 + cc * 2; return st * 1024 + (ob ^ (((ob >> 9) & 1) << 5)); }
__host__ __device__ __forceinline__ void stage_rc(int b, int& R, int& C) { const int st = b / 1024, sb = b % 1024, swz = sb ^ (((sb >> 9) & 1) << 5); R = (st >> 1) * 16 + swz / 64; C = (st & 1) * 32 + (swz % 64) / 2; }
__host__ __device__ __forceinline__ int perm32(int rho) { const int n = rho >> 4, i = rho & 15; return 8 * (i >> 2) + 4 * n + (i & 3); }

__host__ __device__ __forceinline__ int perm32inv(int x) { return 16 * ((x >> 2) & 1) + 4 * (x >> 3) + (x & 3); }
__host__ __device__ __forceinline__ size_t img_off(int row, int col, int nt, bool wrow) { const int r = row & 127, rr = wrow ? (r & ~31) + perm32inv(r & 31) : r; return ((size_t)((row >> 7) * nt + (col >> 6)) << 14) + (size_t)lds_byte(rr, col & 63); }
constexpr bool IMG_A = true, IMG_B = true;
struct Unit { int pm, pn; };
struct Gemm { const bf16_t* A; const bf16_t* Bt; int M, N, K; };

struct StaticOrder {
    int nM, nN, nwg, G, c;
    __host__ __device__ void init(int M, int N, int G_, int c_) { nM = M / BM; nN = N / BM; nwg = nM * nN; G = G_; c = c_; }
    __host__ __device__ bool next(int i, Unit& u) const {
        const long L = (long)i * G + c; if (L >= nwg) return false;
        int wgid = (int)L; { const int q = nwg / NXCD, r = nwg % NXCD, xcd = wgid % NXCD, off = wgid / NXCD; wgid = (xcd < r ? xcd * (q + 1) : r * (q + 1) + (xcd - r) * q) + off; }
        const int nig = WGM * nN, gid = wgid / nig, fm = gid * WGM, gsz = (nM - fm) < WGM ? (nM - fm) : WGM;
        u.pm = fm + ((wgid % nig) % gsz); u.pn = (wgid % nig) / gsz; return true;
    }
    __device__ __forceinline__ void a_ready(const Unit&) const {}
    __device__ __forceinline__ void done(const Unit&) const {}
};

__device__ __forceinline__ unsigned cvt_pk_bf16(float lo, float hi) { unsigned r; asm volatile("v_cvt_pk_bf16_f32 %0, %1, %2" : "=v"(r) : "v"(lo), "v"(hi)); return r; }
constexpr float RMS_EPS_ = 1e-6f, INV_D_ = 1.0f / 1024.0f;
__device__ __forceinline__ void aux_dma(const float* src_lane, PG8_LAS unsigned char* dst_wave) { __builtin_amdgcn_global_load_lds((const unsigned*)src_lane, (PG8_LAS unsigned*)dst_wave, 4, 0, 0); }
typedef _Float16 h16x2 __attribute__((ext_vector_type(2)));
__device__ __forceinline__ unsigned pk_h2(float lo, float hi) { const h16x2 h = {(_Float16)lo, (_Float16)hi}; return __builtin_bit_cast(unsigned, h); }
__device__ __forceinline__ float h_lo(unsigned w) { return (float)__builtin_bit_cast(h16x2, w)[0]; }
__device__ __forceinline__ float h_hi(unsigned w) { return (float)__builtin_bit_cast(h16x2, w)[1]; }
struct EpiBf16Norm {
    static constexpr bool PERM = true, AFTER_DRAIN = false;
    bf16_t* O; int ldc; const float* sumsq; const float* bias; int bias_stride; unsigned char* zb; unsigned char* zc;
    __device__ __forceinline__ void prefetch(const Unit& u, PG8_LAS unsigned char* aux, int wid, int lane) const {
        if (wid < 4) aux_dma(sumsq + u.pm * BM + wid * 64 + lane, aux + wid * 256);
        else aux_dma(bias + (size_t)(u.pm >> 5) * bias_stride + u.pn * BM + (wid - 4) * 64 + lane, aux + 1024 + (wid - 4) * 256);
    }
    __device__ __forceinline__ void operator()(const f32x4 (&acc)[2][2][4][2], const Unit& u, int wr, int wc, int fr_, int fq_, PG8_LAS unsigned char* aux) const {
        unsigned z_; asm volatile("v_mov_b32 %0, 0" : "=v"(z_)); const int ln_ = (int)__builtin_amdgcn_mbcnt_hi(~0u, __builtin_amdgcn_mbcnt_lo(~0u, z_)); const int fr = ln_ & 15, fq = ln_ >> 4;
        const int row0 = u.pm * BM + wr * 64 + fr, col0 = u.pn * BM + wc * 32 + 8 * fq;
        const PG8_LAS float* ass = (const PG8_LAS float*)aux + wr * 64 + fr; const PG8_LAS float* ab = (const PG8_LAS float*)(aux + 1024) + wc * 32 + 8 * fq;
        f32x4 bv[2][2];
#pragma unroll
        for (int bj = 0; bj < 2; ++bj)
#pragma unroll
            for (int n = 0; n < 2; ++n) bv[bj][n] = *(const PG8_LAS f32x4*)(ab + bj * HALF + 4 * n);
#pragma unroll
        for (int ai = 0; ai < 2; ++ai)
#pragma unroll
            for (int m = 0; m < 4; ++m) { const int row = row0 + ai * HALF + m * 16; const float rs = __builtin_amdgcn_rsqf(ass[ai * HALF + m * 16] * INV_D_ + RMS_EPS_);
#pragma unroll
                for (int bj = 0; bj < 2; ++bj) { const f32x4 v0 = acc[ai][bj][m][0] * rs + bv[bj][0], v1 = acc[ai][bj][m][1] * rs + bv[bj][1];
                    u32x4 w; w.x = cvt_pk_bf16(v0[0], v0[1]); w.y = cvt_pk_bf16(v0[2], v0[3]); w.z = cvt_pk_bf16(v1[0], v1[1]); w.w = cvt_pk_bf16(v1[2], v1[3]);
                    const int cb = 2 * u.pn + bj;
                    if (zb != nullptr && cb >= 2 && cb <= 10) { const int t3 = (cb - 2) / 3, g = (cb - 2) % 3, lg = 2 * g, hd = 2 * g + (wc >> 1), c = (wc & 1) * 4 + fq;
                        const int t = row & 8191, b = row >> 13, r = t & ((1 << lg) - 1), n = t >> lg, ti = (r << (8 - lg)) + (n >> 5), key = n & 31;
                        const int off = t3 < 2 ? (c >> 1) * 1024 + (key + 32 * (c & 1)) * 16 : (c >> 2) * 2048 + (key >> 4) * 1024 + (key & 15) * 64 + (c & 3) * 16;
                        *(u32x4*)(zb + ((size_t)(((t3 * 6 + hd) * 4 + b) * 256 + ti) << 12) + off) = w; }
                    else if (zb != nullptr && cb >= 11) {
                        const int hx = cb <= 13 ? 2 * (cb - 11) + (wc >> 1) : (cb == 14 ? 6 : 8) + (wc >> 1), c = (wc & 1) * 4 + fq, t = row & 8191, b = row >> 13, key = t & 31;
                        const int off = cb < 15 ? (c >> 1) * 1024 + (key + 32 * (c & 1)) * 16 : (c >> 2) * 2048 + (key >> 4) * 1024 + (key & 15) * 64 + (c & 3) * 16;
                        *(u32x4*)(zc + ((size_t)((hx * 4 + b) * 256 + (t >> 5)) << 12) + off) = w; }
                    else *(u32x4*)(O + (size_t)row * ldc + col0 + bj * HALF) = w; } }
    }
};
struct EpiSwiGLUNorm {
    static constexpr bool PERM = true, AFTER_DRAIN = false;
    bf16_t* O; int ldc; const float* sumsq; const float* bias; int bias_stride;
    static __device__ __forceinline__ float silu_mul(float g, float u) { return g * u * __builtin_amdgcn_rcpf(1.0f + __builtin_amdgcn_exp2f(-1.4426950408889634f * g)); }
    __device__ __forceinline__ void prefetch(const Unit& u, PG8_LAS unsigned char* aux, int wid, int lane) const {
        if (wid < 4) aux_dma(sumsq + u.pm * BM + wid * 64 + lane, aux + wid * 256);
        else aux_dma(bias + (size_t)(u.pm >> 5) * bias_stride + u.pn * BM + (wid - 4) * 64 + lane, aux + 1024 + (wid - 4) * 256);
    }
    __device__ __forceinline__ void operator()(const f32x4 (&acc)[2][2][4][2], const Unit& u, int wr, int wc, int fr_, int fq_, PG8_LAS unsigned char* aux) const {
        unsigned z_; asm volatile("v_mov_b32 %0, 0" : "=v"(z_)); const int ln_ = (int)__builtin_amdgcn_mbcnt_hi(~0u, __builtin_amdgcn_mbcnt_lo(~0u, z_)); const int fr = ln_ & 15, fq = ln_ >> 4;
        const int row0 = u.pm * BM + wr * 64 + fr, col0 = u.pn * HALF + wc * 32 + 8 * fq;
        const PG8_LAS float* ass = (const PG8_LAS float*)aux + wr * 64 + fr; const PG8_LAS float* ab = (const PG8_LAS float*)(aux + 1024) + wc * 32 + 8 * fq;
        const f32x4 bg0 = *(const PG8_LAS f32x4*)(ab), bg1 = *(const PG8_LAS f32x4*)(ab + 4), bu0 = *(const PG8_LAS f32x4*)(ab + HALF), bu1 = *(const PG8_LAS f32x4*)(ab + HALF + 4);
#pragma unroll
        for (int ai = 0; ai < 2; ++ai)
#pragma unroll
            for (int m = 0; m < 4; ++m) { const int row = row0 + ai * HALF + m * 16; const float rs = __builtin_amdgcn_rsqf(ass[ai * HALF + m * 16] * INV_D_ + RMS_EPS_);
                unsigned char* rowp = (unsigned char*)O + img_off(row, col0, ldc / 64, false);
                const f32x4 g0 = acc[ai][0][m][0] * rs + bg0, g1 = acc[ai][0][m][1] * rs + bg1, u0 = acc[ai][1][m][0] * rs + bu0, u1 = acc[ai][1][m][1] * rs + bu1;
                f32x4 e0 = g0 * -1.4426950408889634f, e1 = g1 * -1.4426950408889634f;
#pragma unroll
                for (int i = 0; i < 4; ++i) { e0[i] = __builtin_amdgcn_exp2f(e0[i]); e1[i] = __builtin_amdgcn_exp2f(e1[i]); }
                e0 = e0 + 1.0f; e1 = e1 + 1.0f;
#pragma unroll
                for (int i = 0; i < 4; ++i) { e0[i] = __builtin_amdgcn_rcpf(e0[i]); e1[i] = __builtin_amdgcn_rcpf(e1[i]); }
                const f32x4 h0 = (g0 * u0) * e0, h1 = (g1 * u1) * e1;
                u32x4 w; w.x = cvt_pk_bf16(h0[0], h0[1]); w.y = cvt_pk_bf16(h0[2], h0[3]); w.z = cvt_pk_bf16(h1[0], h1[1]); w.w = cvt_pk_bf16(h1[2], h1[3]);
                *(u32x4*)rowp = w; }
    }
};
template <bool F32BASE>
struct EpiGateResNormT {
    static constexpr bool PERM = true, AFTER_DRAIN = false;
    const bf16_t* base; bf16_t* out; const float* gate; int gate_stride; bf16_t* Hn; const float* gn; int gn_stride; float* sumsq; int ldc;
    __device__ __forceinline__ void prefetch(const Unit& u, PG8_LAS unsigned char* aux, int wid, int lane) const {
        if (wid < 4) aux_dma(gate + (size_t)(u.pm >> 5) * gate_stride + u.pn * BM + wid * 64 + lane, aux + wid * 256);
        else aux_dma(gn + (size_t)(u.pm >> 5) * gn_stride + u.pn * BM + (wid - 4) * 64 + lane, aux + 1024 + (wid - 4) * 256);
    }
    __device__ __forceinline__ void operator()(const f32x4 (&acc)[2][2][4][2], const Unit& u, int wr, int wc, int fr_, int fq_, PG8_LAS unsigned char* aux) const {
        unsigned z_; asm volatile("v_mov_b32 %0, 0" : "=v"(z_)); const int ln_ = (int)__builtin_amdgcn_mbcnt_hi(~0u, __builtin_amdgcn_mbcnt_lo(~0u, z_)); const int fr = ln_ & 15, fq = ln_ >> 4;
        const int row0 = u.pm * BM + wr * 64 + fr, col0 = u.pn * BM + wc * 32 + 8 * fq;
        const PG8_LAS float* ag = (const PG8_LAS float*)aux + wc * 32 + 8 * fq; const PG8_LAS float* an = (const PG8_LAS float*)(aux + 1024) + wc * 32 + 8 * fq;
#pragma unroll
        for (int am = 0; am < 4; ++am) {
            u32x4 ld[2][2]; f32x4 lf[2][2][2];
#pragma unroll
            for (int mm = 0; mm < 2; ++mm)
#pragma unroll
                for (int bj = 0; bj < 2; ++bj) {
                    if constexpr (F32BASE) { const f32x4* px = (const f32x4*)((const float*)base + (size_t)(row0 + (am >> 1) * HALF + (2 * (am & 1) + mm) * 16) * ldc + col0 + bj * HALF); lf[mm][bj][0] = px[0]; lf[mm][bj][1] = px[1]; }
                    else ld[mm][bj] = *(const u32x4*)((const unsigned char*)base + img_off(row0 + (am >> 1) * HALF + (2 * (am & 1) + mm) * 16, col0 + bj * HALF, ldc / 64, false)); }
#pragma unroll
            for (int mm = 0; mm < 2; ++mm) { const int ai = am >> 1, m = 2 * (am & 1) + mm; const int row = row0 + ai * HALF + m * 16; const size_t off = (size_t)row * ldc + col0; float ss = 0.f;
#pragma unroll
                for (int bj = 0; bj < 2; ++bj) {
                    const f32x4 g0 = *(const PG8_LAS f32x4*)(ag + bj * HALF), g1 = *(const PG8_LAS f32x4*)(ag + bj * HALF + 4);
                    f32x4 b0, b1;
                    if constexpr (F32BASE) { b0 = lf[mm][bj][0]; b1 = lf[mm][bj][1]; }
                    else { const u32x4 bw = ld[mm][bj]; b0 = (f32x4){h_lo(bw.x), h_hi(bw.x), h_lo(bw.y), h_hi(bw.y)}; b1 = (f32x4){h_lo(bw.z), h_hi(bw.z), h_lo(bw.w), h_hi(bw.w)}; }
                    const f32x4 x0 = b0 + g0 * acc[ai][bj][m][0], x1 = b1 + g1 * acc[ai][bj][m][1];
                    u32x4 w; w.x = pk_h2(x0[0], x0[1]); w.y = pk_h2(x0[2], x0[3]); w.z = pk_h2(x1[0], x1[1]); w.w = pk_h2(x1[2], x1[3]);
                    *(u32x4*)((unsigned char*)out + img_off(row, col0 + bj * HALF, ldc / 64, false)) = w;
                    ss += (x0[0] * x0[0] + x0[1] * x0[1]) + (x0[2] * x0[2] + x0[3] * x0[3]) + (x1[0] * x1[0] + x1[1] * x1[1]) + (x1[2] * x1[2] + x1[3] * x1[3]);
                    if (Hn) { const f32x4 n0 = *(const PG8_LAS f32x4*)(an + bj * HALF), n1 = *(const PG8_LAS f32x4*)(an + bj * HALF + 4); const f32x4 h0 = x0 * n0, h1 = x1 * n1;
                        u32x4 hw; hw.x = cvt_pk_bf16(h0[0], h0[1]); hw.y = cvt_pk_bf16(h0[2], h0[3]); hw.z = cvt_pk_bf16(h1[0], h1[1]); hw.w = cvt_pk_bf16(h1[2], h1[3]);
                        *(u32x4*)((unsigned char*)Hn + img_off(row, col0 + bj * HALF, ldc / 64, false)) = hw; } }
                ss += __shfl_xor(ss, 16); ss += __shfl_xor(ss, 32);
                if (fq == 0) atomicAdd(sumsq + row, ss); }
            asm volatile("" ::: "memory"); }
    }
};
typedef EpiGateResNormT<false> EpiGateResNorm;

template <class Epi, class Sched, bool ALIGN_EPI = false, bool SP2 = false>
__device__ __forceinline__ void gemm_phase(PG8_LAS unsigned char* lds, const Gemm g, const Sched& S, const Epi& E, int tid_in) {
    int tid_ = tid_in; asm volatile("" : "+v"(tid_));
    const int tid = tid_, wid = __builtin_amdgcn_readfirstlane(tid >> 6), lane = tid & 63, wr = wid >> 2, wc = wid & 3, fr = lane & 15, fq = lane >> 4;
    const int K = g.K, nt = K / BK;
    unsigned voffA[2], voffB[2];
#pragma unroll
    for (int i = 0; i < 2; ++i) { int R, C; stage_rc(tid * 16 + i * 8192, R, C); const int Rb = Epi::PERM ? ((R & ~31) + perm32(R & 31)) : R;
        voffA[i] = IMG_A ? (unsigned)(tid * 16 + i * 8192) : (unsigned)(R * K + C) * 2u; voffB[i] = IMG_B ? (unsigned)(tid * 16 + i * 8192) : (unsigned)(Rb * K + C) * 2u; }
    const size_t kstepA = IMG_A ? (size_t)(HALF * BK * 2) : (size_t)(BK * 2), kstepB = IMG_B ? (size_t)(HALF * BK * 2) : (size_t)(BK * 2);
    const size_t hstep = (size_t)HALF * K * 2;
    const size_t tstep = 2 * hstep;
    const unsigned ldsw = (unsigned)wid * 1024u;
    const int aoff = lds_byte(wr * 64 + fr, fq * 8), boff = lds_byte(wc * 32 + fr, fq * 8);
#define PG8_SA(b, h) (((b) * 2 + (h)) * HTB)
#define PG8_SB(b, h) ((4 + (b) * 2 + (h)) * HTB)
#define PG8_STAGE(bufoff, gbase, voff) do { _Pragma("unroll") for (int _i = 0; _i < 2; ++_i) \
        __builtin_amdgcn_global_load_lds((const unsigned*)((const char*)(gbase) + (voff)[_i]), (PG8_LAS unsigned*)(lds + (bufoff) + ldsw + _i * 8192), 16, 0, 0); } while (0)
#define PG8_LDA(dst, b, h) do { _Pragma("unroll") for (int m = 0; m < 4; ++m) _Pragma("unroll") for (int k = 0; k < 2; ++k) dst[m][k] = *(const PG8_LAS bf16x8*)(lds + PG8_SA(b, h) + aoff + m * 2048 + k * 1024); } while (0)
#define PG8_LDB(dst, b, h) do { _Pragma("unroll") for (int n = 0; n < 2; ++n) _Pragma("unroll") for (int k = 0; k < 2; ++k) dst[n][k] = *(const PG8_LAS bf16x8*)(lds + PG8_SB(b, h) + boff + n * 2048 + k * 1024); } while (0)
#define PG8_MMA(ai, bj, At, Bt) do { __builtin_amdgcn_s_setprio(1); _Pragma("unroll") for (int m = 0; m < 4; ++m) _Pragma("unroll") for (int n = 0; n < 2; ++n) _Pragma("unroll") for (int k = 0; k < 2; ++k) \
        acc[ai][bj][m][n] = __builtin_amdgcn_mfma_f32_16x16x32_bf16(Bt[n][k], At[m][k], acc[ai][bj][m][n], 0, 0, 0); __builtin_amdgcn_s_setprio(0); } while (0)
#define PG8_WAIT_V(n) asm volatile("s_waitcnt vmcnt(" #n ")" ::: "memory")
#define PG8_WAIT_L(n) asm volatile("s_waitcnt lgkmcnt(" #n ")" ::: "memory")
#define PG8_BAR __builtin_amdgcn_s_barrier()
#define PG8_SCHED __builtin_amdgcn_sched_barrier(0)
    Unit cur, nxt; int ui = 0;
    if (!S.next(0, cur)) return;
    f32x4 acc[2][2][4][2];
#pragma unroll
    for (int a = 0; a < 2; ++a)
#pragma unroll
        for (int b = 0; b < 2; ++b)
#pragma unroll
            for (int m = 0; m < 4; ++m)
#pragma unroll
                for (int n = 0; n < 2; ++n) { float z_; asm volatile("v_mov_b32 %0, 0" : "=v"(z_)); acc[a][b][m][n] = (f32x4){z_, z_, z_, z_}; }
    bf16x8 At[4][2], B0[2][2], B1[2][2];
    const char* cA = (const char*)g.A + (size_t)cur.pm * tstep; const char* cB = (const char*)g.Bt + (size_t)cur.pn * tstep;
    S.a_ready(cur);
    if constexpr (SP2) {
        PG8_STAGE(PG8_SB(0, 0), cB, voffB); PG8_STAGE(PG8_SB(0, 1), cB + hstep, voffB); PG8_STAGE(PG8_SA(0, 0), cA, voffA); PG8_STAGE(PG8_SA(0, 1), cA + hstep, voffA);
        if (wr == 1) PG8_BAR;
        PG8_WAIT_V(2); PG8_BAR;
        PG8_STAGE(PG8_SB(1, 0), cB + kstepB, voffB); PG8_STAGE(PG8_SA(1, 0), cA + kstepA, voffA); PG8_STAGE(PG8_SB(1, 1), cB + hstep + kstepB, voffB);
        PG8_WAIT_V(6); PG8_BAR;
    } else {
        PG8_STAGE(PG8_SB(0, 0), cB, voffB); PG8_STAGE(PG8_SA(0, 0), cA, voffA); PG8_STAGE(PG8_SB(0, 1), cB + hstep, voffB); PG8_STAGE(PG8_SA(0, 1), cA + hstep, voffA);
        if (wr == 1) PG8_BAR;
        PG8_WAIT_V(4); PG8_BAR;
        PG8_STAGE(PG8_SB(1, 0), cB + kstepB, voffB); PG8_STAGE(PG8_SA(1, 0), cA + kstepA, voffA); PG8_STAGE(PG8_SB(1, 1), cB + hstep + kstepB, voffB);
        PG8_WAIT_V(6); PG8_BAR;
    }
    for (;;) {
        const bool has_next = S.next(ui + 1, nxt);
        const char* nA = has_next ? (const char*)g.A + (size_t)nxt.pm * tstep : cA; const char* nB = has_next ? (const char*)g.Bt + (size_t)nxt.pn * tstep : cB;
        for (int t = 0; t < nt; t += 2) {
            const bool last = (t == nt - 2);
            const char* a1 = cA + (size_t)(t + 1) * kstepA;
            const char* a2 = last ? nA : cA + (size_t)(t + 2) * kstepA; const char* b2 = last ? nB : cB + (size_t)(t + 2) * kstepB;
            const char* a3 = a2 + kstepA; const char* b3 = b2 + kstepB;
            if (last && has_next) S.a_ready(nxt);
            if (last) E.prefetch(cur, lds + STAGE_BYTES + 1024, wid, lane);
            if constexpr (SP2) {
            PG8_LDB(B0, 0, 0); PG8_LDB(B1, 0, 1); PG8_SCHED; PG8_LDA(At, 0, 0); PG8_STAGE(PG8_SA(1, 1), a1 + hstep, voffA);
            PG8_WAIT_V(8); PG8_WAIT_L(0); PG8_BAR; PG8_MMA(0, 0, At, B0); PG8_MMA(0, 1, At, B1); PG8_BAR; PG8_SCHED;
            PG8_LDA(At, 0, 1); PG8_STAGE(PG8_SB(0, 0), b2, voffB); PG8_STAGE(PG8_SB(0, 1), b2 + hstep, voffB); PG8_STAGE(PG8_SA(0, 0), a2, voffA);
            PG8_WAIT_V(8); PG8_WAIT_L(0); PG8_BAR; PG8_MMA(1, 0, At, B0); PG8_MMA(1, 1, At, B1); PG8_BAR; PG8_SCHED;
            PG8_LDB(B0, 1, 0); PG8_LDB(B1, 1, 1); PG8_SCHED; PG8_LDA(At, 1, 0); PG8_STAGE(PG8_SA(0, 1), a2 + hstep, voffA);
            PG8_WAIT_V(8); PG8_WAIT_L(0); PG8_BAR; PG8_MMA(0, 0, At, B0); PG8_MMA(0, 1, At, B1); PG8_BAR; PG8_SCHED;
            PG8_LDA(At, 1, 1); PG8_STAGE(PG8_SB(1, 0), b3, voffB); PG8_STAGE(PG8_SB(1, 1), b3 + hstep, voffB); PG8_STAGE(PG8_SA(1, 0), a3, voffA);
            PG8_WAIT_V(8); PG8_WAIT_L(0); PG8_BAR; PG8_MMA(1, 0, At, B0); PG8_MMA(1, 1, At, B1); PG8_BAR; PG8_SCHED;
            } else {
            PG8_LDB(B0, 0, 0); PG8_SCHED; PG8_LDA(At, 0, 0); PG8_STAGE(PG8_SA(1, 1), a1 + hstep, voffA);
            PG8_WAIT_L(8); PG8_BAR; PG8_WAIT_L(0); PG8_MMA(0, 0, At, B0); PG8_BAR; PG8_SCHED;
            PG8_LDB(B1, 0, 1); PG8_STAGE(PG8_SB(0, 0), b2, voffB);
            PG8_BAR; PG8_WAIT_L(0); PG8_MMA(0, 1, At, B1); PG8_BAR;
            PG8_LDA(At, 0, 1); PG8_STAGE(PG8_SA(0, 0), a2, voffA);
            PG8_BAR; PG8_WAIT_L(0); PG8_MMA(1, 0, At, B0); PG8_BAR; PG8_SCHED;
            PG8_STAGE(PG8_SB(0, 1), b2 + hstep, voffB);
            PG8_WAIT_V(6); PG8_BAR; PG8_MMA(1, 1, At, B1); PG8_BAR;
            PG8_LDB(B0, 1, 0); PG8_SCHED; PG8_LDA(At, 1, 0); PG8_STAGE(PG8_SA(0, 1), a2 + hstep, voffA);
            PG8_WAIT_L(8); PG8_BAR; PG8_WAIT_L(0); PG8_MMA(0, 0, At, B0); PG8_BAR; PG8_SCHED;
            PG8_LDB(B1, 1, 1); PG8_STAGE(PG8_SB(1, 0), b3, voffB);
            PG8_BAR; PG8_WAIT_L(0); PG8_MMA(0, 1, At, B1); PG8_BAR;
            PG8_LDA(At, 1, 1); PG8_STAGE(PG8_SA(1, 0), a3, voffA);
            PG8_BAR; PG8_WAIT_L(0); PG8_MMA(1, 0, At, B0); PG8_BAR; PG8_SCHED;
            PG8_STAGE(PG8_SB(1, 1), b3 + hstep, voffB);
            PG8_WAIT_V(6); PG8_BAR; PG8_MMA(1, 1, At, B1); PG8_BAR;
            }
        }
        if constexpr (ALIGN_EPI) { if (wr == 0) PG8_BAR; }
        if constexpr (!Epi::AFTER_DRAIN) { E(acc, cur, wr, wc, fr, fq, lds + STAGE_BYTES + 1024); S.done(cur); }
        if (!has_next) break;
#pragma unroll
        for (int a = 0; a < 2; ++a)
#pragma unroll
            for (int b = 0; b < 2; ++b)
#pragma unroll
                for (int m = 0; m < 4; ++m)
#pragma unroll
                    for (int n = 0; n < 2; ++n) { float z_; asm volatile("v_mov_b32 %0, 0" : "=v"(z_)); acc[a][b][m][n] = (f32x4){z_, z_, z_, z_}; }
        cur = nxt; cA = nA; cB = nB; ++ui;
        if constexpr (ALIGN_EPI) { if (wr == 1) PG8_BAR; }
    }
    PG8_WAIT_V(0);
    if constexpr (!ALIGN_EPI) { if (wr == 0) PG8_BAR; }
    PG8_BAR;
    if constexpr (Epi::AFTER_DRAIN) { E.fused(acc, cur, wr, wc, fr, fq, lds, wid, lane); S.done(cur); }
#undef PG8_SA
#undef PG8_SB
#undef PG8_STAGE
#undef PG8_LDA
#undef PG8_LDB
#undef PG8_MMA
#undef PG8_WAIT_V
#undef PG8_WAIT_L
#undef PG8_BAR
#undef PG8_SCHED
}
}
#define GAS __attribute__((address_space(1)))
#define LAS __attribute__((address_space(3)))
typedef unsigned short bf16;
typedef unsigned v4u __attribute__((ext_vector_type(4)));
typedef float f32x4 __attribute__((ext_vector_type(4)));
typedef short bf16x8 __attribute__((ext_vector_type(8)));
typedef GAS unsigned gu32;
typedef GAS unsigned long long gu64;
#define RLX_AGENT __ATOMIC_RELAXED, __HIP_MEMORY_SCOPE_AGENT
#define LDS_WAIT() asm volatile("s_waitcnt lgkmcnt(0)" ::: "memory")
#define VM_WAIT() asm volatile("s_waitcnt vmcnt(0)" ::: "memory")
__device__ __forceinline__ unsigned long long rt() { return __builtin_amdgcn_s_memrealtime(); }
__device__ __forceinline__ unsigned f2bf(float f) { unsigned u = __builtin_bit_cast(unsigned, f); return (u + 0x7fffu + ((u >> 16) & 1u)) >> 16; }
__device__ __forceinline__ unsigned pk2(float lo, float hi) { return f2bf(lo) | (f2bf(hi) << 16); }

#define XB_TMO      128
#define XB_XCNT(j)  (256  + 64 * (j))
#define XB_XSUB(j)  (1280 + 64 * (j))
#define XB_XGEN(j)  (2304 + 64 * (j))
#define XB_TOP      3328
#define XB_TOPGEN   3392
#define XCD_BAR_WORDS 3456
#define XB_SPIN_CAP (1u << 18)

__device__ __forceinline__ unsigned xb_ld(unsigned* p)              { return __hip_atomic_load(p, __ATOMIC_RELAXED, __HIP_MEMORY_SCOPE_AGENT); }
__device__ __forceinline__ unsigned xb_add(unsigned* p, unsigned v) { return __hip_atomic_fetch_add(p, v, __ATOMIC_RELAXED, __HIP_MEMORY_SCOPE_AGENT); }
__device__ __forceinline__ unsigned xb_xcc_id() { return (unsigned)__builtin_amdgcn_s_getreg((3 << 11) | 20) & 0xFu; }
#define XB_SPIN(cond, bar) do { unsigned _sp = 0; while (cond) { __builtin_amdgcn_s_sleep(1); \
    if ((++_sp & 255u) == 0u) { if (xb_ld(&(bar)[XB_TMO])) break; if (_sp > XB_SPIN_CAP) { atomicAdd(&(bar)[XB_TMO], 1u); break; } } } } while (0)

struct XcdBarrier {
    unsigned* bar; unsigned x;
    volatile LAS unsigned* st;
};

__device__ __forceinline__ XcdBarrier xcd_barrier_post(unsigned* bar, volatile LAS unsigned* st) {
    XcdBarrier b; b.bar = bar; b.x = xb_xcc_id(); b.st = st;
    if (threadIdx.x == 0) (void)xb_add(&bar[XB_XCNT(b.x)], 1u);
    return b;
}
__device__ __forceinline__ void xcd_barrier_complete(unsigned* bar, unsigned x, unsigned& nloc, unsigned& nx) {
    const unsigned G = gridDim.x * gridDim.y * gridDim.z;
    unsigned sum, cnt, mine, sp = 0u;
    for (;;) {
        sum = 0u; cnt = 0u; mine = 0u;
#pragma unroll
        for (unsigned j = 0; j < 16; ++j) { const unsigned c = xb_ld(&bar[XB_XCNT(j)]); sum += c; cnt += (c > 0u) ? 1u : 0u; mine = (j == x) ? c : mine; }
        if (sum == G) break;
        __builtin_amdgcn_s_sleep(1);
        if ((++sp & 255u) == 0u) { if (xb_ld(&bar[XB_TMO])) break; if (sp > XB_SPIN_CAP) { atomicAdd(&bar[XB_TMO], 1u); break; } }
    }
    nloc = mine > 0u ? mine : 1u; nx = cnt > 0u ? cnt : 1u;
}

__device__ __forceinline__ void xcd_barrier(const XcdBarrier& b) {
    asm volatile("s_waitcnt vmcnt(0)" ::: "memory");
    __syncthreads();
    if (threadIdx.x == 0) {
        unsigned* bar = b.bar;
        __builtin_amdgcn_s_waitcnt(0);
        unsigned nloc = b.st[0], nx = b.st[1];
        if (nloc == 0u) { xcd_barrier_complete(bar, b.x, nloc, nx); b.st[0] = nloc; b.st[1] = nx; }
        const unsigned old = xb_add(&bar[XB_XSUB(b.x)], 1u);
        const unsigned gen = old / nloc;
        if (old + 1u == (gen + 1u) * nloc) {
            __builtin_amdgcn_fence(__ATOMIC_RELEASE, "agent");
            asm volatile("s_waitcnt vmcnt(0)" ::: "memory");
            const unsigned og = xb_add(&bar[XB_TOP], 1u);
            const unsigned tg = og / nx;
            if (og + 1u == (tg + 1u) * nx) xb_add(&bar[XB_TOPGEN], 1u);
            else XB_SPIN(xb_ld(&bar[XB_TOPGEN]) == tg, bar);
            __builtin_amdgcn_fence(__ATOMIC_ACQUIRE, "agent");
            xb_add(&bar[XB_XGEN(b.x)], 1u);
            asm volatile("s_waitcnt vmcnt(0)" ::: "memory");
        } else {
            XB_SPIN(xb_ld(&bar[XB_XGEN(b.x)]) == gen, bar);
            __builtin_amdgcn_fence(__ATOMIC_ACQUIRE, "agent");
            asm volatile("s_waitcnt vmcnt(0)" ::: "memory");
        }
    }
    __syncthreads();
}

constexpr int NWAVES = 8;
constexpr int BATCH = 4, SEQ = 8192, D = 1024, M = BATCH * SEQ, DEPTH = 2;
constexpr int INW = 2048, DFF = 2816, NMOD = 6;
constexpr int O_U = 0, O_QB = 256, O_KB = 640, O_VB = 1024, O_QC = 1408, O_KC = 1792, O_VC = 1920;
constexpr float RMS_EPS = 1e-6f;
constexpr float LOG2E = 1.4426950408889634f;
constexpr float QSCALE = 0.125f * LOG2E;

constexpr size_t MiB = 1u << 20;
constexpr size_t WS_CTL = 0, CTL_ZERO_BYTES = 131072;
constexpr size_t WS_MOD = 1 * MiB;
constexpr size_t WS_W = 2 * MiB, W_LAYER = 24 * MiB;
constexpr size_t W_IN = 0, W_OUT = 4 * MiB, W_GU = 6 * MiB, W_DN = 17 * MiB, W_PT = 23 * MiB;
constexpr size_t WS_H = 50 * MiB;
constexpr size_t WS_Z = 114 * MiB;
constexpr size_t WS_MIX = 242 * MiB;
constexpr size_t WS_HID = 114 * MiB;
constexpr size_t WS_XS = 306 * MiB;
constexpr size_t WS_AUX = 434 * MiB;
constexpr size_t WS_SUMSQ = WS_AUX;
constexpr size_t WS_GV = WS_AUX + 1 * MiB;
constexpr size_t WS_BIAS = WS_GV + 65536;
constexpr size_t BIAS_LAYER = (size_t)BATCH * (2048 + 5632) * 4;
constexpr size_t WS_BSCR = 370 * MiB;
constexpr size_t WS_ZC = 202 * MiB;
constexpr size_t WS_ZB = 130 * MiB;
constexpr size_t WS_END = 436 * MiB;
static_assert(WS_Z + (size_t)M * 256 * 2 <= WS_ZB && WS_ZB + 72 * MiB <= WS_ZC && WS_ZC + 40 * MiB <= WS_MIX, "z region map");
static_assert(WS_HID + (size_t)M * DFF * 2 <= WS_XS && WS_MIX + (size_t)M * D * 2 <= WS_XS && WS_Z + (size_t)M * 256 * 2 <= WS_MIX && WS_H + (size_t)M * D * 2 <= WS_Z, "ws map");
constexpr int CW_TMO = 0, CW_CODE = 1, CW_BAR = 4096  , CW_QUEUE = 20480, CW_ZEROS = 24576  ;

constexpr int RING_OFF = 0, RING_BYTES = 131072;
constexpr int LDSCTL_OFF = RING_BYTES, MISC_OFF = 147456 - 256, LSEB_OFF = MISC_OFF - 6144;
constexpr int LDS_BYTES = 147456;

constexpr int PH_PRO = 0, PH_CONV = 1, PH_L0 = 2, PH_PER_LAYER = 5, PH_FINAL = PH_L0 + DEPTH * PH_PER_LAYER, NPHASES = PH_FINAL + 1;
#ifndef PROBE_DUP
#define PROBE_DUP 0
#endif
#ifndef PROBE_CUT
#define PROBE_CUT 0
#endif
#ifndef PROBE_MIXSEL
#define PROBE_MIXSEL 0
#endif
#ifndef PROBE_NOSTORE
#define PROBE_NOSTORE 0
#endif
#ifndef MK_ONE_LAUNCH
#define MK_ONE_LAUNCH 1
#endif

struct Frame {
    LAS unsigned char* lds;
    volatile LAS unsigned* MISC;
    gu32* ctl;
    int tid, lane, wave, G, vcu;
};

__device__ __forceinline__ float wave_sum(float v) {
#pragma unroll
    for (int o = 1; o < 64; o <<= 1) v += __shfl_xor(v, o);
    return v;
}
__device__ __forceinline__ float bf2f(unsigned short b) { return __uint_as_float((unsigned)b << 16); }
__device__ __forceinline__ float zero_() { float z; asm volatile("v_mov_b32 %0, 0" : "=v"(z)); return z; }
__device__ __forceinline__ f32x4 zero4_() { const float z = zero_(); return (f32x4){z, z, z, z}; }

__device__ __forceinline__ void tr_item(const float* W, int N, int k0, int n0, bf16* WT, int ldt, int drow0, float scale, LAS float* scr, int lane, bool img = true) {
#pragma unroll 8
    for (int i = 0; i < 32; ++i) { const int kk = 2 * i + (lane >> 5); scr[kk * 33 + (lane & 31)] = __builtin_nontemporal_load(W + (size_t)(k0 + kk) * N + n0 + (lane & 31)); }
    LDS_WAIT(); asm volatile("" ::: "memory");
    const int c = lane & 7;
#pragma unroll
    for (int j = 0; j < 4; ++j) { const int n = (lane >> 3) + 8 * j; const LAS float* s = scr + (8 * c) * 33 + n;
        v4u o; o.x = pk2(s[0 * 33] * scale, s[1 * 33] * scale); o.y = pk2(s[2 * 33] * scale, s[3 * 33] * scale); o.z = pk2(s[4 * 33] * scale, s[5 * 33] * scale); o.w = pk2(s[6 * 33] * scale, s[7 * 33] * scale);
        if (img) *(GAS v4u*)((unsigned char*)WT + pg8::img_off(drow0 + n, k0 + 8 * c, ldt / 64, true)) = o;
        else *(GAS v4u*)(WT + (size_t)(drow0 + n) * ldt + k0 + 8 * c) = o; }
    LDS_WAIT(); asm volatile("" ::: "memory");
}
constexpr int TI_IN = 16 * 64, TI_OUT = 16 * 32, TI_G = 16 * 88, TI_DN = 44 * 32, TI_P = 8, TI_LAYER = TI_IN + TI_OUT + 2 * TI_G + TI_DN + TI_P;
__device__ __forceinline__ void weight_item(const float* const* in, unsigned char* ws, int it, LAS float* scr, int lane) {
    const int l = it / TI_LAYER; int r = it % TI_LAYER;
    unsigned char* wl = ws + WS_W + (size_t)l * W_LAYER;
    if (r < TI_IN) { const int kb = r / 64, n0 = 32 * (r % 64); const bool isq = (n0 >= O_QB && n0 < O_KB) || (n0 >= O_QC && n0 < O_KC);
        tr_item(in[6] + (size_t)l * D * INW, INW, 64 * kb, n0, (bf16*)(wl + W_IN), D, n0, isq ? QSCALE : 1.0f, scr, lane); return; }
    r -= TI_IN;
    if (r < TI_OUT) { const int kb = r / 32, n0 = 32 * (r % 32); tr_item(in[10] + (size_t)l * D * D, D, 64 * kb, n0, (bf16*)(wl + W_OUT), D, n0, 1.0f, scr, lane); return; }
    r -= TI_OUT;
    if (r < 2 * TI_G) { const int up = r >= TI_G; if (up) r -= TI_G; const int kb = r / 88, n0 = 32 * (r % 88);
        tr_item(in[up ? 12 : 11] + (size_t)l * D * DFF, DFF, 64 * kb, n0, (bf16*)(wl + W_GU), D, 256 * (n0 >> 7) + 128 * up + (n0 & 127), 1.0f, scr, lane); return; }
    r -= 2 * TI_G;
    if (r < TI_DN) { const int kb = r / 32, n0 = 32 * (r % 32); tr_item(in[13] + (size_t)l * DFF * D, D, 64 * kb, n0, (bf16*)(wl + W_DN), DFF, n0, 1.0f, scr, lane); return; }
    r -= TI_DN;
    { const int g = r >> 1, n0 = 32 * (r & 1); tr_item(in[7] + (size_t)l * 16384 + g * 4096, 64, 0, n0, (bf16*)(wl + W_PT) + g * 4096, 64, n0, 1.0f, scr, lane, false); }
}
__device__ __forceinline__ void ada_item(Frame& F, const float* const* in, unsigned char* ws, int item) {
    LAS float* cact = (LAS float*)(F.lds);
    LAS float* red = (LAS float*)(F.lds + 16384);
    const int l = item / 96, cb = item % 96;
    const float* c = in[1];
    for (int i = F.tid; i < BATCH * D; i += NWAVES * 64) { const int b = i >> 10, k = i & 1023; const float v = c[i]; cact[k * 4 + b] = v / (1.0f + __expf(-v)); }
    __syncthreads();
    const float* W = in[4] + (size_t)l * D * (NMOD * D) + 64 * cb + F.lane;
    float a0 = 0.f, a1 = 0.f, a2 = 0.f, a3 = 0.f;
    const int kbeg = 128 * F.wave;
#pragma unroll 16
    for (int kk = 0; kk < 128; ++kk) { const float wv = __builtin_nontemporal_load(W + (size_t)(kbeg + kk) * (NMOD * D)); const f32x4 ca = *(const LAS f32x4*)(cact + (kbeg + kk) * 4);
        a0 += ca.x * wv; a1 += ca.y * wv; a2 += ca.z * wv; a3 += ca.w * wv; }
    red[(F.wave * 4 + 0) * 64 + F.lane] = a0; red[(F.wave * 4 + 1) * 64 + F.lane] = a1; red[(F.wave * 4 + 2) * 64 + F.lane] = a2; red[(F.wave * 4 + 3) * 64 + F.lane] = a3;
    __syncthreads();
    if (F.wave < 4) { float s = in[5][(size_t)l * NMOD * D + 64 * cb + F.lane];
#pragma unroll
        for (int w = 0; w < 8; ++w) s += red[(w * 4 + F.wave) * 64 + F.lane];
        ((float*)(ws + WS_MOD))[((size_t)l * BATCH + F.wave) * (NMOD * D) + 64 * cb + F.lane] = s; }
    __syncthreads();
}
__device__ __forceinline__ void p_prologue(Frame& F, const float* const* in, unsigned char* ws) {
    for (int item = blockIdx.x; item < DEPTH * 96; item += F.G) ada_item(F, in, ws, item);
    LAS float* scr = (LAS float*)(F.lds + RING_OFF + F.wave * 16384);
    const int gw = blockIdx.x * NWAVES + F.wave, NGW = F.G * NWAVES;
    for (int it = gw; it < DEPTH * TI_LAYER; it += NGW) weight_item(in, ws, it, scr, F.lane);
    { GAS f32x4* z = (GAS f32x4*)(ws + WS_SUMSQ) + M / 4; const int n4 = 4 * M / 4;
      for (int i = blockIdx.x * (NWAVES * 64) + F.tid; i < n4; i += F.G * NWAVES * 64) z[i] = zero4_(); }
}

__device__ __forceinline__ void p_conv(Frame& F, const float* const* in, unsigned char* ws) {
    const float* MOD = (const float*)(ws + WS_MOD);
    const int NGW = F.G * NWAVES, gw = blockIdx.x * NWAVES + F.wave, rpw = M / NGW;
    {
        const int row0 = gw * rpw, b = row0 / SEQ;
        const float* mb = MOD + (size_t)b * (NMOD * D);
        const float* xin = in[0]; bf16* hout = (bf16*)(ws + WS_H); float* ssq = (float*)(ws + WS_SUMSQ);
        f32x4 Gv[4];
#pragma unroll
        for (int j = 0; j < 4; ++j) { const int cidx = 8 * F.lane + 512 * (j >> 1) + 4 * (j & 1); const f32x4 g = *(const f32x4*)(in[2] + cidx), sc = *(const f32x4*)(mb + 1 * D + cidx); Gv[j] = g * (sc + 1.0f); }
        for (int rr = 0; rr < rpw; rr += 4) {
            f32x4 v[4][4];
#pragma unroll
            for (int i = 0; i < 4; ++i) { const GAS f32x4* xr = (const GAS f32x4*)(xin + (size_t)(row0 + rr + i) * D) + 2 * F.lane;
#pragma unroll
                for (int j = 0; j < 4; ++j) v[i][j] = __builtin_nontemporal_load(xr + 128 * (j >> 1) + (j & 1)); }
#pragma unroll
            for (int i = 0; i < 4; ++i) { const size_t row = (size_t)(row0 + rr + i); float s = 0.f;
#pragma unroll
                for (int j = 0; j < 4; ++j) s += (v[i][j].x * v[i][j].x + v[i][j].y * v[i][j].y) + (v[i][j].z * v[i][j].z + v[i][j].w * v[i][j].w);
                s = wave_sum(s); if (F.lane == 0) ssq[row] = s;
#pragma unroll
                for (int jj = 0; jj < 2; ++jj) { const f32x4 o0 = v[i][2 * jj] * Gv[2 * jj], o1 = v[i][2 * jj + 1] * Gv[2 * jj + 1];
                    v4u w; w.x = pk2(o0.x, o0.y); w.y = pk2(o0.z, o0.w); w.z = pk2(o1.x, o1.y); w.w = pk2(o1.z, o1.w);
                    *(GAS v4u*)((unsigned char*)hout + pg8::img_off((int)row, 8 * F.lane + 512 * jj, D / 64, false)) = w; } }
        }
    }
    {
        float* GV = (float*)(ws + WS_GV);
        for (int i = blockIdx.x * (NWAVES * 64) + F.tid; i < DEPTH * 2 * BATCH * D; i += F.G * NWAVES * 64) { const int col = i & (D - 1), b = (i >> 10) & 3, w = (i >> 12) & 1, l = i >> 13;
            GV[i] = in[w ? 3 : 2][l * D + col] * (1.0f + MOD[((size_t)l * BATCH + b) * (NMOD * D) + (w ? 4 : 1) * D + col]); }
    }
    {
        const int g0 = 8 * gw;
        if (g0 < DEPTH * (INW + 2 * DFF)) {
            const int l = g0 / (INW + 2 * DFF), rl = g0 % (INW + 2 * DFF), w = rl >= INW, n0 = w ? rl - INW : rl, N = w ? 2 * DFF : INW;
            const unsigned char* Bt = ws + WS_W + (size_t)l * W_LAYER + (w ? W_GU : W_IN);
            float* bias = (float*)(ws + WS_BIAS + (size_t)l * BIAS_LAYER) + (w ? BATCH * INW : 0);
            const float* shp = MOD + (size_t)l * BATCH * (NMOD * D) + (w ? 3 : 0) * D + 16 * F.lane;
            v4u wr[8][2];
#pragma unroll
            for (int i = 0; i < 8; ++i) { wr[i][0] = *(const GAS v4u*)(Bt + pg8::img_off(n0 + i, 16 * F.lane, D / 64, true)); wr[i][1] = *(const GAS v4u*)(Bt + pg8::img_off(n0 + i, 16 * F.lane + 8, D / 64, true)); }
            f32x4 sh[4][4];
#pragma unroll
            for (int b = 0; b < 4; ++b)
#pragma unroll
                for (int j = 0; j < 4; ++j) sh[b][j] = *(const f32x4*)(shp + (size_t)b * (NMOD * D) + 4 * j);
#pragma unroll
            for (int i = 0; i < 8; ++i) { const v4u w0 = wr[i][0], w1 = wr[i][1];
                float wf[16];
                wf[0] = __uint_as_float(w0.x << 16); wf[1] = __uint_as_float(w0.x & 0xffff0000u); wf[2] = __uint_as_float(w0.y << 16); wf[3] = __uint_as_float(w0.y & 0xffff0000u);
                wf[4] = __uint_as_float(w0.z << 16); wf[5] = __uint_as_float(w0.z & 0xffff0000u); wf[6] = __uint_as_float(w0.w << 16); wf[7] = __uint_as_float(w0.w & 0xffff0000u);
                wf[8] = __uint_as_float(w1.x << 16); wf[9] = __uint_as_float(w1.x & 0xffff0000u); wf[10] = __uint_as_float(w1.y << 16); wf[11] = __uint_as_float(w1.y & 0xffff0000u);
                wf[12] = __uint_as_float(w1.z << 16); wf[13] = __uint_as_float(w1.z & 0xffff0000u); wf[14] = __uint_as_float(w1.w << 16); wf[15] = __uint_as_float(w1.w & 0xffff0000u);
                float acc[4];
#pragma unroll
                for (int b = 0; b < 4; ++b) { float a = 0.f;
#pragma unroll
                    for (int j = 0; j < 4; ++j) a += (wf[4 * j] * sh[b][j].x + wf[4 * j + 1] * sh[b][j].y) + (wf[4 * j + 2] * sh[b][j].z + wf[4 * j + 3] * sh[b][j].w);
                    acc[b] = wave_sum(a); }
                if (F.lane < 4) bias[(size_t)F.lane * N + n0 + i] = F.lane == 0 ? acc[0] : F.lane == 1 ? acc[1] : F.lane == 2 ? acc[2] : acc[3]; }
        }
    }
}
__device__ __forceinline__ void p_norm_final(Frame& F, const bf16* xin, const float* ssq, float* out, const float* gvec) {
    const int NGW = F.G * NWAVES, gw = blockIdx.x * NWAVES + F.wave, rpw = M / NGW;
    const int row0 = gw * rpw;
    f32x4 Gv[4];
#pragma unroll
    for (int j = 0; j < 4; ++j) Gv[j] = *(const f32x4*)(gvec + 4 * F.lane + 256 * j);
    for (int rr = 0; rr < rpw; rr += 4) {
        unsigned long long w[4][4]; float ss[4];
#pragma unroll
        for (int i = 0; i < 4; ++i) { const unsigned char* xr = (const unsigned char*)xin + 8 * (F.lane & 1); ss[i] = ssq[row0 + rr + i];
#pragma unroll
            for (int j = 0; j < 4; ++j) w[i][j] = *(const GAS unsigned long long*)(xr + pg8::img_off(row0 + rr + i, (4 * F.lane + 256 * j) & ~7, D / 64, false)); }
#pragma unroll
        for (int i = 0; i < 4; ++i) { const float rstd = 1.0f / sqrtf(ss[i] * (1.0f / D) + RMS_EPS);
            GAS f32x4* o = (GAS f32x4*)(out + (size_t)(row0 + rr + i) * D) + F.lane;
#pragma unroll
            for (int j = 0; j < 4; ++j) { const unsigned wl = (unsigned)w[i][j], wh = (unsigned)(w[i][j] >> 32);
                const f32x4 v = {pg8::h_lo(wl), pg8::h_hi(wl), pg8::h_lo(wh), pg8::h_hi(wh)};
                __builtin_nontemporal_store(v * rstd * Gv[j], o + 64 * j); } }
    }
}

namespace mx {
typedef short bf16x8 __attribute__((ext_vector_type(8)));
typedef short s16x4 __attribute__((ext_vector_type(4)));
typedef float f32x16 __attribute__((ext_vector_type(16)));
typedef unsigned u32x4 __attribute__((ext_vector_type(4)));
typedef unsigned u32x2 __attribute__((ext_vector_type(2)));
typedef float f32x2_t __attribute__((ext_vector_type(2))); typedef __bf16 bf16x2_t __attribute__((ext_vector_type(2)));
constexpr float THR = 8.0f;
constexpr int POOL_PITCH = 544;
__device__ __forceinline__ unsigned cvtpk(float lo, float hi) { f32x2_t v = {lo, hi}; bf16x2_t b = __builtin_convertvector(v, bf16x2_t); return __builtin_bit_cast(unsigned, b); }
__device__ __forceinline__ float hswap_max(float v) { auto rr = __builtin_amdgcn_permlane32_swap(__float_as_uint(v), __float_as_uint(v), false, false); return fmaxf(__uint_as_float(rr[0]), __uint_as_float(rr[1])); }
__device__ __forceinline__ float hswap_sum(float v) { auto rr = __builtin_amdgcn_permlane32_swap(__float_as_uint(v), __float_as_uint(v), false, false); return __uint_as_float(rr[0]) + __uint_as_float(rr[1]); }
__device__ __forceinline__ s16x4 vtr(const LAS char* p) { return __builtin_bit_cast(s16x4, __builtin_amdgcn_ds_read_tr16_b64_v4i16((LAS s16x4*)p)); }
__device__ __forceinline__ f32x16 zero16_() { const float z = zero_(); return (f32x16){z, z, z, z, z, z, z, z, z, z, z, z, z, z, z, z}; }
__device__ __forceinline__ int kt_of(int i) { return (i & 1) ? -((i + 1) >> 1) : (i >> 1); }

template <int VAR>
__device__ __forceinline__ float scores(f32x16& t, const bf16x8 (&kf)[4], const bf16x8 (&qf)[4], float relf, float sl, float slope2, float Rf) {
    f32x16 s = {0.f, 0.f, 0.f, 0.f, 0.f, 0.f, 0.f, 0.f, 0.f, 0.f, 0.f, 0.f, 0.f, 0.f, 0.f, 0.f};
#pragma unroll
    for (int i = 0; i < 4; ++i) s = __builtin_amdgcn_mfma_f32_32x32x16_bf16(kf[i], qf[i], s, 0, 0, 0);
    if (VAR == 0) {
#pragma unroll
        for (int r = 0; r < 16; ++r) t[r] = __builtin_fmaf(-__builtin_fabsf(relf - (float)((r & 3) + 8 * (r >> 2))), slope2, s[r]);
        return 0.f;
    } else {
#pragma unroll
        for (int r = 0; r < 16; ++r) { const float c = (float)((r & 3) + 8 * (r >> 2)); float v = __builtin_fmaf(sl, c, s[r]); if (VAR == 2) v = __builtin_fabsf(relf - c) > Rf ? -INFINITY : v; t[r] = v; }
        return -sl * relf;
    }
}
__device__ __forceinline__ float lane_max(const f32x16& t) {
    float a = fmaxf(fmaxf(t[0], t[1]), fmaxf(t[2], t[3])), b = fmaxf(fmaxf(t[4], t[5]), fmaxf(t[6], t[7])), c = fmaxf(fmaxf(t[8], t[9]), fmaxf(t[10], t[11])), d = fmaxf(fmaxf(t[12], t[13]), fmaxf(t[14], t[15]));
    return fmaxf(fmaxf(a, b), fmaxf(c, d));
}
__device__ __forceinline__ float tile_max(const f32x16& t) {
    float a = fmaxf(fmaxf(t[0], t[1]), fmaxf(t[2], t[3])), b = fmaxf(fmaxf(t[4], t[5]), fmaxf(t[6], t[7])), c = fmaxf(fmaxf(t[8], t[9]), fmaxf(t[10], t[11])), d = fmaxf(fmaxf(t[12], t[13]), fmaxf(t[14], t[15]));
    return hswap_max(fmaxf(fmaxf(a, b), fmaxf(c, d)));
}
__device__ __forceinline__ void load_frag4(bf16x8 (&f)[4], const bf16* rowp, int hi) {
#pragma unroll
    for (int i = 0; i < 4; ++i) f[i] = *(const bf16x8*)(rowp + 16 * i + 8 * hi);
}
__device__ __forceinline__ void load_tile_frags(bf16x8 (&f)[4], const char* tile, int lane) {
#pragma unroll
    for (int s = 0; s < 4; ++s) f[s] = *(const bf16x8*)(tile + s * 1024 + lane * 16);
}
__device__ __forceinline__ void dma_tile(LAS char* dst, const char* tile, int lane) {
#pragma unroll
    for (int j = 0; j < 4; ++j) __builtin_amdgcn_global_load_lds((const unsigned*)(tile + j * 1024 + lane * 16), (LAS unsigned*)(dst + j * 1024), 16, 0, 0);
}
__device__ __forceinline__ void dma_v(LAS char* vb, const bf16* vrow0, long rs, int lane) {
#pragma unroll
    for (int j = 0; j < 4; ++j) __builtin_amdgcn_global_load_lds((const unsigned*)(vrow0 + (long)(16 * (j & 1) + (lane >> 2)) * rs + (4 * (j >> 1) + (lane & 3)) * 8), (LAS unsigned*)(vb + j * 1024), 16, 0, 0);
}
__device__ __forceinline__ void load_vfrags(bf16x8 (&vf)[2][2], const LAS char* vaddr) {
#pragma unroll
    for (int d0 = 0; d0 < 2; ++d0)
#pragma unroll
        for (int ks = 0; ks < 2; ++ks) { const s16x4 lo = vtr(vaddr + d0 * 2048 + ks * 1024), hh = vtr(vaddr + d0 * 2048 + ks * 1024 + 512);
            vf[d0][ks] = (bf16x8){lo[0], lo[1], lo[2], lo[3], hh[0], hh[1], hh[2], hh[3]}; }
}
__device__ __forceinline__ void pv_tile(f32x16 (&o)[2], const bf16x8 (&vf)[2][2], const f32x16& p) {
    u32x4 w0, w1;
    w0.x = cvtpk(p[0], p[1]); w0.y = cvtpk(p[2], p[3]); w0.z = cvtpk(p[4], p[5]); w0.w = cvtpk(p[6], p[7]);
    w1.x = cvtpk(p[8], p[9]); w1.y = cvtpk(p[10], p[11]); w1.z = cvtpk(p[12], p[13]); w1.w = cvtpk(p[14], p[15]);
    const bf16x8 pa0 = __builtin_bit_cast(bf16x8, w0), pa1 = __builtin_bit_cast(bf16x8, w1);
#pragma unroll
    for (int d0 = 0; d0 < 2; ++d0) { o[d0] = __builtin_amdgcn_mfma_f32_32x32x16_bf16(vf[d0][0], pa0, o[d0], 0, 0, 0); o[d0] = __builtin_amdgcn_mfma_f32_32x32x16_bf16(vf[d0][1], pa1, o[d0], 0, 0, 0); }
}
__device__ __forceinline__ void store_o(bf16* MIX, int row, int col, const f32x16 (&o)[2], float scale, int hi) {
#pragma unroll
    for (int d0 = 0; d0 < 2; ++d0)
#pragma unroll
        for (int g = 0; g < 4; g += 2) {
            const unsigned ax = cvtpk(o[d0][4 * g] * scale, o[d0][4 * g + 1] * scale), ay = cvtpk(o[d0][4 * g + 2] * scale, o[d0][4 * g + 3] * scale);
            const unsigned bx = cvtpk(o[d0][4 * g + 4] * scale, o[d0][4 * g + 5] * scale), by = cvtpk(o[d0][4 * g + 6] * scale, o[d0][4 * g + 7] * scale);
            const auto rx = __builtin_amdgcn_permlane32_swap(ax, bx, false, false); const auto ry = __builtin_amdgcn_permlane32_swap(ay, by, false, false);
            u32x4 w; w.x = rx[0]; w.y = ry[0]; w.z = rx[1]; w.w = ry[1];
            *(u32x4*)((unsigned char*)MIX + pg8::img_off(row, col + 32 * d0 + 8 * g + 8 * hi, D / 64, false)) = w; }
}
__device__ __forceinline__ void pack_o(u32x4 (&w)[4], const f32x16 (&o)[2], float scale) {
#pragma unroll
    for (int d0 = 0; d0 < 2; ++d0)
#pragma unroll
        for (int g = 0; g < 4; g += 2) {
            const unsigned ax = cvtpk(o[d0][4 * g] * scale, o[d0][4 * g + 1] * scale), ay = cvtpk(o[d0][4 * g + 2] * scale, o[d0][4 * g + 3] * scale);
            const unsigned bx = cvtpk(o[d0][4 * g + 4] * scale, o[d0][4 * g + 5] * scale), by = cvtpk(o[d0][4 * g + 6] * scale, o[d0][4 * g + 7] * scale);
            const auto rx = __builtin_amdgcn_permlane32_swap(ax, bx, false, false); const auto ry = __builtin_amdgcn_permlane32_swap(ay, by, false, false);
            w[2 * d0 + (g >> 1)] = (u32x4){rx[0], ry[0], rx[1], ry[1]}; }
}
__device__ __forceinline__ float alibi_slope(int k  ) { return __builtin_amdgcn_exp2f(-8.0f * (float)(k + 1) / 12.0f); }
__device__ __forceinline__ void scale_o(f32x16 (&o)[2], float f) {
#pragma unroll
    for (int r = 0; r < 16; ++r) { o[0][r] *= f; o[1][r] *= f; }
}

template <bool FIRST, bool WITH_O>
__device__ __forceinline__ void step_rest(f32x16 (&o)[2], float& m, float& l, f32x16& t, float off, const bf16x8 (&vf)[2][2]) {
    const float tm = hswap_max(lane_max(t) + off);
    if (FIRST) m = tm;
    else if (__any(tm - m > THR)) { const float dl = fmaxf(tm - m, 0.f), f = __builtin_amdgcn_exp2f(-dl); l *= f; if (WITH_O) scale_o(o, f); m += dl; }
    const float bm = off - m; float ps = 0.f;
#pragma unroll
    for (int r = 0; r < 16; ++r) { t[r] = __builtin_amdgcn_exp2f(t[r] + bm); ps += t[r]; }
    l += ps;
    if (WITH_O) pv_tile(o, vf, t);
}
template <int VAR, bool FIRST, bool WITH_O>
__device__ __forceinline__ void step(f32x16 (&o)[2], float& m, float& l, const bf16x8 (&kf)[4], const bf16x8 (&qf)[4], const bf16x8 (&vf)[2][2], float relf, float sl, float slope2, float Rf) {
    f32x16 t; const float off = scores<VAR>(t, kf, qf, relf, sl, slope2, Rf);
    step_rest<FIRST, WITH_O>(o, m, l, t, off, vf);
}

__device__ __forceinline__ void pair_rest(f32x16 (&o)[2], float& m, float& l, f32x16& tL, f32x16& tR, float offL, float offR, const LAS char* vL, const LAS char* vR) {
    const float tm = hswap_max(fmaxf(lane_max(tL) + offL, lane_max(tR) + offR));
    if (__any(tm - m > THR)) { const float dl = fmaxf(tm - m, 0.f), f = __builtin_amdgcn_exp2f(-dl); l *= f; scale_o(o, f); m += dl; }
    const float bL = offL - m, bR = offR - m; float psL = 0.f, psR = 0.f;
#pragma unroll
    for (int r = 0; r < 16; ++r) { tL[r] = __builtin_amdgcn_exp2f(tL[r] + bL); tR[r] = __builtin_amdgcn_exp2f(tR[r] + bR); psL += tL[r]; psR += tR[r]; }
    l += psL + psR;
    { bf16x8 vf[2][2]; load_vfrags(vf, vL); pv_tile(o, vf, tL); }
    { bf16x8 vf[2][2]; load_vfrags(vf, vR); pv_tile(o, vf, tR); }
}
template <int VAR>
__device__ __forceinline__ void step_pair_lds(f32x16 (&o)[2], float& m, float& l, const LAS char* kL, const LAS char* kR, const LAS char* vL, const LAS char* vR, bf16x8 (&qf)[4],
                                              float relfL, float relfR, float slope2, float Rf, const char* qnext = nullptr, int lane = 0) {
    f32x16 tL, tR; float offL, offR;
    { bf16x8 kf[4];
#pragma unroll
      for (int s = 0; s < 4; ++s) kf[s] = *(const LAS bf16x8*)(kL + s * 1024);
      offL = scores<VAR>(tL, kf, qf, relfL, slope2, slope2, Rf); }
    { bf16x8 kf[4];
#pragma unroll
      for (int s = 0; s < 4; ++s) kf[s] = *(const LAS bf16x8*)(kR + s * 1024);
      offR = scores<VAR>(tR, kf, qf, relfR, -slope2, slope2, Rf); }
    if (qnext) load_tile_frags(qf, qnext, lane);
    pair_rest(o, m, l, tL, tR, offL, offR, vL, vR);
}
template <int VAR>
__device__ __forceinline__ void step_pair_regk(f32x16 (&o)[2], float& m, float& l, const bf16x8 (&kfL)[4], const bf16x8 (&kfR)[4], const LAS char* vL, const LAS char* vR, const bf16x8 (&qf)[4],
                                               float relfL, float relfR, float slope2, float Rf) {
    f32x16 tL, tR; const float offL = scores<VAR>(tL, kfL, qf, relfL, slope2, slope2, Rf), offR = scores<VAR>(tR, kfR, qf, relfR, -slope2, slope2, Rf);
    pair_rest(o, m, l, tL, tR, offL, offR, vL, vR);
}

__device__ __forceinline__ void dma_k(LAS char* kb, const bf16* krow0, long rs, int lane) {
#pragma unroll
    for (int s = 0; s < 4; ++s) __builtin_amdgcn_global_load_lds((const unsigned*)(krow0 + (long)(lane & 31) * rs + 16 * s + 8 * (lane >> 5)), (LAS unsigned*)(kb + s * 1024), 16, 0, 0);
}
struct BTile { const char* qb; const char* kb; const char* vb; int nt  , t0  , n0, head, d, r, tl; float slope2; };
__device__ __forceinline__ BTile b_decode(const char* ZB, int b, int c, int j, int qi, int q) {
    BTile t; const int g = qi >> 4, i = qi & 15, lg = 2 * g; t.d = 1 << lg;
    t.r = i >> (4 - lg); const int isub = i & ((16 >> lg) - 1); t.n0 = ((512 * c) >> lg) + 32 * isub; t.nt = 256 >> lg; t.t0 = t.n0 >> 5;
    t.head = 2 * g + j; t.slope2 = alibi_slope(6 + t.head) * (float)t.d * LOG2E;
    const size_t tb = (size_t)(t.head * 4 + b) * 256 + ((size_t)t.r << (8 - lg));
    t.qb = ZB + (tb << 12); t.kb = ZB + ((tb + 6 * 4 * 256) << 12); t.vb = ZB + ((tb + 2 * 6 * 4 * 256) << 12);
    t.tl = g * 512 + (32 * isub + q) * t.d + t.r;
    return t;
}
__device__ __forceinline__ void b_issue_qk(const BTile& t, bf16x8 (&qf)[4], bf16x8 (&kf)[5][4], bool (&val)[5], int (&kc)[5], int lane) {
    load_tile_frags(qf, t.qb + ((size_t)t.t0 << 12), lane);
#pragma unroll
    for (int i = 0; i < 5; ++i) { const int kt = t.t0 + kt_of(i); val[i] = kt >= 0 && kt < t.nt; kc[i] = kt < 0 ? 0 : (kt >= t.nt ? t.nt - 1 : kt);
        load_tile_frags(kf[i], t.kb + ((size_t)kc[i] << 12), lane); }
}
__device__ __forceinline__ void fill_ninf(f32x16& t) {
#pragma unroll
    for (int r = 0; r < 16; ++r) t[r] = -INFINITY;
}
__device__ __forceinline__ float b_qtile(f32x16 (&o)[2], const BTile& t, const BTile& tn, bool has_next, bf16x8 (&qf)[4], bf16x8 (&kf)[5][4], bool (&val)[5], int (&kc)[5], LAS char* vb, int lane) {
    const int q = lane & 31, hi = lane >> 5;
    const float slope2 = t.slope2;
    const LAS char* vaddr = vb + (4 * hi + ((lane & 15) >> 2)) * 64 + ((lane >> 4) & 1) * 32 + (lane & 3) * 8;
    float m = 0.f, l = 0.f;
    {
        bf16x8 vf[2][2]; load_vfrags(vf, vaddr);
        asm volatile("s_waitcnt lgkmcnt(0)" ::: "memory"); dma_tile(vb, t.vb + ((size_t)kc[4] << 12), lane);
        step<0, true, true>(o, m, l, kf[0], qf, vf, (float)(q - 4 * hi), slope2, slope2, 64.0f); }
    {
        f32x16 tL, tR; const float offL = scores<1>(tL, kf[1], qf, (float)(q + 32 - 4 * hi), slope2, slope2, 64.0f), offR = scores<1>(tR, kf[2], qf, (float)(q - 32 - 4 * hi), -slope2, slope2, 64.0f);
        if (!val[1]) fill_ninf(tL); if (!val[2]) fill_ninf(tR);
        pair_rest(o, m, l, tL, tR, offL, offR, vaddr + 4096, vaddr + 8192); }
    asm volatile("s_waitcnt vmcnt(0)" ::: "memory");
    {
        f32x16 tL, tR; const float offL = scores<2>(tL, kf[3], qf, (float)(q + 64 - 4 * hi), slope2, slope2, 64.0f), offR = scores<2>(tR, kf[4], qf, (float)(q - 64 - 4 * hi), -slope2, slope2, 64.0f);
        if (!val[3]) fill_ninf(tL); if (!val[4]) fill_ninf(tR);
        if (has_next) {
            asm volatile("s_waitcnt lgkmcnt(0)" ::: "memory");
            b_issue_qk(tn, qf, kf, val, kc, lane);
            dma_tile(vb + 4096, tn.vb + ((size_t)kc[1] << 12), lane); dma_tile(vb + 8192, tn.vb + ((size_t)kc[2] << 12), lane); }
        pair_rest(o, m, l, tL, tR, offL, offR, vaddr + 12288, vaddr);
        if (has_next) { asm volatile("s_waitcnt lgkmcnt(0)" ::: "memory");
            dma_tile(vb, tn.vb + ((size_t)kc[0] << 12), lane); dma_tile(vb + 12288, tn.vb + ((size_t)kc[3] << 12), lane); } }
    const float lt = hswap_sum(l);
    scale_o(o, 1.0f / lt);
    return m + __builtin_amdgcn_logf(lt);
}
__device__ __forceinline__ void b_unit(const char* ZB, bf16* MIX, char* SCR, int u, LAS char* lds, int wave, int lane) {
    const int b = u >> 5, c = (u >> 1) & 15, j = u & 1;
    LAS float* lseb = (LAS float*)(lds + LSEB_OFF);
    LAS char* vb = lds + wave * 16384;
    char* scr = SCR + ((size_t)(u * 8 + wave) * 6 << 12) + lane * 16;
    const int q = lane & 31, hi = lane >> 5;
    bf16x8 qf[4], kf[5][4]; bool val[5]; int kc[5];
    BTile t = b_decode(ZB, b, c, j, wave, q);
    b_issue_qk(t, qf, kf, val, kc, lane);
#pragma unroll
    for (int i = 0; i < 4; ++i) dma_tile(vb + i * 4096, t.vb + ((size_t)kc[i] << 12), lane);
#pragma unroll 1
    for (int it = 0; it < 6; ++it) { const bool has_next = it < 5; const BTile tn = b_decode(ZB, b, c, j, wave + 8 * (has_next ? it + 1 : it), q);
        if (it == 0) asm volatile("s_waitcnt vmcnt(0)" ::: "memory"); else asm volatile("s_waitcnt vmcnt(4)" ::: "memory");
        f32x16 o[2]; o[0] = zero16_(); o[1] = zero16_();
        const float lse = b_qtile(o, t, tn, has_next, qf, kf, val, kc, vb, lane);
        if (hi == 0) lseb[t.tl] = lse;
        u32x4 w[4]; pack_o(w, o, 1.0f);
#pragma unroll
        for (int k = 0; k < 4; ++k) *(u32x4*)(scr + ((size_t)it << 12) + k * 1024) = w[k];
        t = tn; }
    __syncthreads();
#pragma unroll 1
    for (int it0 = 0; it0 < 6; it0 += 3) { u32x4 w[3][4];
#pragma unroll
        for (int ii = 0; ii < 3; ++ii)
#pragma unroll
            for (int k = 0; k < 4; ++k) w[ii][k] = *(const u32x4*)(scr + ((size_t)(it0 + ii) << 12) + k * 1024);
#pragma unroll
        for (int ii = 0; ii < 3; ++ii) { const BTile tt = b_decode(ZB, b, c, j, wave + 8 * (it0 + ii), q);
            const int tk = tt.tl & 511; const float l0 = lseb[tk], l1 = lseb[512 + tk], l2 = lseb[1024 + tk], own = lseb[tt.tl]; const float mm = fmaxf(l0, fmaxf(l1, l2));
            const float a = __builtin_amdgcn_exp2f(own - mm) / (__builtin_amdgcn_exp2f(l0 - mm) + __builtin_amdgcn_exp2f(l1 - mm) + __builtin_amdgcn_exp2f(l2 - mm));
            const int orow = b * SEQ + (tt.n0 + q) * tt.d + tt.r, ocol = 256 + 64 * tt.head + 8 * hi;
#pragma unroll
            for (int k = 0; k < 4; ++k) { const u32x4 x = w[ii][k]; u32x4 y;
                y.x = cvtpk(__uint_as_float(x.x << 16) * a, __uint_as_float(x.x & 0xffff0000u) * a); y.y = cvtpk(__uint_as_float(x.y << 16) * a, __uint_as_float(x.y & 0xffff0000u) * a);
                y.z = cvtpk(__uint_as_float(x.z << 16) * a, __uint_as_float(x.z & 0xffff0000u) * a); y.w = cvtpk(__uint_as_float(x.w << 16) * a, __uint_as_float(x.w & 0xffff0000u) * a);
                *(u32x4*)((unsigned char*)MIX + pg8::img_off(orow, ocol + 32 * (k >> 1) + 16 * (k & 1), D / 64, false)) = y; } } }
    __syncthreads();
}
__device__ __forceinline__ void c_unit(const char* ZC, bf16* MIX, const float* sink, int u, LAS char* lds, int wave, int lane) {
    const int b = u >> 6, kvh = (u >> 5) & 1, q0 = 256 * (u & 31), n0 = q0 + 32 * wave;
    const int q = lane & 31, hi = lane >> 5;
    const char* kt0 = ZC + ((size_t)((6 + kvh) * 4 + b) * 256 << 12); const char* vt0 = ZC + ((size_t)((8 + kvh) * 4 + b) * 256 << 12);
#pragma unroll
    for (int tt = 0; tt < 2; ++tt) { const int t = 2 * wave + tt, T = (q0 >> 5) - 4 + t;
        if (T >= 0 && T < SEQ / 32) { dma_tile(lds + t * 8192, kt0 + ((size_t)T << 12), lane); dma_tile(lds + t * 8192 + 4096, vt0 + ((size_t)T << 12), lane); } }
    const char* qt0 = ZC + (((size_t)((3 * kvh) * 4 + b) * 256 + (n0 >> 5)) << 12);
    bf16x8 qf[4]; load_tile_frags(qf, qt0, lane);
    asm volatile("s_waitcnt vmcnt(0)" ::: "memory");
    __syncthreads();
    const LAS char* kbase = lds + lane * 16;
    const LAS char* vbase = lds + 4096 + (4 * hi + ((lane & 15) >> 2)) * 64 + ((lane >> 4) & 1) * 32 + (lane & 3) * 8;
#pragma unroll 1
    for (int hh = 0; hh < 3; ++hh) { const int head = 3 * kvh + hh;
        const char* qnext = hh < 2 ? qt0 + ((size_t)(hh + 1) * 4 * 256 << 12) : nullptr; bool reloaded = false;
        f32x16 o[2]; o[0] = zero16_(); o[1] = zero16_();
        float m = sink[head] * LOG2E, l = hi ? 0.f : 1.0f; const float slope2 = alibi_slope(head) * LOG2E;
        {
            const int t = wave + 4; bf16x8 kf[4];
#pragma unroll
            for (int s = 0; s < 4; ++s) kf[s] = *(const LAS bf16x8*)(kbase + t * 8192 + s * 1024);
            bf16x8 vf[2][2]; load_vfrags(vf, vbase + t * 8192);
            step<0, false, true>(o, m, l, kf, qf, vf, (float)(q - 4 * hi), slope2, slope2, 128.0f); }
#pragma unroll 1
        for (int k = 1; k <= 4; ++k) { const int tL = wave + 4 - k, tR = wave + 4 + k; const bool vL = n0 - 32 * k >= 0, vR = n0 + 32 * k < SEQ;
            const float relfL = (float)(q + 32 * k - 4 * hi), relfR = (float)(q - 32 * k - 4 * hi);
            if (vL && vR) {
                if (k < 4) step_pair_lds<1>(o, m, l, kbase + tL * 8192, kbase + tR * 8192, vbase + tL * 8192, vbase + tR * 8192, qf, relfL, relfR, slope2, 128.0f);
                else { step_pair_lds<2>(o, m, l, kbase + tL * 8192, kbase + tR * 8192, vbase + tL * 8192, vbase + tR * 8192, qf, relfL, relfR, slope2, 128.0f, qnext, lane); reloaded = true; } }
            else if (vL || vR) { const int t = vL ? tL : tR; bf16x8 kf[4];
#pragma unroll
                for (int s = 0; s < 4; ++s) kf[s] = *(const LAS bf16x8*)(kbase + t * 8192 + s * 1024);
                bf16x8 vf[2][2]; load_vfrags(vf, vbase + t * 8192);
                const float relf = vL ? relfL : relfR, sl = vL ? slope2 : -slope2;
                if (k < 4) step<1, false, true>(o, m, l, kf, qf, vf, relf, sl, slope2, 128.0f); else step<2, false, true>(o, m, l, kf, qf, vf, relf, sl, slope2, 128.0f); } }
        if (!reloaded && qnext) load_tile_frags(qf, qnext, lane);
        store_o(MIX, b * SEQ + n0 + q, 640 + 64 * head, o, 1.0f / hswap_sum(l), hi); }
    __syncthreads();
}
template <int G>
__device__ __forceinline__ void pool_group(const LAS char* rows, bf16* MIX, const bf16* wpt, const float* pscale, int row0, int tok, int kq, int lane) {
    constexpr int R = 1 << G, W = 2 * R + 1;
    int lo = tok - R, hi2 = tok + R + 1; lo = lo < 0 ? 0 : lo; hi2 = hi2 > SEQ ? SEQ : hi2; const float inv = 1.0f / (float)(hi2 - lo);
    f32x4 acc[4];
#pragma unroll
    for (int dt = 0; dt < 4; ++dt) acc[dt] = zero4_();
#pragma unroll
    for (int kb = 0; kb < 2; ++kb) { float s[8]; bf16x8 uc;
        const LAS char* rp = rows + ((lane & 15) + 8 - R) * POOL_PITCH + (8 * G + 4 * kb + kq) * 16;
#pragma unroll
        for (int e = 0; e < 8; ++e) s[e] = 0.f;
#pragma unroll
        for (int j = 0; j < W; ++j) { const int tt = tok + j - R; const float w = (tt >= 0 && tt < SEQ) ? 1.0f : 0.0f; const bf16x8 v = *(const LAS bf16x8*)(rp + j * POOL_PITCH); if (j == R) uc = v;
#pragma unroll
            for (int e = 0; e < 8; ++e) s[e] += w * bf2f((unsigned short)v[e]); }
        u32x4 pw; float pe[8];
#pragma unroll
        for (int e = 0; e < 8; ++e) pe[e] = s[e] * inv - bf2f((unsigned short)uc[e]);
        pw.x = cvtpk(pe[0], pe[1]); pw.y = cvtpk(pe[2], pe[3]); pw.z = cvtpk(pe[4], pe[5]); pw.w = cvtpk(pe[6], pe[7]);
        const bf16x8 bfrag = __builtin_bit_cast(bf16x8, pw);
#pragma unroll
        for (int dt = 0; dt < 4; ++dt) { const bf16x8 afrag = *(const bf16x8*)(wpt + (size_t)(G * 64 + dt * 16 + (lane & 15)) * 64 + kb * 32 + 8 * kq);
            acc[dt] = __builtin_amdgcn_mfma_f32_16x16x32_bf16(afrag, bfrag, acc[dt], 0, 0, 0); } }
#pragma unroll
    for (int dt = 0; dt < 4; ++dt) { const int dcol = G * 64 + dt * 16 + 4 * kq; const f32x4 sc = *(const f32x4*)(pscale + dcol);
        u32x2 w; w.x = cvtpk(acc[dt][0] * sc.x, acc[dt][1] * sc.y); w.y = cvtpk(acc[dt][2] * sc.z, acc[dt][3] * sc.w);
        *(u32x2*)((unsigned char*)MIX + pg8::img_off(row0 + (lane & 15), dcol & ~7, D / 64, false) + 2 * (dcol & 7)) = w; }
}
__device__ __forceinline__ void pool_item(const bf16* Z, bf16* MIX, const bf16* wpt, const float* pscale, int item, LAS char* rows, int lane) {
    const int row0 = 16 * item, b = row0 / SEQ, t0 = row0 % SEQ;
    const int tok = t0 + (lane & 15), kq = lane >> 4;
    const bf16* zb = Z + (size_t)b * SEQ * 256;
    u32x4 st[16];
#pragma unroll
    for (int i = 0; i < 16; ++i) { const int idx = i * 64 + lane, r = idx >> 5, c = idx & 31; int tt = t0 - 8 + r; tt = (tt >= 0 && tt < SEQ) ? tt : t0; st[i] = *(const u32x4*)(zb + (size_t)tt * 256 + 8 * c); }
#pragma unroll
    for (int i = 0; i < 16; ++i) { const int idx = i * 64 + lane, r = idx >> 5, c = idx & 31; *(LAS u32x4*)(rows + r * POOL_PITCH + c * 16) = st[i]; }
    pool_group<0>(rows, MIX, wpt, pscale, row0, tok, kq, lane); pool_group<1>(rows, MIX, wpt, pscale, row0, tok, kq, lane);
    pool_group<2>(rows, MIX, wpt, pscale, row0, tok, kq, lane); pool_group<3>(rows, MIX, wpt, pscale, row0, tok, kq, lane);
}
constexpr int N_B_UNITS = 128, N_C_UNITS = 256, N_P_ITEMS = M / 16;
}

__device__ __forceinline__ void p_mixers(Frame& F, const float* const* in, unsigned char* ws, int lq, int sel  ) {
    const int l = lq & 1;
    const bf16* Z = (const bf16*)(ws + WS_Z); bf16* MIX = (bf16*)(ws + WS_MIX);
    LAS char* lds = (LAS char*)F.lds;
    const float* sink = in[9] + 6 * l;
    {
        const int nb = (F.G >= 2 * mx::N_B_UNITS) ? mx::N_B_UNITS : (F.G + 1) / 2;
        const bool xl = (F.G == 256);
        if ((int)blockIdx.x < nb) {
            if (sel & 1) {
#pragma unroll 1
                for (int u0 = blockIdx.x; u0 < mx::N_B_UNITS; u0 += nb) { const int u = xl ? ((u0 & 7) >> 1) * 32 + (u0 >> 3) * 2 + (u0 & 1) : u0;     unsigned z_; asm volatile("v_mov_b32 %0, 0" : "=v"(z_)); const int lane = (int)__builtin_amdgcn_mbcnt_hi(~0u, __builtin_amdgcn_mbcnt_lo(~0u, z_)); mx::b_unit((const char*)(ws + WS_ZB), MIX, (char*)(ws + WS_BSCR), u, lds, F.wave, lane); } }
        } else if (sel & 2) {
#pragma unroll 1
            for (int v = (int)blockIdx.x - nb, u0 = v, k = 0; u0 < mx::N_C_UNITS; u0 += F.G - nb, ++k) { const int u = xl ? (v & 7) * 32 + (v >> 3) * 2 + k : u0;     unsigned z_; asm volatile("v_mov_b32 %0, 0" : "=v"(z_)); const int lane = (int)__builtin_amdgcn_mbcnt_hi(~0u, __builtin_amdgcn_mbcnt_lo(~0u, z_)); mx::c_unit((const char*)(ws + WS_ZC), MIX, sink, u, lds, F.wave, lane); }
        }
        __syncthreads();
    }
    if (sel & 4) { const bf16* wpt = (const bf16*)(ws + WS_W + (size_t)l * W_LAYER + W_PT); const float* pscale = in[8] + 256 * l;
        for (int it = blockIdx.x * NWAVES + F.wave; it < mx::N_P_ITEMS; it += F.G * NWAVES) mx::pool_item(Z, MIX, wpt, pscale, it, lds + F.wave * (32 * mx::POOL_PITCH), F.lane); }
}

struct Args { const float* in[15]; float* out; unsigned char* ws; int ph_lo, ph_hi, li, dup; };
__global__ void __launch_bounds__(NWAVES * 64, 2) mk_fwd(Args args) {
    extern __shared__ __attribute__((aligned(16))) unsigned char lds[];
    Frame F;
    F.lds = (LAS unsigned char*)lds;
    F.MISC = (volatile LAS unsigned*)(F.lds + MISC_OFF);
    F.tid = threadIdx.x; F.lane = F.tid & 63; F.wave = __builtin_amdgcn_readfirstlane(F.tid >> 6);
    const int wave0 = F.wave;
    F.G = gridDim.x; { const int bx = blockIdx.x; F.vcu = (F.G % 8 == 0) ? (bx % 8) * (F.G / 8) + bx / 8 : bx; }
    unsigned char* ws = args.ws;
    F.ctl = (gu32*)(ws + WS_CTL);
    for (int u = F.tid; u < (LDS_BYTES - LDSCTL_OFF) / 4; u += NWAVES * 64) ((LAS unsigned*)(F.lds + LDSCTL_OFF))[u] = 0u;
    __syncthreads();
    XcdBarrier bar; bar.bar = (unsigned*)(F.ctl + CW_BAR) + args.li * XCD_BAR_WORDS; bar.x = 0; bar.st = nullptr;
    const int lo = args.ph_lo, hi = args.ph_hi;
    if (hi - lo > 1) bar = xcd_barrier_post((unsigned*)(F.ctl + CW_BAR) + args.li * XCD_BAR_WORDS, F.MISC + 8);
    const float* const* in = args.in;
    bf16* XS = (bf16*)(ws + WS_XS);
    bf16* H = (bf16*)(ws + WS_H);
    const float* MOD = (const float*)(ws + WS_MOD);
    float* SSQ = (float*)(ws + WS_SUMSQ);
    const float* GV = (const float*)(ws + WS_GV);

    const int dup = args.dup & 1, msel = ((args.dup >> 1) & 15) ? ((args.dup >> 1) & 15) : 7;
#pragma unroll 1
    for (int ph = lo; ph < hi; ++ph) {
        { unsigned z_; asm volatile("v_mov_b32 %0, 0" : "=v"(z_)); const int t_ = wave0 * 64 + (int)__builtin_amdgcn_mbcnt_hi(~0u, __builtin_amdgcn_mbcnt_lo(~0u, z_)); F.tid = t_; F.lane = t_ & 63; F.wave = wave0; }
        if (ph == PH_PRO) p_prologue(F, in, ws);
        else if (ph == PH_CONV) p_conv(F, in, ws);
        else if (ph == PH_FINAL) p_norm_final(F, XS, SSQ + (size_t)4 * M, args.out, in[14]);
        else {
            const int l = (ph - PH_L0) / PH_PER_LAYER, k = (ph - PH_L0) % PH_PER_LAYER;
            unsigned char* wl = ws + WS_W + (size_t)l * W_LAYER;
            const float* modl = MOD + (size_t)l * BATCH * NMOD * D;
            const float* biasl = (const float*)(ws + WS_BIAS + (size_t)l * BIAS_LAYER);
            if (k == 0) { pg8::Gemm g{H, (const bf16*)(wl + W_IN), M, INW, D}; pg8::StaticOrder S; S.init(M, INW, F.G, (int)blockIdx.x);
                pg8::EpiBf16Norm E{(bf16*)(ws + WS_Z), 256, SSQ + (size_t)(2 * l) * M, biasl, INW, ws + WS_ZB, ws + WS_ZC};
                pg8::gemm_phase<pg8::EpiBf16Norm, pg8::StaticOrder, true, true>(F.lds + RING_OFF, g, S, E, F.tid); }
            else if (k == 1) p_mixers(F, in, ws, l + 2 * dup, msel);
            else if (k == 2 && l == 0 && !dup) {
                pg8::Gemm g{(const bf16*)(ws + WS_MIX), (const bf16*)(wl + W_OUT), M, D, D}; pg8::StaticOrder S; S.init(M, D, F.G, (int)blockIdx.x);
                pg8::EpiGateResNormT<true> E{(const bf16*)in[0], XS, modl + 2 * D, NMOD * D, H, GV + (size_t)1 * BATCH * D, D, SSQ + (size_t)1 * M, D};
                pg8::gemm_phase<pg8::EpiGateResNormT<true>, pg8::StaticOrder, true, true>(F.lds + RING_OFF, g, S, E, F.tid); }
            else if (k == 2 || k == 4) { const bool dn = (k == 4); const bool last = dn && (l == DEPTH - 1);
                pg8::Gemm g{(const bf16*)(ws + (dn ? WS_HID : WS_MIX)), (const bf16*)(wl + (dn ? W_DN : W_OUT)), M, D, dn ? DFF : D}; pg8::StaticOrder S; S.init(M, D, F.G, (int)blockIdx.x);
                pg8::EpiGateResNorm E{XS, XS, dup ? (const float*)(F.ctl + CW_ZEROS) : modl + (dn ? 5 : 2) * D, dup ? 0 : NMOD * D,
                    (last || dup) ? (bf16*)nullptr : H, GV + (size_t)((dn ? 2 * (l + 1) : 2 * l + 1) % (2 * DEPTH)) * BATCH * D, D, SSQ + (size_t)(dup ? 5 : 2 * l + (dn ? 2 : 1)) * M, D};
                pg8::gemm_phase<pg8::EpiGateResNorm, pg8::StaticOrder, true, true>(F.lds + RING_OFF, g, S, E, F.tid); }
            else { pg8::Gemm g{H, (const bf16*)(wl + W_GU), M, 2 * DFF, D}; pg8::StaticOrder S; S.init(M, 2 * DFF, F.G, (int)blockIdx.x);
                pg8::EpiSwiGLUNorm E{(bf16*)(ws + WS_HID), DFF, SSQ + (size_t)(2 * l + 1) * M, biasl + BATCH * INW, 2 * DFF};
                pg8::gemm_phase<pg8::EpiSwiGLUNorm, pg8::StaticOrder, true, true>(F.lds + RING_OFF, g, S, E, F.tid); }
        }
        if (ph + 1 < hi) xcd_barrier(bar);
    }
}

extern "C" void kernel_launch(void* const* d_in, const int* in_sizes, int n_in, void* d_out, int out_size, void* d_ws, size_t ws_size, hipStream_t stream) {
    static int grid = 0;
    if (grid == 0) {
        if (n_in != 15 || in_sizes[0] != M * D || out_size != M * D || ws_size < WS_END) { fprintf(stderr, "kernel_launch: unexpected shapes (n_in %d, in0 %d, out %d, ws %zu); nothing launched\n", n_in, n_in > 0 ? in_sizes[0] : -1, out_size, ws_size); grid = -1; return; }
        int dev = 0, cus = 0, per_cu = 0;
        if (hipGetDevice(&dev) != hipSuccess || hipDeviceGetAttribute(&cus, hipDeviceAttributeMultiprocessorCount, dev) != hipSuccess) { grid = -1; return; }
        if (hipFuncSetAttribute((const void*)mk_fwd, hipFuncAttributeMaxDynamicSharedMemorySize, LDS_BYTES) != hipSuccess) { fprintf(stderr, "kernel_launch: hipFuncSetAttribute failed\n"); grid = -1; return; }
        if (hipOccupancyMaxActiveBlocksPerMultiprocessor(&per_cu, (const void*)mk_fwd, NWAVES * 64, LDS_BYTES) != hipSuccess || per_cu < 1) fprintf(stderr, "kernel_launch: occupancy query reports %d blocks per CU\n", per_cu);
        (void)hipGetLastError();
        grid = cus;
        if (grid != 256) fprintf(stderr, "kernel_launch: %d CUs; this kernel is laid out for 256\n", grid);
    }
    if (grid < 0) return;
    if (hipMemsetAsync((char*)d_ws + WS_CTL, 0, CTL_ZERO_BYTES, stream) != hipSuccess) return;
    Args a{};
    for (int i = 0; i < 15; ++i) a.in[i] = (const float*)d_in[i];
    a.out = (float*)d_out; a.ws = (unsigned char*)d_ws;
#if PROBE_DUP == 0 && PROBE_CUT == 0
    a.ph_lo = 0; a.ph_hi = NPHASES; a.li = 0; a.dup = 0;
    hipLaunchKernelGGL(mk_fwd, dim3(grid), dim3(NWAVES * 64), LDS_BYTES, stream, a);
#else
    { int lo = 0, li = 0;
      for (int ph = 0; ph < NPHASES; ++ph) { const bool cut = ((PROBE_CUT | PROBE_DUP) >> ph) & 1;
        if (cut || ph == NPHASES - 1) { a.ph_lo = lo; a.ph_hi = ph + 1; a.li = (ph + 1 - lo > 1) ? li++ : 0; a.dup = 0; hipLaunchKernelGGL(mk_fwd, dim3(grid), dim3(NWAVES * 64), LDS_BYTES, stream, a);
            if ((PROBE_DUP >> ph) & 1) { a.ph_lo = ph; a.ph_hi = ph + 1; a.li = 0; a.dup = 1 | (PROBE_MIXSEL << 1) | (PROBE_NOSTORE << 4); hipLaunchKernelGGL(mk_fwd, dim3(grid), dim3(NWAVES * 64), LDS_BYTES, stream, a); }
            lo = ph + 1; } } }
#endif
}
```

```cpp
#include <hip/hip_runtime.h>
#include <cstdio>
#include <cstdint>
namespace pg8 {
#define PG8_LAS __attribute__((address_space(3)))
typedef unsigned short bf16_t;
typedef short bf16x8 __attribute__((ext_vector_type(8)));
typedef float f32x4 __attribute__((ext_vector_type(4)));
typedef unsigned u32x4 __attribute__((ext_vector_type(4)));
constexpr int BM = 256, BK = 64, HALF = 128, HTB = HALF * BK * 2  , STAGE_BYTES = 8 * HTB, NXCD = 8, WGM = 8;

__host__ __device__ __forceinline__ int lds_byte(int r, int c) { const int st = (r >> 4) * 2 + (c >> 5), rr = r & 15, cc = c & 31, ob = rr * 64 + cc * 2; return st * 1024 + (ob ^ (((ob >> 9) & 1) << 5)); }
__host__ __device__ __forceinline__ void stage_rc(int b, int& R, int& C) { const int st = b / 1024, sb = b % 1024, swz = sb ^ (((sb >> 9) & 1) << 5); R = (st >> 1) * 16 + swz / 64; C = (st & 1) * 32 + (swz % 64) / 2; }
__host__ __device__ __forceinline__ int perm32(int rho) { const int n = rho >> 4, i = rho & 15; return 8 * (i >> 2) + 4 * n + (i & 3); }

__host__ __device__ __forceinline__ int perm32inv(int x) { return 16 * ((x >> 2) & 1) + 4 * (x >> 3) + (x & 3); }
__host__ __device__ __forceinline__ size_t img_off(int row, int col, int nt, bool wrow) { const int r = row & 127, rr = wrow ? (r & ~31) + perm32inv(r & 31) : r; return ((size_t)((row >> 7) * nt + (col >> 6)) << 14) + (size_t)lds_byte(rr, col & 63); }
constexpr bool IMG_A = true, IMG_B = true;
struct Unit { int pm, pn; };
struct Gemm { const bf16_t* A; const bf16_t* Bt; int M, N, K; };

struct StaticOrder {
    int nM, nN, nwg, G, c;
    __host__ __device__ void init(int M, int N, int G_, int c_) { nM = M / BM; nN = N / BM; nwg = nM * nN; G = G_; c = c_; }
    __host__ __device__ bool next(int i, Unit& u) const {
        const long L = (long)i * G + c; if (L >= nwg) return false;
        int wgid = (int)L; { const int q = nwg / NXCD, r = nwg % NXCD, xcd = wgid % NXCD, off = wgid / NXCD; wgid = (xcd < r ? xcd * (q + 1) : r * (q + 1) + (xcd - r) * q) + off; }
        const int nig = WGM * nN, gid = wgid / nig, fm = gid * WGM, gsz = (nM - fm) < WGM ? (nM - fm) : WGM;
        u.pm = fm + ((wgid % nig) % gsz); u.pn = (wgid % nig) / gsz; return true;
    }
    __device__ __forceinline__ void a_ready(const Unit&) const {}
    __device__ __forceinline__ void done(const Unit&) const {}
};

__device__ __forceinline__ unsigned cvt_pk_bf16(float lo, float hi) { unsigned r; asm volatile("v_cvt_pk_bf16_f32 %0, %1, %2" : "=v"(r) : "v"(lo), "v"(hi)); return r; }
constexpr float RMS_EPS_ = 1e-6f, INV_D_ = 1.0f / 1024.0f;
__device__ __forceinline__ void aux_dma(const float* src_lane, PG8_LAS unsigned char* dst_wave) { __builtin_amdgcn_global_load_lds((const unsigned*)src_lane, (PG8_LAS unsigned*)dst_wave, 4, 0, 0); }
typedef _Float16 h16x2 __attribute__((ext_vector_type(2)));
__device__ __forceinline__ unsigned pk_h2(float lo, float hi) { const h16x2 h = {(_Float16)lo, (_Float16)hi}; return __builtin_bit_cast(unsigned, h); }
__device__ __forceinline__ float h_lo(unsigned w) { return (float)__builtin_bit_cast(h16x2, w)[0]; }
__device__ __forceinline__ float h_hi(unsigned w) { return (float)__builtin_bit_cast(h16x2, w)[1]; }
struct EpiBf16Norm {
    static constexpr bool PERM = true, AFTER_DRAIN = false;
    bf16_t* O; int ldc; const float* sumsq; const float* bias; int bias_stride; unsigned char* zb; unsigned char* zc;
    __device__ __forceinline__ void prefetch(const Unit& u, PG8_LAS unsigned char* aux, int wid, int lane) const {
        if (wid < 4) aux_dma(sumsq + u.pm * BM + wid * 64 + lane, aux + wid * 256);
        else aux_dma(bias + (size_t)(u.pm >> 5) * bias_stride + u.pn * BM + (wid - 4) * 64 + lane, aux + 1024 + (wid - 4) * 256);
    }
    __device__ __forceinline__ void operator()(const f32x4 (&acc)[2][2][4][2], const Unit& u, int wr, int wc, int fr_, int fq_, PG8_LAS unsigned char* aux) const {
        unsigned z_; asm volatile("v_mov_b32 %0, 0" : "=v"(z_)); const int ln_ = (int)__builtin_amdgcn_mbcnt_hi(~0u, __builtin_amdgcn_mbcnt_lo(~0u, z_)); const int fr = ln_ & 15, fq = ln_ >> 4;
        const int row0 = u.pm * BM + wr * 64 + fr, col0 = u.pn * BM + wc * 32 + 8 * fq;
        const PG8_LAS float* ass = (const PG8_LAS float*)aux + wr * 64 + fr; const PG8_LAS float* ab = (const PG8_LAS float*)(aux + 1024) + wc * 32 + 8 * fq;
        f32x4 bv[2][2];
#pragma unroll
        for (int bj = 0; bj < 2; ++bj)
#pragma unroll
            for (int n = 0; n < 2; ++n) bv[bj][n] = *(const PG8_LAS f32x4*)(ab + bj * HALF + 4 * n);
#pragma unroll
        for (int ai = 0; ai < 2; ++ai)
#pragma unroll
            for (int m = 0; m < 4; ++m) { const int row = row0 + ai * HALF + m * 16; const float rs = __builtin_amdgcn_rsqf(ass[ai * HALF + m * 16] * INV_D_ + RMS_EPS_);
#pragma unroll
                for (int bj = 0; bj < 2; ++bj) { const f32x4 v0 = acc[ai][bj][m][0] * rs + bv[bj][0], v1 = acc[ai][bj][m][1] * rs + bv[bj][1];
                    u32x4 w; w.x = cvt_pk_bf16(v0[0], v0[1]); w.y = cvt_pk_bf16(v0[2], v0[3]); w.z = cvt_pk_bf16(v1[0], v1[1]); w.w = cvt_pk_bf16(v1[2], v1[3]);
                    const int cb = 2 * u.pn + bj;
                    if (zb != nullptr && cb >= 2 && cb <= 10) { const int t3 = (cb - 2) / 3, g = (cb - 2) % 3, lg = 2 * g, hd = 2 * g + (wc >> 1), c = (wc & 1) * 4 + fq;
                        const int t = row & 8191, b = row >> 13, r = t & ((1 << lg) - 1), n = t >> lg, ti = (r << (8 - lg)) + (n >> 5), key = n & 31;
                        const int off = t3 < 2 ? (c >> 1) * 1024 + (key + 32 * (c & 1)) * 16 : (c >> 2) * 2048 + (key >> 4) * 1024 + (key & 15) * 64 + (c & 3) * 16;
                        *(u32x4*)(zb + ((size_t)(((t3 * 6 + hd) * 4 + b) * 256 + ti) << 12) + off) = w; }
                    else if (zb != nullptr && cb >= 11) {
                        const int hx = cb <= 13 ? 2 * (cb - 11) + (wc >> 1) : (cb == 14 ? 6 : 8) + (wc >> 1), c = (wc & 1) * 4 + fq, t = row & 8191, b = row >> 13, key = t & 31;
                        const int off = cb < 15 ? (c >> 1) * 1024 + (key + 32 * (c & 1)) * 16 : (c >> 2) * 2048 + (key >> 4) * 1024 + (key & 15) * 64 + (c & 3) * 16;
                        *(u32x4*)(zc + ((size_t)((hx * 4 + b) * 256 + (t >> 5)) << 12) + off) = w; }
                    else *(u32x4*)(O + (size_t)row * ldc + col0 + bj * HALF) = w; } }
    }
};
struct EpiSwiGLUNorm {
    static constexpr bool PERM = true, AFTER_DRAIN = false;
    bf16_t* O; int ldc; const float* sumsq; const float* bias; int bias_stride;
    static __device__ __forceinline__ float silu_mul(float g, float u) { return g * u * __builtin_amdgcn_rcpf(1.0f + __builtin_amdgcn_exp2f(-1.4426950408889634f * g)); }
    __device__ __forceinline__ void prefetch(const Unit& u, PG8_LAS unsigned char* aux, int wid, int lane) const {
        if (wid < 4) aux_dma(sumsq + u.pm * BM + wid * 64 + lane, aux + wid * 256);
        else aux_dma(bias + (size_t)(u.pm >> 5) * bias_stride + u.pn * BM + (wid - 4) * 64 + lane, aux + 1024 + (wid - 4) * 256);
    }
    __device__ __forceinline__ void operator()(const f32x4 (&acc)[2][2][4][2], const Unit& u, int wr, int wc, int fr_, int fq_, PG8_LAS unsigned char* aux) const {
        unsigned z_; asm volatile("v_mov_b32 %0, 0" : "=v"(z_)); const int ln_ = (int)__builtin_amdgcn_mbcnt_hi(~0u, __builtin_amdgcn_mbcnt_lo(~0u, z_)); const int fr = ln_ & 15, fq = ln_ >> 4;
        const int row0 = u.pm * BM + wr * 64 + fr, col0 = u.pn * HALF + wc * 32 + 8 * fq;
        const PG8_LAS float* ass = (const PG8_LAS float*)aux + wr * 64 + fr; const PG8_LAS float* ab = (const PG8_LAS float*)(aux + 1024) + wc * 32 + 8 * fq;
        const f32x4 bg0 = *(const PG8_LAS f32x4*)(ab), bg1 = *(const PG8_LAS f32x4*)(ab + 4), bu0 = *(const PG8_LAS f32x4*)(ab + HALF), bu1 = *(const PG8_LAS f32x4*)(ab + HALF + 4);
#pragma unroll
        for (int ai = 0; ai < 2; ++ai)
#pragma unroll
            for (int m = 0; m < 4; ++m) { const int row = row0 + ai * HALF + m * 16; const float rs = __builtin_amdgcn_rsqf(ass[ai * HALF + m * 16] * INV_D_ + RMS_EPS_);
                unsigned char* rowp = (unsigned char*)O + img_off(row, col0, ldc / 64, false);
                const f32x4 g0 = acc[ai][0][m][0] * rs + bg0, g1 = acc[ai][0][m][1] * rs + bg1, u0 = acc[ai][1][m][0] * rs + bu0, u1 = acc[ai][1][m][1] * rs + bu1;
                f32x4 e0 = g0 * -1.4426950408889634f, e1 = g1 * -1.4426950408889634f;
#pragma unroll
                for (int i = 0; i < 4; ++i) { e0[i] = __builtin_amdgcn_exp2f(e0[i]); e1[i] = __builtin_amdgcn_exp2f(e1[i]); }
                e0 = e0 + 1.0f; e1 = e1 + 1.0f;
#pragma unroll
                for (int i = 0; i < 4; ++i) { e0[i] = __builtin_amdgcn_rcpf(e0[i]); e1[i] = __builtin_amdgcn_rcpf(e1[i]); }
                const f32x4 h0 = (g0 * u0) * e0, h1 = (g1 * u1) * e1;
                u32x4 w; w.x = cvt_pk_bf16(h0[0], h0[1]); w.y = cvt_pk_bf16(h0[2], h0[3]); w.z = cvt_pk_bf16(h1[0], h1[1]); w.w = cvt_pk_bf16(h1[2], h1[3]);
                *(u32x4*)rowp = w; }
    }
};
template <bool F32BASE>
struct EpiGateResNormT {
    static constexpr bool PERM = true, AFTER_DRAIN = false;
    const bf16_t* base; bf16_t* out; const float* gate; int gate_stride; bf16_t* Hn; const float* gn; int gn_stride; float* sumsq; int ldc;
    __device__ __forceinline__ void prefetch(const Unit& u, PG8_LAS unsigned char* aux, int wid, int lane) const {
        if (wid < 4) aux_dma(gate + (size_t)(u.pm >> 5) * gate_stride + u.pn * BM + wid * 64 + lane, aux + wid * 256);
        else aux_dma(gn + (size_t)(u.pm >> 5) * gn_stride + u.pn * BM + (wid - 4) * 64 + lane, aux + 1024 + (wid - 4) * 256);
    }
    __device__ __forceinline__ void operator()(const f32x4 (&acc)[2][2][4][2], const Unit& u, int wr, int wc, int fr_, int fq_, PG8_LAS unsigned char* aux) const {
        unsigned z_; asm volatile("v_mov_b32 %0, 0" : "=v"(z_)); const int ln_ = (int)__builtin_amdgcn_mbcnt_hi(~0u, __builtin_amdgcn_mbcnt_lo(~0u, z_)); const int fr = ln_ & 15, fq = ln_ >> 4;
        const int row0 = u.pm * BM + wr * 64 + fr, col0 = u.pn * BM + wc * 32 + 8 * fq;
        const PG8_LAS float* ag = (const PG8_LAS float*)aux + wc * 32 + 8 * fq; const PG8_LAS float* an = (const PG8_LAS float*)(aux + 1024) + wc * 32 + 8 * fq;
#pragma unroll
        for (int am = 0; am < 4; ++am) {
            u32x4 ld[2][2]; f32x4 lf[2][2][2];
#pragma unroll
            for (int mm = 0; mm < 2; ++mm)
#pragma unroll
                for (int bj = 0; bj < 2; ++bj) {
                    if constexpr (F32BASE) { const f32x4* px = (const f32x4*)((const float*)base + (size_t)(row0 + (am >> 1) * HALF + (2 * (am & 1) + mm) * 16) * ldc + col0 + bj * HALF); lf[mm][bj][0] = px[0]; lf[mm][bj][1] = px[1]; }
                    else ld[mm][bj] = *(const u32x4*)((const unsigned char*)base + img_off(row0 + (am >> 1) * HALF + (2 * (am & 1) + mm) * 16, col0 + bj * HALF, ldc / 64, false)); }
#pragma unroll
            for (int mm = 0; mm < 2; ++mm) { const int ai = am >> 1, m = 2 * (am & 1) + mm; const int row = row0 + ai * HALF + m * 16; const size_t off = (size_t)row * ldc + col0; float ss = 0.f;
#pragma unroll
                for (int bj = 0; bj < 2; ++bj) {
                    const f32x4 g0 = *(const PG8_LAS f32x4*)(ag + bj * HALF), g1 = *(const PG8_LAS f32x4*)(ag + bj * HALF + 4);
                    f32x4 b0, b1;
                    if constexpr (F32BASE) { b0 = lf[mm][bj][0]; b1 = lf[mm][bj][1]; }
                    else { const u32x4 bw = ld[mm][bj]; b0 = (f32x4){h_lo(bw.x), h_hi(bw.x), h_lo(bw.y), h_hi(bw.y)}; b1 = (f32x4){h_lo(bw.z), h_hi(bw.z), h_lo(bw.w), h_hi(bw.w)}; }
                    const f32x4 x0 = b0 + g0 * acc[ai][bj][m][0], x1 = b1 + g1 * acc[ai][bj][m][1];
                    u32x4 w; w.x = pk_h2(x0[0], x0[1]); w.y = pk_h2(x0[2], x0[3]); w.z = pk_h2(x1[0], x1[1]); w.w = pk_h2(x1[2], x1[3]);
                    *(u32x4*)((unsigned char*)out + img_off(row, col0 + bj * HALF, ldc / 64, false)) = w;
                    ss += (x0[0] * x0[0] + x0[1] * x0[1]) + (x0[2] * x0[2] + x0[3] * x0[3]) + (x1[0] * x1[0] + x1[1] * x1[1]) + (x1[2] * x1[2] + x1[3] * x1[3]);
                    if (Hn) { const f32x4 n0 = *(const PG8_LAS f32x4*)(an + bj * HALF), n1 = *(const PG8_LAS f32x4*)(an + bj * HALF + 4); const f32x4 h0 = x0 * n0, h1 = x1 * n1;
                        u32x4 hw; hw.x = cvt_pk_bf16(h0[0], h0[1]); hw.y = cvt_pk_bf16(h0[2], h0[3]); hw.z = cvt_pk_bf16(h1[0], h1[1]); hw.w = cvt_pk_bf16(h1[2], h1[3]);
                        *(u32x4*)((unsigned char*)Hn + img_off(row, col0 + bj * HALF, ldc / 64, false)) = hw; } }
                ss += __shfl_xor(ss, 16); ss += __shfl_xor(ss, 32);
                if (fq == 0) atomicAdd(sumsq + row, ss); }
            asm volatile("" ::: "memory"); }
    }
};
typedef EpiGateResNormT<false> EpiGateResNorm;

template <class Epi, class Sched, bool ALIGN_EPI = false, bool SP2 = false>
__device__ __forceinline__ void gemm_phase(PG8_LAS unsigned char* lds, const Gemm g, const Sched& S, const Epi& E, int tid_in) {
    int tid_ = tid_in; asm volatile("" : "+v"(tid_));
    const int tid = tid_, wid = __builtin_amdgcn_readfirstlane(tid >> 6), lane = tid & 63, wr = wid >> 2, wc = wid & 3, fr = lane & 15, fq = lane >> 4;
    const int K = g.K, nt = K / BK;
    unsigned voffA[2], voffB[2];
#pragma unroll
    for (int i = 0; i < 2; ++i) { int R, C; stage_rc(tid * 16 + i * 8192, R, C); const int Rb = Epi::PERM ? ((R & ~31) + perm32(R & 31)) : R;
        voffA[i] = IMG_A ? (unsigned)(tid * 16 + i * 8192) : (unsigned)(R * K + C) * 2u; voffB[i] = IMG_B ? (unsigned)(tid * 16 + i * 8192) : (unsigned)(Rb * K + C) * 2u; }
    const size_t kstepA = IMG_A ? (size_t)(HALF * BK * 2) : (size_t)(BK * 2), kstepB = IMG_B ? (size_t)(HALF * BK * 2) : (size_t)(BK * 2);
    const size_t hstep = (size_t)HALF * K * 2;
    const size_t tstep = 2 * hstep;
    const unsigned ldsw = (unsigned)wid * 1024u;
    const int aoff = lds_byte(wr * 64 + fr, fq * 8), boff = lds_byte(wc * 32 + fr, fq * 8);
#define PG8_SA(b, h) (((b) * 2 + (h)) * HTB)
#define PG8_SB(b, h) ((4 + (b) * 2 + (h)) * HTB)
#define PG8_STAGE(bufoff, gbase, voff) do { _Pragma("unroll") for (int _i = 0; _i < 2; ++_i) \
        __builtin_amdgcn_global_load_lds((const unsigned*)((const char*)(gbase) + (voff)[_i]), (PG8_LAS unsigned*)(lds + (bufoff) + ldsw + _i * 8192), 16, 0, 0); } while (0)
#define PG8_LDA(dst, b, h) do { _Pragma("unroll") for (int m = 0; m < 4; ++m) _Pragma("unroll") for (int k = 0; k < 2; ++k) dst[m][k] = *(const PG8_LAS bf16x8*)(lds + PG8_SA(b, h) + aoff + m * 2048 + k * 1024); } while (0)
#define PG8_LDB(dst, b, h) do { _Pragma("unroll") for (int n = 0; n < 2; ++n) _Pragma("unroll") for (int k = 0; k < 2; ++k) dst[n][k] = *(const PG8_LAS bf16x8*)(lds + PG8_SB(b, h) + boff + n * 2048 + k * 1024); } while (0)
#define PG8_MMA(ai, bj, At, Bt) do { __builtin_amdgcn_s_setprio(1); _Pragma("unroll") for (int m = 0; m < 4; ++m) _Pragma("unroll") for (int n = 0; n < 2; ++n) _Pragma("unroll") for (int k = 0; k < 2; ++k) \
        acc[ai][bj][m][n] = __builtin_amdgcn_mfma_f32_16x16x32_bf16(Bt[n][k], At[m][k], acc[ai][bj][m][n], 0, 0, 0); __builtin_amdgcn_s_setprio(0); } while (0)
#define PG8_WAIT_V(n) asm volatile("s_waitcnt vmcnt(" #n ")" ::: "memory")
#define PG8_WAIT_L(n) asm volatile("s_waitcnt lgkmcnt(" #n ")" ::: "memory")
#define PG8_BAR __builtin_amdgcn_s_barrier()
#define PG8_SCHED __builtin_amdgcn_sched_barrier(0)
    Unit cur, nxt; int ui = 0;
    if (!S.next(0, cur)) return;
    f32x4 acc[2][2][4][2];
#pragma unroll
    for (int a = 0; a < 2; ++a)
#pragma unroll
        for (int b = 0; b < 2; ++b)
#pragma unroll
            for (int m = 0; m < 4; ++m)
#pragma unroll
                for (int n = 0; n < 2; ++n) { float z_; asm volatile("v_mov_b32 %0, 0" : "=v"(z_)); acc[a][b][m][n] = (f32x4){z_, z_, z_, z_}; }
    bf16x8 At[4][2], B0[2][2], B1[2][2];
    const char* cA = (const char*)g.A + (size_t)cur.pm * tstep; const char* cB = (const char*)g.Bt + (size_t)cur.pn * tstep;
    S.a_ready(cur);
    if constexpr (SP2) {
        PG8_STAGE(PG8_SB(0, 0), cB, voffB); PG8_STAGE(PG8_SB(0, 1), cB + hstep, voffB); PG8_STAGE(PG8_SA(0, 0), cA, voffA); PG8_STAGE(PG8_SA(0, 1), cA + hstep, voffA);
        if (wr == 1) PG8_BAR;
        PG8_WAIT_V(2); PG8_BAR;
        PG8_STAGE(PG8_SB(1, 0), cB + kstepB, voffB); PG8_STAGE(PG8_SA(1, 0), cA + kstepA, voffA); PG8_STAGE(PG8_SB(1, 1), cB + hstep + kstepB, voffB);
        PG8_WAIT_V(6); PG8_BAR;
    } else {
        PG8_STAGE(PG8_SB(0, 0), cB, voffB); PG8_STAGE(PG8_SA(0, 0), cA, voffA); PG8_STAGE(PG8_SB(0, 1), cB + hstep, voffB); PG8_STAGE(PG8_SA(0, 1), cA + hstep, voffA);
        if (wr == 1) PG8_BAR;
        PG8_WAIT_V(4); PG8_BAR;
        PG8_STAGE(PG8_SB(1, 0), cB + kstepB, voffB); PG8_STAGE(PG8_SA(1, 0), cA + kstepA, voffA); PG8_STAGE(PG8_SB(1, 1), cB + hstep + kstepB, voffB);
        PG8_WAIT_V(6); PG8_BAR;
    }
    for (;;) {
        const bool has_next = S.next(ui + 1, nxt);
        const char* nA = has_next ? (const char*)g.A + (size_t)nxt.pm * tstep : cA; const char* nB = has_next ? (const char*)g.Bt + (size_t)nxt.pn * tstep : cB;
        for (int t = 0; t < nt; t += 2) {
            const bool last = (t == nt - 2);
            const char* a1 = cA + (size_t)(t + 1) * kstepA;
            const char* a2 = last ? nA : cA + (size_t)(t + 2) * kstepA; const char* b2 = last ? nB : cB + (size_t)(t + 2) * kstepB;
            const char* a3 = a2 + kstepA; const char* b3 = b2 + kstepB;
            if (last && has_next) S.a_ready(nxt);
            if (last) E.prefetch(cur, lds + STAGE_BYTES + 1024, wid, lane);
            if constexpr (SP2) {
            PG8_LDB(B0, 0, 0); PG8_LDB(B1, 0, 1); PG8_SCHED; PG8_LDA(At, 0, 0); PG8_STAGE(PG8_SA(1, 1), a1 + hstep, voffA);
            PG8_WAIT_V(8); PG8_WAIT_L(0); PG8_BAR; PG8_MMA(0, 0, At, B0); PG8_MMA(0, 1, At, B1); PG8_BAR; PG8_SCHED;
            PG8_LDA(At, 0, 1); PG8_STAGE(PG8_SB(0, 0), b2, voffB); PG8_STAGE(PG8_SB(0, 1), b2 + hstep, voffB); PG8_STAGE(PG8_SA(0, 0), a2, voffA);
            PG8_WAIT_V(8); PG8_WAIT_L(0); PG8_BAR; PG8_MMA(1, 0, At, B0); PG8_MMA(1, 1, At, B1); PG8_BAR; PG8_SCHED;
            PG8_LDB(B0, 1, 0); PG8_LDB(B1, 1, 1); PG8_SCHED; PG8_LDA(At, 1, 0); PG8_STAGE(PG8_SA(0, 1), a2 + hstep, voffA);
            PG8_WAIT_V(8); PG8_WAIT_L(0); PG8_BAR; PG8_MMA(0, 0, At, B0); PG8_MMA(0, 1, At, B1); PG8_BAR; PG8_SCHED;
            PG8_LDA(At, 1, 1); PG8_STAGE(PG8_SB(1, 0), b3, voffB); PG8_STAGE(PG8_SB(1, 1), b3 + hstep, voffB); PG8_STAGE(PG8_SA(1, 0), a3, voffA);
            PG8_WAIT_V(8); PG8_WAIT_L(0); PG8_BAR; PG8_MMA(1, 0, At, B0); PG8_MMA(1, 1, At, B1); PG8_BAR; PG8_SCHED;
            } else {
            PG8_LDB(B0, 0, 0); PG8_SCHED; PG8_LDA(At, 0, 0); PG8_STAGE(PG8_SA(1, 1), a1 + hstep, voffA);
            PG8_WAIT_L(8); PG8_BAR; PG8_WAIT_L(0); PG8_MMA(0, 0, At, B0); PG8_BAR; PG8_SCHED;
            PG8_LDB(B1, 0, 1); PG8_STAGE(PG8_SB(0, 0), b2, voffB);
            PG8_BAR; PG8_WAIT_L(0); PG8_MMA(0, 1, At, B1); PG8_BAR;
            PG8_LDA(At, 0, 1); PG8_STAGE(PG8_SA(0, 0), a2, voffA);
            PG8_BAR; PG8_WAIT_L(0); PG8_MMA(1, 0, At, B0); PG8_BAR; PG8_SCHED;
            PG8_STAGE(PG8_SB(0, 1), b2 + hstep, voffB);
            PG8_WAIT_V(6); PG8_BAR; PG8_MMA(1, 1, At, B1); PG8_BAR;
            PG8_LDB(B0, 1, 0); PG8_SCHED; PG8_LDA(At, 1, 0); PG8_STAGE(PG8_SA(0, 1), a2 + hstep, voffA);
            PG8_WAIT_L(8); PG8_BAR; PG8_WAIT_L(0); PG8_MMA(0, 0, At, B0); PG8_BAR; PG8_SCHED;
            PG8_LDB(B1, 1, 1); PG8_STAGE(PG8_SB(1, 0), b3, voffB);
            PG8_BAR; PG8_WAIT_L(0); PG8_MMA(0, 1, At, B1); PG8_BAR;
            PG8_LDA(At, 1, 1); PG8_STAGE(PG8_SA(1, 0), a3, voffA);
            PG8_BAR; PG8_WAIT_L(0); PG8_MMA(1, 0, At, B0); PG8_BAR; PG8_SCHED;
            PG8_STAGE(PG8_SB(1, 1), b3 + hstep, voffB);
            PG8_WAIT_V(6); PG8_BAR; PG8_MMA(1, 1, At, B1); PG8_BAR;
            }
        }
        if constexpr (ALIGN_EPI) { if (wr == 0) PG8_BAR; }
        if constexpr (!Epi::AFTER_DRAIN) { E(acc, cur, wr, wc, fr, fq, lds + STAGE_BYTES + 1024); S.done(cur); }
        if (!has_next) break;
#pragma unroll
        for (int a = 0; a < 2; ++a)
#pragma unroll
            for (int b = 0; b < 2; ++b)
#pragma unroll
                for (int m = 0; m < 4; ++m)
#pragma unroll
                    for (int n = 0; n < 2; ++n) { float z_; asm volatile("v_mov_b32 %0, 0" : "=v"(z_)); acc[a][b][m][n] = (f32x4){z_, z_, z_, z_}; }
        cur = nxt; cA = nA; cB = nB; ++ui;
        if constexpr (ALIGN_EPI) { if (wr == 1) PG8_BAR; }
    }
    PG8_WAIT_V(0);
    if constexpr (!ALIGN_EPI) { if (wr == 0) PG8_BAR; }
    PG8_BAR;
    if constexpr (Epi::AFTER_DRAIN) { E.fused(acc, cur, wr, wc, fr, fq, lds, wid, lane); S.done(cur); }
#undef PG8_SA
#undef PG8_SB
#undef PG8_STAGE
#undef PG8_LDA
#undef PG8_LDB
#undef PG8_MMA
#undef PG8_WAIT_V
#undef PG8_WAIT_L
#undef PG8_BAR
#undef PG8_SCHED
}
}
#define GAS __attribute__((address_space(1)))
#define LAS __attribute__((address_space(3)))
typedef unsigned short bf16;
typedef unsigned v4u __attribute__((ext_vector_type(4)));
typedef float f32x4 __attribute__((ext_vector_type(4)));
typedef short bf16x8 __attribute__((ext_vector_type(8)));
typedef GAS unsigned gu32;
typedef GAS unsigned long long gu64;
#define RLX_AGENT __ATOMIC_RELAXED, __HIP_MEMORY_SCOPE_AGENT
#define LDS_WAIT() asm volatile("s_waitcnt lgkmcnt(0)" ::: "memory")
#define VM_WAIT() asm volatile("s_waitcnt vmcnt(0)" ::: "memory")
__device__ __forceinline__ unsigned long long rt() { return __builtin_amdgcn_s_memrealtime(); }
__device__ __forceinline__ unsigned f2bf(float f) { unsigned u = __builtin_bit_cast(unsigned, f); return (u + 0x7fffu + ((u >> 16) & 1u)) >> 16; }
__device__ __forceinline__ unsigned pk2(float lo, float hi) { return f2bf(lo) | (f2bf(hi) << 16); }

#define XB_TMO      128
#define XB_XCNT(j)  (256  + 64 * (j))
#define XB_XSUB(j)  (1280 + 64 * (j))
#define XB_XGEN(j)  (2304 + 64 * (j))
#define XB_TOP      3328
#define XB_TOPGEN   3392
#define XCD_BAR_WORDS 3456
#define XB_SPIN_CAP (1u << 18)

__device__ __forceinline__ unsigned xb_ld(unsigned* p)              { return __hip_atomic_load(p, __ATOMIC_RELAXED, __HIP_MEMORY_SCOPE_AGENT); }
__device__ __forceinline__ unsigned xb_add(unsigned* p, unsigned v) { return __hip_atomic_fetch_add(p, v, __ATOMIC_RELAXED, __HIP_MEMORY_SCOPE_AGENT); }
__device__ __forceinline__ unsigned xb_xcc_id() { return (unsigned)__builtin_amdgcn_s_getreg((3 << 11) | 20) & 0xFu; }
#define XB_SPIN(cond, bar) do { unsigned _sp = 0; while (cond) { __builtin_amdgcn_s_sleep(1); \
    if ((++_sp & 255u) == 0u) { if (xb_ld(&(bar)[XB_TMO])) break; if (_sp > XB_SPIN_CAP) { atomicAdd(&(bar)[XB_TMO], 1u); break; } } } } while (0)

struct XcdBarrier {
    unsigned* bar; unsigned x;
    volatile LAS unsigned* st;
};

__device__ __forceinline__ XcdBarrier xcd_barrier_post(unsigned* bar, volatile LAS unsigned* st) {
    XcdBarrier b; b.bar = bar; b.x = xb_xcc_id(); b.st = st;
    if (threadIdx.x == 0) (void)xb_add(&bar[XB_XCNT(b.x)], 1u);
    return b;
}
__device__ __forceinline__ void xcd_barrier_complete(unsigned* bar, unsigned x, unsigned& nloc, unsigned& nx) {
    const unsigned G = gridDim.x * gridDim.y * gridDim.z;
    unsigned sum, cnt, mine, sp = 0u;
    for (;;) {
        sum = 0u; cnt = 0u; mine = 0u;
#pragma unroll
        for (unsigned j = 0; j < 16; ++j) { const unsigned c = xb_ld(&bar[XB_XCNT(j)]); sum += c; cnt += (c > 0u) ? 1u : 0u; mine = (j == x) ? c : mine; }
        if (sum == G) break;
        __builtin_amdgcn_s_sleep(1);
        if ((++sp & 255u) == 0u) { if (xb_ld(&bar[XB_TMO])) break; if (sp > XB_SPIN_CAP) { atomicAdd(&bar[XB_TMO], 1u); break; } }
    }
    nloc = mine > 0u ? mine : 1u; nx = cnt > 0u ? cnt : 1u;
}

__device__ __forceinline__ void xcd_barrier(const XcdBarrier& b) {
    asm volatile("s_waitcnt vmcnt(0)" ::: "memory");
    __syncthreads();
    if (threadIdx.x == 0) {
        unsigned* bar = b.bar;
        __builtin_amdgcn_s_waitcnt(0);
        unsigned nloc = b.st[0], nx = b.st[1];
        if (nloc == 0u) { xcd_barrier_complete(bar, b.x, nloc, nx); b.st[0] = nloc; b.st[1] = nx; }
        const unsigned old = xb_add(&bar[XB_XSUB(b.x)], 1u);
        const unsigned gen = old / nloc;
        if (old + 1u == (gen + 1u) * nloc) {
            __builtin_amdgcn_fence(__ATOMIC_RELEASE, "agent");
            asm volatile("s_waitcnt vmcnt(0)" ::: "memory");
            const unsigned og = xb_add(&bar[XB_TOP], 1u);
            const unsigned tg = og / nx;
            if (og + 1u == (tg + 1u) * nx) xb_add(&bar[XB_TOPGEN], 1u);
            else XB_SPIN(xb_ld(&bar[XB_TOPGEN]) == tg, bar);
            __builtin_amdgcn_fence(__ATOMIC_ACQUIRE, "agent");
            xb_add(&bar[XB_XGEN(b.x)], 1u);
            asm volatile("s_waitcnt vmcnt(0)" ::: "memory");
        } else {
            XB_SPIN(xb_ld(&bar[XB_XGEN(b.x)]) == gen, bar);
            __builtin_amdgcn_fence(__ATOMIC_ACQUIRE, "agent");
            asm volatile("s_waitcnt vmcnt(0)" ::: "memory");
        }
    }
    __syncthreads();
}

constexpr int NWAVES = 8;
constexpr int BATCH = 4, SEQ = 8192, D = 1024, M = BATCH * SEQ, DEPTH = 2;
constexpr int INW = 2048, DFF = 2816, NMOD = 6;
constexpr int O_U = 0, O_QB = 256, O_KB = 640, O_VB = 1024, O_QC = 1408, O_KC = 1792, O_VC = 1920;
constexpr float RMS_EPS = 1e-6f;
constexpr float LOG2E = 1.4426950408889634f;
constexpr float QSCALE = 0.125f * LOG2E;

constexpr size_t MiB = 1u << 20;
constexpr size_t WS_CTL = 0, CTL_ZERO_BYTES = 131072;
constexpr size_t WS_MOD = 1 * MiB;
constexpr size_t WS_W = 2 * MiB, W_LAYER = 24 * MiB;
constexpr size_t W_IN = 0, W_OUT = 4 * MiB, W_GU = 6 * MiB, W_DN = 17 * MiB, W_PT = 23 * MiB;
constexpr size_t WS_H = 50 * MiB;
constexpr size_t WS_Z = 114 * MiB;
constexpr size_t WS_MIX = 242 * MiB;
constexpr size_t WS_HID = 114 * MiB;
constexpr size_t WS_XS = 306 * MiB;
constexpr size_t WS_AUX = 434 * MiB;
constexpr size_t WS_SUMSQ = WS_AUX;
constexpr size_t WS_GV = WS_AUX + 1 * MiB;
constexpr size_t WS_BIAS = WS_GV + 65536;
constexpr size_t BIAS_LAYER = (size_t)BATCH * (2048 + 5632) * 4;
constexpr size_t WS_BSCR = 370 * MiB;
constexpr size_t WS_ZC = 202 * MiB;
constexpr size_t WS_ZB = 130 * MiB;
constexpr size_t WS_END = 436 * MiB;
static_assert(WS_Z + (size_t)M * 256 * 2 <= WS_ZB && WS_ZB + 72 * MiB <= WS_ZC && WS_ZC + 40 * MiB <= WS_MIX, "z region map");
static_assert(WS_HID + (size_t)M * DFF * 2 <= WS_XS && WS_MIX + (size_t)M * D * 2 <= WS_XS && WS_Z + (size_t)M * 256 * 2 <= WS_MIX && WS_H + (size_t)M * D * 2 <= WS_Z, "ws map");
constexpr int CW_TMO = 0, CW_CODE = 1, CW_BAR = 4096  , CW_QUEUE = 20480, CW_ZEROS = 24576  ;

constexpr int RING_OFF = 0, RING_BYTES = 131072;
constexpr int LDSCTL_OFF = RING_BYTES, MISC_OFF = 147456 - 256, LSEB_OFF = MISC_OFF - 6144;
constexpr int LDS_BYTES = 147456;

constexpr int PH_PRO = 0, PH_CONV = 1, PH_L0 = 2, PH_PER_LAYER = 5, PH_FINAL = PH_L0 + DEPTH * PH_PER_LAYER, NPHASES = PH_FINAL + 1;
#ifndef PROBE_DUP
#define PROBE_DUP 0
#endif
#ifndef PROBE_CUT
#define PROBE_CUT 0
#endif
#ifndef PROBE_MIXSEL
#define PROBE_MIXSEL 0
#endif
#ifndef PROBE_NOSTORE
#define PROBE_NOSTORE 0
#endif
#ifndef MK_ONE_LAUNCH
#define MK_ONE_LAUNCH 1
#endif

struct Frame {
    LAS unsigned char* lds;
    volatile LAS unsigned* MISC;
    gu32* ctl;
    int tid, lane, wave, G, vcu;
};

__device__ __forceinline__ float wave_sum(float v) {
#pragma unroll
    for (int o = 1; o < 64; o <<= 1) v += __shfl_xor(v, o);
    return v;
}
__device__ __forceinline__ float bf2f(unsigned short b) { return __uint_as_float((unsigned)b << 16); }
__device__ __forceinline__ float zero_() { float z; asm volatile("v_mov_b32 %0, 0" : "=v"(z)); return z; }
__device__ __forceinline__ f32x4 zero4_() { const float z = zero_(); return (f32x4){z, z, z, z}; }

__device__ __forceinline__ void tr_item(const float* W, int N, int k0, int n0, bf16* WT, int ldt, int drow0, float scale, LAS float* scr, int lane, bool img = true) {
#pragma unroll 8
    for (int i = 0; i < 32; ++i) { const int kk = 2 * i + (lane >> 5); scr[kk * 33 + (lane & 31)] = __builtin_nontemporal_load(W + (size_t)(k0 + kk) * N + n0 + (lane & 31)); }
    LDS_WAIT(); asm volatile("" ::: "memory");
    const int c = lane & 7;
#pragma unroll
    for (int j = 0; j < 4; ++j) { const int n = (lane >> 3) + 8 * j; const LAS float* s = scr + (8 * c) * 33 + n;
        v4u o; o.x = pk2(s[0 * 33] * scale, s[1 * 33] * scale); o.y = pk2(s[2 * 33] * scale, s[3 * 33] * scale); o.z = pk2(s[4 * 33] * scale, s[5 * 33] * scale); o.w = pk2(s[6 * 33] * scale, s[7 * 33] * scale);
        if (img) *(GAS v4u*)((unsigned char*)WT + pg8::img_off(drow0 + n, k0 + 8 * c, ldt / 64, true)) = o;
        else *(GAS v4u*)(WT + (size_t)(drow0 + n) * ldt + k0 + 8 * c) = o; }
    LDS_WAIT(); asm volatile("" ::: "memory");
}
constexpr int TI_IN = 16 * 64, TI_OUT = 16 * 32, TI_G = 16 * 88, TI_DN = 44 * 32, TI_P = 8, TI_LAYER = TI_IN + TI_OUT + 2 * TI_G + TI_DN + TI_P;
__device__ __forceinline__ void weight_item(const float* const* in, unsigned char* ws, int it, LAS float* scr, int lane) {
    const int l = it / TI_LAYER; int r = it % TI_LAYER;
    unsigned char* wl = ws + WS_W + (size_t)l * W_LAYER;
    if (r < TI_IN) { const int kb = r / 64, n0 = 32 * (r % 64); const bool isq = (n0 >= O_QB && n0 < O_KB) || (n0 >= O_QC && n0 < O_KC);
        tr_item(in[6] + (size_t)l * D * INW, INW, 64 * kb, n0, (bf16*)(wl + W_IN), D, n0, isq ? QSCALE : 1.0f, scr, lane); return; }
    r -= TI_IN;
    if (r < TI_OUT) { const int kb = r / 32, n0 = 32 * (r % 32); tr_item(in[10] + (size_t)l * D * D, D, 64 * kb, n0, (bf16*)(wl + W_OUT), D, n0, 1.0f, scr, lane); return; }
    r -= TI_OUT;
    if (r < 2 * TI_G) { const int up = r >= TI_G; if (up) r -= TI_G; const int kb = r / 88, n0 = 32 * (r % 88);
        tr_item(in[up ? 12 : 11] + (size_t)l * D * DFF, DFF, 64 * kb, n0, (bf16*)(wl + W_GU), D, 256 * (n0 >> 7) + 128 * up + (n0 & 127), 1.0f, scr, lane); return; }
    r -= 2 * TI_G;
    if (r < TI_DN) { const int kb = r / 32, n0 = 32 * (r % 32); tr_item(in[13] + (size_t)l * DFF * D, D, 64 * kb, n0, (bf16*)(wl + W_DN), DFF, n0, 1.0f, scr, lane); return; }
    r -= TI_DN;
    { const int g = r >> 1, n0 = 32 * (r & 1); tr_item(in[7] + (size_t)l * 16384 + g * 4096, 64, 0, n0, (bf16*)(wl + W_PT) + g * 4096, 64, n0, 1.0f, scr, lane, false); }
}
__device__ __forceinline__ void ada_item(Frame& F, const float* const* in, unsigned char* ws, int item) {
    LAS float* cact = (LAS float*)(F.lds);
    LAS float* red = (LAS float*)(F.lds + 16384);
    const int l = item / 96, cb = item % 96;
    const float* c = in[1];
    for (int i = F.tid; i < BATCH * D; i += NWAVES * 64) { const int b = i >> 10, k = i & 1023; const float v = c[i]; cact[k * 4 + b] = v / (1.0f + __expf(-v)); }
    __syncthreads();
    const float* W = in[4] + (size_t)l * D * (NMOD * D) + 64 * cb + F.lane;
    float a0 = 0.f, a1 = 0.f, a2 = 0.f, a3 = 0.f;
    const int kbeg = 128 * F.wave;
#pragma unroll 16
    for (int kk = 0; kk < 128; ++kk) { const float wv = __builtin_nontemporal_load(W + (size_t)(kbeg + kk) * (NMOD * D)); const f32x4 ca = *(const LAS f32x4*)(cact + (kbeg + kk) * 4);
        a0 += ca.x * wv; a1 += ca.y * wv; a2 += ca.z * wv; a3 += ca.w * wv; }
    red[(F.wave * 4 + 0) * 64 + F.lane] = a0; red[(F.wave * 4 + 1) * 64 + F.lane] = a1; red[(F.wave * 4 + 2) * 64 + F.lane] = a2; red[(F.wave * 4 + 3) * 64 + F.lane] = a3;
    __syncthreads();
    if (F.wave < 4) { float s = in[5][(size_t)l * NMOD * D + 64 * cb + F.lane];
#pragma unroll
        for (int w = 0; w < 8; ++w) s += red[(w * 4 + F.wave) * 64 + F.lane];
        ((float*)(ws + WS_MOD))[((size_t)l * BATCH + F.wave) * (NMOD * D) + 64 * cb + F.lane] = s; }
    __syncthreads();
}
__device__ __forceinline__ void p_prologue(Frame& F, const float* const* in, unsigned char* ws) {
    for (int item = blockIdx.x; item < DEPTH * 96; item += F.G) ada_item(F, in, ws, item);
    LAS float* scr = (LAS float*)(F.lds + RING_OFF + F.wave * 16384);
    const int gw = blockIdx.x * NWAVES + F.wave, NGW = F.G * NWAVES;
    for (int it = gw; it < DEPTH * TI_LAYER; it += NGW) weight_item(in, ws, it, scr, F.lane);
    { GAS f32x4* z = (GAS f32x4*)(ws + WS_SUMSQ) + M / 4; const int n4 = 4 * M / 4;
      for (int i = blockIdx.x * (NWAVES * 64) + F.tid; i < n4; i += F.G * NWAVES * 64) z[i] = zero4_(); }
}

__device__ __forceinline__ void p_conv(Frame& F, const float* const* in, unsigned char* ws) {
    const float* MOD = (const float*)(ws + WS_MOD);
    const int NGW = F.G * NWAVES, gw = blockIdx.x * NWAVES + F.wave, rpw = M / NGW;
    {
        const int row0 = gw * rpw, b = row0 / SEQ;
        const float* mb = MOD + (size_t)b * (NMOD * D);
        const float* xin = in[0]; bf16* hout = (bf16*)(ws + WS_H); float* ssq = (float*)(ws + WS_SUMSQ);
        f32x4 Gv[4];
#pragma unroll
        for (int j = 0; j < 4; ++j) { const int cidx = 4 * F.lane + 256 * j; const f32x4 g = *(const f32x4*)(in[2] + cidx), sc = *(const f32x4*)(mb + 1 * D + cidx); Gv[j] = g * (sc + 1.0f); }
        for (int rr = 0; rr < rpw; rr += 4) {
            f32x4 v[4][4];
#pragma unroll
            for (int i = 0; i < 4; ++i) { const GAS f32x4* xr = (const GAS f32x4*)(xin + (size_t)(row0 + rr + i) * D) + F.lane;
#pragma unroll
                for (int j = 0; j < 4; ++j) v[i][j] = __builtin_nontemporal_load(xr + 64 * j); }
#pragma unroll
            for (int i = 0; i < 4; ++i) { const size_t row = (size_t)(row0 + rr + i); float s = 0.f;
#pragma unroll
                for (int j = 0; j < 4; ++j) s += (v[i][j].x * v[i][j].x + v[i][j].y * v[i][j].y) + (v[i][j].z * v[i][j].z + v[i][j].w * v[i][j].w);
                s = wave_sum(s); if (F.lane == 0) ssq[row] = s;
                unsigned char* hb = (unsigned char*)hout + 8 * (F.lane & 1);
#pragma unroll
                for (int j = 0; j < 4; ++j) { const f32x4 o = v[i][j] * Gv[j]; *(GAS unsigned long long*)(hb + pg8::img_off((int)row, (4 * F.lane + 256 * j) & ~7, D / 64, false)) = (unsigned long long)pk2(o.x, o.y) | ((unsigned long long)pk2(o.z, o.w) << 32);
 } }
        }
    }
    {
        float* GV = (float*)(ws + WS_GV);
        for (int i = blockIdx.x * (NWAVES * 64) + F.tid; i < DEPTH * 2 * BATCH * D; i += F.G * NWAVES * 64) { const int col = i & (D - 1), b = (i >> 10) & 3, w = (i >> 12) & 1, l = i >> 13;
            GV[i] = in[w ? 3 : 2][l * D + col] * (1.0f + MOD[((size_t)l * BATCH + b) * (NMOD * D) + (w ? 4 : 1) * D + col]); }
    }
    {
        const int g0 = 8 * gw;
        if (g0 < DEPTH * (INW + 2 * DFF)) {
            const int l = g0 / (INW + 2 * DFF), rl = g0 % (INW + 2 * DFF), w = rl >= INW, n0 = w ? rl - INW : rl, N = w ? 2 * DFF : INW;
            const unsigned char* Bt = ws + WS_W + (size_t)l * W_LAYER + (w ? W_GU : W_IN);
            float* bias = (float*)(ws + WS_BIAS + (size_t)l * BIAS_LAYER) + (w ? BATCH * INW : 0);
            const float* shp = MOD + (size_t)l * BATCH * (NMOD * D) + (w ? 3 : 0) * D + 16 * F.lane;
            v4u wr[8][2];
#pragma unroll
            for (int i = 0; i < 8; ++i) { wr[i][0] = *(const GAS v4u*)(Bt + pg8::img_off(n0 + i, 16 * F.lane, D / 64, true)); wr[i][1] = *(const GAS v4u*)(Bt + pg8::img_off(n0 + i, 16 * F.lane + 8, D / 64, true)); }
            f32x4 sh[4][4];
#pragma unroll
            for (int b = 0; b < 4; ++b)
#pragma unroll
                for (int j = 0; j < 4; ++j) sh[b][j] = *(const f32x4*)(shp + (size_t)b * (NMOD * D) + 4 * j);
#pragma unroll
            for (int i = 0; i < 8; ++i) { const v4u w0 = wr[i][0], w1 = wr[i][1];
                float wf[16];
                wf[0] = __uint_as_float(w0.x << 16); wf[1] = __uint_as_float(w0.x & 0xffff0000u); wf[2] = __uint_as_float(w0.y << 16); wf[3] = __uint_as_float(w0.y & 0xffff0000u);
                wf[4] = __uint_as_float(w0.z << 16); wf[5] = __uint_as_float(w0.z & 0xffff0000u); wf[6] = __uint_as_float(w0.w << 16); wf[7] = __uint_as_float(w0.w & 0xffff0000u);
                wf[8] = __uint_as_float(w1.x << 16); wf[9] = __uint_as_float(w1.x & 0xffff0000u); wf[10] = __uint_as_float(w1.y << 16); wf[11] = __uint_as_float(w1.y & 0xffff0000u);
                wf[12] = __uint_as_float(w1.z << 16); wf[13] = __uint_as_float(w1.z & 0xffff0000u); wf[14] = __uint_as_float(w1.w << 16); wf[15] = __uint_as_float(w1.w & 0xffff0000u);
                float acc[4];
#pragma unroll
                for (int b = 0; b < 4; ++b) { float a = 0.f;
#pragma unroll
                    for (int j = 0; j < 4; ++j) a += (wf[4 * j] * sh[b][j].x + wf[4 * j + 1] * sh[b][j].y) + (wf[4 * j + 2] * sh[b][j].z + wf[4 * j + 3] * sh[b][j].w);
                    acc[b] = wave_sum(a); }
                if (F.lane < 4) bias[(size_t)F.lane * N + n0 + i] = F.lane == 0 ? acc[0] : F.lane == 1 ? acc[1] : F.lane == 2 ? acc[2] : acc[3]; }
        }
    }
}
__device__ __forceinline__ void p_norm_final(Frame& F, const bf16* xin, const float* ssq, float* out, const float* gvec) {
    const int NGW = F.G * NWAVES, gw = blockIdx.x * NWAVES + F.wave, rpw = M / NGW;
    const int row0 = gw * rpw;
    f32x4 Gv[4];
#pragma unroll
    for (int j = 0; j < 4; ++j) Gv[j] = *(const f32x4*)(gvec + 4 * F.lane + 256 * j);
    for (int rr = 0; rr < rpw; rr += 4) {
        unsigned long long w[4][4]; float ss[4];
#pragma unroll
        for (int i = 0; i < 4; ++i) { const unsigned char* xr = (const unsigned char*)xin + 8 * (F.lane & 1); ss[i] = ssq[row0 + rr + i];
#pragma unroll
            for (int j = 0; j < 4; ++j) w[i][j] = *(const GAS unsigned long long*)(xr + pg8::img_off(row0 + rr + i, (4 * F.lane + 256 * j) & ~7, D / 64, false)); }
#pragma unroll
        for (int i = 0; i < 4; ++i) { const float rstd = 1.0f / sqrtf(ss[i] * (1.0f / D) + RMS_EPS);
            GAS f32x4* o = (GAS f32x4*)(out + (size_t)(row0 + rr + i) * D) + F.lane;
#pragma unroll
            for (int j = 0; j < 4; ++j) { const unsigned wl = (unsigned)w[i][j], wh = (unsigned)(w[i][j] >> 32);
                const f32x4 v = {pg8::h_lo(wl), pg8::h_hi(wl), pg8::h_lo(wh), pg8::h_hi(wh)};
                __builtin_nontemporal_store(v * rstd * Gv[j], o + 64 * j); } }
    }
}

namespace mx {
typedef short bf16x8 __attribute__((ext_vector_type(8)));
typedef short s16x4 __attribute__((ext_vector_type(4)));
typedef float f32x16 __attribute__((ext_vector_type(16)));
typedef unsigned u32x4 __attribute__((ext_vector_type(4)));
typedef unsigned u32x2 __attribute__((ext_vector_type(2)));
typedef float f32x2_t __attribute__((ext_vector_type(2))); typedef __bf16 bf16x2_t __attribute__((ext_vector_type(2)));
constexpr float THR = 8.0f;
constexpr int POOL_PITCH = 544;
__device__ __forceinline__ unsigned cvtpk(float lo, float hi) { f32x2_t v = {lo, hi}; bf16x2_t b = __builtin_convertvector(v, bf16x2_t); return __builtin_bit_cast(unsigned, b); }
__device__ __forceinline__ float hswap_max(float v) { auto rr = __builtin_amdgcn_permlane32_swap(__float_as_uint(v), __float_as_uint(v), false, false); return fmaxf(__uint_as_float(rr[0]), __uint_as_float(rr[1])); }
__device__ __forceinline__ float hswap_sum(float v) { auto rr = __builtin_amdgcn_permlane32_swap(__float_as_uint(v), __float_as_uint(v), false, false); return __uint_as_float(rr[0]) + __uint_as_float(rr[1]); }
__device__ __forceinline__ s16x4 vtr(const LAS char* p) { return __builtin_bit_cast(s16x4, __builtin_amdgcn_ds_read_tr16_b64_v4i16((LAS s16x4*)p)); }
__device__ __forceinline__ f32x16 zero16_() { const float z = zero_(); return (f32x16){z, z, z, z, z, z, z, z, z, z, z, z, z, z, z, z}; }
__device__ __forceinline__ int kt_of(int i) { return (i & 1) ? -((i + 1) >> 1) : (i >> 1); }

template <int VAR>
__device__ __forceinline__ float scores(f32x16& t, const bf16x8 (&kf)[4], const bf16x8 (&qf)[4], float relf, float sl, float slope2, float Rf) {
    f32x16 s = {0.f, 0.f, 0.f, 0.f, 0.f, 0.f, 0.f, 0.f, 0.f, 0.f, 0.f, 0.f, 0.f, 0.f, 0.f, 0.f};
#pragma unroll
    for (int i = 0; i < 4; ++i) s = __builtin_amdgcn_mfma_f32_32x32x16_bf16(kf[i], qf[i], s, 0, 0, 0);
    if (VAR == 0) {
#pragma unroll
        for (int r = 0; r < 16; ++r) t[r] = __builtin_fmaf(-__builtin_fabsf(relf - (float)((r & 3) + 8 * (r >> 2))), slope2, s[r]);
        return 0.f;
    } else {
#pragma unroll
        for (int r = 0; r < 16; ++r) { const float c = (float)((r & 3) + 8 * (r >> 2)); float v = __builtin_fmaf(sl, c, s[r]); if (VAR == 2) v = __builtin_fabsf(relf - c) > Rf ? -INFINITY : v; t[r] = v; }
        return -sl * relf;
    }
}
__device__ __forceinline__ float lane_max(const f32x16& t) {
    float a = fmaxf(fmaxf(t[0], t[1]), fmaxf(t[2], t[3])), b = fmaxf(fmaxf(t[4], t[5]), fmaxf(t[6], t[7])), c = fmaxf(fmaxf(t[8], t[9]), fmaxf(t[10], t[11])), d = fmaxf(fmaxf(t[12], t[13]), fmaxf(t[14], t[15]));
    return fmaxf(fmaxf(a, b), fmaxf(c, d));
}
__device__ __forceinline__ float tile_max(const f32x16& t) {
    float a = fmaxf(fmaxf(t[0], t[1]), fmaxf(t[2], t[3])), b = fmaxf(fmaxf(t[4], t[5]), fmaxf(t[6], t[7])), c = fmaxf(fmaxf(t[8], t[9]), fmaxf(t[10], t[11])), d = fmaxf(fmaxf(t[12], t[13]), fmaxf(t[14], t[15]));
    return hswap_max(fmaxf(fmaxf(a, b), fmaxf(c, d)));
}
__device__ __forceinline__ void load_frag4(bf16x8 (&f)[4], const bf16* rowp, int hi) {
#pragma unroll
    for (int i = 0; i < 4; ++i) f[i] = *(const bf16x8*)(rowp + 16 * i + 8 * hi);
}
__device__ __forceinline__ void load_tile_frags(bf16x8 (&f)[4], const char* tile, int lane) {
#pragma unroll
    for (int s = 0; s < 4; ++s) f[s] = *(const bf16x8*)(tile + s * 1024 + lane * 16);
}
__device__ __forceinline__ void dma_tile(LAS char* dst, const char* tile, int lane) {
#pragma unroll
    for (int j = 0; j < 4; ++j) __builtin_amdgcn_global_load_lds((const unsigned*)(tile + j * 1024 + lane * 16), (LAS unsigned*)(dst + j * 1024), 16, 0, 0);
}
__device__ __forceinline__ void dma_v(LAS char* vb, const bf16* vrow0, long rs, int lane) {
#pragma unroll
    for (int j = 0; j < 4; ++j) __builtin_amdgcn_global_load_lds((const unsigned*)(vrow0 + (long)(16 * (j & 1) + (lane >> 2)) * rs + (4 * (j >> 1) + (lane & 3)) * 8), (LAS unsigned*)(vb + j * 1024), 16, 0, 0);
}
__device__ __forceinline__ void load_vfrags(bf16x8 (&vf)[2][2], const LAS char* vaddr) {
#pragma unroll
    for (int d0 = 0; d0 < 2; ++d0)
#pragma unroll
        for (int ks = 0; ks < 2; ++ks) { const s16x4 lo = vtr(vaddr + d0 * 2048 + ks * 1024), hh = vtr(vaddr + d0 * 2048 + ks * 1024 + 512);
            vf[d0][ks] = (bf16x8){lo[0], lo[1], lo[2], lo[3], hh[0], hh[1], hh[2], hh[3]}; }
}
__device__ __forceinline__ void pv_tile(f32x16 (&o)[2], const bf16x8 (&vf)[2][2], const f32x16& p) {
    u32x4 w0, w1;
    w0.x = cvtpk(p[0], p[1]); w0.y = cvtpk(p[2], p[3]); w0.z = cvtpk(p[4], p[5]); w0.w = cvtpk(p[6], p[7]);
    w1.x = cvtpk(p[8], p[9]); w1.y = cvtpk(p[10], p[11]); w1.z = cvtpk(p[12], p[13]); w1.w = cvtpk(p[14], p[15]);
    const bf16x8 pa0 = __builtin_bit_cast(bf16x8, w0), pa1 = __builtin_bit_cast(bf16x8, w1);
#pragma unroll
    for (int d0 = 0; d0 < 2; ++d0) { o[d0] = __builtin_amdgcn_mfma_f32_32x32x16_bf16(vf[d0][0], pa0, o[d0], 0, 0, 0); o[d0] = __builtin_amdgcn_mfma_f32_32x32x16_bf16(vf[d0][1], pa1, o[d0], 0, 0, 0); }
}
__device__ __forceinline__ void store_o(bf16* MIX, int row, int col, const f32x16 (&o)[2], float scale, int hi) {
#pragma unroll
    for (int d0 = 0; d0 < 2; ++d0)
#pragma unroll
        for (int g = 0; g < 4; g += 2) {
            const unsigned ax = cvtpk(o[d0][4 * g] * scale, o[d0][4 * g + 1] * scale), ay = cvtpk(o[d0][4 * g + 2] * scale, o[d0][4 * g + 3] * scale);
            const unsigned bx = cvtpk(o[d0][4 * g + 4] * scale, o[d0][4 * g + 5] * scale), by = cvtpk(o[d0][4 * g + 6] * scale, o[d0][4 * g + 7] * scale);
            const auto rx = __builtin_amdgcn_permlane32_swap(ax, bx, false, false); const auto ry = __builtin_amdgcn_permlane32_swap(ay, by, false, false);
            u32x4 w; w.x = rx[0]; w.y = ry[0]; w.z = rx[1]; w.w = ry[1];
            *(u32x4*)((unsigned char*)MIX + pg8::img_off(row, col + 32 * d0 + 8 * g + 8 * hi, D / 64, false)) = w; }
}
__device__ __forceinline__ void pack_o(u32x4 (&w)[4], const f32x16 (&o)[2], float scale) {
#pragma unroll
    for (int d0 = 0; d0 < 2; ++d0)
#pragma unroll
        for (int g = 0; g < 4; g += 2) {
            const unsigned ax = cvtpk(o[d0][4 * g] * scale, o[d0][4 * g + 1] * scale), ay = cvtpk(o[d0][4 * g + 2] * scale, o[d0][4 * g + 3] * scale);
            const unsigned bx = cvtpk(o[d0][4 * g + 4] * scale, o[d0][4 * g + 5] * scale), by = cvtpk(o[d0][4 * g + 6] * scale, o[d0][4 * g + 7] * scale);
            const auto rx = __builtin_amdgcn_permlane32_swap(ax, bx, false, false); const auto ry = __builtin_amdgcn_permlane32_swap(ay, by, false, false);
            w[2 * d0 + (g >> 1)] = (u32x4){rx[0], ry[0], rx[1], ry[1]}; }
}
__device__ __forceinline__ float alibi_slope(int k  ) { return __builtin_amdgcn_exp2f(-8.0f * (float)(k + 1) / 12.0f); }
__device__ __forceinline__ void scale_o(f32x16 (&o)[2], float f) {
#pragma unroll
    for (int r = 0; r < 16; ++r) { o[0][r] *= f; o[1][r] *= f; }
}

template <bool FIRST, bool WITH_O>
__device__ __forceinline__ void step_rest(f32x16 (&o)[2], float& m, float& l, f32x16& t, float off, const bf16x8 (&vf)[2][2]) {
    const float tm = hswap_max(lane_max(t) + off);
    if (FIRST) m = tm;
    else if (__any(tm - m > THR)) { const float dl = fmaxf(tm - m, 0.f), f = __builtin_amdgcn_exp2f(-dl); l *= f; if (WITH_O) scale_o(o, f); m += dl; }
    const float bm = off - m; float ps = 0.f;
#pragma unroll
    for (int r = 0; r < 16; ++r) { t[r] = __builtin_amdgcn_exp2f(t[r] + bm); ps += t[r]; }
    l += ps;
    if (WITH_O) pv_tile(o, vf, t);
}
template <int VAR, bool FIRST, bool WITH_O>
__device__ __forceinline__ void step(f32x16 (&o)[2], float& m, float& l, const bf16x8 (&kf)[4], const bf16x8 (&qf)[4], const bf16x8 (&vf)[2][2], float relf, float sl, float slope2, float Rf) {
    f32x16 t; const float off = scores<VAR>(t, kf, qf, relf, sl, slope2, Rf);
    step_rest<FIRST, WITH_O>(o, m, l, t, off, vf);
}

__device__ __forceinline__ void pair_rest(f32x16 (&o)[2], float& m, float& l, f32x16& tL, f32x16& tR, float offL, float offR, const LAS char* vL, const LAS char* vR) {
    const float tm = hswap_max(fmaxf(lane_max(tL) + offL, lane_max(tR) + offR));
    if (__any(tm - m > THR)) { const float dl = fmaxf(tm - m, 0.f), f = __builtin_amdgcn_exp2f(-dl); l *= f; scale_o(o, f); m += dl; }
    const float bL = offL - m, bR = offR - m; float psL = 0.f, psR = 0.f;
#pragma unroll
    for (int r = 0; r < 16; ++r) { tL[r] = __builtin_amdgcn_exp2f(tL[r] + bL); tR[r] = __builtin_amdgcn_exp2f(tR[r] + bR); psL += tL[r]; psR += tR[r]; }
    l += psL + psR;
    { bf16x8 vf[2][2]; load_vfrags(vf, vL); pv_tile(o, vf, tL); }
    { bf16x8 vf[2][2]; load_vfrags(vf, vR); pv_tile(o, vf, tR); }
}
template <int VAR>
__device__ __forceinline__ void step_pair_lds(f32x16 (&o)[2], float& m, float& l, const LAS char* kL, const LAS char* kR, const LAS char* vL, const LAS char* vR, bf16x8 (&qf)[4],
                                              float relfL, float relfR, float slope2, float Rf, const char* qnext = nullptr, int lane = 0) {
    f32x16 tL, tR; float offL, offR;
    { bf16x8 kf[4];
#pragma unroll
      for (int s = 0; s < 4; ++s) kf[s] = *(const LAS bf16x8*)(kL + s * 1024);
      offL = scores<VAR>(tL, kf, qf, relfL, slope2, slope2, Rf); }
    { bf16x8 kf[4];
#pragma unroll
      for (int s = 0; s < 4; ++s) kf[s] = *(const LAS bf16x8*)(kR + s * 1024);
      offR = scores<VAR>(tR, kf, qf, relfR, -slope2, slope2, Rf); }
    if (qnext) load_tile_frags(qf, qnext, lane);
    pair_rest(o, m, l, tL, tR, offL, offR, vL, vR);
}
template <int VAR>
__device__ __forceinline__ void step_pair_regk(f32x16 (&o)[2], float& m, float& l, const bf16x8 (&kfL)[4], const bf16x8 (&kfR)[4], const LAS char* vL, const LAS char* vR, const bf16x8 (&qf)[4],
                                               float relfL, float relfR, float slope2, float Rf) {
    f32x16 tL, tR; const float offL = scores<VAR>(tL, kfL, qf, relfL, slope2, slope2, Rf), offR = scores<VAR>(tR, kfR, qf, relfR, -slope2, slope2, Rf);
    pair_rest(o, m, l, tL, tR, offL, offR, vL, vR);
}

__device__ __forceinline__ void dma_k(LAS char* kb, const bf16* krow0, long rs, int lane) {
#pragma unroll
    for (int s = 0; s < 4; ++s) __builtin_amdgcn_global_load_lds((const unsigned*)(krow0 + (long)(lane & 31) * rs + 16 * s + 8 * (lane >> 5)), (LAS unsigned*)(kb + s * 1024), 16, 0, 0);
}
struct BTile { const char* qb; const char* kb; const char* vb; int nt  , t0  , n0, head, d, r, tl; float slope2; };
__device__ __forceinline__ BTile b_decode(const char* ZB, int b, int c, int j, int qi, int q) {
    BTile t; const int g = qi >> 4, i = qi & 15, lg = 2 * g; t.d = 1 << lg;
    t.r = i >> (4 - lg); const int isub = i & ((16 >> lg) - 1); t.n0 = ((512 * c) >> lg) + 32 * isub; t.nt = 256 >> lg; t.t0 = t.n0 >> 5;
    t.head = 2 * g + j; t.slope2 = alibi_slope(6 + t.head) * (float)t.d * LOG2E;
    const size_t tb = (size_t)(t.head * 4 + b) * 256 + ((size_t)t.r << (8 - lg));
    t.qb = ZB + (tb << 12); t.kb = ZB + ((tb + 6 * 4 * 256) << 12); t.vb = ZB + ((tb + 2 * 6 * 4 * 256) << 12);
    t.tl = g * 512 + (32 * isub + q) * t.d + t.r;
    return t;
}
__device__ __forceinline__ void b_issue_qk(const BTile& t, bf16x8 (&qf)[4], bf16x8 (&kf)[5][4], bool (&val)[5], int (&kc)[5], int lane) {
    load_tile_frags(qf, t.qb + ((size_t)t.t0 << 12), lane);
#pragma unroll
    for (int i = 0; i < 5; ++i) { const int kt = t.t0 + kt_of(i); val[i] = kt >= 0 && kt < t.nt; kc[i] = kt < 0 ? 0 : (kt >= t.nt ? t.nt - 1 : kt);
        load_tile_frags(kf[i], t.kb + ((size_t)kc[i] << 12), lane); }
}
__device__ __forceinline__ void fill_ninf(f32x16& t) {
#pragma unroll
    for (int r = 0; r < 16; ++r) t[r] = -INFINITY;
}
__device__ __forceinline__ float b_qtile(f32x16 (&o)[2], const BTile& t, const BTile& tn, bool has_next, bf16x8 (&qf)[4], bf16x8 (&kf)[5][4], bool (&val)[5], int (&kc)[5], LAS char* vb, int lane) {
    const int q = lane & 31, hi = lane >> 5;
    const float slope2 = t.slope2;
    const LAS char* vaddr = vb + (4 * hi + ((lane & 15) >> 2)) * 64 + ((lane >> 4) & 1) * 32 + (lane & 3) * 8;
    float m = 0.f, l = 0.f;
    {
        bf16x8 vf[2][2]; load_vfrags(vf, vaddr);
        asm volatile("s_waitcnt lgkmcnt(0)" ::: "memory"); dma_tile(vb, t.vb + ((size_t)kc[4] << 12), lane);
        step<0, true, true>(o, m, l, kf[0], qf, vf, (float)(q - 4 * hi), slope2, slope2, 64.0f); }
    {
        f32x16 tL, tR; const float offL = scores<1>(tL, kf[1], qf, (float)(q + 32 - 4 * hi), slope2, slope2, 64.0f), offR = scores<1>(tR, kf[2], qf, (float)(q - 32 - 4 * hi), -slope2, slope2, 64.0f);
        if (!val[1]) fill_ninf(tL); if (!val[2]) fill_ninf(tR);
        pair_rest(o, m, l, tL, tR, offL, offR, vaddr + 4096, vaddr + 8192); }
    asm volatile("s_waitcnt vmcnt(0)" ::: "memory");
    {
        f32x16 tL, tR; const float offL = scores<2>(tL, kf[3], qf, (float)(q + 64 - 4 * hi), slope2, slope2, 64.0f), offR = scores<2>(tR, kf[4], qf, (float)(q - 64 - 4 * hi), -slope2, slope2, 64.0f);
        if (!val[3]) fill_ninf(tL); if (!val[4]) fill_ninf(tR);
        if (has_next) {
            asm volatile("s_waitcnt lgkmcnt(0)" ::: "memory");
            b_issue_qk(tn, qf, kf, val, kc, lane);
            dma_tile(vb + 4096, tn.vb + ((size_t)kc[1] << 12), lane); dma_tile(vb + 8192, tn.vb + ((size_t)kc[2] << 12), lane); }
        pair_rest(o, m, l, tL, tR, offL, offR, vaddr + 12288, vaddr);
        if (has_next) { asm volatile("s_waitcnt lgkmcnt(0)" ::: "memory");
            dma_tile(vb, tn.vb + ((size_t)kc[0] << 12), lane); dma_tile(vb + 12288, tn.vb + ((size_t)kc[3] << 12), lane); } }
    const float lt = hswap_sum(l);
    scale_o(o, 1.0f / lt);
    return m + __builtin_amdgcn_logf(lt);
}
__device__ __forceinline__ void b_unit(const char* ZB, bf16* MIX, char* SCR, int u, LAS char* lds, int wave, int lane) {
    const int b = u >> 5, c = (u >> 1) & 15, j = u & 1;
    LAS float* lseb = (LAS float*)(lds + LSEB_OFF);
    LAS char* vb = lds + wave * 16384;
    char* scr = SCR + ((size_t)(u * 8 + wave) * 6 << 12) + lane * 16;
    const int q = lane & 31, hi = lane >> 5;
    bf16x8 qf[4], kf[5][4]; bool val[5]; int kc[5];
    BTile t = b_decode(ZB, b, c, j, wave, q);
    b_issue_qk(t, qf, kf, val, kc, lane);
#pragma unroll
    for (int i = 0; i < 4; ++i) dma_tile(vb + i * 4096, t.vb + ((size_t)kc[i] << 12), lane);
#pragma unroll 1
    for (int it = 0; it < 6; ++it) { const bool has_next = it < 5; const BTile tn = b_decode(ZB, b, c, j, wave + 8 * (has_next ? it + 1 : it), q);
        if (it == 0) asm volatile("s_waitcnt vmcnt(0)" ::: "memory"); else asm volatile("s_waitcnt vmcnt(4)" ::: "memory");
        f32x16 o[2]; o[0] = zero16_(); o[1] = zero16_();
        const float lse = b_qtile(o, t, tn, has_next, qf, kf, val, kc, vb, lane);
        if (hi == 0) lseb[t.tl] = lse;
        u32x4 w[4]; pack_o(w, o, 1.0f);
#pragma unroll
        for (int k = 0; k < 4; ++k) *(u32x4*)(scr + ((size_t)it << 12) + k * 1024) = w[k];
        t = tn; }
    __syncthreads();
#pragma unroll 1
    for (int it0 = 0; it0 < 6; it0 += 3) { u32x4 w[3][4];
#pragma unroll
        for (int ii = 0; ii < 3; ++ii)
#pragma unroll
            for (int k = 0; k < 4; ++k) w[ii][k] = *(const u32x4*)(scr + ((size_t)(it0 + ii) << 12) + k * 1024);
#pragma unroll
        for (int ii = 0; ii < 3; ++ii) { const BTile tt = b_decode(ZB, b, c, j, wave + 8 * (it0 + ii), q);
            const int tk = tt.tl & 511; const float l0 = lseb[tk], l1 = lseb[512 + tk], l2 = lseb[1024 + tk], own = lseb[tt.tl]; const float mm = fmaxf(l0, fmaxf(l1, l2));
            const float a = __builtin_amdgcn_exp2f(own - mm) / (__builtin_amdgcn_exp2f(l0 - mm) + __builtin_amdgcn_exp2f(l1 - mm) + __builtin_amdgcn_exp2f(l2 - mm));
            const int orow = b * SEQ + (tt.n0 + q) * tt.d + tt.r, ocol = 256 + 64 * tt.head + 8 * hi;
#pragma unroll
            for (int k = 0; k < 4; ++k) { const u32x4 x = w[ii][k]; u32x4 y;
                y.x = cvtpk(__uint_as_float(x.x << 16) * a, __uint_as_float(x.x & 0xffff0000u) * a); y.y = cvtpk(__uint_as_float(x.y << 16) * a, __uint_as_float(x.y & 0xffff0000u) * a);
                y.z = cvtpk(__uint_as_float(x.z << 16) * a, __uint_as_float(x.z & 0xffff0000u) * a); y.w = cvtpk(__uint_as_float(x.w << 16) * a, __uint_as_float(x.w & 0xffff0000u) * a);
                *(u32x4*)((unsigned char*)MIX + pg8::img_off(orow, ocol + 32 * (k >> 1) + 16 * (k & 1), D / 64, false)) = y; } } }
    __syncthreads();
}
__device__ __forceinline__ void c_unit(const char* ZC, bf16* MIX, const float* sink, int u, LAS char* lds, int wave, int lane) {
    const int b = u >> 6, kvh = (u >> 5) & 1, q0 = 256 * (u & 31), n0 = q0 + 32 * wave;
    const int q = lane & 31, hi = lane >> 5;
    const char* kt0 = ZC + ((size_t)((6 + kvh) * 4 + b) * 256 << 12); const char* vt0 = ZC + ((size_t)((8 + kvh) * 4 + b) * 256 << 12);
#pragma unroll
    for (int tt = 0; tt < 2; ++tt) { const int t = 2 * wave + tt, T = (q0 >> 5) - 4 + t;
        if (T >= 0 && T < SEQ / 32) { dma_tile(lds + t * 8192, kt0 + ((size_t)T << 12), lane); dma_tile(lds + t * 8192 + 4096, vt0 + ((size_t)T << 12), lane); } }
    const char* qt0 = ZC + (((size_t)((3 * kvh) * 4 + b) * 256 + (n0 >> 5)) << 12);
    bf16x8 qf[4]; load_tile_frags(qf, qt0, lane);
    asm volatile("s_waitcnt vmcnt(0)" ::: "memory");
    __syncthreads();
    const LAS char* kbase = lds + lane * 16;
    const LAS char* vbase = lds + 4096 + (4 * hi + ((lane & 15) >> 2)) * 64 + ((lane >> 4) & 1) * 32 + (lane & 3) * 8;
#pragma unroll 1
    for (int hh = 0; hh < 3; ++hh) { const int head = 3 * kvh + hh;
        const char* qnext = hh < 2 ? qt0 + ((size_t)(hh + 1) * 4 * 256 << 12) : nullptr; bool reloaded = false;
        f32x16 o[2]; o[0] = zero16_(); o[1] = zero16_();
        float m = sink[head] * LOG2E, l = hi ? 0.f : 1.0f; const float slope2 = alibi_slope(head) * LOG2E;
        {
            const int t = wave + 4; bf16x8 kf[4];
#pragma unroll
            for (int s = 0; s < 4; ++s) kf[s] = *(const LAS bf16x8*)(kbase + t * 8192 + s * 1024);
            bf16x8 vf[2][2]; load_vfrags(vf, vbase + t * 8192);
            step<0, false, true>(o, m, l, kf, qf, vf, (float)(q - 4 * hi), slope2, slope2, 128.0f); }
#pragma unroll 1
        for (int k = 1; k <= 4; ++k) { const int tL = wave + 4 - k, tR = wave + 4 + k; const bool vL = n0 - 32 * k >= 0, vR = n0 + 32 * k < SEQ;
            const float relfL = (float)(q + 32 * k - 4 * hi), relfR = (float)(q - 32 * k - 4 * hi);
            if (vL && vR) {
                if (k < 4) step_pair_lds<1>(o, m, l, kbase + tL * 8192, kbase + tR * 8192, vbase + tL * 8192, vbase + tR * 8192, qf, relfL, relfR, slope2, 128.0f);
                else { step_pair_lds<2>(o, m, l, kbase + tL * 8192, kbase + tR * 8192, vbase + tL * 8192, vbase + tR * 8192, qf, relfL, relfR, slope2, 128.0f, qnext, lane); reloaded = true; } }
            else if (vL || vR) { const int t = vL ? tL : tR; bf16x8 kf[4];
#pragma unroll
                for (int s = 0; s < 4; ++s) kf[s] = *(const LAS bf16x8*)(kbase + t * 8192 + s * 1024);
                bf16x8 vf[2][2]; load_vfrags(vf, vbase + t * 8192);
                const float relf = vL ? relfL : relfR, sl = vL ? slope2 : -slope2;
                if (k < 4) step<1, false, true>(o, m, l, kf, qf, vf, relf, sl, slope2, 128.0f); else step<2, false, true>(o, m, l, kf, qf, vf, relf, sl, slope2, 128.0f); } }
        if (!reloaded && qnext) load_tile_frags(qf, qnext, lane);
        store_o(MIX, b * SEQ + n0 + q, 640 + 64 * head, o, 1.0f / hswap_sum(l), hi); }
    __syncthreads();
}
template <int G>
__device__ __forceinline__ void pool_group(const LAS char* rows, bf16* MIX, const bf16* wpt, const float* pscale, int row0, int tok, int kq, int lane) {
    constexpr int R = 1 << G, W = 2 * R + 1;
    int lo = tok - R, hi2 = tok + R + 1; lo = lo < 0 ? 0 : lo; hi2 = hi2 > SEQ ? SEQ : hi2; const float inv = 1.0f / (float)(hi2 - lo);
    f32x4 acc[4];
#pragma unroll
    for (int dt = 0; dt < 4; ++dt) acc[dt] = zero4_();
#pragma unroll
    for (int kb = 0; kb < 2; ++kb) { float s[8]; bf16x8 uc;
        const LAS char* rp = rows + ((lane & 15) + 8 - R) * POOL_PITCH + (8 * G + 4 * kb + kq) * 16;
#pragma unroll
        for (int e = 0; e < 8; ++e) s[e] = 0.f;
#pragma unroll
        for (int j = 0; j < W; ++j) { const int tt = tok + j - R; const float w = (tt >= 0 && tt < SEQ) ? 1.0f : 0.0f; const bf16x8 v = *(const LAS bf16x8*)(rp + j * POOL_PITCH); if (j == R) uc = v;
#pragma unroll
            for (int e = 0; e < 8; ++e) s[e] += w * bf2f((unsigned short)v[e]); }
        u32x4 pw; float pe[8];
#pragma unroll
        for (int e = 0; e < 8; ++e) pe[e] = s[e] * inv - bf2f((unsigned short)uc[e]);
        pw.x = cvtpk(pe[0], pe[1]); pw.y = cvtpk(pe[2], pe[3]); pw.z = cvtpk(pe[4], pe[5]); pw.w = cvtpk(pe[6], pe[7]);
        const bf16x8 bfrag = __builtin_bit_cast(bf16x8, pw);
#pragma unroll
        for (int dt = 0; dt < 4; ++dt) { const bf16x8 afrag = *(const bf16x8*)(wpt + (size_t)(G * 64 + dt * 16 + (lane & 15)) * 64 + kb * 32 + 8 * kq);
            acc[dt] = __builtin_amdgcn_mfma_f32_16x16x32_bf16(afrag, bfrag, acc[dt], 0, 0, 0); } }
#pragma unroll
    for (int dt = 0; dt < 4; ++dt) { const int dcol = G * 64 + dt * 16 + 4 * kq; const f32x4 sc = *(const f32x4*)(pscale + dcol);
        u32x2 w; w.x = cvtpk(acc[dt][0] * sc.x, acc[dt][1] * sc.y); w.y = cvtpk(acc[dt][2] * sc.z, acc[dt][3] * sc.w);
        *(u32x2*)((unsigned char*)MIX + pg8::img_off(row0 + (lane & 15), dcol & ~7, D / 64, false) + 2 * (dcol & 7)) = w; }
}
__device__ __forceinline__ void pool_item(const bf16* Z, bf16* MIX, const bf16* wpt, const float* pscale, int item, LAS char* rows, int lane) {
    const int row0 = 16 * item, b = row0 / SEQ, t0 = row0 % SEQ;
    const int tok = t0 + (lane & 15), kq = lane >> 4;
    const bf16* zb = Z + (size_t)b * SEQ * 256;
    u32x4 st[16];
#pragma unroll
    for (int i = 0; i < 16; ++i) { const int idx = i * 64 + lane, r = idx >> 5, c = idx & 31; int tt = t0 - 8 + r; tt = (tt >= 0 && tt < SEQ) ? tt : t0; st[i] = *(const u32x4*)(zb + (size_t)tt * 256 + 8 * c); }
#pragma unroll
    for (int i = 0; i < 16; ++i) { const int idx = i * 64 + lane, r = idx >> 5, c = idx & 31; *(LAS u32x4*)(rows + r * POOL_PITCH + c * 16) = st[i]; }
    pool_group<0>(rows, MIX, wpt, pscale, row0, tok, kq, lane); pool_group<1>(rows, MIX, wpt, pscale, row0, tok, kq, lane);
    pool_group<2>(rows, MIX, wpt, pscale, row0, tok, kq, lane); pool_group<3>(rows, MIX, wpt, pscale, row0, tok, kq, lane);
}
constexpr int N_B_UNITS = 128, N_C_UNITS = 256, N_P_ITEMS = M / 16;
}

__device__ __forceinline__ void p_mixers(Frame& F, const float* const* in, unsigned char* ws, int lq, int sel  ) {
    const int l = lq & 1;
    const bf16* Z = (const bf16*)(ws + WS_Z); bf16* MIX = (bf16*)(ws + WS_MIX);
    LAS char* lds = (LAS char*)F.lds;
    const float* sink = in[9] + 6 * l;
    {
        const int nb = (F.G >= 2 * mx::N_B_UNITS) ? mx::N_B_UNITS : (F.G + 1) / 2;
        const bool xl = (F.G == 256);
        if ((int)blockIdx.x < nb) {
            if (sel & 1) {
#pragma unroll 1
                for (int u0 = blockIdx.x; u0 < mx::N_B_UNITS; u0 += nb) { const int u = xl ? ((u0 & 7) >> 1) * 32 + (u0 >> 3) * 2 + (u0 & 1) : u0;     unsigned z_; asm volatile("v_mov_b32 %0, 0" : "=v"(z_)); const int lane = (int)__builtin_amdgcn_mbcnt_hi(~0u, __builtin_amdgcn_mbcnt_lo(~0u, z_)); mx::b_unit((const char*)(ws + WS_ZB), MIX, (char*)(ws + WS_BSCR), u, lds, F.wave, lane); } }
        } else if (sel & 2) {
#pragma unroll 1
            for (int v = (int)blockIdx.x - nb, u0 = v, k = 0; u0 < mx::N_C_UNITS; u0 += F.G - nb, ++k) { const int u = xl ? (v & 7) * 32 + (v >> 3) * 2 + k : u0;     unsigned z_; asm volatile("v_mov_b32 %0, 0" : "=v"(z_)); const int lane = (int)__builtin_amdgcn_mbcnt_hi(~0u, __builtin_amdgcn_mbcnt_lo(~0u, z_)); mx::c_unit((const char*)(ws + WS_ZC), MIX, sink, u, lds, F.wave, lane); }
        }
        __syncthreads();
    }
    if (sel & 4) { const bf16* wpt = (const bf16*)(ws + WS_W + (size_t)l * W_LAYER + W_PT); const float* pscale = in[8] + 256 * l;
        for (int it = blockIdx.x * NWAVES + F.wave; it < mx::N_P_ITEMS; it += F.G * NWAVES) mx::pool_item(Z, MIX, wpt, pscale, it, lds + F.wave * (32 * mx::POOL_PITCH), F.lane); }
}

struct Args { const float* in[15]; float* out; unsigned char* ws; int ph_lo, ph_hi, li, dup; };
__global__ void __launch_bounds__(NWAVES * 64, 2) mk_fwd(Args args) {
    extern __shared__ __attribute__((aligned(16))) unsigned char lds[];
    Frame F;
    F.lds = (LAS unsigned char*)lds;
    F.MISC = (volatile LAS unsigned*)(F.lds + MISC_OFF);
    F.tid = threadIdx.x; F.lane = F.tid & 63; F.wave = __builtin_amdgcn_readfirstlane(F.tid >> 6);
    const int wave0 = F.wave;
    F.G = gridDim.x; { const int bx = blockIdx.x; F.vcu = (F.G % 8 == 0) ? (bx % 8) * (F.G / 8) + bx / 8 : bx; }
    unsigned char* ws = args.ws;
    F.ctl = (gu32*)(ws + WS_CTL);
    for (int u = F.tid; u < (LDS_BYTES - LDSCTL_OFF) / 4; u += NWAVES * 64) ((LAS unsigned*)(F.lds + LDSCTL_OFF))[u] = 0u;
    __syncthreads();
    XcdBarrier bar; bar.bar = (unsigned*)(F.ctl + CW_BAR) + args.li * XCD_BAR_WORDS; bar.x = 0; bar.st = nullptr;
    const int lo = args.ph_lo, hi = args.ph_hi;
    if (hi - lo > 1) bar = xcd_barrier_post((unsigned*)(F.ctl + CW_BAR) + args.li * XCD_BAR_WORDS, F.MISC + 8);
    const float* const* in = args.in;
    bf16* XS = (bf16*)(ws + WS_XS);
    bf16* H = (bf16*)(ws + WS_H);
    const float* MOD = (const float*)(ws + WS_MOD);
    float* SSQ = (float*)(ws + WS_SUMSQ);
    const float* GV = (const float*)(ws + WS_GV);

    const int dup = args.dup & 1, msel = ((args.dup >> 1) & 15) ? ((args.dup >> 1) & 15) : 7;
#pragma unroll 1
    for (int ph = lo; ph < hi; ++ph) {
        { unsigned z_; asm volatile("v_mov_b32 %0, 0" : "=v"(z_)); const int t_ = wave0 * 64 + (int)__builtin_amdgcn_mbcnt_hi(~0u, __builtin_amdgcn_mbcnt_lo(~0u, z_)); F.tid = t_; F.lane = t_ & 63; F.wave = wave0; }
        if (ph == PH_PRO) p_prologue(F, in, ws);
        else if (ph == PH_CONV) p_conv(F, in, ws);
        else if (ph == PH_FINAL) p_norm_final(F, XS, SSQ + (size_t)4 * M, args.out, in[14]);
        else {
            const int l = (ph - PH_L0) / PH_PER_LAYER, k = (ph - PH_L0) % PH_PER_LAYER;
            unsigned char* wl = ws + WS_W + (size_t)l * W_LAYER;
            const float* modl = MOD + (size_t)l * BATCH * NMOD * D;
            const float* biasl = (const float*)(ws + WS_BIAS + (size_t)l * BIAS_LAYER);
            if (k == 0) { pg8::Gemm g{H, (const bf16*)(wl + W_IN), M, INW, D}; pg8::StaticOrder S; S.init(M, INW, F.G, (int)blockIdx.x);
                pg8::EpiBf16Norm E{(bf16*)(ws + WS_Z), 256, SSQ + (size_t)(2 * l) * M, biasl, INW, ws + WS_ZB, ws + WS_ZC};
                pg8::gemm_phase<pg8::EpiBf16Norm, pg8::StaticOrder, true, true>(F.lds + RING_OFF, g, S, E, F.tid); }
            else if (k == 1) p_mixers(F, in, ws, l + 2 * dup, msel);
            else if (k == 2 && l == 0 && !dup) {
                pg8::Gemm g{(const bf16*)(ws + WS_MIX), (const bf16*)(wl + W_OUT), M, D, D}; pg8::StaticOrder S; S.init(M, D, F.G, (int)blockIdx.x);
                pg8::EpiGateResNormT<true> E{(const bf16*)in[0], XS, modl + 2 * D, NMOD * D, H, GV + (size_t)1 * BATCH * D, D, SSQ + (size_t)1 * M, D};
                pg8::gemm_phase<pg8::EpiGateResNormT<true>, pg8::StaticOrder, true, true>(F.lds + RING_OFF, g, S, E, F.tid); }
            else if (k == 2 || k == 4) { const bool dn = (k == 4); const bool last = dn && (l == DEPTH - 1);
                pg8::Gemm g{(const bf16*)(ws + (dn ? WS_HID : WS_MIX)), (const bf16*)(wl + (dn ? W_DN : W_OUT)), M, D, dn ? DFF : D}; pg8::StaticOrder S; S.init(M, D, F.G, (int)blockIdx.x);
                pg8::EpiGateResNorm E{XS, XS, dup ? (const float*)(F.ctl + CW_ZEROS) : modl + (dn ? 5 : 2) * D, dup ? 0 : NMOD * D,
                    (last || dup) ? (bf16*)nullptr : H, GV + (size_t)((dn ? 2 * (l + 1) : 2 * l + 1) % (2 * DEPTH)) * BATCH * D, D, SSQ + (size_t)(dup ? 5 : 2 * l + (dn ? 2 : 1)) * M, D};
                pg8::gemm_phase<pg8::EpiGateResNorm, pg8::StaticOrder, true, true>(F.lds + RING_OFF, g, S, E, F.tid); }
            else { pg8::Gemm g{H, (const bf16*)(wl + W_GU), M, 2 * DFF, D}; pg8::StaticOrder S; S.init(M, 2 * DFF, F.G, (int)blockIdx.x);
                pg8::EpiSwiGLUNorm E{(bf16*)(ws + WS_HID), DFF, SSQ + (size_t)(2 * l + 1) * M, biasl + BATCH * INW, 2 * DFF};
                pg8::gemm_phase<pg8::EpiSwiGLUNorm, pg8::StaticOrder, true, true>(F.lds + RING_OFF, g, S, E, F.tid); }
        }
        if (ph + 1 < hi) xcd_barrier(bar);
    }
}

extern "C" void kernel_launch(void* const* d_in, const int* in_sizes, int n_in, void* d_out, int out_size, void* d_ws, size_t ws_size, hipStream_t stream) {
    static int grid = 0;
    if (grid == 0) {
        if (n_in != 15 || in_sizes[0] != M * D || out_size != M * D || ws_size < WS_END) { fprintf(stderr, "kernel_launch: unexpected shapes (n_in %d, in0 %d, out %d, ws %zu); nothing launched\n", n_in, n_in > 0 ? in_sizes[0] : -1, out_size, ws_size); grid = -1; return; }
        int dev = 0, cus = 0, per_cu = 0;
        if (hipGetDevice(&dev) != hipSuccess || hipDeviceGetAttribute(&cus, hipDeviceAttributeMultiprocessorCount, dev) != hipSuccess) { grid = -1; return; }
        if (hipFuncSetAttribute((const void*)mk_fwd, hipFuncAttributeMaxDynamicSharedMemorySize, LDS_BYTES) != hipSuccess) { fprintf(stderr, "kernel_launch: hipFuncSetAttribute failed\n"); grid = -1; return; }
        if (hipOccupancyMaxActiveBlocksPerMultiprocessor(&per_cu, (const void*)mk_fwd, NWAVES * 64, LDS_BYTES) != hipSuccess || per_cu < 1) fprintf(stderr, "kernel_launch: occupancy query reports %d blocks per CU\n", per_cu);
        (void)hipGetLastError();
        grid = cus;
        if (grid != 256) fprintf(stderr, "kernel_launch: %d CUs; this kernel is laid out for 256\n", grid);
    }
    if (grid < 0) return;
    if (hipMemsetAsync((char*)d_ws + WS_CTL, 0, CTL_ZERO_BYTES, stream) != hipSuccess) return;
    Args a{};
    for (int i = 0; i < 15; ++i) a.in[i] = (const float*)d_in[i];
    a.out = (float*)d_out; a.ws = (unsigned char*)d_ws;
#if PROBE_DUP == 0 && PROBE_CUT == 0
    a.ph_lo = 0; a.ph_hi = NPHASES; a.li = 0; a.dup = 0;
    hipLaunchKernelGGL(mk_fwd, dim3(grid), dim3(NWAVES * 64), LDS_BYTES, stream, a);
#else
    { int lo = 0, li = 0;
      for (int ph = 0; ph < NPHASES; ++ph) { const bool cut = ((PROBE_CUT | PROBE_DUP) >> ph) & 1;
        if (cut || ph == NPHASES - 1) { a.ph_lo = lo; a.ph_hi = ph + 1; a.li = (ph + 1 - lo > 1) ? li++ : 0; a.dup = 0; hipLaunchKernelGGL(mk_fwd, dim3(grid), dim3(NWAVES * 64), LDS_BYTES, stream, a);
            if ((PROBE_DUP >> ph) & 1) { a.ph_lo = ph; a.ph_hi = ph + 1; a.li = 0; a.dup = 1 | (PROBE_MIXSEL << 1) | (PROBE_NOSTORE << 4); hipLaunchKernelGGL(mk_fwd, dim3(grid), dim3(NWAVES * 64), LDS_BYTES, stream, a); }
            lo = ph + 1; } } }
#endif
}
```

```cpp
#include <hip/hip_runtime.h>
#include <cstdio>
#include <cstdint>
namespace pg8 {
#define PG8_LAS __attribute__((address_space(3)))
typedef unsigned short bf16_t;
typedef short bf16x8 __attribute__((ext_vector_type(8)));
typedef float f32x4 __attribute__((ext_vector_type(4)));
typedef unsigned u32x4 __attribute__((ext_vector_type(4)));
constexpr int BM = 256, BK = 64, HALF = 128, HTB = HALF * BK * 2  , STAGE_BYTES = 8 * HTB, NXCD = 8, WGM = 8;

__host__ __device__ __forceinline__ int lds_byte(int r, int c) { const int st = (r >> 4) * 2 + (c >> 5), rr = r & 15, cc = c & 31, ob = rr * 64 + cc * 2; return st * 1024 + (ob ^ (((ob >> 9) & 1) << 5)); }
__host__ __device__ __forceinline__ void stage_rc(int b, int& R, int& C) { const int st = b / 1024, sb = b % 1024, swz = sb ^ (((sb >> 9) & 1) << 5); R = (st >> 1) * 16 + swz / 64; C = (st & 1) * 32 + (swz % 64) / 2; }
__host__ __device__ __forceinline__ int perm32(int rho) { const int n = rho >> 4, i = rho & 15; return 8 * (i >> 2) + 4 * n + (i & 3); }

__host__ __device__ __forceinline__ int perm32inv(int x) { return 16 * ((x >> 2) & 1) + 4 * (x >> 3) + (x & 3); }
__host__ __device__ __forceinline__ size_t img_off(int row, int col, int nt, bool wrow) { const int r = row & 127, rr = wrow ? (r & ~31) + perm32inv(r & 31) : r; return ((size_t)((row >> 7) * nt + (col >> 6)) << 14) + (size_t)lds_byte(rr, col & 63); }
constexpr bool IMG_A = true, IMG_B = true;
struct Unit { int pm, pn; };
struct Gemm { const bf16_t* A; const bf16_t* Bt; int M, N, K; };

struct StaticOrder {
    int nM, nN, nwg, G, c;
    __host__ __device__ void init(int M, int N, int G_, int c_) { nM = M / BM; nN = N / BM; nwg = nM * nN; G = G_; c = c_; }
    __host__ __device__ bool next(int i, Unit& u) const {
        const long L = (long)i * G + c; if (L >= nwg) return false;
        int wgid = (int)L; { const int q = nwg / NXCD, r = nwg % NXCD, xcd = wgid % NXCD, off = wgid / NXCD; wgid = (xcd < r ? xcd * (q + 1) : r * (q + 1) + (xcd - r) * q) + off; }
        const int nig = WGM * nN, gid = wgid / nig, fm = gid * WGM, gsz = (nM - fm) < WGM ? (nM - fm) : WGM;
        u.pm = fm + ((wgid % nig) % gsz); u.pn = (wgid % nig) / gsz; return true;
    }
    __device__ __forceinline__ void a_ready(const Unit&) const {}
    __device__ __forceinline__ void done(const Unit&) const {}
};

__device__ __forceinline__ unsigned cvt_pk_bf16(float lo, float hi) { unsigned r; asm volatile("v_cvt_pk_bf16_f32 %0, %1, %2" : "=v"(r) : "v"(lo), "v"(hi)); return r; }
constexpr float RMS_EPS_ = 1e-6f, INV_D_ = 1.0f / 1024.0f;
__device__ __forceinline__ void aux_dma(const float* src_lane, PG8_LAS unsigned char* dst_wave) { __builtin_amdgcn_global_load_lds((const unsigned*)src_lane, (PG8_LAS unsigned*)dst_wave, 4, 0, 0); }
typedef _Float16 h16x2 __attribute__((ext_vector_type(2)));
__device__ __forceinline__ unsigned pk_h2(float lo, float hi) { const h16x2 h = {(_Float16)lo, (_Float16)hi}; return __builtin_bit_cast(unsigned, h); }
__device__ __forceinline__ float h_lo(unsigned w) { return (float)__builtin_bit_cast(h16x2, w)[0]; }
__device__ __forceinline__ float h_hi(unsigned w) { return (float)__builtin_bit_cast(h16x2, w)[1]; }
struct EpiBf16Norm {
    static constexpr bool PERM = true, AFTER_DRAIN = false;
    bf16_t* O; int ldc; const float* sumsq; const float* bias; int bias_stride; unsigned char* zb; unsigned char* zc;
    __device__ __forceinline__ void prefetch(const Unit& u, PG8_LAS unsigned char* aux, int wid, int lane) const {
        if (wid < 4) aux_dma(sumsq + u.pm * BM + wid * 64 + lane, aux + wid * 256);
        else aux_dma(bias + (size_t)(u.pm >> 5) * bias_stride + u.pn * BM + (wid - 4) * 64 + lane, aux + 1024 + (wid - 4) * 256);
    }
    __device__ __forceinline__ void operator()(const f32x4 (&acc)[2][2][4][2], const Unit& u, int wr, int wc, int fr_, int fq_, PG8_LAS unsigned char* aux) const {
        unsigned z_; asm volatile("v_mov_b32 %0, 0" : "=v"(z_)); const int ln_ = (int)__builtin_amdgcn_mbcnt_hi(~0u, __builtin_amdgcn_mbcnt_lo(~0u, z_)); const int fr = ln_ & 15, fq = ln_ >> 4;
        const int row0 = u.pm * BM + wr * 64 + fr, col0 = u.pn * BM + wc * 32 + 8 * fq;
        const PG8_LAS float* ass = (const PG8_LAS float*)aux + wr * 64 + fr; const PG8_LAS float* ab = (const PG8_LAS float*)(aux + 1024) + wc * 32 + 8 * fq;
        f32x4 bv[2][2];
#pragma unroll
        for (int bj = 0; bj < 2; ++bj)
#pragma unroll
            for (int n = 0; n < 2; ++n) bv[bj][n] = *(const PG8_LAS f32x4*)(ab + bj * HALF + 4 * n);
#pragma unroll
        for (int ai = 0; ai < 2; ++ai)
#pragma unroll
            for (int m = 0; m < 4; ++m) { const int row = row0 + ai * HALF + m * 16; const float rs = __builtin_amdgcn_rsqf(ass[ai * HALF + m * 16] * INV_D_ + RMS_EPS_);
#pragma unroll
                for (int bj = 0; bj < 2; ++bj) { const f32x4 v0 = acc[ai][bj][m][0] * rs + bv[bj][0], v1 = acc[ai][bj][m][1] * rs + bv[bj][1];
                    u32x4 w; w.x = cvt_pk_bf16(v0[0], v0[1]); w.y = cvt_pk_bf16(v0[2], v0[3]); w.z = cvt_pk_bf16(v1[0], v1[1]); w.w = cvt_pk_bf16(v1[2], v1[3]);
                    const int cb = 2 * u.pn + bj;
                    if (zb != nullptr && cb >= 2 && cb <= 10) { const int t3 = (cb - 2) / 3, g = (cb - 2) % 3, lg = 2 * g, hd = 2 * g + (wc >> 1), c = (wc & 1) * 4 + fq;
                        const int t = row & 8191, b = row >> 13, r = t & ((1 << lg) - 1), n = t >> lg, ti = (r << (8 - lg)) + (n >> 5), key = n & 31;
                        const int off = t3 < 2 ? (c >> 1) * 1024 + (key + 32 * (c & 1)) * 16 : (c >> 2) * 2048 + (key >> 4) * 1024 + (key & 15) * 64 + (c & 3) * 16;
                        *(u32x4*)(zb + ((size_t)(((t3 * 6 + hd) * 4 + b) * 256 + ti) << 12) + off) = w; }
                    else if (zb != nullptr && cb >= 11) {
                        const int hx = cb <= 13 ? 2 * (cb - 11) + (wc >> 1) : (cb == 14 ? 6 : 8) + (wc >> 1), c = (wc & 1) * 4 + fq, t = row & 8191, b = row >> 13, key = t & 31;
                        const int off = cb < 15 ? (c >> 1) * 1024 + (key + 32 * (c & 1)) * 16 : (c >> 2) * 2048 + (key >> 4) * 1024 + (key & 15) * 64 + (c & 3) * 16;
                        *(u32x4*)(zc + ((size_t)((hx * 4 + b) * 256 + (t >> 5)) << 12) + off) = w; }
                    else *(u32x4*)(O + (size_t)row * ldc + col0 + bj * HALF) = w; } }
    }
};
struct EpiSwiGLUNorm {
    static constexpr bool PERM = true, AFTER_DRAIN = false;
    bf16_t* O; int ldc; const float* sumsq; const float* bias; int bias_stride;
    static __device__ __forceinline__ float silu_mul(float g, float u) { return g * u * __builtin_amdgcn_rcpf(1.0f + __builtin_amdgcn_exp2f(-1.4426950408889634f * g)); }
    __device__ __forceinline__ void prefetch(const Unit& u, PG8_LAS unsigned char* aux, int wid, int lane) const {
        if (wid < 4) aux_dma(sumsq + u.pm * BM + wid * 64 + lane, aux + wid * 256);
        else aux_dma(bias + (size_t)(u.pm >> 5) * bias_stride + u.pn * BM + (wid - 4) * 64 + lane, aux + 1024 + (wid - 4) * 256);
    }
    __device__ __forceinline__ void operator()(const f32x4 (&acc)[2][2][4][2], const Unit& u, int wr, int wc, int fr_, int fq_, PG8_LAS unsigned char* aux) const {
        unsigned z_; asm volatile("v_mov_b32 %0, 0" : "=v"(z_)); const int ln_ = (int)__builtin_amdgcn_mbcnt_hi(~0u, __builtin_amdgcn_mbcnt_lo(~0u, z_)); const int fr = ln_ & 15, fq = ln_ >> 4;
        const int row0 = u.pm * BM + wr * 64 + fr, col0 = u.pn * HALF + wc * 32 + 8 * fq;
        const PG8_LAS float* ass = (const PG8_LAS float*)aux + wr * 64 + fr; const PG8_LAS float* ab = (const PG8_LAS float*)(aux + 1024) + wc * 32 + 8 * fq;
        const f32x4 bg0 = *(const PG8_LAS f32x4*)(ab), bg1 = *(const PG8_LAS f32x4*)(ab + 4), bu0 = *(const PG8_LAS f32x4*)(ab + HALF), bu1 = *(const PG8_LAS f32x4*)(ab + HALF + 4);
#pragma unroll
        for (int ai = 0; ai < 2; ++ai)
#pragma unroll
            for (int m = 0; m < 4; ++m) { const int row = row0 + ai * HALF + m * 16; const float rs = __builtin_amdgcn_rsqf(ass[ai * HALF + m * 16] * INV_D_ + RMS_EPS_);
                unsigned char* rowp = (unsigned char*)O + img_off(row, col0, ldc / 64, false);
                const f32x4 g0 = acc[ai][0][m][0] * rs + bg0, g1 = acc[ai][0][m][1] * rs + bg1, u0 = acc[ai][1][m][0] * rs + bu0, u1 = acc[ai][1][m][1] * rs + bu1;
                f32x4 e0 = g0 * -1.4426950408889634f, e1 = g1 * -1.4426950408889634f;
#pragma unroll
                for (int i = 0; i < 4; ++i) { e0[i] = __builtin_amdgcn_exp2f(e0[i]); e1[i] = __builtin_amdgcn_exp2f(e1[i]); }
                e0 = e0 + 1.0f; e1 = e1 + 1.0f;
#pragma unroll
                for (int i = 0; i < 4; ++i) { e0[i] = __builtin_amdgcn_rcpf(e0[i]); e1[i] = __builtin_amdgcn_rcpf(e1[i]); }
                const f32x4 h0 = (g0 * u0) * e0, h1 = (g1 * u1) * e1;
                u32x4 w; w.x = cvt_pk_bf16(h0[0], h0[1]); w.y = cvt_pk_bf16(h0[2], h0[3]); w.z = cvt_pk_bf16(h1[0], h1[1]); w.w = cvt_pk_bf16(h1[2], h1[3]);
                *(u32x4*)rowp = w; }
    }
};
template <bool F32BASE>
struct EpiGateResNormT {
    static constexpr bool PERM = true, AFTER_DRAIN = false;
    const bf16_t* base; bf16_t* out; const float* gate; int gate_stride; bf16_t* Hn; const float* gn; int gn_stride; float* sumsq; int ldc;
    __device__ __forceinline__ void prefetch(const Unit& u, PG8_LAS unsigned char* aux, int wid, int lane) const {
        if (wid < 4) aux_dma(gate + (size_t)(u.pm >> 5) * gate_stride + u.pn * BM + wid * 64 + lane, aux + wid * 256);
        else aux_dma(gn + (size_t)(u.pm >> 5) * gn_stride + u.pn * BM + (wid - 4) * 64 + lane, aux + 1024 + (wid - 4) * 256);
    }
    __device__ __forceinline__ void operator()(const f32x4 (&acc)[2][2][4][2], const Unit& u, int wr, int wc, int fr_, int fq_, PG8_LAS unsigned char* aux) const {
        unsigned z_; asm volatile("v_mov_b32 %0, 0" : "=v"(z_)); const int ln_ = (int)__builtin_amdgcn_mbcnt_hi(~0u, __builtin_amdgcn_mbcnt_lo(~0u, z_)); const int fr = ln_ & 15, fq = ln_ >> 4;
        const int row0 = u.pm * BM + wr * 64 + fr, col0 = u.pn * BM + wc * 32 + 8 * fq;
        const PG8_LAS float* ag = (const PG8_LAS float*)aux + wc * 32 + 8 * fq; const PG8_LAS float* an = (const PG8_LAS float*)(aux + 1024) + wc * 32 + 8 * fq;
#pragma unroll
        for (int am = 0; am < 4; ++am) {
            u32x4 ld[2][2]; f32x4 lf[2][2][2];
#pragma unroll
            for (int mm = 0; mm < 2; ++mm)
#pragma unroll
                for (int bj = 0; bj < 2; ++bj) {
                    if constexpr (F32BASE) { const f32x4* px = (const f32x4*)((const float*)base + (size_t)(row0 + (am >> 1) * HALF + (2 * (am & 1) + mm) * 16) * ldc + col0 + bj * HALF); lf[mm][bj][0] = px[0]; lf[mm][bj][1] = px[1]; }
                    else ld[mm][bj] = *(const u32x4*)((const unsigned char*)base + img_off(row0 + (am >> 1) * HALF + (2 * (am & 1) + mm) * 16, col0 + bj * HALF, ldc / 64, false)); }
#pragma unroll
            for (int mm = 0; mm < 2; ++mm) { const int ai = am >> 1, m = 2 * (am & 1) + mm; const int row = row0 + ai * HALF + m * 16; const size_t off = (size_t)row * ldc + col0; float ss = 0.f;
#pragma unroll
                for (int bj = 0; bj < 2; ++bj) {
                    const f32x4 g0 = *(const PG8_LAS f32x4*)(ag + bj * HALF), g1 = *(const PG8_LAS f32x4*)(ag + bj * HALF + 4);
                    f32x4 b0, b1;
                    if constexpr (F32BASE) { b0 = lf[mm][bj][0]; b1 = lf[mm][bj][1]; }
                    else { const u32x4 bw = ld[mm][bj]; b0 = (f32x4){h_lo(bw.x), h_hi(bw.x), h_lo(bw.y), h_hi(bw.y)}; b1 = (f32x4){h_lo(bw.z), h_hi(bw.z), h_lo(bw.w), h_hi(bw.w)}; }
                    const f32x4 x0 = b0 + g0 * acc[ai][bj][m][0], x1 = b1 + g1 * acc[ai][bj][m][1];
                    u32x4 w; w.x = pk_h2(x0[0], x0[1]); w.y = pk_h2(x0[2], x0[3]); w.z = pk_h2(x1[0], x1[1]); w.w = pk_h2(x1[2], x1[3]);
                    *(u32x4*)((unsigned char*)out + img_off(row, col0 + bj * HALF, ldc / 64, false)) = w;
                    ss += (x0[0] * x0[0] + x0[1] * x0[1]) + (x0[2] * x0[2] + x0[3] * x0[3]) + (x1[0] * x1[0] + x1[1] * x1[1]) + (x1[2] * x1[2] + x1[3] * x1[3]);
                    if (Hn) { const f32x4 n0 = *(const PG8_LAS f32x4*)(an + bj * HALF), n1 = *(const PG8_LAS f32x4*)(an + bj * HALF + 4); const f32x4 h0 = x0 * n0, h1 = x1 * n1;
                        u32x4 hw; hw.x = cvt_pk_bf16(h0[0], h0[1]); hw.y = cvt_pk_bf16(h0[2], h0[3]); hw.z = cvt_pk_bf16(h1[0], h1[1]); hw.w = cvt_pk_bf16(h1[2], h1[3]);
                        *(u32x4*)((unsigned char*)Hn + img_off(row, col0 + bj * HALF, ldc / 64, false)) = hw; } }
                ss += __shfl_xor(ss, 16); ss += __shfl_xor(ss, 32);
                if (fq == 0) atomicAdd(sumsq + row, ss); }
            asm volatile("" ::: "memory"); }
    }
};
typedef EpiGateResNormT<false> EpiGateResNorm;

template <class Epi, class Sched, bool ALIGN_EPI = false, bool SP2 = false>
__device__ __forceinline__ void gemm_phase(PG8_LAS unsigned char* lds, const Gemm g, const Sched& S, const Epi& E, int tid_in) {
    int tid_ = tid_in; asm volatile("" : "+v"(tid_));
    const int tid = tid_, wid = __builtin_amdgcn_readfirstlane(tid >> 6), lane = tid & 63, wr = wid >> 2, wc = wid & 3, fr = lane & 15, fq = lane >> 4;
    const int K = g.K, nt = K / BK;
    unsigned voffA[2], voffB[2];
#pragma unroll
    for (int i = 0; i < 2; ++i) { int R, C; stage_rc(tid * 16 + i * 8192, R, C); const int Rb = Epi::PERM ? ((R & ~31) + perm32(R & 31)) : R;
        voffA[i] = IMG_A ? (unsigned)(tid * 16 + i * 8192) : (unsigned)(R * K + C) * 2u; voffB[i] = IMG_B ? (unsigned)(tid * 16 + i * 8192) : (unsigned)(Rb * K + C) * 2u; }
    const size_t kstepA = IMG_A ? (size_t)(HALF * BK * 2) : (size_t)(BK * 2), kstepB = IMG_B ? (size_t)(HALF * BK * 2) : (size_t)(BK * 2);
    const size_t hstep = (size_t)HALF * K * 2;
    const size_t tstep = 2 * hstep;
    const unsigned ldsw = (unsigned)wid * 1024u;
    const int aoff = lds_byte(wr * 64 + fr, fq * 8), boff = lds_byte(wc * 32 + fr, fq * 8);
#define PG8_SA(b, h) (((b) * 2 + (h)) * HTB)
#define PG8_SB(b, h) ((4 + (b) * 2 + (h)) * HTB)
#define PG8_STAGE(bufoff, gbase, voff) do { _Pragma("unroll") for (int _i = 0; _i < 2; ++_i) \
        __builtin_amdgcn_global_load_lds((const unsigned*)((const char*)(gbase) + (voff)[_i]), (PG8_LAS unsigned*)(lds + (bufoff) + ldsw + _i * 8192), 16, 0, 0); } while (0)
#define PG8_LDA(dst, b, h) do { _Pragma("unroll") for (int m = 0; m < 4; ++m) _Pragma("unroll") for (int k = 0; k < 2; ++k) dst[m][k] = *(const PG8_LAS bf16x8*)(lds + PG8_SA(b, h) + aoff + m * 2048 + k * 1024); } while (0)
#define PG8_LDB(dst, b, h) do { _Pragma("unroll") for (int n = 0; n < 2; ++n) _Pragma("unroll") for (int k = 0; k < 2; ++k) dst[n][k] = *(const PG8_LAS bf16x8*)(lds + PG8_SB(b, h) + boff + n * 2048 + k * 1024); } while (0)
#define PG8_MMA(ai, bj, At, Bt) do { __builtin_amdgcn_s_setprio(1); _Pragma("unroll") for (int m = 0; m < 4; ++m) _Pragma("unroll") for (int n = 0; n < 2; ++n) _Pragma("unroll") for (int k = 0; k < 2; ++k) \
        acc[ai][bj][m][n] = __builtin_amdgcn_mfma_f32_16x16x32_bf16(Bt[n][k], At[m][k], acc[ai][bj][m][n], 0, 0, 0); __builtin_amdgcn_s_setprio(0); } while (0)
#define PG8_WAIT_V(n) asm volatile("s_waitcnt vmcnt(" #n ")" ::: "memory")
#define PG8_WAIT_L(n) asm volatile("s_waitcnt lgkmcnt(" #n ")" ::: "memory")
#define PG8_BAR __builtin_amdgcn_s_barrier()
#define PG8_SCHED __builtin_amdgcn_sched_barrier(0)
    Unit cur, nxt; int ui = 0;
    if (!S.next(0, cur)) return;
    f32x4 acc[2][2][4][2];
#pragma unroll
    for (int a = 0; a < 2; ++a)
#pragma unroll
        for (int b = 0; b < 2; ++b)
#pragma unroll
            for (int m = 0; m < 4; ++m)
#pragma unroll
                for (int n = 0; n < 2; ++n) { float z_; asm volatile("v_mov_b32 %0, 0" : "=v"(z_)); acc[a][b][m][n] = (f32x4){z_, z_, z_, z_}; }
    bf16x8 At[4][2], B0[2][2], B1[2][2];
    const char* cA = (const char*)g.A + (size_t)cur.pm * tstep; const char* cB = (const char*)g.Bt + (size_t)cur.pn * tstep;
    S.a_ready(cur);
    if constexpr (SP2) {
        PG8_STAGE(PG8_SB(0, 0), cB, voffB); PG8_STAGE(PG8_SB(0, 1), cB + hstep, voffB); PG8_STAGE(PG8_SA(0, 0), cA, voffA); PG8_STAGE(PG8_SA(0, 1), cA + hstep, voffA);
        if (wr == 1) PG8_BAR;
        PG8_WAIT_V(2); PG8_BAR;
        PG8_STAGE(PG8_SB(1, 0), cB + kstepB, voffB); PG8_STAGE(PG8_SA(1, 0), cA + kstepA, voffA); PG8_STAGE(PG8_SB(1, 1), cB + hstep + kstepB, voffB);
        PG8_WAIT_V(6); PG8_BAR;
    } else {
        PG8_STAGE(PG8_SB(0, 0), cB, voffB); PG8_STAGE(PG8_SA(0, 0), cA, voffA); PG8_STAGE(PG8_SB(0, 1), cB + hstep, voffB); PG8_STAGE(PG8_SA(0, 1), cA + hstep, voffA);
        if (wr == 1) PG8_BAR;
        PG8_WAIT_V(4); PG8_BAR;
        PG8_STAGE(PG8_SB(1, 0), cB + kstepB, voffB); PG8_STAGE(PG8_SA(1, 0), cA + kstepA, voffA); PG8_STAGE(PG8_SB(1, 1), cB + hstep + kstepB, voffB);
        PG8_WAIT_V(6); PG8_BAR;
    }
    for (;;) {
        const bool has_next = S.next(ui + 1, nxt);
        const char* nA = has_next ? (const char*)g.A + (size_t)nxt.pm * tstep : cA; const char* nB = has_next ? (const char*)g.Bt + (size_t)nxt.pn * tstep : cB;
        for (int t = 0; t < nt; t += 2) {
            const bool last = (t == nt - 2);
            const char* a1 = cA + (size_t)(t + 1) * kstepA;
            const char* a2 = last ? nA : cA + (size_t)(t + 2) * kstepA; const char* b2 = last ? nB : cB + (size_t)(t + 2) * kstepB;
            const char* a3 = a2 + kstepA; const char* b3 = b2 + kstepB;
            if (last && has_next) S.a_ready(nxt);
            if (last) E.prefetch(cur, lds + STAGE_BYTES + 1024, wid, lane);
            if constexpr (SP2) {
            PG8_LDB(B0, 0, 0); PG8_LDB(B1, 0, 1); PG8_SCHED; PG8_LDA(At, 0, 0); PG8_STAGE(PG8_SA(1, 1), a1 + hstep, voffA);
            PG8_WAIT_V(8); PG8_WAIT_L(0); PG8_BAR; PG8_MMA(0, 0, At, B0); PG8_MMA(0, 1, At, B1); PG8_BAR; PG8_SCHED;
            PG8_LDA(At, 0, 1); PG8_STAGE(PG8_SB(0, 0), b2, voffB); PG8_STAGE(PG8_SB(0, 1), b2 + hstep, voffB); PG8_STAGE(PG8_SA(0, 0), a2, voffA);
            PG8_WAIT_V(8); PG8_WAIT_L(0); PG8_BAR; PG8_MMA(1, 0, At, B0); PG8_MMA(1, 1, At, B1); PG8_BAR; PG8_SCHED;
            PG8_LDB(B0, 1, 0); PG8_LDB(B1, 1, 1); PG8_SCHED; PG8_LDA(At, 1, 0); PG8_STAGE(PG8_SA(0, 1), a2 + hstep, voffA);
            PG8_WAIT_V(8); PG8_WAIT_L(0); PG8_BAR; PG8_MMA(0, 0, At, B0); PG8_MMA(0, 1, At, B1); PG8_BAR; PG8_SCHED;
            PG8_LDA(At, 1, 1); PG8_STAGE(PG8_SB(1, 0), b3, voffB); PG8_STAGE(PG8_SB(1, 1), b3 + hstep, voffB); PG8_STAGE(PG8_SA(1, 0), a3, voffA);
            PG8_WAIT_V(8); PG8_WAIT_L(0); PG8_BAR; PG8_MMA(1, 0, At, B0); PG8_MMA(1, 1, At, B1); PG8_BAR; PG8_SCHED;
            } else {
            PG8_LDB(B0, 0, 0); PG8_SCHED; PG8_LDA(At, 0, 0); PG8_STAGE(PG8_SA(1, 1), a1 + hstep, voffA);
            PG8_WAIT_L(8); PG8_BAR; PG8_WAIT_L(0); PG8_MMA(0, 0, At, B0); PG8_BAR; PG8_SCHED;
            PG8_LDB(B1, 0, 1); PG8_STAGE(PG8_SB(0, 0), b2, voffB);
            PG8_BAR; PG8_WAIT_L(0); PG8_MMA(0, 1, At, B1); PG8_BAR;
            PG8_LDA(At, 0, 1); PG8_STAGE(PG8_SA(0, 0), a2, voffA);
            PG8_BAR; PG8_WAIT_L(0); PG8_MMA(1, 0, At, B0); PG8_BAR; PG8_SCHED;
            PG8_STAGE(PG8_SB(0, 1), b2 + hstep, voffB);
            PG8_WAIT_V(6); PG8_BAR; PG8_MMA(1, 1, At, B1); PG8_BAR;
            PG8_LDB(B0, 1, 0); PG8_SCHED; PG8_LDA(At, 1, 0); PG8_STAGE(PG8_SA(0, 1), a2 + hstep, voffA);
            PG8_WAIT_L(8); PG8_BAR; PG8_WAIT_L(0); PG8_MMA(0, 0, At, B0); PG8_BAR; PG8_SCHED;
            PG8_LDB(B1, 1, 1); PG8_STAGE(PG8_SB(1, 0), b3, voffB);
            PG8_BAR; PG8_WAIT_L(0); PG8_MMA(0, 1, At, B1); PG8_BAR;
            PG8_LDA(At, 1, 1); PG8_STAGE(PG8_SA(1, 0), a3, voffA);
            PG8_BAR; PG8_WAIT_L(0); PG8_MMA(1, 0, At, B0); PG8_BAR; PG8_SCHED;
            PG8_STAGE(PG8_SB(1, 1), b3 + hstep, voffB);
            PG8_WAIT_V(6); PG8_BAR; PG8_MMA(1, 1, At, B1); PG8_BAR;
            }
        }
        if constexpr (ALIGN_EPI) { if (wr == 0) PG8_BAR; }
        if constexpr (!Epi::AFTER_DRAIN) { E(acc, cur, wr, wc, fr, fq, lds + STAGE_BYTES + 1024); S.done(cur); }
        if (!has_next) break;
#pragma unroll
        for (int a = 0; a < 2; ++a)
#pragma unroll
            for (int b = 0; b < 2; ++b)
#pragma unroll
                for (int m = 0; m < 4; ++m)
#pragma unroll
                    for (int n = 0; n < 2; ++n) { float z_; asm volatile("v_mov_b32 %0, 0" : "=v"(z_)); acc[a][b][m][n] = (f32x4){z_, z_, z_, z_}; }
        cur = nxt; cA = nA; cB = nB; ++ui;
        if constexpr (ALIGN_EPI) { if (wr == 1) PG8_BAR; }
    }
    PG8_WAIT_V(0);
    if constexpr (!ALIGN_EPI) { if (wr == 0) PG8_BAR; }
    PG8_BAR;
    if constexpr (Epi::AFTER_DRAIN) { E.fused(acc, cur, wr, wc, fr, fq, lds, wid, lane); S.done(cur); }
#undef PG8_SA
#undef PG8_SB
#undef PG8_STAGE
#undef PG8_LDA
#undef PG8_LDB
#undef PG8_MMA
#undef PG8_WAIT_V
#undef PG8_WAIT_L
#undef PG8_BAR
#undef PG8_SCHED
}
}
#define GAS __attribute__((address_space(1)))
#define LAS __attribute__((address_space(3)))
typedef unsigned short bf16;
typedef unsigned v4u __attribute__((ext_vector_type(4)));
typedef float f32x4 __attribute__((ext_vector_type(4)));
typedef short bf16x8 __attribute__((ext_vector_type(8)));
typedef GAS unsigned gu32;
typedef GAS unsigned long long gu64;
#define RLX_AGENT __ATOMIC_RELAXED, __HIP_MEMORY_SCOPE_AGENT
#define LDS_WAIT() asm volatile("s_waitcnt lgkmcnt(0)" ::: "memory")
#define VM_WAIT() asm volatile("s_waitcnt vmcnt(0)" ::: "memory")
__device__ __forceinline__ unsigned long long rt() { return __builtin_amdgcn_s_memrealtime(); }
__device__ __forceinline__ unsigned f2bf(float f) { unsigned u = __builtin_bit_cast(unsigned, f); return (u + 0x7fffu + ((u >> 16) & 1u)) >> 16; }
__device__ __forceinline__ unsigned pk2(float lo, float hi) { return f2bf(lo) | (f2bf(hi) << 16); }

#define XB_TMO      128
#define XB_XCNT(j)  (256  + 64 * (j))
#define XB_XSUB(j)  (1280 + 64 * (j))
#define XB_XGEN(j)  (2304 + 64 * (j))
#define XB_TOP      3328
#define XB_TOPGEN   3392
#define XCD_BAR_WORDS 3456
#define XB_SPIN_CAP (1u << 18)

__device__ __forceinline__ unsigned xb_ld(unsigned* p)              { return __hip_atomic_load(p, __ATOMIC_RELAXED, __HIP_MEMORY_SCOPE_AGENT); }
__device__ __forceinline__ unsigned xb_add(unsigned* p, unsigned v) { return __hip_atomic_fetch_add(p, v, __ATOMIC_RELAXED, __HIP_MEMORY_SCOPE_AGENT); }
__device__ __forceinline__ unsigned xb_xcc_id() { return (unsigned)__builtin_amdgcn_s_getreg((3 << 11) | 20) & 0xFu; }
#define XB_SPIN(cond, bar) do { unsigned _sp = 0; while (cond) { __builtin_amdgcn_s_sleep(1); \
    if ((++_sp & 255u) == 0u) { if (xb_ld(&(bar)[XB_TMO])) break; if (_sp > XB_SPIN_CAP) { atomicAdd(&(bar)[XB_TMO], 1u); break; } } } } while (0)

struct XcdBarrier {
    unsigned* bar; unsigned x;
    volatile LAS unsigned* st;
};

__device__ __forceinline__ XcdBarrier xcd_barrier_post(unsigned* bar, volatile LAS unsigned* st) {
    XcdBarrier b; b.bar = bar; b.x = xb_xcc_id(); b.st = st;
    if (threadIdx.x == 0) (void)xb_add(&bar[XB_XCNT(b.x)], 1u);
    return b;
}
__device__ __forceinline__ void xcd_barrier_complete(unsigned* bar, unsigned x, unsigned& nloc, unsigned& nx) {
    const unsigned G = gridDim.x * gridDim.y * gridDim.z;
    unsigned sum, cnt, mine, sp = 0u;
    for (;;) {
        sum = 0u; cnt = 0u; mine = 0u;
#pragma unroll
        for (unsigned j = 0; j < 16; ++j) { const unsigned c = xb_ld(&bar[XB_XCNT(j)]); sum += c; cnt += (c > 0u) ? 1u : 0u; mine = (j == x) ? c : mine; }
        if (sum == G) break;
        __builtin_amdgcn_s_sleep(1);
        if ((++sp & 255u) == 0u) { if (xb_ld(&bar[XB_TMO])) break; if (sp > XB_SPIN_CAP) { atomicAdd(&bar[XB_TMO], 1u); break; } }
    }
    nloc = mine > 0u ? mine : 1u; nx = cnt > 0u ? cnt : 1u;
}

__device__ __forceinline__ void xcd_barrier(const XcdBarrier& b) {
    asm volatile("s_waitcnt vmcnt(0)" ::: "memory");
    __syncthreads();
    if (threadIdx.x == 0) {
        unsigned* bar = b.bar;
        __builtin_amdgcn_s_waitcnt(0);
        unsigned nloc = b.st[0], nx = b.st[1];
        if (nloc == 0u) { xcd_barrier_complete(bar, b.x, nloc, nx); b.st[0] = nloc; b.st[1] = nx; }
        const unsigned old = xb_add(&bar[XB_XSUB(b.x)], 1u);
        const unsigned gen = old / nloc;
        if (old + 1u == (gen + 1u) * nloc) {
            __builtin_amdgcn_fence(__ATOMIC_RELEASE, "agent");
            asm volatile("s_waitcnt vmcnt(0)" ::: "memory");
            const unsigned og = xb_add(&bar[XB_TOP], 1u);
            const unsigned tg = og / nx;
            if (og + 1u == (tg + 1u) * nx) xb_add(&bar[XB_TOPGEN], 1u);
            else XB_SPIN(xb_ld(&bar[XB_TOPGEN]) == tg, bar);
            __builtin_amdgcn_fence(__ATOMIC_ACQUIRE, "agent");
            xb_add(&bar[XB_XGEN(b.x)], 1u);
            asm volatile("s_waitcnt vmcnt(0)" ::: "memory");
        } else {
            XB_SPIN(xb_ld(&bar[XB_XGEN(b.x)]) == gen, bar);
            __builtin_amdgcn_fence(__ATOMIC_ACQUIRE, "agent");
            asm volatile("s_waitcnt vmcnt(0)" ::: "memory");
        }
    }
    __syncthreads();
}

constexpr int NWAVES = 8;
constexpr int BATCH = 4, SEQ = 8192, D = 1024, M = BATCH * SEQ, DEPTH = 2;
constexpr int INW = 2048, DFF = 2816, NMOD = 6;
constexpr int O_U = 0, O_QB = 256, O_KB = 640, O_VB = 1024, O_QC = 1408, O_KC = 1792, O_VC = 1920;
constexpr float RMS_EPS = 1e-6f;
constexpr float LOG2E = 1.4426950408889634f;
constexpr float QSCALE = 0.125f * LOG2E;

constexpr size_t MiB = 1u << 20;
constexpr size_t WS_CTL = 0, CTL_ZERO_BYTES = 131072;
constexpr size_t WS_MOD = 1 * MiB;
constexpr size_t WS_W = 2 * MiB, W_LAYER = 24 * MiB;
constexpr size_t W_IN = 0, W_OUT = 4 * MiB, W_GU = 6 * MiB, W_DN = 17 * MiB, W_PT = 23 * MiB;
constexpr size_t WS_H = 50 * MiB;
constexpr size_t WS_Z = 114 * MiB;
constexpr size_t WS_MIX = 242 * MiB;
constexpr size_t WS_HID = 114 * MiB;
constexpr size_t WS_XS = 306 * MiB;
constexpr size_t WS_AUX = 434 * MiB;
constexpr size_t WS_SUMSQ = WS_AUX;
constexpr size_t WS_GV = WS_AUX + 1 * MiB;
constexpr size_t WS_BIAS = WS_GV + 65536;
constexpr size_t BIAS_LAYER = (size_t)BATCH * (2048 + 5632) * 4;
constexpr size_t WS_BSCR = 370 * MiB;
constexpr size_t WS_ZC = 202 * MiB;
constexpr size_t WS_ZB = 130 * MiB;
constexpr size_t WS_END = 436 * MiB;
static_assert(WS_Z + (size_t)M * 256 * 2 <= WS_ZB && WS_ZB + 72 * MiB <= WS_ZC && WS_ZC + 40 * MiB <= WS_MIX, "z region map");
static_assert(WS_HID + (size_t)M * DFF * 2 <= WS_XS && WS_MIX + (size_t)M * D * 2 <= WS_XS && WS_Z + (size_t)M * 256 * 2 <= WS_MIX && WS_H + (size_t)M * D * 2 <= WS_Z, "ws map");
constexpr int CW_TMO = 0, CW_CODE = 1, CW_BAR = 4096  , CW_QUEUE = 20480, CW_ZEROS = 24576  ;

constexpr int RING_OFF = 0, RING_BYTES = 131072;
constexpr int LDSCTL_OFF = RING_BYTES, MISC_OFF = 147456 - 256, LSEB_OFF = MISC_OFF - 6144;
constexpr int LDS_BYTES = 147456;

constexpr int PH_PRO = 0, PH_CONV = 1, PH_L0 = 2, PH_PER_LAYER = 5, PH_FINAL = PH_L0 + DEPTH * PH_PER_LAYER, NPHASES = PH_FINAL + 1;
#ifndef PROBE_DUP
#define PROBE_DUP 0
#endif
#ifndef PROBE_CUT
#define PROBE_CUT 0
#endif
#ifndef PROBE_MIXSEL
#define PROBE_MIXSEL 0
#endif
#ifndef PROBE_NOSTORE
#define PROBE_NOSTORE 0
#endif
#ifndef MK_ONE_LAUNCH
#define MK_ONE_LAUNCH 1
#endif

struct Frame {
    LAS unsigned char* lds;
    volatile LAS unsigned* MISC;
    gu32* ctl;
    int tid, lane, wave, G, vcu;
};

__device__ __forceinline__ float wave_sum(float v) {
#pragma unroll
    for (int o = 1; o < 64; o <<= 1) v += __shfl_xor(v, o);
    return v;
}
__device__ __forceinline__ float bf2f(unsigned short b) { return __uint_as_float((unsigned)b << 16); }
__device__ __forceinline__ float zero_() { float z; asm volatile("v_mov_b32 %0, 0" : "=v"(z)); return z; }
__device__ __forceinline__ f32x4 zero4_() { const float z = zero_(); return (f32x4){z, z, z, z}; }

__device__ __forceinline__ void tr_item(const float* W, int N, int k0, int n0, bf16* WT, int ldt, int drow0, float scale, LAS float* scr, int lane, bool img = true) {
#pragma unroll 8
    for (int i = 0; i < 32; ++i) { const int kk = 2 * i + (lane >> 5); scr[kk * 33 + (lane & 31)] = __builtin_nontemporal_load(W + (size_t)(k0 + kk) * N + n0 + (lane & 31)); }
    LDS_WAIT(); asm volatile("" ::: "memory");
    const int c = lane & 7;
#pragma unroll
    for (int j = 0; j < 4; ++j) { const int n = (lane >> 3) + 8 * j; const LAS float* s = scr + (8 * c) * 33 + n;
        v4u o; o.x = pk2(s[0 * 33] * scale, s[1 * 33] * scale); o.y = pk2(s[2 * 33] * scale, s[3 * 33] * scale); o.z = pk2(s[4 * 33] * scale, s[5 * 33] * scale); o.w = pk2(s[6 * 33] * scale, s[7 * 33] * scale);
        if (img) *(GAS v4u*)((unsigned char*)WT + pg8::img_off(drow0 + n, k0 + 8 * c, ldt / 64, true)) = o;
        else *(GAS v4u*)(WT + (size_t)(drow0 + n) * ldt + k0 + 8 * c) = o; }
    LDS_WAIT(); asm volatile("" ::: "memory");
}
constexpr int TI_IN = 16 * 64, TI_OUT = 16 * 32, TI_G = 16 * 88, TI_DN = 44 * 32, TI_P = 8, TI_LAYER = TI_IN + TI_OUT + 2 * TI_G + TI_DN + TI_P;
__device__ __forceinline__ void weight_item(const float* const* in, unsigned char* ws, int it, LAS float* scr, int lane) {
    const int l = it / TI_LAYER; int r = it % TI_LAYER;
    unsigned char* wl = ws + WS_W + (size_t)l * W_LAYER;
    if (r < TI_IN) { const int kb = r / 64, n0 = 32 * (r % 64); const bool isq = (n0 >= O_QB && n0 < O_KB) || (n0 >= O_QC && n0 < O_KC);
        tr_item(in[6] + (size_t)l * D * INW, INW, 64 * kb, n0, (bf16*)(wl + W_IN), D, n0, isq ? QSCALE : 1.0f, scr, lane); return; }
    r -= TI_IN;
    if (r < TI_OUT) { const int kb = r / 32, n0 = 32 * (r % 32); tr_item(in[10] + (size_t)l * D * D, D, 64 * kb, n0, (bf16*)(wl + W_OUT), D, n0, 1.0f, scr, lane); return; }
    r -= TI_OUT;
    if (r < 2 * TI_G) { const int up = r >= TI_G; if (up) r -= TI_G; const int kb = r / 88, n0 = 32 * (r % 88);
        tr_item(in[up ? 12 : 11] + (size_t)l * D * DFF, DFF, 64 * kb, n0, (bf16*)(wl + W_GU), D, 256 * (n0 >> 7) + 128 * up + (n0 & 127), 1.0f, scr, lane); return; }
    r -= 2 * TI_G;
    if (r < TI_DN) { const int kb = r / 32, n0 = 32 * (r % 32); tr_item(in[13] + (size_t)l * DFF * D, D, 64 * kb, n0, (bf16*)(wl + W_DN), DFF, n0, 1.0f, scr, lane); return; }
    r -= TI_DN;
    { const int g = r >> 1, n0 = 32 * (r & 1); tr_item(in[7] + (size_t)l * 16384 + g * 4096, 64, 0, n0, (bf16*)(wl + W_PT) + g * 4096, 64, n0, 1.0f, scr, lane, false); }
}
__device__ __forceinline__ void ada_item(Frame& F, const float* const* in, unsigned char* ws, int item) {
    LAS float* cact = (LAS float*)(F.lds);
    LAS float* red = (LAS float*)(F.lds + 16384);
    const int l = item / 96, cb = item % 96;
    const float* c = in[1];
    for (int i = F.tid; i < BATCH * D; i += NWAVES * 64) { const int b = i >> 10, k = i & 1023; const float v = c[i]; cact[k * 4 + b] = v / (1.0f + __expf(-v)); }
    __syncthreads();
    const float* W = in[4] + (size_t)l * D * (NMOD * D) + 64 * cb + F.lane;
    float a0 = 0.f, a1 = 0.f, a2 = 0.f, a3 = 0.f;
    const int kbeg = 128 * F.wave;
#pragma unroll 16
    for (int kk = 0; kk < 128; ++kk) { const float wv = __builtin_nontemporal_load(W + (size_t)(kbeg + kk) * (NMOD * D)); const f32x4 ca = *(const LAS f32x4*)(cact + (kbeg + kk) * 4);
        a0 += ca.x * wv; a1 += ca.y * wv; a2 += ca.z * wv; a3 += ca.w * wv; }
    red[(F.wave * 4 + 0) * 64 + F.lane] = a0; red[(F.wave * 4 + 1) * 64 + F.lane] = a1; red[(F.wave * 4 + 2) * 64 + F.lane] = a2; red[(F.wave * 4 + 3) * 64 + F.lane] = a3;
    __syncthreads();
    if (F.wave < 4) { float s = in[5][(size_t)l * NMOD * D + 64 * cb + F.lane];
#pragma unroll
        for (int w = 0; w < 8; ++w) s += red[(w * 4 + F.wave) * 64 + F.lane];
        ((float*)(ws + WS_MOD))[((size_t)l * BATCH + F.wave) * (NMOD * D) + 64 * cb + F.lane] = s; }
    __syncthreads();
}
__device__ __forceinline__ void p_prologue(Frame& F, const float* const* in, unsigned char* ws) {
    for (int item = blockIdx.x; item < DEPTH * 96; item += F.G) ada_item(F, in, ws, item);
    LAS float* scr = (LAS float*)(F.lds + RING_OFF + F.wave * 16384);
    const int gw = blockIdx.x * NWAVES + F.wave, NGW = F.G * NWAVES;
    for (int it = gw; it < DEPTH * TI_LAYER; it += NGW) weight_item(in, ws, it, scr, F.lane);
    { GAS f32x4* z = (GAS f32x4*)(ws + WS_SUMSQ) + M / 4; const int n4 = 4 * M / 4;
      for (int i = blockIdx.x * (NWAVES * 64) + F.tid; i < n4; i += F.G * NWAVES * 64) z[i] = zero4_(); }
}

__device__ __forceinline__ void p_conv(Frame& F, const float* const* in, unsigned char* ws) {
    const float* MOD = (const float*)(ws + WS_MOD);
    const int NGW = F.G * NWAVES, gw = blockIdx.x * NWAVES + F.wave, rpw = M / NGW;
    {
        const int row0 = gw * rpw, b = row0 / SEQ;
        const float* mb = MOD + (size_t)b * (NMOD * D);
        const float* xin = in[0]; bf16* hout = (bf16*)(ws + WS_H); float* ssq = (float*)(ws + WS_SUMSQ);
        f32x4 Gv[4];
#pragma unroll
        for (int j = 0; j < 4; ++j) { const int cidx = 4 * F.lane + 256 * j; const f32x4 g = *(const f32x4*)(in[2] + cidx), sc = *(const f32x4*)(mb + 1 * D + cidx); Gv[j] = g * (sc + 1.0f); }
        for (int rr = 0; rr < rpw; rr += 4) {
            f32x4 v[4][4];
#pragma unroll
            for (int i = 0; i < 4; ++i) { const GAS f32x4* xr = (const GAS f32x4*)(xin + (size_t)(row0 + rr + i) * D) + F.lane;
#pragma unroll
                for (int j = 0; j < 4; ++j) v[i][j] = __builtin_nontemporal_load(xr + 64 * j); }
#pragma unroll
            for (int i = 0; i < 4; ++i) { const size_t row = (size_t)(row0 + rr + i); float s = 0.f;
#pragma unroll
                for (int j = 0; j < 4; ++j) s += (v[i][j].x * v[i][j].x + v[i][j].y * v[i][j].y) + (v[i][j].z * v[i][j].z + v[i][j].w * v[i][j].w);
                s = wave_sum(s); if (F.lane == 0) ssq[row] = s;
                unsigned char* hb = (unsigned char*)hout + 8 * (F.lane & 1);
#pragma unroll
                for (int j = 0; j < 4; ++j) { const f32x4 o = v[i][j] * Gv[j]; *(GAS unsigned long long*)(hb + pg8::img_off((int)row, (4 * F.lane + 256 * j) & ~7, D / 64, false)) = (unsigned long long)pk2(o.x, o.y) | ((unsigned long long)pk2(o.z, o.w) << 32);
 } }
        }
    }
    {
        float* GV = (float*)(ws + WS_GV);
        for (int i = blockIdx.x * (NWAVES * 64) + F.tid; i < DEPTH * 2 * BATCH * D; i += F.G * NWAVES * 64) { const int col = i & (D - 1), b = (i >> 10) & 3, w = (i >> 12) & 1, l = i >> 13;
            GV[i] = in[w ? 3 : 2][l * D + col] * (1.0f + MOD[((size_t)l * BATCH + b) * (NMOD * D) + (w ? 4 : 1) * D + col]); }
    }
    {
        const int g0 = 8 * gw;
        if (g0 < DEPTH * (INW + 2 * DFF)) {
            const int l = g0 / (INW + 2 * DFF), rl = g0 % (INW + 2 * DFF), w = rl >= INW, n0 = w ? rl - INW : rl, N = w ? 2 * DFF : INW;
            const unsigned char* Bt = ws + WS_W + (size_t)l * W_LAYER + (w ? W_GU : W_IN);
            float* bias = (float*)(ws + WS_BIAS + (size_t)l * BIAS_LAYER) + (w ? BATCH * INW : 0);
            const float* shp = MOD + (size_t)l * BATCH * (NMOD * D) + (w ? 3 : 0) * D + 16 * F.lane;
            v4u wr[8][2];
#pragma unroll
            for (int i = 0; i < 8; ++i) { wr[i][0] = *(const GAS v4u*)(Bt + pg8::img_off(n0 + i, 16 * F.lane, D / 64, true)); wr[i][1] = *(const GAS v4u*)(Bt + pg8::img_off(n0 + i, 16 * F.lane + 8, D / 64, true)); }
            f32x4 sh[4][4];
#pragma unroll
            for (int b = 0; b < 4; ++b)
#pragma unroll
                for (int j = 0; j < 4; ++j) sh[b][j] = *(const f32x4*)(shp + (size_t)b * (NMOD * D) + 4 * j);
#pragma unroll
            for (int i = 0; i < 8; ++i) { const v4u w0 = wr[i][0], w1 = wr[i][1];
                float wf[16];
                wf[0] = __uint_as_float(w0.x << 16); wf[1] = __uint_as_float(w0.x & 0xffff0000u); wf[2] = __uint_as_float(w0.y << 16); wf[3] = __uint_as_float(w0.y & 0xffff0000u);
                wf[4] = __uint_as_float(w0.z << 16); wf[5] = __uint_as_float(w0.z & 0xffff0000u); wf[6] = __uint_as_float(w0.w << 16); wf[7] = __uint_as_float(w0.w & 0xffff0000u);
                wf[8] = __uint_as_float(w1.x << 16); wf[9] = __uint_as_float(w1.x & 0xffff0000u); wf[10] = __uint_as_float(w1.y << 16); wf[11] = __uint_as_float(w1.y & 0xffff0000u);
                wf[12] = __uint_as_float(w1.z << 16); wf[13] = __uint_as_float(w1.z & 0xffff0000u); wf[14] = __uint_as_float(w1.w << 16); wf[15] = __uint_as_float(w1.w & 0xffff0000u);
                float acc[4];
#pragma unroll
                for (int b = 0; b < 4; ++b) { float a = 0.f;
#pragma unroll
                    for (int j = 0; j < 4; ++j) a += (wf[4 * j] * sh[b][j].x + wf[4 * j + 1] * sh[b][j].y) + (wf[4 * j + 2] * sh[b][j].z + wf[4 * j + 3] * sh[b][j].w);
                    acc[b] = wave_sum(a); }
                if (F.lane < 4) bias[(size_t)F.lane * N + n0 + i] = F.lane == 0 ? acc[0] : F.lane == 1 ? acc[1] : F.lane == 2 ? acc[2] : acc[3]; }
        }
    }
}
__device__ __forceinline__ void p_norm_final(Frame& F, const bf16* xin, const float* ssq, float* out, const float* gvec) {
    const int NGW = F.G * NWAVES, gw = blockIdx.x * NWAVES + F.wave, rpw = M / NGW;
    const int row0 = gw * rpw;
    f32x4 Gv[4];
#pragma unroll
    for (int j = 0; j < 4; ++j) Gv[j] = *(const f32x4*)(gvec + 4 * F.lane + 256 * j);
    for (int rr = 0; rr < rpw; rr += 4) {
        unsigned long long w[4][4]; float ss[4];
#pragma unroll
        for (int i = 0; i < 4; ++i) { const unsigned char* xr = (const unsigned char*)xin + 8 * (F.lane & 1); ss[i] = ssq[row0 + rr + i];
#pragma unroll
            for (int j = 0; j < 4; ++j) w[i][j] = *(const GAS unsigned long long*)(xr + pg8::img_off(row0 + rr + i, (4 * F.lane + 256 * j) & ~7, D / 64, false)); }
#pragma unroll
        for (int i = 0; i < 4; ++i) { const float rstd = 1.0f / sqrtf(ss[i] * (1.0f / D) + RMS_EPS);
            GAS f32x4* o = (GAS f32x4*)(out + (size_t)(row0 + rr + i) * D) + F.lane;
#pragma unroll
            for (int j = 0; j < 4; ++j) { const unsigned wl = (unsigned)w[i][j], wh = (unsigned)(w[i][j] >> 32);
                const f32x4 v = {pg8::h_lo(wl), pg8::h_hi(wl), pg8::h_lo(wh), pg8::h_hi(wh)};
                __builtin_nontemporal_store(v * rstd * Gv[j], o + 64 * j); } }
    }
}

namespace mx {
typedef short bf16x8 __attribute__((ext_vector_type(8)));
typedef short s16x4 __attribute__((ext_vector_type(4)));
typedef float f32x16 __attribute__((ext_vector_type(16)));
typedef unsigned u32x4 __attribute__((ext_vector_type(4)));
typedef unsigned u32x2 __attribute__((ext_vector_type(2)));
typedef float f32x2_t __attribute__((ext_vector_type(2))); typedef __bf16 bf16x2_t __attribute__((ext_vector_type(2)));
constexpr float THR = 8.0f;
constexpr int POOL_PITCH = 544;
__device__ __forceinline__ unsigned cvtpk(float lo, float hi) { f32x2_t v = {lo, hi}; bf16x2_t b = __builtin_convertvector(v, bf16x2_t); return __builtin_bit_cast(unsigned, b); }
__device__ __forceinline__ float hswap_max(float v) { auto rr = __builtin_amdgcn_permlane32_swap(__float_as_uint(v), __float_as_uint(v), false, false); return fmaxf(__uint_as_float(rr[0]), __uint_as_float(rr[1])); }
__device__ __forceinline__ float hswap_sum(float v) { auto rr = __builtin_amdgcn_permlane32_swap(__float_as_uint(v), __float_as_uint(v), false, false); return __uint_as_float(rr[0]) + __uint_as_float(rr[1]); }
__device__ __forceinline__ s16x4 vtr(const LAS char* p) { return __builtin_bit_cast(s16x4, __builtin_amdgcn_ds_read_tr16_b64_v4i16((LAS s16x4*)p)); }
__device__ __forceinline__ f32x16 zero16_() { const float z = zero_(); return (f32x16){z, z, z, z, z, z, z, z, z, z, z, z, z, z, z, z}; }
__device__ __forceinline__ int kt_of(int i) { return (i & 1) ? -((i + 1) >> 1) : (i >> 1); }

template <int VAR>
__device__ __forceinline__ float scores(f32x16& t, const bf16x8 (&kf)[4], const bf16x8 (&qf)[4], float relf, float sl, float slope2, float Rf) {
    f32x16 s = {0.f, 0.f, 0.f, 0.f, 0.f, 0.f, 0.f, 0.f, 0.f, 0.f, 0.f, 0.f, 0.f, 0.f, 0.f, 0.f};
#pragma unroll
    for (int i = 0; i < 4; ++i) s = __builtin_amdgcn_mfma_f32_32x32x16_bf16(kf[i], qf[i], s, 0, 0, 0);
    if (VAR == 0) {
#pragma unroll
        for (int r = 0; r < 16; ++r) t[r] = __builtin_fmaf(-__builtin_fabsf(relf - (float)((r & 3) + 8 * (r >> 2))), slope2, s[r]);
        return 0.f;
    } else {
#pragma unroll
        for (int r = 0; r < 16; ++r) { const float c = (float)((r & 3) + 8 * (r >> 2)); float v = __builtin_fmaf(sl, c, s[r]); if (VAR == 2) v = __builtin_fabsf(relf - c) > Rf ? -INFINITY : v; t[r] = v; }
        return -sl * relf;
    }
}
__device__ __forceinline__ float lane_max(const f32x16& t) {
    float a = fmaxf(fmaxf(t[0], t[1]), fmaxf(t[2], t[3])), b = fmaxf(fmaxf(t[4], t[5]), fmaxf(t[6], t[7])), c = fmaxf(fmaxf(t[8], t[9]), fmaxf(t[10], t[11])), d = fmaxf(fmaxf(t[12], t[13]), fmaxf(t[14], t[15]));
    return fmaxf(fmaxf(a, b), fmaxf(c, d));
}
__device__ __forceinline__ float tile_max(const f32x16& t) {
    float a = fmaxf(fmaxf(t[0], t[1]), fmaxf(t[2], t[3])), b = fmaxf(fmaxf(t[4], t[5]), fmaxf(t[6], t[7])), c = fmaxf(fmaxf(t[8], t[9]), fmaxf(t[10], t[11])), d = fmaxf(fmaxf(t[12], t[13]), fmaxf(t[14], t[15]));
    return hswap_max(fmaxf(fmaxf(a, b), fmaxf(c, d)));
}
__device__ __forceinline__ void load_frag4(bf16x8 (&f)[4], const bf16* rowp, int hi) {
#pragma unroll
    for (int i = 0; i < 4; ++i) f[i] = *(const bf16x8*)(rowp + 16 * i + 8 * hi);
}
__device__ __forceinline__ void load_tile_frags(bf16x8 (&f)[4], const char* tile, int lane) {
#pragma unroll
    for (int s = 0; s < 4; ++s) f[s] = *(const bf16x8*)(tile + s * 1024 + lane * 16);
}
__device__ __forceinline__ void dma_tile(LAS char* dst, const char* tile, int lane) {
#pragma unroll
    for (int j = 0; j < 4; ++j) __builtin_amdgcn_global_load_lds((const unsigned*)(tile + j * 1024 + lane * 16), (LAS unsigned*)(dst + j * 1024), 16, 0, 0);
}
__device__ __forceinline__ void dma_v(LAS char* vb, const bf16* vrow0, long rs, int lane) {
#pragma unroll
    for (int j = 0; j < 4; ++j) __builtin_amdgcn_global_load_lds((const unsigned*)(vrow0 + (long)(16 * (j & 1) + (lane >> 2)) * rs + (4 * (j >> 1) + (lane & 3)) * 8), (LAS unsigned*)(vb + j * 1024), 16, 0, 0);
}
__device__ __forceinline__ void load_vfrags(bf16x8 (&vf)[2][2], const LAS char* vaddr) {
#pragma unroll
    for (int d0 = 0; d0 < 2; ++d0)
#pragma unroll
        for (int ks = 0; ks < 2; ++ks) { const s16x4 lo = vtr(vaddr + d0 * 2048 + ks * 1024), hh = vtr(vaddr + d0 * 2048 + ks * 1024 + 512);
            vf[d0][ks] = (bf16x8){lo[0], lo[1], lo[2], lo[3], hh[0], hh[1], hh[2], hh[3]}; }
}
__device__ __forceinline__ void pv_tile(f32x16 (&o)[2], const bf16x8 (&vf)[2][2], const f32x16& p) {
    u32x4 w0, w1;
    w0.x = cvtpk(p[0], p[1]); w0.y = cvtpk(p[2], p[3]); w0.z = cvtpk(p[4], p[5]); w0.w = cvtpk(p[6], p[7]);
    w1.x = cvtpk(p[8], p[9]); w1.y = cvtpk(p[10], p[11]); w1.z = cvtpk(p[12], p[13]); w1.w = cvtpk(p[14], p[15]);
    const bf16x8 pa0 = __builtin_bit_cast(bf16x8, w0), pa1 = __builtin_bit_cast(bf16x8, w1);
#pragma unroll
    for (int d0 = 0; d0 < 2; ++d0) { o[d0] = __builtin_amdgcn_mfma_f32_32x32x16_bf16(vf[d0][0], pa0, o[d0], 0, 0, 0); o[d0] = __builtin_amdgcn_mfma_f32_32x32x16_bf16(vf[d0][1], pa1, o[d0], 0, 0, 0); }
}
__device__ __forceinline__ void store_o(bf16* MIX, int row, int col, const f32x16 (&o)[2], float scale, int hi) {
#pragma unroll
    for (int d0 = 0; d0 < 2; ++d0)
#pragma unroll
        for (int g = 0; g < 4; g += 2) {
            const unsigned ax = cvtpk(o[d0][4 * g] * scale, o[d0][4 * g + 1] * scale), ay = cvtpk(o[d0][4 * g + 2] * scale, o[d0][4 * g + 3] * scale);
            const unsigned bx = cvtpk(o[d0][4 * g + 4] * scale, o[d0][4 * g + 5] * scale), by = cvtpk(o[d0][4 * g + 6] * scale, o[d0][4 * g + 7] * scale);
            const auto rx = __builtin_amdgcn_permlane32_swap(ax, bx, false, false); const auto ry = __builtin_amdgcn_permlane32_swap(ay, by, false, false);
            u32x4 w; w.x = rx[0]; w.y = ry[0]; w.z = rx[1]; w.w = ry[1];
            *(u32x4*)((unsigned char*)MIX + pg8::img_off(row, col + 32 * d0 + 8 * g + 8 * hi, D / 64, false)) = w; }
}
__device__ __forceinline__ void pack_o(u32x4 (&w)[4], const f32x16 (&o)[2], float scale) {
#pragma unroll
    for (int d0 = 0; d0 < 2; ++d0)
#pragma unroll
        for (int g = 0; g < 4; g += 2) {
            const unsigned ax = cvtpk(o[d0][4 * g] * scale, o[d0][4 * g + 1] * scale), ay = cvtpk(o[d0][4 * g + 2] * scale, o[d0][4 * g + 3] * scale);
            const unsigned bx = cvtpk(o[d0][4 * g + 4] * scale, o[d0][4 * g + 5] * scale), by = cvtpk(o[d0][4 * g + 6] * scale, o[d0][4 * g + 7] * scale);
            const auto rx = __builtin_amdgcn_permlane32_swap(ax, bx, false, false); const auto ry = __builtin_amdgcn_permlane32_swap(ay, by, false, false);
            w[2 * d0 + (g >> 1)] = (u32x4){rx[0], ry[0], rx[1], ry[1]}; }
}
__device__ __forceinline__ float alibi_slope(int k  ) { return __builtin_amdgcn_exp2f(-8.0f * (float)(k + 1) / 12.0f); }
__device__ __forceinline__ void scale_o(f32x16 (&o)[2], float f) {
#pragma unroll
    for (int r = 0; r < 16; ++r) { o[0][r] *= f; o[1][r] *= f; }
}

template <bool FIRST, bool WITH_O>
__device__ __forceinline__ void step_rest(f32x16 (&o)[2], float& m, float& l, f32x16& t, float off, const bf16x8 (&vf)[2][2]) {
    const float tm = hswap_max(lane_max(t) + off);
    if (FIRST) m = tm;
    else if (__any(tm - m > THR)) { const float dl = fmaxf(tm - m, 0.f), f = __builtin_amdgcn_exp2f(-dl); l *= f; if (WITH_O) scale_o(o, f); m += dl; }
    const float bm = off - m; f32x2_t ps = {0.f, 0.f}; const f32x2_t bm2 = {bm, bm};
#pragma unroll
    for (int r = 0; r < 16; r += 2) { const f32x2_t x = (f32x2_t){t[r], t[r + 1]} + bm2; t[r] = __builtin_amdgcn_exp2f(x.x); t[r + 1] = __builtin_amdgcn_exp2f(x.y); ps += (f32x2_t){t[r], t[r + 1]}; }
    l += ps.x + ps.y;
    if (WITH_O) pv_tile(o, vf, t);
}
template <int VAR, bool FIRST, bool WITH_O>
__device__ __forceinline__ void step(f32x16 (&o)[2], float& m, float& l, const bf16x8 (&kf)[4], const bf16x8 (&qf)[4], const bf16x8 (&vf)[2][2], float relf, float sl, float slope2, float Rf) {
    f32x16 t; const float off = scores<VAR>(t, kf, qf, relf, sl, slope2, Rf);
    step_rest<FIRST, WITH_O>(o, m, l, t, off, vf);
}

__device__ __forceinline__ void pair_rest(f32x16 (&o)[2], float& m, float& l, f32x16& tL, f32x16& tR, float offL, float offR, const LAS char* vL, const LAS char* vR) {
    const float tm = hswap_max(fmaxf(lane_max(tL) + offL, lane_max(tR) + offR));
    if (__any(tm - m > THR)) { const float dl = fmaxf(tm - m, 0.f), f = __builtin_amdgcn_exp2f(-dl); l *= f; scale_o(o, f); m += dl; }
    const float bL = offL - m, bR = offR - m; f32x2_t ps = {0.f, 0.f}; const f32x2_t bL2 = {bL, bL}, bR2 = {bR, bR};
#pragma unroll
    for (int r = 0; r < 16; r += 2) { const f32x2_t xL = (f32x2_t){tL[r], tL[r + 1]} + bL2, xR = (f32x2_t){tR[r], tR[r + 1]} + bR2;
        tL[r] = __builtin_amdgcn_exp2f(xL.x); tL[r + 1] = __builtin_amdgcn_exp2f(xL.y); tR[r] = __builtin_amdgcn_exp2f(xR.x); tR[r + 1] = __builtin_amdgcn_exp2f(xR.y);
        ps += (f32x2_t){tL[r], tL[r + 1]}; ps += (f32x2_t){tR[r], tR[r + 1]}; }
    l += ps.x + ps.y;
    { bf16x8 vf[2][2]; load_vfrags(vf, vL); pv_tile(o, vf, tL); }
    { bf16x8 vf[2][2]; load_vfrags(vf, vR); pv_tile(o, vf, tR); }
}
template <int VAR>
__device__ __forceinline__ void step_pair_lds(f32x16 (&o)[2], float& m, float& l, const LAS char* kL, const LAS char* kR, const LAS char* vL, const LAS char* vR, bf16x8 (&qf)[4],
                                              float relfL, float relfR, float slope2, float Rf, const char* qnext = nullptr, int lane = 0) {
    f32x16 tL, tR; float offL, offR;
    { bf16x8 kf[4];
#pragma unroll
      for (int s = 0; s < 4; ++s) kf[s] = *(const LAS bf16x8*)(kL + s * 1024);
      offL = scores<VAR>(tL, kf, qf, relfL, slope2, slope2, Rf); }
    { bf16x8 kf[4];
#pragma unroll
      for (int s = 0; s < 4; ++s) kf[s] = *(const LAS bf16x8*)(kR + s * 1024);
      offR = scores<VAR>(tR, kf, qf, relfR, -slope2, slope2, Rf); }
    if (qnext) load_tile_frags(qf, qnext, lane);
    pair_rest(o, m, l, tL, tR, offL, offR, vL, vR);
}
template <int VAR>
__device__ __forceinline__ void step_pair_regk(f32x16 (&o)[2], float& m, float& l, const bf16x8 (&kfL)[4], const bf16x8 (&kfR)[4], const LAS char* vL, const LAS char* vR, const bf16x8 (&qf)[4],
                                               float relfL, float relfR, float slope2, float Rf) {
    f32x16 tL, tR; const float offL = scores<VAR>(tL, kfL, qf, relfL, slope2, slope2, Rf), offR = scores<VAR>(tR, kfR, qf, relfR, -slope2, slope2, Rf);
    pair_rest(o, m, l, tL, tR, offL, offR, vL, vR);
}

__device__ __forceinline__ void dma_k(LAS char* kb, const bf16* krow0, long rs, int lane) {
#pragma unroll
    for (int s = 0; s < 4; ++s) __builtin_amdgcn_global_load_lds((const unsigned*)(krow0 + (long)(lane & 31) * rs + 16 * s + 8 * (lane >> 5)), (LAS unsigned*)(kb + s * 1024), 16, 0, 0);
}
struct BTile { const char* qb; const char* kb; const char* vb; int nt  , t0  , n0, head, d, r, tl; float slope2; };
__device__ __forceinline__ BTile b_decode(const char* ZB, int b, int c, int j, int qi, int q) {
    BTile t; const int g = qi >> 4, i = qi & 15, lg = 2 * g; t.d = 1 << lg;
    t.r = i >> (4 - lg); const int isub = i & ((16 >> lg) - 1); t.n0 = ((512 * c) >> lg) + 32 * isub; t.nt = 256 >> lg; t.t0 = t.n0 >> 5;
    t.head = 2 * g + j; t.slope2 = alibi_slope(6 + t.head) * (float)t.d * LOG2E;
    const size_t tb = (size_t)(t.head * 4 + b) * 256 + ((size_t)t.r << (8 - lg));
    t.qb = ZB + (tb << 12); t.kb = ZB + ((tb + 6 * 4 * 256) << 12); t.vb = ZB + ((tb + 2 * 6 * 4 * 256) << 12);
    t.tl = g * 512 + (32 * isub + q) * t.d + t.r;
    return t;
}
__device__ __forceinline__ void b_issue_qk(const BTile& t, bf16x8 (&qf)[4], bf16x8 (&kf)[5][4], bool (&val)[5], int (&kc)[5], int lane) {
    load_tile_frags(qf, t.qb + ((size_t)t.t0 << 12), lane);
#pragma unroll
    for (int i = 0; i < 5; ++i) { const int kt = t.t0 + kt_of(i); val[i] = kt >= 0 && kt < t.nt; kc[i] = kt < 0 ? 0 : (kt >= t.nt ? t.nt - 1 : kt);
        load_tile_frags(kf[i], t.kb + ((size_t)kc[i] << 12), lane); }
}
__device__ __forceinline__ void fill_ninf(f32x16& t) {
#pragma unroll
    for (int r = 0; r < 16; ++r) t[r] = -INFINITY;
}
__device__ __forceinline__ float b_qtile(f32x16 (&o)[2], const BTile& t, const BTile& tn, bool has_next, bf16x8 (&qf)[4], bf16x8 (&kf)[5][4], bool (&val)[5], int (&kc)[5], LAS char* vb, int lane) {
    const int q = lane & 31, hi = lane >> 5;
    const float slope2 = t.slope2;
    const LAS char* vaddr = vb + (4 * hi + ((lane & 15) >> 2)) * 64 + ((lane >> 4) & 1) * 32 + (lane & 3) * 8;
    float m = 0.f, l = 0.f;
    {
        bf16x8 vf[2][2]; load_vfrags(vf, vaddr);
        asm volatile("s_waitcnt lgkmcnt(0)" ::: "memory"); dma_tile(vb, t.vb + ((size_t)kc[4] << 12), lane);
        step<0, true, true>(o, m, l, kf[0], qf, vf, (float)(q - 4 * hi), slope2, slope2, 64.0f); }
    {
        f32x16 tL, tR; const float offL = scores<1>(tL, kf[1], qf, (float)(q + 32 - 4 * hi), slope2, slope2, 64.0f), offR = scores<1>(tR, kf[2], qf, (float)(q - 32 - 4 * hi), -slope2, slope2, 64.0f);
        if (!val[1]) fill_ninf(tL); if (!val[2]) fill_ninf(tR);
        pair_rest(o, m, l, tL, tR, offL, offR, vaddr + 4096, vaddr + 8192); }
    asm volatile("s_waitcnt vmcnt(0)" ::: "memory");
    {
        f32x16 tL, tR; const float offL = scores<2>(tL, kf[3], qf, (float)(q + 64 - 4 * hi), slope2, slope2, 64.0f), offR = scores<2>(tR, kf[4], qf, (float)(q - 64 - 4 * hi), -slope2, slope2, 64.0f);
        if (!val[3]) fill_ninf(tL); if (!val[4]) fill_ninf(tR);
        if (has_next) {
            asm volatile("s_waitcnt lgkmcnt(0)" ::: "memory");
            b_issue_qk(tn, qf, kf, val, kc, lane);
            dma_tile(vb + 4096, tn.vb + ((size_t)kc[1] << 12), lane); dma_tile(vb + 8192, tn.vb + ((size_t)kc[2] << 12), lane); }
        pair_rest(o, m, l, tL, tR, offL, offR, vaddr + 12288, vaddr);
        if (has_next) { asm volatile("s_waitcnt lgkmcnt(0)" ::: "memory");
            dma_tile(vb, tn.vb + ((size_t)kc[0] << 12), lane); dma_tile(vb + 12288, tn.vb + ((size_t)kc[3] << 12), lane); } }
    const float lt = hswap_sum(l);
    scale_o(o, 1.0f / lt);
    return m + __builtin_amdgcn_logf(lt);
}
__device__ __forceinline__ void b_unit(const char* ZB, bf16* MIX, char* SCR, int u, LAS char* lds, int wave, int lane) {
    const int b = u >> 5, c = (u >> 1) & 15, j = u & 1;
    LAS float* lseb = (LAS float*)(lds + LSEB_OFF);
    LAS char* vb = lds + wave * 16384;
    char* scr = SCR + ((size_t)(u * 8 + wave) * 6 << 12) + lane * 16;
    const int q = lane & 31, hi = lane >> 5;
    bf16x8 qf[4], kf[5][4]; bool val[5]; int kc[5];
    BTile t = b_decode(ZB, b, c, j, wave, q);
    b_issue_qk(t, qf, kf, val, kc, lane);
#pragma unroll
    for (int i = 0; i < 4; ++i) dma_tile(vb + i * 4096, t.vb + ((size_t)kc[i] << 12), lane);
#pragma unroll 1
    for (int it = 0; it < 6; ++it) { const bool has_next = it < 5; const BTile tn = b_decode(ZB, b, c, j, wave + 8 * (has_next ? it + 1 : it), q);
        if (it == 0) asm volatile("s_waitcnt vmcnt(0)" ::: "memory"); else asm volatile("s_waitcnt vmcnt(4)" ::: "memory");
        f32x16 o[2]; o[0] = zero16_(); o[1] = zero16_();
        const float lse = b_qtile(o, t, tn, has_next, qf, kf, val, kc, vb, lane);
        if (hi == 0) lseb[t.tl] = lse;
        u32x4 w[4]; pack_o(w, o, 1.0f);
#pragma unroll
        for (int k = 0; k < 4; ++k) *(u32x4*)(scr + ((size_t)it << 12) + k * 1024) = w[k];
        t = tn; }
    __syncthreads();
#pragma unroll 1
    for (int it0 = 0; it0 < 6; it0 += 3) { u32x4 w[3][4];
#pragma unroll
        for (int ii = 0; ii < 3; ++ii)
#pragma unroll
            for (int k = 0; k < 4; ++k) w[ii][k] = *(const u32x4*)(scr + ((size_t)(it0 + ii) << 12) + k * 1024);
#pragma unroll
        for (int ii = 0; ii < 3; ++ii) { const BTile tt = b_decode(ZB, b, c, j, wave + 8 * (it0 + ii), q);
            const int tk = tt.tl & 511; const float l0 = lseb[tk], l1 = lseb[512 + tk], l2 = lseb[1024 + tk], own = lseb[tt.tl]; const float mm = fmaxf(l0, fmaxf(l1, l2));
            const float a = __builtin_amdgcn_exp2f(own - mm) / (__builtin_amdgcn_exp2f(l0 - mm) + __builtin_amdgcn_exp2f(l1 - mm) + __builtin_amdgcn_exp2f(l2 - mm));
            const int orow = b * SEQ + (tt.n0 + q) * tt.d + tt.r, ocol = 256 + 64 * tt.head + 8 * hi;
#pragma unroll
            for (int k = 0; k < 4; ++k) { const u32x4 x = w[ii][k]; u32x4 y;
                y.x = cvtpk(__uint_as_float(x.x << 16) * a, __uint_as_float(x.x & 0xffff0000u) * a); y.y = cvtpk(__uint_as_float(x.y << 16) * a, __uint_as_float(x.y & 0xffff0000u) * a);
                y.z = cvtpk(__uint_as_float(x.z << 16) * a, __uint_as_float(x.z & 0xffff0000u) * a); y.w = cvtpk(__uint_as_float(x.w << 16) * a, __uint_as_float(x.w & 0xffff0000u) * a);
                *(u32x4*)((unsigned char*)MIX + pg8::img_off(orow, ocol + 32 * (k >> 1) + 16 * (k & 1), D / 64, false)) = y; } } }
    __syncthreads();
}
__device__ __forceinline__ void c_unit(const char* ZC, bf16* MIX, const float* sink, int u, LAS char* lds, int wave, int lane) {
    const int b = u >> 6, kvh = (u >> 5) & 1, q0 = 256 * (u & 31), n0 = q0 + 32 * wave;
    const int q = lane & 31, hi = lane >> 5;
    const char* kt0 = ZC + ((size_t)((6 + kvh) * 4 + b) * 256 << 12); const char* vt0 = ZC + ((size_t)((8 + kvh) * 4 + b) * 256 << 12);
#pragma unroll
    for (int tt = 0; tt < 2; ++tt) { const int t = 2 * wave + tt, T = (q0 >> 5) - 4 + t;
        if (T >= 0 && T < SEQ / 32) { dma_tile(lds + t * 8192, kt0 + ((size_t)T << 12), lane); dma_tile(lds + t * 8192 + 4096, vt0 + ((size_t)T << 12), lane); } }
    const char* qt0 = ZC + (((size_t)((3 * kvh) * 4 + b) * 256 + (n0 >> 5)) << 12);
    bf16x8 qf[4]; load_tile_frags(qf, qt0, lane);
    asm volatile("s_waitcnt vmcnt(0)" ::: "memory");
    __syncthreads();
    const LAS char* kbase = lds + lane * 16;
    const LAS char* vbase = lds + 4096 + (4 * hi + ((lane & 15) >> 2)) * 64 + ((lane >> 4) & 1) * 32 + (lane & 3) * 8;
#pragma unroll 1
    for (int hh = 0; hh < 3; ++hh) { const int head = 3 * kvh + hh;
        const char* qnext = hh < 2 ? qt0 + ((size_t)(hh + 1) * 4 * 256 << 12) : nullptr; bool reloaded = false;
        f32x16 o[2]; o[0] = zero16_(); o[1] = zero16_();
        float m = sink[head] * LOG2E, l = hi ? 0.f : 1.0f; const float slope2 = alibi_slope(head) * LOG2E;
        {
            const int t = wave + 4; bf16x8 kf[4];
#pragma unroll
            for (int s = 0; s < 4; ++s) kf[s] = *(const LAS bf16x8*)(kbase + t * 8192 + s * 1024);
            bf16x8 vf[2][2]; load_vfrags(vf, vbase + t * 8192);
            step<0, false, true>(o, m, l, kf, qf, vf, (float)(q - 4 * hi), slope2, slope2, 128.0f); }
#pragma unroll 1
        for (int k = 1; k <= 4; ++k) { const int tL = wave + 4 - k, tR = wave + 4 + k; const bool vL = n0 - 32 * k >= 0, vR = n0 + 32 * k < SEQ;
            const float relfL = (float)(q + 32 * k - 4 * hi), relfR = (float)(q - 32 * k - 4 * hi);
            if (vL && vR) {
                if (k < 4) step_pair_lds<1>(o, m, l, kbase + tL * 8192, kbase + tR * 8192, vbase + tL * 8192, vbase + tR * 8192, qf, relfL, relfR, slope2, 128.0f);
                else { step_pair_lds<2>(o, m, l, kbase + tL * 8192, kbase + tR * 8192, vbase + tL * 8192, vbase + tR * 8192, qf, relfL, relfR, slope2, 128.0f, qnext, lane); reloaded = true; } }
            else if (vL || vR) { const int t = vL ? tL : tR; bf16x8 kf[4];
#pragma unroll
                for (int s = 0; s < 4; ++s) kf[s] = *(const LAS bf16x8*)(kbase + t * 8192 + s * 1024);
                bf16x8 vf[2][2]; load_vfrags(vf, vbase + t * 8192);
                const float relf = vL ? relfL : relfR, sl = vL ? slope2 : -slope2;
                if (k < 4) step<1, false, true>(o, m, l, kf, qf, vf, relf, sl, slope2, 128.0f); else step<2, false, true>(o, m, l, kf, qf, vf, relf, sl, slope2, 128.0f); } }
        if (!reloaded && qnext) load_tile_frags(qf, qnext, lane);
        store_o(MIX, b * SEQ + n0 + q, 640 + 64 * head, o, 1.0f / hswap_sum(l), hi); }
    __syncthreads();
}
template <int G>
__device__ __forceinline__ void pool_group(const LAS char* rows, bf16* MIX, const bf16* wpt, const float* pscale, int row0, int tok, int kq, int lane) {
    constexpr int R = 1 << G, W = 2 * R + 1;
    int lo = tok - R, hi2 = tok + R + 1; lo = lo < 0 ? 0 : lo; hi2 = hi2 > SEQ ? SEQ : hi2; const float inv = 1.0f / (float)(hi2 - lo);
    f32x4 acc[4];
#pragma unroll
    for (int dt = 0; dt < 4; ++dt) acc[dt] = zero4_();
#pragma unroll
    for (int kb = 0; kb < 2; ++kb) { float s[8]; bf16x8 uc;
        const LAS char* rp = rows + ((lane & 15) + 8 - R) * POOL_PITCH + (8 * G + 4 * kb + kq) * 16;
#pragma unroll
        for (int e = 0; e < 8; ++e) s[e] = 0.f;
#pragma unroll
        for (int j = 0; j < W; ++j) { const int tt = tok + j - R; const float w = (tt >= 0 && tt < SEQ) ? 1.0f : 0.0f; const bf16x8 v = *(const LAS bf16x8*)(rp + j * POOL_PITCH); if (j == R) uc = v;
#pragma unroll
            for (int e = 0; e < 8; ++e) s[e] += w * bf2f((unsigned short)v[e]); }
        u32x4 pw; float pe[8];
#pragma unroll
        for (int e = 0; e < 8; ++e) pe[e] = s[e] * inv - bf2f((unsigned short)uc[e]);
        pw.x = cvtpk(pe[0], pe[1]); pw.y = cvtpk(pe[2], pe[3]); pw.z = cvtpk(pe[4], pe[5]); pw.w = cvtpk(pe[6], pe[7]);
        const bf16x8 bfrag = __builtin_bit_cast(bf16x8, pw);
#pragma unroll
        for (int dt = 0; dt < 4; ++dt) { const bf16x8 afrag = *(const bf16x8*)(wpt + (size_t)(G * 64 + dt * 16 + (lane & 15)) * 64 + kb * 32 + 8 * kq);
            acc[dt] = __builtin_amdgcn_mfma_f32_16x16x32_bf16(afrag, bfrag, acc[dt], 0, 0, 0); } }
#pragma unroll
    for (int dt = 0; dt < 4; ++dt) { const int dcol = G * 64 + dt * 16 + 4 * kq; const f32x4 sc = *(const f32x4*)(pscale + dcol);
        u32x2 w; w.x = cvtpk(acc[dt][0] * sc.x, acc[dt][1] * sc.y); w.y = cvtpk(acc[dt][2] * sc.z, acc[dt][3] * sc.w);
        *(u32x2*)((unsigned char*)MIX + pg8::img_off(row0 + (lane & 15), dcol & ~7, D / 64, false) + 2 * (dcol & 7)) = w; }
}
__device__ __forceinline__ void pool_item(const bf16* Z, bf16* MIX, const bf16* wpt, const float* pscale, int item, LAS char* rows, int lane) {
    const int row0 = 16 * item, b = row0 / SEQ, t0 = row0 % SEQ;
    const int tok = t0 + (lane & 15), kq = lane >> 4;
    const bf16* zb = Z + (size_t)b * SEQ * 256;
    u32x4 st[16];
#pragma unroll
    for (int i = 0; i < 16; ++i) { const int idx = i * 64 + lane, r = idx >> 5, c = idx & 31; int tt = t0 - 8 + r; tt = (tt >= 0 && tt < SEQ) ? tt : t0; st[i] = *(const u32x4*)(zb + (size_t)tt * 256 + 8 * c); }
#pragma unroll
    for (int i = 0; i < 16; ++i) { const int idx = i * 64 + lane, r = idx >> 5, c = idx & 31; *(LAS u32x4*)(rows + r * POOL_PITCH + c * 16) = st[i]; }
    pool_group<0>(rows, MIX, wpt, pscale, row0, tok, kq, lane); pool_group<1>(rows, MIX, wpt, pscale, row0, tok, kq, lane);
    pool_group<2>(rows, MIX, wpt, pscale, row0, tok, kq, lane); pool_group<3>(rows, MIX, wpt, pscale, row0, tok, kq, lane);
}
constexpr int N_B_UNITS = 128, N_C_UNITS = 256, N_P_ITEMS = M / 16;
}

__device__ __forceinline__ void p_mixers(Frame& F, const float* const* in, unsigned char* ws, int lq, int sel  ) {
    const int l = lq & 1;
    const bf16* Z = (const bf16*)(ws + WS_Z); bf16* MIX = (bf16*)(ws + WS_MIX);
    LAS char* lds = (LAS char*)F.lds;
    const float* sink = in[9] + 6 * l;
    {
        const int nb = (F.G >= 2 * mx::N_B_UNITS) ? mx::N_B_UNITS : (F.G + 1) / 2;
        const bool xl = (F.G == 256);
        if ((int)blockIdx.x < nb) {
            if (sel & 1) {
#pragma unroll 1
                for (int u0 = blockIdx.x; u0 < mx::N_B_UNITS; u0 += nb) { const int u = xl ? ((u0 & 7) >> 1) * 32 + (u0 >> 3) * 2 + (u0 & 1) : u0;     unsigned z_; asm volatile("v_mov_b32 %0, 0" : "=v"(z_)); const int lane = (int)__builtin_amdgcn_mbcnt_hi(~0u, __builtin_amdgcn_mbcnt_lo(~0u, z_)); mx::b_unit((const char*)(ws + WS_ZB), MIX, (char*)(ws + WS_BSCR), u, lds, F.wave, lane); } }
        } else if (sel & 2) {
#pragma unroll 1
            for (int v = (int)blockIdx.x - nb, u0 = v, k = 0; u0 < mx::N_C_UNITS; u0 += F.G - nb, ++k) { const int u = xl ? (v & 7) * 32 + (v >> 3) * 2 + k : u0;     unsigned z_; asm volatile("v_mov_b32 %0, 0" : "=v"(z_)); const int lane = (int)__builtin_amdgcn_mbcnt_hi(~0u, __builtin_amdgcn_mbcnt_lo(~0u, z_)); mx::c_unit((const char*)(ws + WS_ZC), MIX, sink, u, lds, F.wave, lane); }
        }
        __syncthreads();
    }
    if (sel & 4) { const bf16* wpt = (const bf16*)(ws + WS_W + (size_t)l * W_LAYER + W_PT); const float* pscale = in[8] + 256 * l;
        for (int it = blockIdx.x * NWAVES + F.wave; it < mx::N_P_ITEMS; it += F.G * NWAVES) mx::pool_item(Z, MIX, wpt, pscale, it, lds + F.wave * (32 * mx::POOL_PITCH), F.lane); }
}

struct Args { const float* in[15]; float* out; unsigned char* ws; int ph_lo, ph_hi, li, dup; };
__global__ void __launch_bounds__(NWAVES * 64, 2) mk_fwd(Args args) {
    extern __shared__ __attribute__((aligned(16))) unsigned char lds[];
    Frame F;
    F.lds = (LAS unsigned char*)lds;
    F.MISC = (volatile LAS unsigned*)(F.lds + MISC_OFF);
    F.tid = threadIdx.x; F.lane = F.tid & 63; F.wave = __builtin_amdgcn_readfirstlane(F.tid >> 6);
    const int wave0 = F.wave;
    F.G = gridDim.x; { const int bx = blockIdx.x; F.vcu = (F.G % 8 == 0) ? (bx % 8) * (F.G / 8) + bx / 8 : bx; }
    unsigned char* ws = args.ws;
    F.ctl = (gu32*)(ws + WS_CTL);
    for (int u = F.tid; u < (LDS_BYTES - LDSCTL_OFF) / 4; u += NWAVES * 64) ((LAS unsigned*)(F.lds + LDSCTL_OFF))[u] = 0u;
    __syncthreads();
    XcdBarrier bar; bar.bar = (unsigned*)(F.ctl + CW_BAR) + args.li * XCD_BAR_WORDS; bar.x = 0; bar.st = nullptr;
    const int lo = args.ph_lo, hi = args.ph_hi;
    if (hi - lo > 1) bar = xcd_barrier_post((unsigned*)(F.ctl + CW_BAR) + args.li * XCD_BAR_WORDS, F.MISC + 8);
    const float* const* in = args.in;
    bf16* XS = (bf16*)(ws + WS_XS);
    bf16* H = (bf16*)(ws + WS_H);
    const float* MOD = (const float*)(ws + WS_MOD);
    float* SSQ = (float*)(ws + WS_SUMSQ);
    const float* GV = (const float*)(ws + WS_GV);

    const int dup = args.dup & 1, msel = ((args.dup >> 1) & 15) ? ((args.dup >> 1) & 15) : 7;
#pragma unroll 1
    for (int ph = lo; ph < hi; ++ph) {
        { unsigned z_; asm volatile("v_mov_b32 %0, 0" : "=v"(z_)); const int t_ = wave0 * 64 + (int)__builtin_amdgcn_mbcnt_hi(~0u, __builtin_amdgcn_mbcnt_lo(~0u, z_)); F.tid = t_; F.lane = t_ & 63; F.wave = wave0; }
        if (ph == PH_PRO) p_prologue(F, in, ws);
        else if (ph == PH_CONV) p_conv(F, in, ws);
        else if (ph == PH_FINAL) p_norm_final(F, XS, SSQ + (size_t)4 * M, args.out, in[14]);
        else {
            const int l = (ph - PH_L0) / PH_PER_LAYER, k = (ph - PH_L0) % PH_PER_LAYER;
            unsigned char* wl = ws + WS_W + (size_t)l * W_LAYER;
            const float* modl = MOD + (size_t)l * BATCH * NMOD * D;
            const float* biasl = (const float*)(ws + WS_BIAS + (size_t)l * BIAS_LAYER);
            if (k == 0) { pg8::Gemm g{H, (const bf16*)(wl + W_IN), M, INW, D}; pg8::StaticOrder S; S.init(M, INW, F.G, (int)blockIdx.x);
                pg8::EpiBf16Norm E{(bf16*)(ws + WS_Z), 256, SSQ + (size_t)(2 * l) * M, biasl, INW, ws + WS_ZB, ws + WS_ZC};
                pg8::gemm_phase<pg8::EpiBf16Norm, pg8::StaticOrder, true, true>(F.lds + RING_OFF, g, S, E, F.tid); }
            else if (k == 1) p_mixers(F, in, ws, l + 2 * dup, msel);
            else if (k == 2 && l == 0 && !dup) {
                pg8::Gemm g{(const bf16*)(ws + WS_MIX), (const bf16*)(wl + W_OUT), M, D, D}; pg8::StaticOrder S; S.init(M, D, F.G, (int)blockIdx.x);
                pg8::EpiGateResNormT<true> E{(const bf16*)in[0], XS, modl + 2 * D, NMOD * D, H, GV + (size_t)1 * BATCH * D, D, SSQ + (size_t)1 * M, D};
                pg8::gemm_phase<pg8::EpiGateResNormT<true>, pg8::StaticOrder, true, true>(F.lds + RING_OFF, g, S, E, F.tid); }
            else if (k == 2 || k == 4) { const bool dn = (k == 4); const bool last = dn && (l == DEPTH - 1);
                pg8::Gemm g{(const bf16*)(ws + (dn ? WS_HID : WS_MIX)), (const bf16*)(wl + (dn ? W_DN : W_OUT)), M, D, dn ? DFF : D}; pg8::StaticOrder S; S.init(M, D, F.G, (int)blockIdx.x);
                pg8::EpiGateResNorm E{XS, XS, dup ? (const float*)(F.ctl + CW_ZEROS) : modl + (dn ? 5 : 2) * D, dup ? 0 : NMOD * D,
                    (last || dup) ? (bf16*)nullptr : H, GV + (size_t)((dn ? 2 * (l + 1) : 2 * l + 1) % (2 * DEPTH)) * BATCH * D, D, SSQ + (size_t)(dup ? 5 : 2 * l + (dn ? 2 : 1)) * M, D};
                pg8::gemm_phase<pg8::EpiGateResNorm, pg8::StaticOrder, true, true>(F.lds + RING_OFF, g, S, E, F.tid); }
            else { pg8::Gemm g{H, (const bf16*)(wl + W_GU), M, 2 * DFF, D}; pg8::StaticOrder S; S.init(M, 2 * DFF, F.G, (int)blockIdx.x);
                pg8::EpiSwiGLUNorm E{(bf16*)(ws + WS_HID), DFF, SSQ + (size_t)(2 * l + 1) * M, biasl + BATCH * INW, 2 * DFF};
                pg8::gemm_phase<pg8::EpiSwiGLUNorm, pg8::StaticOrder, true, true>(F.lds + RING_OFF, g, S, E, F.tid); }
        }
        if (ph + 1 < hi) xcd_barrier(bar);
    }
}

extern "C" void kernel_launch(void* const* d_in, const int* in_sizes, int n_in, void* d_out, int out_size, void* d_ws, size_t ws_size, hipStream_t stream) {
    static int grid = 0;
    if (grid == 0) {
        if (n_in != 15 || in_sizes[0] != M * D || out_size != M * D || ws_size < WS_END) { fprintf(stderr, "kernel_launch: unexpected shapes (n_in %d, in0 %d, out %d, ws %zu); nothing launched\n", n_in, n_in > 0 ? in_sizes[0] : -1, out_size, ws_size); grid = -1; return; }
        int dev = 0, cus = 0, per_cu = 0;
        if (hipGetDevice(&dev) != hipSuccess || hipDeviceGetAttribute(&cus, hipDeviceAttributeMultiprocessorCount, dev) != hipSuccess) { grid = -1; return; }
        if (hipFuncSetAttribute((const void*)mk_fwd, hipFuncAttributeMaxDynamicSharedMemorySize, LDS_BYTES) != hipSuccess) { fprintf(stderr, "kernel_launch: hipFuncSetAttribute failed\n"); grid = -1; return; }
        if (hipOccupancyMaxActiveBlocksPerMultiprocessor(&per_cu, (const void*)mk_fwd, NWAVES * 64, LDS_BYTES) != hipSuccess || per_cu < 1) fprintf(stderr, "kernel_launch: occupancy query reports %d blocks per CU\n", per_cu);
        (void)hipGetLastError();
        grid = cus;
        if (grid != 256) fprintf(stderr, "kernel_launch: %d CUs; this kernel is laid out for 256\n", grid);
    }
    if (grid < 0) return;
    if (hipMemsetAsync((char*)d_ws + WS_CTL, 0, CTL_ZERO_BYTES, stream) != hipSuccess) return;
    Args a{};
    for (int i = 0; i < 15; ++i) a.in[i] = (const float*)d_in[i];
    a.out = (float*)d_out; a.ws = (unsigned char*)d_ws;
#if PROBE_DUP == 0 && PROBE_CUT == 0
    a.ph_lo = 0; a.ph_hi = NPHASES; a.li = 0; a.dup = 0;
    hipLaunchKernelGGL(mk_fwd, dim3(grid), dim3(NWAVES * 64), LDS_BYTES, stream, a);
#else
    { int lo = 0, li = 0;
      for (int ph = 0; ph < NPHASES; ++ph) { const bool cut = ((PROBE_CUT | PROBE_DUP) >> ph) & 1;
        if (cut || ph == NPHASES - 1) { a.ph_lo = lo; a.ph_hi = ph + 1; a.li = (ph + 1 - lo > 1) ? li++ : 0; a.dup = 0; hipLaunchKernelGGL(mk_fwd, dim3(grid), dim3(NWAVES * 64), LDS_BYTES, stream, a);
            if ((PROBE_DUP >> ph) & 1) { a.ph_lo = ph; a.ph_hi = ph + 1; a.li = 0; a.dup = 1 | (PROBE_MIXSEL << 1) | (PROBE_NOSTORE << 4); hipLaunchKernelGGL(mk_fwd, dim3(grid), dim3(NWAVES * 64), LDS_BYTES, stream, a); }
            lo = ph + 1; } } }
#endif
}
```

```cpp
#include <hip/hip_runtime.h>
#include <cstdio>
#include <cstdint>
namespace pg8 {
#define PG8_LAS __attribute__((address_space(3)))
typedef unsigned short bf16_t;
typedef short bf16x8 __attribute__((ext_vector_type(8)));
typedef float f32x4 __attribute__((ext_vector_type(4)));
typedef unsigned u32x4 __attribute__((ext_vector_type(4)));
constexpr int BM = 256, BK = 64, HALF = 128, HTB = HALF * BK * 2  , STAGE_BYTES = 8 * HTB, NXCD = 8, WGM = 8;

__host__ __device__ __forceinline__ int lds_byte(int r, int c) { const int st = (r >> 4) * 2 + (c >> 5), rr = r & 15, cc = c & 31, ob = rr * 64 + cc * 2; return st * 1024 + (ob ^ (((ob >> 9) & 1) << 5)); }
__host__ __device__ __forceinline__ void stage_rc(int b, int& R, int& C) { const int st = b / 1024, sb = b % 1024, swz = sb ^ (((sb >> 9) & 1) << 5); R = (st >> 1) * 16 + swz / 64; C = (st & 1) * 32 + (swz % 64) / 2; }
__host__ __device__ __forceinline__ int perm32(int rho) { const int n = rho >> 4, i = rho & 15; return 8 * (i >> 2) + 4 * n + (i & 3); }

__host__ __device__ __forceinline__ int perm32inv(int x) { return 16 * ((x >> 2) & 1) + 4 * (x >> 3) + (x & 3); }
__host__ __device__ __forceinline__ size_t img_off(int row, int col, int nt, bool wrow) { const int r = row & 127, rr = wrow ? (r & ~31) + perm32inv(r & 31) : r; return ((size_t)((row >> 7) * nt + (col >> 6)) << 14) + (size_t)lds_byte(rr, col & 63); }
constexpr bool IMG_A = true, IMG_B = true;
struct Unit { int pm, pn; };
struct Gemm { const bf16_t* A; const bf16_t* Bt; int M, N, K; };

struct StaticOrder {
    int nM, nN, nwg, G, c;
    __host__ __device__ void init(int M, int N, int G_, int c_) { nM = M / BM; nN = N / BM; nwg = nM * nN; G = G_; c = c_; }
    __host__ __device__ bool next(int i, Unit& u) const {
        const long L = (long)i * G + c; if (L >= nwg) return false;
        int wgid = (int)L; { const int q = nwg / NXCD, r = nwg % NXCD, xcd = wgid % NXCD, off = wgid / NXCD; wgid = (xcd < r ? xcd * (q + 1) : r * (q + 1) + (xcd - r) * q) + off; }
        const int nig = WGM * nN, gid = wgid / nig, fm = gid * WGM, gsz = (nM - fm) < WGM ? (nM - fm) : WGM;
        u.pm = fm + ((wgid % nig) % gsz); u.pn = (wgid % nig) / gsz; return true;
    }
    __device__ __forceinline__ void a_ready(const Unit&) const {}
    __device__ __forceinline__ void done(const Unit&) const {}
};

__device__ __forceinline__ unsigned cvt_pk_bf16(float lo, float hi) { unsigned r; asm volatile("v_cvt_pk_bf16_f32 %0, %1, %2" : "=v"(r) : "v"(lo), "v"(hi)); return r; }
constexpr float RMS_EPS_ = 1e-6f, INV_D_ = 1.0f / 1024.0f;
__device__ __forceinline__ void aux_dma(const float* src_lane, PG8_LAS unsigned char* dst_wave) { __builtin_amdgcn_global_load_lds((const unsigned*)src_lane, (PG8_LAS unsigned*)dst_wave, 4, 0, 0); }
typedef _Float16 h16x2 __attribute__((ext_vector_type(2)));
__device__ __forceinline__ unsigned pk_h2(float lo, float hi) { const h16x2 h = {(_Float16)lo, (_Float16)hi}; return __builtin_bit_cast(unsigned, h); }
__device__ __forceinline__ float h_lo(unsigned w) { return (float)__builtin_bit_cast(h16x2, w)[0]; }
__device__ __forceinline__ float h_hi(unsigned w) { return (float)__builtin_bit_cast(h16x2, w)[1]; }
struct EpiBf16Norm {
    static constexpr bool PERM = true, AFTER_DRAIN = false;
    bf16_t* O; int ldc; const float* sumsq; const float* bias; int bias_stride; unsigned char* zb; unsigned char* zc;
    __device__ __forceinline__ void prefetch(const Unit& u, PG8_LAS unsigned char* aux, int wid, int lane) const {
        if (wid < 4) aux_dma(sumsq + u.pm * BM + wid * 64 + lane, aux + wid * 256);
        else aux_dma(bias + (size_t)(u.pm >> 5) * bias_stride + u.pn * BM + (wid - 4) * 64 + lane, aux + 1024 + (wid - 4) * 256);
    }
    __device__ __forceinline__ void operator()(const f32x4 (&acc)[2][2][4][2], const Unit& u, int wr, int wc, int fr_, int fq_, PG8_LAS unsigned char* aux) const {
        unsigned z_; asm volatile("v_mov_b32 %0, 0" : "=v"(z_)); const int ln_ = (int)__builtin_amdgcn_mbcnt_hi(~0u, __builtin_amdgcn_mbcnt_lo(~0u, z_)); const int fr = ln_ & 15, fq = ln_ >> 4;
        const int row0 = u.pm * BM + wr * 64 + fr, col0 = u.pn * BM + wc * 32 + 8 * fq;
        const PG8_LAS float* ass = (const PG8_LAS float*)aux + wr * 64 + fr; const PG8_LAS float* ab = (const PG8_LAS float*)(aux + 1024) + wc * 32 + 8 * fq;
        f32x4 bv[2][2];
#pragma unroll
        for (int bj = 0; bj < 2; ++bj)
#pragma unroll
            for (int n = 0; n < 2; ++n) bv[bj][n] = *(const PG8_LAS f32x4*)(ab + bj * HALF + 4 * n);
#pragma unroll
        for (int ai = 0; ai < 2; ++ai)
#pragma unroll
            for (int m = 0; m < 4; ++m) { const int row = row0 + ai * HALF + m * 16; const float rs = __builtin_amdgcn_rsqf(ass[ai * HALF + m * 16] * INV_D_ + RMS_EPS_);
#pragma unroll
                for (int bj = 0; bj < 2; ++bj) { const f32x4 v0 = acc[ai][bj][m][0] * rs + bv[bj][0], v1 = acc[ai][bj][m][1] * rs + bv[bj][1];
                    u32x4 w; w.x = cvt_pk_bf16(v0[0], v0[1]); w.y = cvt_pk_bf16(v0[2], v0[3]); w.z = cvt_pk_bf16(v1[0], v1[1]); w.w = cvt_pk_bf16(v1[2], v1[3]);
                    const int cb = 2 * u.pn + bj;
                    if (zb != nullptr && cb >= 2 && cb <= 10) { const int t3 = (cb - 2) / 3, g = (cb - 2) % 3, lg = 2 * g, hd = 2 * g + (wc >> 1), c = (wc & 1) * 4 + fq;
                        const int t = row & 8191, b = row >> 13, r = t & ((1 << lg) - 1), n = t >> lg, ti = (r << (8 - lg)) + (n >> 5), key = n & 31;
                        const int off = t3 < 2 ? (c >> 1) * 1024 + (key + 32 * (c & 1)) * 16 : (c >> 2) * 2048 + (key >> 4) * 1024 + (key & 15) * 64 + (c & 3) * 16;
                        *(u32x4*)(zb + ((size_t)(((t3 * 6 + hd) * 4 + b) * 256 + ti) << 12) + off) = w; }
                    else if (zb != nullptr && cb >= 11) {
                        const int hx = cb <= 13 ? 2 * (cb - 11) + (wc >> 1) : (cb == 14 ? 6 : 8) + (wc >> 1), c = (wc & 1) * 4 + fq, t = row & 8191, b = row >> 13, key = t & 31;
                        const int off = cb < 15 ? (c >> 1) * 1024 + (key + 32 * (c & 1)) * 16 : (c >> 2) * 2048 + (key >> 4) * 1024 + (key & 15) * 64 + (c & 3) * 16;
                        *(u32x4*)(zc + ((size_t)((hx * 4 + b) * 256 + (t >> 5)) << 12) + off) = w; }
                    else *(u32x4*)(O + (size_t)row * ldc + col0 + bj * HALF) = w; } }
    }
};
struct EpiSwiGLUNorm {
    static constexpr bool PERM = true, AFTER_DRAIN = false;
    bf16_t* O; int ldc; const float* sumsq; const float* bias; int bias_stride;
    static __device__ __forceinline__ float silu_mul(float g, float u) { return g * u * __builtin_amdgcn_rcpf(1.0f + __builtin_amdgcn_exp2f(-1.4426950408889634f * g)); }
    __device__ __forceinline__ void prefetch(const Unit& u, PG8_LAS unsigned char* aux, int wid, int lane) const {
        if (wid < 4) aux_dma(sumsq + u.pm * BM + wid * 64 + lane, aux + wid * 256);
        else aux_dma(bias + (size_t)(u.pm >> 5) * bias_stride + u.pn * BM + (wid - 4) * 64 + lane, aux + 1024 + (wid - 4) * 256);
    }
    __device__ __forceinline__ void operator()(const f32x4 (&acc)[2][2][4][2], const Unit& u, int wr, int wc, int fr_, int fq_, PG8_LAS unsigned char* aux) const {
        unsigned z_; asm volatile("v_mov_b32 %0, 0" : "=v"(z_)); const int ln_ = (int)__builtin_amdgcn_mbcnt_hi(~0u, __builtin_amdgcn_mbcnt_lo(~0u, z_)); const int fr = ln_ & 15, fq = ln_ >> 4;
        const int row0 = u.pm * BM + wr * 64 + fr, col0 = u.pn * HALF + wc * 32 + 8 * fq;
        const PG8_LAS float* ass = (const PG8_LAS float*)aux + wr * 64 + fr; const PG8_LAS float* ab = (const PG8_LAS float*)(aux + 1024) + wc * 32 + 8 * fq;
        const f32x4 bg0 = *(const PG8_LAS f32x4*)(ab), bg1 = *(const PG8_LAS f32x4*)(ab + 4), bu0 = *(const PG8_LAS f32x4*)(ab + HALF), bu1 = *(const PG8_LAS f32x4*)(ab + HALF + 4);
#pragma unroll
        for (int ai = 0; ai < 2; ++ai)
#pragma unroll
            for (int m = 0; m < 4; ++m) { const int row = row0 + ai * HALF + m * 16; const float rs = __builtin_amdgcn_rsqf(ass[ai * HALF + m * 16] * INV_D_ + RMS_EPS_);
                unsigned char* rowp = (unsigned char*)O + img_off(row, col0, ldc / 64, false);
                const f32x4 g0 = acc[ai][0][m][0] * rs + bg0, g1 = acc[ai][0][m][1] * rs + bg1, u0 = acc[ai][1][m][0] * rs + bu0, u1 = acc[ai][1][m][1] * rs + bu1;
                f32x4 e0 = g0 * -1.4426950408889634f, e1 = g1 * -1.4426950408889634f;
#pragma unroll
                for (int i = 0; i < 4; ++i) { e0[i] = __builtin_amdgcn_exp2f(e0[i]); e1[i] = __builtin_amdgcn_exp2f(e1[i]); }
                e0 = e0 + 1.0f; e1 = e1 + 1.0f;
#pragma unroll
                for (int i = 0; i < 4; ++i) { e0[i] = __builtin_amdgcn_rcpf(e0[i]); e1[i] = __builtin_amdgcn_rcpf(e1[i]); }
                const f32x4 h0 = (g0 * u0) * e0, h1 = (g1 * u1) * e1;
                u32x4 w; w.x = cvt_pk_bf16(h0[0], h0[1]); w.y = cvt_pk_bf16(h0[2], h0[3]); w.z = cvt_pk_bf16(h1[0], h1[1]); w.w = cvt_pk_bf16(h1[2], h1[3]);
                *(u32x4*)rowp = w; }
    }
};
template <bool F32BASE>
struct EpiGateResNormT {
    static constexpr bool PERM = true, AFTER_DRAIN = false;
    const bf16_t* base; bf16_t* out; const float* gate; int gate_stride; bf16_t* Hn; const float* gn; int gn_stride; float* sumsq; int ldc;
    __device__ __forceinline__ void prefetch(const Unit& u, PG8_LAS unsigned char* aux, int wid, int lane) const {
        if (wid < 4) aux_dma(gate + (size_t)(u.pm >> 5) * gate_stride + u.pn * BM + wid * 64 + lane, aux + wid * 256);
        else aux_dma(gn + (size_t)(u.pm >> 5) * gn_stride + u.pn * BM + (wid - 4) * 64 + lane, aux + 1024 + (wid - 4) * 256);
    }
    __device__ __forceinline__ void operator()(const f32x4 (&acc)[2][2][4][2], const Unit& u, int wr, int wc, int fr_, int fq_, PG8_LAS unsigned char* aux) const {
        unsigned z_; asm volatile("v_mov_b32 %0, 0" : "=v"(z_)); const int ln_ = (int)__builtin_amdgcn_mbcnt_hi(~0u, __builtin_amdgcn_mbcnt_lo(~0u, z_)); const int fr = ln_ & 15, fq = ln_ >> 4;
        const int row0 = u.pm * BM + wr * 64 + fr, col0 = u.pn * BM + wc * 32 + 8 * fq;
        const PG8_LAS float* ag = (const PG8_LAS float*)aux + wc * 32 + 8 * fq; const PG8_LAS float* an = (const PG8_LAS float*)(aux + 1024) + wc * 32 + 8 * fq;
#pragma unroll
        for (int am = 0; am < 4; ++am) {
            u32x4 ld[2][2]; f32x4 lf[2][2][2];
#pragma unroll
            for (int mm = 0; mm < 2; ++mm)
#pragma unroll
                for (int bj = 0; bj < 2; ++bj) {
                    if constexpr (F32BASE) { const f32x4* px = (const f32x4*)((const float*)base + (size_t)(row0 + (am >> 1) * HALF + (2 * (am & 1) + mm) * 16) * ldc + col0 + bj * HALF); lf[mm][bj][0] = px[0]; lf[mm][bj][1] = px[1]; }
                    else ld[mm][bj] = *(const u32x4*)((const unsigned char*)base + img_off(row0 + (am >> 1) * HALF + (2 * (am & 1) + mm) * 16, col0 + bj * HALF, ldc / 64, false)); }
#pragma unroll
            for (int mm = 0; mm < 2; ++mm) { const int ai = am >> 1, m = 2 * (am & 1) + mm; const int row = row0 + ai * HALF + m * 16; const size_t off = (size_t)row * ldc + col0; float ss = 0.f;
#pragma unroll
                for (int bj = 0; bj < 2; ++bj) {
                    const f32x4 g0 = *(const PG8_LAS f32x4*)(ag + bj * HALF), g1 = *(const PG8_LAS f32x4*)(ag + bj * HALF + 4);
                    f32x4 b0, b1;
                    if constexpr (F32BASE) { b0 = lf[mm][bj][0]; b1 = lf[mm][bj][1]; }
                    else { const u32x4 bw = ld[mm][bj]; b0 = (f32x4){h_lo(bw.x), h_hi(bw.x), h_lo(bw.y), h_hi(bw.y)}; b1 = (f32x4){h_lo(bw.z), h_hi(bw.z), h_lo(bw.w), h_hi(bw.w)}; }
                    const f32x4 x0 = b0 + g0 * acc[ai][bj][m][0], x1 = b1 + g1 * acc[ai][bj][m][1];
                    u32x4 w; w.x = pk_h2(x0[0], x0[1]); w.y = pk_h2(x0[2], x0[3]); w.z = pk_h2(x1[0], x1[1]); w.w = pk_h2(x1[2], x1[3]);
                    *(u32x4*)((unsigned char*)out + img_off(row, col0 + bj * HALF, ldc / 64, false)) = w;
                    ss += (x0[0] * x0[0] + x0[1] * x0[1]) + (x0[2] * x0[2] + x0[3] * x0[3]) + (x1[0] * x1[0] + x1[1] * x1[1]) + (x1[2] * x1[2] + x1[3] * x1[3]);
                    if (Hn) { const f32x4 n0 = *(const PG8_LAS f32x4*)(an + bj * HALF), n1 = *(const PG8_LAS f32x4*)(an + bj * HALF + 4); const f32x4 h0 = x0 * n0, h1 = x1 * n1;
                        u32x4 hw; hw.x = cvt_pk_bf16(h0[0], h0[1]); hw.y = cvt_pk_bf16(h0[2], h0[3]); hw.z = cvt_pk_bf16(h1[0], h1[1]); hw.w = cvt_pk_bf16(h1[2], h1[3]);
                        *(u32x4*)((unsigned char*)Hn + img_off(row, col0 + bj * HALF, ldc / 64, false)) = hw; } }
                ss += __shfl_xor(ss, 16); ss += __shfl_xor(ss, 32);
                if (fq == 0) atomicAdd(sumsq + row, ss); }
            asm volatile("" ::: "memory"); }
    }
};
typedef EpiGateResNormT<false> EpiGateResNorm;

template <class Epi, class Sched, bool ALIGN_EPI = false, bool SP2 = false>
__device__ __forceinline__ void gemm_phase(PG8_LAS unsigned char* lds, const Gemm g, const Sched& S, const Epi& E, int tid_in) {
    int tid_ = tid_in; asm volatile("" : "+v"(tid_));
    const int tid = tid_, wid = __builtin_amdgcn_readfirstlane(tid >> 6), lane = tid & 63, wr = wid >> 2, wc = wid & 3, fr = lane & 15, fq = lane >> 4;
    const int K = g.K, nt = K / BK;
    unsigned voffA[2], voffB[2];
#pragma unroll
    for (int i = 0; i < 2; ++i) { int R, C; stage_rc(tid * 16 + i * 8192, R, C); const int Rb = Epi::PERM ? ((R & ~31) + perm32(R & 31)) : R;
        voffA[i] = IMG_A ? (unsigned)(tid * 16 + i * 8192) : (unsigned)(R * K + C) * 2u; voffB[i] = IMG_B ? (unsigned)(tid * 16 + i * 8192) : (unsigned)(Rb * K + C) * 2u; }
    const size_t kstepA = IMG_A ? (size_t)(HALF * BK * 2) : (size_t)(BK * 2), kstepB = IMG_B ? (size_t)(HALF * BK * 2) : (size_t)(BK * 2);
    const size_t hstep = (size_t)HALF * K * 2;
    const size_t tstep = 2 * hstep;
    const unsigned ldsw = (unsigned)wid * 1024u;
    const int aoff = lds_byte(wr * 64 + fr, fq * 8), boff = lds_byte(wc * 32 + fr, fq * 8);
#define PG8_SA(b, h) (((b) * 2 + (h)) * HTB)
#define PG8_SB(b, h) ((4 + (b) * 2 + (h)) * HTB)
#define PG8_STAGE(bufoff, gbase, voff) do { _Pragma("unroll") for (int _i = 0; _i < 2; ++_i) \
        __builtin_amdgcn_global_load_lds((const unsigned*)((const char*)(gbase) + (voff)[_i]), (PG8_LAS unsigned*)(lds + (bufoff) + ldsw + _i * 8192), 16, 0, 0); } while (0)
#define PG8_LDA(dst, b, h) do { _Pragma("unroll") for (int m = 0; m < 4; ++m) _Pragma("unroll") for (int k = 0; k < 2; ++k) dst[m][k] = *(const PG8_LAS bf16x8*)(lds + PG8_SA(b, h) + aoff + m * 2048 + k * 1024); } while (0)
#define PG8_LDB(dst, b, h) do { _Pragma("unroll") for (int n = 0; n < 2; ++n) _Pragma("unroll") for (int k = 0; k < 2; ++k) dst[n][k] = *(const PG8_LAS bf16x8*)(lds + PG8_SB(b, h) + boff + n * 2048 + k * 1024); } while (0)
#define PG8_MMA(ai, bj, At, Bt) do { __builtin_amdgcn_s_setprio(1); _Pragma("unroll") for (int m = 0; m < 4; ++m) _Pragma("unroll") for (int n = 0; n < 2; ++n) _Pragma("unroll") for (int k = 0; k < 2; ++k) \
        acc[ai][bj][m][n] = __builtin_amdgcn_mfma_f32_16x16x32_bf16(Bt[n][k], At[m][k], acc[ai][bj][m][n], 0, 0, 0); __builtin_amdgcn_s_setprio(0); } while (0)
#define PG8_WAIT_V(n) asm volatile("s_waitcnt vmcnt(" #n ")" ::: "memory")
#define PG8_WAIT_L(n) asm volatile("s_waitcnt lgkmcnt(" #n ")" ::: "memory")
#define PG8_BAR __builtin_amdgcn_s_barrier()
#define PG8_SCHED __builtin_amdgcn_sched_barrier(0)
    Unit cur, nxt; int ui = 0;
    if (!S.next(0, cur)) return;
    f32x4 acc[2][2][4][2];
#pragma unroll
    for (int a = 0; a < 2; ++a)
#pragma unroll
        for (int b = 0; b < 2; ++b)
#pragma unroll
            for (int m = 0; m < 4; ++m)
#pragma unroll
                for (int n = 0; n < 2; ++n) { float z_; asm volatile("v_mov_b32 %0, 0" : "=v"(z_)); acc[a][b][m][n] = (f32x4){z_, z_, z_, z_}; }
    bf16x8 At[4][2], B0[2][2], B1[2][2];
    const char* cA = (const char*)g.A + (size_t)cur.pm * tstep; const char* cB = (const char*)g.Bt + (size_t)cur.pn * tstep;
    S.a_ready(cur);
    if constexpr (SP2) {
        PG8_STAGE(PG8_SB(0, 0), cB, voffB); PG8_STAGE(PG8_SB(0, 1), cB + hstep, voffB); PG8_STAGE(PG8_SA(0, 0), cA, voffA); PG8_STAGE(PG8_SA(0, 1), cA + hstep, voffA);
        if (wr == 1) PG8_BAR;
        PG8_WAIT_V(2); PG8_BAR;
        PG8_STAGE(PG8_SB(1, 0), cB + kstepB, voffB); PG8_STAGE(PG8_SA(1, 0), cA + kstepA, voffA); PG8_STAGE(PG8_SB(1, 1), cB + hstep + kstepB, voffB);
        PG8_WAIT_V(6); PG8_BAR;
    } else {
        PG8_STAGE(PG8_SB(0, 0), cB, voffB); PG8_STAGE(PG8_SA(0, 0), cA, voffA); PG8_STAGE(PG8_SB(0, 1), cB + hstep, voffB); PG8_STAGE(PG8_SA(0, 1), cA + hstep, voffA);
        if (wr == 1) PG8_BAR;
        PG8_WAIT_V(4); PG8_BAR;
        PG8_STAGE(PG8_SB(1, 0), cB + kstepB, voffB); PG8_STAGE(PG8_SA(1, 0), cA + kstepA, voffA); PG8_STAGE(PG8_SB(1, 1), cB + hstep + kstepB, voffB);
        PG8_WAIT_V(6); PG8_BAR;
    }
    for (;;) {
        const bool has_next = S.next(ui + 1, nxt);
        const char* nA = has_next ? (const char*)g.A + (size_t)nxt.pm * tstep : cA; const char* nB = has_next ? (const char*)g.Bt + (size_t)nxt.pn * tstep : cB;
        for (int t = 0; t < nt; t += 2) {
            const bool last = (t == nt - 2);
            const char* a1 = cA + (size_t)(t + 1) * kstepA;
            const char* a2 = last ? nA : cA + (size_t)(t + 2) * kstepA; const char* b2 = last ? nB : cB + (size_t)(t + 2) * kstepB;
            const char* a3 = a2 + kstepA; const char* b3 = b2 + kstepB;
            if (last && has_next) S.a_ready(nxt);
            if (last) E.prefetch(cur, lds + STAGE_BYTES + 1024, wid, lane);
            if constexpr (SP2) {
            PG8_LDB(B0, 0, 0); PG8_LDB(B1, 0, 1); PG8_SCHED; PG8_LDA(At, 0, 0); PG8_STAGE(PG8_SA(1, 1), a1 + hstep, voffA);
            PG8_WAIT_V(8); PG8_WAIT_L(0); PG8_BAR; PG8_MMA(0, 0, At, B0); PG8_MMA(0, 1, At, B1); PG8_BAR; PG8_SCHED;
            PG8_LDA(At, 0, 1); PG8_STAGE(PG8_SB(0, 0), b2, voffB); PG8_STAGE(PG8_SB(0, 1), b2 + hstep, voffB); PG8_STAGE(PG8_SA(0, 0), a2, voffA);
            PG8_WAIT_V(8); PG8_WAIT_L(0); PG8_BAR; PG8_MMA(1, 0, At, B0); PG8_MMA(1, 1, At, B1); PG8_BAR; PG8_SCHED;
            PG8_LDB(B0, 1, 0); PG8_LDB(B1, 1, 1); PG8_SCHED; PG8_LDA(At, 1, 0); PG8_STAGE(PG8_SA(0, 1), a2 + hstep, voffA);
            PG8_WAIT_V(8); PG8_WAIT_L(0); PG8_BAR; PG8_MMA(0, 0, At, B0); PG8_MMA(0, 1, At, B1); PG8_BAR; PG8_SCHED;
            PG8_LDA(At, 1, 1); PG8_STAGE(PG8_SB(1, 0), b3, voffB); PG8_STAGE(PG8_SB(1, 1), b3 + hstep, voffB); PG8_STAGE(PG8_SA(1, 0), a3, voffA);
            PG8_WAIT_V(8); PG8_WAIT_L(0); PG8_BAR; PG8_MMA(1, 0, At, B0); PG8_MMA(1, 1, At, B1); PG8_BAR; PG8_SCHED;
            } else {
            PG8_LDB(B0, 0, 0); PG8_SCHED; PG8_LDA(At, 0, 0); PG8_STAGE(PG8_SA(1, 1), a1 + hstep, voffA);
            PG8_WAIT_L(8); PG8_BAR; PG8_WAIT_L(0); PG8_MMA(0, 0, At, B0); PG8_BAR; PG8_SCHED;
            PG8_LDB(B1, 0, 1); PG8_STAGE(PG8_SB(0, 0), b2, voffB);
            PG8_BAR; PG8_WAIT_L(0); PG8_MMA(0, 1, At, B1); PG8_BAR;
            PG8_LDA(At, 0, 1); PG8_STAGE(PG8_SA(0, 0), a2, voffA);
            PG8_BAR; PG8_WAIT_L(0); PG8_MMA(1, 0, At, B0); PG8_BAR; PG8_SCHED;
            PG8_STAGE(PG8_SB(0, 1), b2 + hstep, voffB);
            PG8_WAIT_V(6); PG8_BAR; PG8_MMA(1, 1, At, B1); PG8_BAR;
            PG8_LDB(B0, 1, 0); PG8_SCHED; PG8_LDA(At, 1, 0); PG8_STAGE(PG8_SA(0, 1), a2 + hstep, voffA);
            PG8_WAIT_L(8); PG8_BAR; PG8_WAIT_L(0); PG8_MMA(0, 0, At, B0); PG8_BAR; PG8_SCHED;
            PG8_LDB(B1, 1, 1); PG8_STAGE(PG8_SB(1, 0), b3, voffB);
            PG8_BAR; PG8_WAIT_L(0); PG8_MMA(0, 1, At, B1); PG8_BAR;
            PG8_LDA(At, 1, 1); PG8_STAGE(PG8_SA(1, 0), a3, voffA);
            PG8_BAR; PG8_WAIT_L(0); PG8_MMA(1, 0, At, B0); PG8_BAR; PG8_SCHED;
            PG8_STAGE(PG8_SB(1, 1), b3 + hstep, voffB);
            PG8_WAIT_V(6); PG8_BAR; PG8_MMA(1, 1, At, B1); PG8_BAR;
            }
        }
        if constexpr (ALIGN_EPI) { if (wr == 0) PG8_BAR; }
        if constexpr (!Epi::AFTER_DRAIN) { E(acc, cur, wr, wc, fr, fq, lds + STAGE_BYTES + 1024); S.done(cur); }
        if (!has_next) break;
#pragma unroll
        for (int a = 0; a < 2; ++a)
#pragma unroll
            for (int b = 0; b < 2; ++b)
#pragma unroll
                for (int m = 0; m < 4; ++m)
#pragma unroll
                    for (int n = 0; n < 2; ++n) { float z_; asm volatile("v_mov_b32 %0, 0" : "=v"(z_)); acc[a][b][m][n] = (f32x4){z_, z_, z_, z_}; }
        cur = nxt; cA = nA; cB = nB; ++ui;
        if constexpr (ALIGN_EPI) { if (wr == 1) PG8_BAR; }
    }
    PG8_WAIT_V(0);
    if constexpr (!ALIGN_EPI) { if (wr == 0) PG8_BAR; }
    PG8_BAR;
    if constexpr (Epi::AFTER_DRAIN) { E.fused(acc, cur, wr, wc, fr, fq, lds, wid, lane); S.done(cur); }
#undef PG8_SA
#undef PG8_SB
#undef PG8_STAGE
#undef PG8_LDA
#undef PG8_LDB
#undef PG8_MMA
#undef PG8_WAIT_V
#undef PG8_WAIT_L
#undef PG8_BAR
#undef PG8_SCHED
}
}
#define GAS __attribute__((address_space(1)))
#define LAS __attribute__((address_space(3)))
typedef unsigned short bf16;
typedef unsigned v4u __attribute__((ext_vector_type(4)));
typedef float f32x4 __attribute__((ext_vector_type(4)));
typedef short bf16x8 __attribute__((ext_vector_type(8)));
typedef GAS unsigned gu32;
typedef GAS unsigned long long gu64;
#define RLX_AGENT __ATOMIC_RELAXED, __HIP_MEMORY_SCOPE_AGENT
#define LDS_WAIT() asm volatile("s_waitcnt lgkmcnt(0)" ::: "memory")
#define VM_WAIT() asm volatile("s_waitcnt vmcnt(0)" ::: "memory")
__device__ __forceinline__ unsigned long long rt() { return __builtin_amdgcn_s_memrealtime(); }
__device__ __forceinline__ unsigned f2bf(float f) { unsigned u = __builtin_bit_cast(unsigned, f); return (u + 0x7fffu + ((u >> 16) & 1u)) >> 16; }
__device__ __forceinline__ unsigned pk2(float lo, float hi) { return f2bf(lo) | (f2bf(hi) << 16); }

#define XB_TMO      128
#define XB_XCNT(j)  (256  + 64 * (j))
#define XB_XSUB(j)  (1280 + 64 * (j))
#define XB_XGEN(j)  (2304 + 64 * (j))
#define XB_TOP      3328
#define XB_TOPGEN   3392
#define XCD_BAR_WORDS 3456
#define XB_SPIN_CAP (1u << 18)

__device__ __forceinline__ unsigned xb_ld(unsigned* p)              { return __hip_atomic_load(p, __ATOMIC_RELAXED, __HIP_MEMORY_SCOPE_AGENT); }
__device__ __forceinline__ unsigned xb_add(unsigned* p, unsigned v) { return __hip_atomic_fetch_add(p, v, __ATOMIC_RELAXED, __HIP_MEMORY_SCOPE_AGENT); }
__device__ __forceinline__ unsigned xb_xcc_id() { return (unsigned)__builtin_amdgcn_s_getreg((3 << 11) | 20) & 0xFu; }
#define XB_SPIN(cond, bar) do { unsigned _sp = 0; while (cond) { __builtin_amdgcn_s_sleep(1); \
    if ((++_sp & 255u) == 0u) { if (xb_ld(&(bar)[XB_TMO])) break; if (_sp > XB_SPIN_CAP) { atomicAdd(&(bar)[XB_TMO], 1u); break; } } } } while (0)

struct XcdBarrier {
    unsigned* bar; unsigned x;
    volatile LAS unsigned* st;
};

__device__ __forceinline__ XcdBarrier xcd_barrier_post(unsigned* bar, volatile LAS unsigned* st) {
    XcdBarrier b; b.bar = bar; b.x = xb_xcc_id(); b.st = st;
    if (threadIdx.x == 0) (void)xb_add(&bar[XB_XCNT(b.x)], 1u);
    return b;
}
__device__ __forceinline__ void xcd_barrier_complete(unsigned* bar, unsigned x, unsigned& nloc, unsigned& nx) {
    const unsigned G = gridDim.x * gridDim.y * gridDim.z;
    unsigned sum, cnt, mine, sp = 0u;
    for (;;) {
        sum = 0u; cnt = 0u; mine = 0u;
#pragma unroll
        for (unsigned j = 0; j < 16; ++j) { const unsigned c = xb_ld(&bar[XB_XCNT(j)]); sum += c; cnt += (c > 0u) ? 1u : 0u; mine = (j == x) ? c : mine; }
        if (sum == G) break;
        __builtin_amdgcn_s_sleep(1);
        if ((++sp & 255u) == 0u) { if (xb_ld(&bar[XB_TMO])) break; if (sp > XB_SPIN_CAP) { atomicAdd(&bar[XB_TMO], 1u); break; } }
    }
    nloc = mine > 0u ? mine : 1u; nx = cnt > 0u ? cnt : 1u;
}

__device__ __forceinline__ void xcd_barrier(const XcdBarrier& b) {
    asm volatile("s_waitcnt vmcnt(0)" ::: "memory");
    __syncthreads();
    if (threadIdx.x == 0) {
        unsigned* bar = b.bar;
        __builtin_amdgcn_s_waitcnt(0);
        unsigned nloc = b.st[0], nx = b.st[1];
        if (nloc == 0u) { xcd_barrier_complete(bar, b.x, nloc, nx); b.st[0] = nloc; b.st[1] = nx; }
        const unsigned old = xb_add(&bar[XB_XSUB(b.x)], 1u);
        const unsigned gen = old / nloc;
        if (old + 1u == (gen + 1u) * nloc) {
            __builtin_amdgcn_fence(__ATOMIC_RELEASE, "agent");
            asm volatile("s_waitcnt vmcnt(0)" ::: "memory");
            const unsigned og = xb_add(&bar[XB_TOP], 1u);
            const unsigned tg = og / nx;
            if (og + 1u == (tg + 1u) * nx) xb_add(&bar[XB_TOPGEN], 1u);
            else XB_SPIN(xb_ld(&bar[XB_TOPGEN]) == tg, bar);
            __builtin_amdgcn_fence(__ATOMIC_ACQUIRE, "agent");
            xb_add(&bar[XB_XGEN(b.x)], 1u);
            asm volatile("s_waitcnt vmcnt(0)" ::: "memory");
        } else {
            XB_SPIN(xb_ld(&bar[XB_XGEN(b.x)]) == gen, bar);
            __builtin_amdgcn_fence(__ATOMIC_ACQUIRE, "agent");
            asm volatile("s_waitcnt vmcnt(0)" ::: "memory");
        }
    }
    __syncthreads();
}

constexpr int NWAVES = 8;
constexpr int BATCH = 4, SEQ = 8192, D = 1024, M = BATCH * SEQ, DEPTH = 2;
constexpr int INW = 2048, DFF = 2816, NMOD = 6;
constexpr int O_U = 0, O_QB = 256, O_KB = 640, O_VB = 1024, O_QC = 1408, O_KC = 1792, O_VC = 1920;
constexpr float RMS_EPS = 1e-6f;
constexpr float LOG2E = 1.4426950408889634f;
constexpr float QSCALE = 0.125f * LOG2E;

constexpr size_t MiB = 1u << 20;
constexpr size_t WS_CTL = 0, CTL_ZERO_BYTES = 131072;
constexpr size_t WS_MOD = 1 * MiB;
constexpr size_t WS_W = 2 * MiB, W_LAYER = 24 * MiB;
constexpr size_t W_IN = 0, W_OUT = 4 * MiB, W_GU = 6 * MiB, W_DN = 17 * MiB, W_PT = 23 * MiB;
constexpr size_t WS_H = 50 * MiB;
constexpr size_t WS_Z = 114 * MiB;
constexpr size_t WS_MIX = 242 * MiB;
constexpr size_t WS_HID = 114 * MiB;
constexpr size_t WS_XS = 306 * MiB;
constexpr size_t WS_AUX = 434 * MiB;
constexpr size_t WS_SUMSQ = WS_AUX;
constexpr size_t WS_GV = WS_AUX + 1 * MiB;
constexpr size_t WS_BIAS = WS_GV + 65536;
constexpr size_t BIAS_LAYER = (size_t)BATCH * (2048 + 5632) * 4;
constexpr size_t WS_BSCR = 370 * MiB;
constexpr size_t WS_ZC = 202 * MiB;
constexpr size_t WS_ZB = 130 * MiB;
constexpr size_t WS_END = 436 * MiB;
static_assert(WS_Z + (size_t)M * 256 * 2 <= WS_ZB && WS_ZB + 72 * MiB <= WS_ZC && WS_ZC + 40 * MiB <= WS_MIX, "z region map");
static_assert(WS_HID + (size_t)M * DFF * 2 <= WS_XS && WS_MIX + (size_t)M * D * 2 <= WS_XS && WS_Z + (size_t)M * 256 * 2 <= WS_MIX && WS_H + (size_t)M * D * 2 <= WS_Z, "ws map");
constexpr int CW_TMO = 0, CW_CODE = 1, CW_BAR = 4096  , CW_QUEUE = 20480, CW_ZEROS = 24576  ;

constexpr int RING_OFF = 0, RING_BYTES = 131072;
constexpr int LDSCTL_OFF = RING_BYTES, MISC_OFF = 147456 - 256, LSEB_OFF = MISC_OFF - 6144;
constexpr int LDS_BYTES = 147456;

constexpr int PH_PRO = 0, PH_CONV = 1, PH_L0 = 2, PH_PER_LAYER = 5, PH_FINAL = PH_L0 + DEPTH * PH_PER_LAYER, NPHASES = PH_FINAL + 1;
#ifndef PROBE_DUP
#define PROBE_DUP 0
#endif
#ifndef PROBE_CUT
#define PROBE_CUT 0
#endif
#ifndef PROBE_MIXSEL
#define PROBE_MIXSEL 0
#endif
#ifndef PROBE_NOSTORE
#define PROBE_NOSTORE 0
#endif
#ifndef MK_ONE_LAUNCH
#define MK_ONE_LAUNCH 1
#endif

struct Frame {
    LAS unsigned char* lds;
    volatile LAS unsigned* MISC;
    gu32* ctl;
    int tid, lane, wave, G, vcu;
};

__device__ __forceinline__ float wave_sum(float v) {
#pragma unroll
    for (int o = 1; o < 64; o <<= 1) v += __shfl_xor(v, o);
    return v;
}
__device__ __forceinline__ float bf2f(unsigned short b) { return __uint_as_float((unsigned)b << 16); }
__device__ __forceinline__ float zero_() { float z; asm volatile("v_mov_b32 %0, 0" : "=v"(z)); return z; }
__device__ __forceinline__ f32x4 zero4_() { const float z = zero_(); return (f32x4){z, z, z, z}; }

__device__ __forceinline__ void tr_item(const float* W, int N, int k0, int n0, bf16* WT, int ldt, int drow0, float scale, LAS float* scr, int lane, bool img = true) {
#pragma unroll 8
    for (int i = 0; i < 32; ++i) { const int kk = 2 * i + (lane >> 5); scr[kk * 33 + (lane & 31)] = __builtin_nontemporal_load(W + (size_t)(k0 + kk) * N + n0 + (lane & 31)); }
    LDS_WAIT(); asm volatile("" ::: "memory");
    const int c = lane & 7;
#pragma unroll
    for (int j = 0; j < 4; ++j) { const int n = (lane >> 3) + 8 * j; const LAS float* s = scr + (8 * c) * 33 + n;
        v4u o; o.x = pk2(s[0 * 33] * scale, s[1 * 33] * scale); o.y = pk2(s[2 * 33] * scale, s[3 * 33] * scale); o.z = pk2(s[4 * 33] * scale, s[5 * 33] * scale); o.w = pk2(s[6 * 33] * scale, s[7 * 33] * scale);
        if (img) *(GAS v4u*)((unsigned char*)WT + pg8::img_off(drow0 + n, k0 + 8 * c, ldt / 64, true)) = o;
        else *(GAS v4u*)(WT + (size_t)(drow0 + n) * ldt + k0 + 8 * c) = o; }
    LDS_WAIT(); asm volatile("" ::: "memory");
}
constexpr int TI_IN = 16 * 64, TI_OUT = 16 * 32, TI_G = 16 * 88, TI_DN = 44 * 32, TI_P = 8, TI_LAYER = TI_IN + TI_OUT + 2 * TI_G + TI_DN + TI_P;
__device__ __forceinline__ void weight_item(const float* const* in, unsigned char* ws, int it, LAS float* scr, int lane) {
    const int l = it / TI_LAYER; int r = it % TI_LAYER;
    unsigned char* wl = ws + WS_W + (size_t)l * W_LAYER;
    if (r < TI_IN) { const int kb = r / 64, n0 = 32 * (r % 64); const bool isq = (n0 >= O_QB && n0 < O_KB) || (n0 >= O_QC && n0 < O_KC);
        tr_item(in[6] + (size_t)l * D * INW, INW, 64 * kb, n0, (bf16*)(wl + W_IN), D, n0, isq ? QSCALE : 1.0f, scr, lane); return; }
    r -= TI_IN;
    if (r < TI_OUT) { const int kb = r / 32, n0 = 32 * (r % 32); tr_item(in[10] + (size_t)l * D * D, D, 64 * kb, n0, (bf16*)(wl + W_OUT), D, n0, 1.0f, scr, lane); return; }
    r -= TI_OUT;
    if (r < 2 * TI_G) { const int up = r >= TI_G; if (up) r -= TI_G; const int kb = r / 88, n0 = 32 * (r % 88);
        tr_item(in[up ? 12 : 11] + (size_t)l * D * DFF, DFF, 64 * kb, n0, (bf16*)(wl + W_GU), D, 256 * (n0 >> 7) + 128 * up + (n0 & 127), 1.0f, scr, lane); return; }
    r -= 2 * TI_G;
    if (r < TI_DN) { const int kb = r / 32, n0 = 32 * (r % 32); tr_item(in[13] + (size_t)l * DFF * D, D, 64 * kb, n0, (bf16*)(wl + W_DN), DFF, n0, 1.0f, scr, lane); return; }
    r -= TI_DN;
    { const int g = r >> 1, n0 = 32 * (r & 1); tr_item(in[7] + (size_t)l * 16384 + g * 4096, 64, 0, n0, (bf16*)(wl + W_PT) + g * 4096, 64, n0, 1.0f, scr, lane, false); }
}
__device__ __forceinline__ void ada_item(Frame& F, const float* const* in, unsigned char* ws, int item) {
    LAS float* cact = (LAS float*)(F.lds);
    LAS float* red = (LAS float*)(F.lds + 16384);
    const int l = item / 96, cb = item % 96;
    const float* c = in[1];
    for (int i = F.tid; i < BATCH * D; i += NWAVES * 64) { const int b = i >> 10, k = i & 1023; const float v = c[i]; cact[k * 4 + b] = v / (1.0f + __expf(-v)); }
    __syncthreads();
    const float* W = in[4] + (size_t)l * D * (NMOD * D) + 64 * cb + F.lane;
    float a0 = 0.f, a1 = 0.f, a2 = 0.f, a3 = 0.f;
    const int kbeg = 128 * F.wave;
#pragma unroll 16
    for (int kk = 0; kk < 128; ++kk) { const float wv = __builtin_nontemporal_load(W + (size_t)(kbeg + kk) * (NMOD * D)); const f32x4 ca = *(const LAS f32x4*)(cact + (kbeg + kk) * 4);
        a0 += ca.x * wv; a1 += ca.y * wv; a2 += ca.z * wv; a3 += ca.w * wv; }
    red[(F.wave * 4 + 0) * 64 + F.lane] = a0; red[(F.wave * 4 + 1) * 64 + F.lane] = a1; red[(F.wave * 4 + 2) * 64 + F.lane] = a2; red[(F.wave * 4 + 3) * 64 + F.lane] = a3;
    __syncthreads();
    if (F.wave < 4) { float s = in[5][(size_t)l * NMOD * D + 64 * cb + F.lane];
#pragma unroll
        for (int w = 0; w < 8; ++w) s += red[(w * 4 + F.wave) * 64 + F.lane];
        ((float*)(ws + WS_MOD))[((size_t)l * BATCH + F.wave) * (NMOD * D) + 64 * cb + F.lane] = s; }
    __syncthreads();
}
__device__ __forceinline__ void p_prologue(Frame& F, const float* const* in, unsigned char* ws) {
    for (int item = blockIdx.x; item < DEPTH * 96; item += F.G) ada_item(F, in, ws, item);
    LAS float* scr = (LAS float*)(F.lds + RING_OFF + F.wave * 16384);
    const int gw = blockIdx.x * NWAVES + F.wave, NGW = F.G * NWAVES;
    for (int it = gw; it < DEPTH * TI_LAYER; it += NGW) weight_item(in, ws, it, scr, F.lane);
    { GAS f32x4* z = (GAS f32x4*)(ws + WS_SUMSQ) + M / 4; const int n4 = 4 * M / 4;
      for (int i = blockIdx.x * (NWAVES * 64) + F.tid; i < n4; i += F.G * NWAVES * 64) z[i] = zero4_(); }
}

__device__ __forceinline__ void p_conv(Frame& F, const float* const* in, unsigned char* ws) {
    const float* MOD = (const float*)(ws + WS_MOD);
    const int NGW = F.G * NWAVES, gw = blockIdx.x * NWAVES + F.wave, rpw = M / NGW;
    {
        const int row0 = gw * rpw, b = row0 / SEQ;
        const float* mb = MOD + (size_t)b * (NMOD * D);
        const float* xin = in[0]; bf16* hout = (bf16*)(ws + WS_H); float* ssq = (float*)(ws + WS_SUMSQ);
        f32x4 Gv[4];
#pragma unroll
        for (int j = 0; j < 4; ++j) { const int cidx = 4 * F.lane + 256 * j; const f32x4 g = *(const f32x4*)(in[2] + cidx), sc = *(const f32x4*)(mb + 1 * D + cidx); Gv[j] = g * (sc + 1.0f); }
        for (int rr = 0; rr < rpw; rr += 4) {
            f32x4 v[4][4];
#pragma unroll
            for (int i = 0; i < 4; ++i) { const GAS f32x4* xr = (const GAS f32x4*)(xin + (size_t)(row0 + rr + i) * D) + F.lane;
#pragma unroll
                for (int j = 0; j < 4; ++j) v[i][j] = __builtin_nontemporal_load(xr + 64 * j); }
#pragma unroll
            for (int i = 0; i < 4; ++i) { const size_t row = (size_t)(row0 + rr + i); float s = 0.f;
#pragma unroll
                for (int j = 0; j < 4; ++j) s += (v[i][j].x * v[i][j].x + v[i][j].y * v[i][j].y) + (v[i][j].z * v[i][j].z + v[i][j].w * v[i][j].w);
                s = wave_sum(s); if (F.lane == 0) ssq[row] = s;
                unsigned char* hb = (unsigned char*)hout + 8 * (F.lane & 1);
#pragma unroll
                for (int j = 0; j < 4; ++j) { const f32x4 o = v[i][j] * Gv[j]; *(GAS unsigned long long*)(hb + pg8::img_off((int)row, (4 * F.lane + 256 * j) & ~7, D / 64, false)) = (unsigned long long)pk2(o.x, o.y) | ((unsigned long long)pk2(o.z, o.w) << 32);
 } }
        }
    }
    {
        float* GV = (float*)(ws + WS_GV);
        for (int i = blockIdx.x * (NWAVES * 64) + F.tid; i < DEPTH * 2 * BATCH * D; i += F.G * NWAVES * 64) { const int col = i & (D - 1), b = (i >> 10) & 3, w = (i >> 12) & 1, l = i >> 13;
            GV[i] = in[w ? 3 : 2][l * D + col] * (1.0f + MOD[((size_t)l * BATCH + b) * (NMOD * D) + (w ? 4 : 1) * D + col]); }
    }
    {
        const int g0 = 8 * gw;
        if (g0 < DEPTH * (INW + 2 * DFF)) {
            const int l = g0 / (INW + 2 * DFF), rl = g0 % (INW + 2 * DFF), w = rl >= INW, n0 = w ? rl - INW : rl, N = w ? 2 * DFF : INW;
            const unsigned char* Bt = ws + WS_W + (size_t)l * W_LAYER + (w ? W_GU : W_IN);
            float* bias = (float*)(ws + WS_BIAS + (size_t)l * BIAS_LAYER) + (w ? BATCH * INW : 0);
            const float* shp = MOD + (size_t)l * BATCH * (NMOD * D) + (w ? 3 : 0) * D + 16 * F.lane;
            v4u wr[8][2];
#pragma unroll
            for (int i = 0; i < 8; ++i) { wr[i][0] = *(const GAS v4u*)(Bt + pg8::img_off(n0 + i, 16 * F.lane, D / 64, true)); wr[i][1] = *(const GAS v4u*)(Bt + pg8::img_off(n0 + i, 16 * F.lane + 8, D / 64, true)); }
            f32x4 sh[4][4];
#pragma unroll
            for (int b = 0; b < 4; ++b)
#pragma unroll
                for (int j = 0; j < 4; ++j) sh[b][j] = *(const f32x4*)(shp + (size_t)b * (NMOD * D) + 4 * j);
#pragma unroll
            for (int i = 0; i < 8; ++i) { const v4u w0 = wr[i][0], w1 = wr[i][1];
                float wf[16];
                wf[0] = __uint_as_float(w0.x << 16); wf[1] = __uint_as_float(w0.x & 0xffff0000u); wf[2] = __uint_as_float(w0.y << 16); wf[3] = __uint_as_float(w0.y & 0xffff0000u);
                wf[4] = __uint_as_float(w0.z << 16); wf[5] = __uint_as_float(w0.z & 0xffff0000u); wf[6] = __uint_as_float(w0.w << 16); wf[7] = __uint_as_float(w0.w & 0xffff0000u);
                wf[8] = __uint_as_float(w1.x << 16); wf[9] = __uint_as_float(w1.x & 0xffff0000u); wf[10] = __uint_as_float(w1.y << 16); wf[11] = __uint_as_float(w1.y & 0xffff0000u);
                wf[12] = __uint_as_float(w1.z << 16); wf[13] = __uint_as_float(w1.z & 0xffff0000u); wf[14] = __uint_as_float(w1.w << 16); wf[15] = __uint_as_float(w1.w & 0xffff0000u);
                float acc[4];
#pragma unroll
                for (int b = 0; b < 4; ++b) { float a = 0.f;
#pragma unroll
                    for (int j = 0; j < 4; ++j) a += (wf[4 * j] * sh[b][j].x + wf[4 * j + 1] * sh[b][j].y) + (wf[4 * j + 2] * sh[b][j].z + wf[4 * j + 3] * sh[b][j].w);
                    acc[b] = wave_sum(a); }
                if (F.lane < 4) bias[(size_t)F.lane * N + n0 + i] = F.lane == 0 ? acc[0] : F.lane == 1 ? acc[1] : F.lane == 2 ? acc[2] : acc[3]; }
        }
    }
}
__device__ __forceinline__ void p_norm_final(Frame& F, const bf16* xin, const float* ssq, float* out, const float* gvec) {
    const int NGW = F.G * NWAVES, gw = blockIdx.x * NWAVES + F.wave, rpw = M / NGW;
    const int row0 = gw * rpw;
    f32x4 Gv[4];
#pragma unroll
    for (int j = 0; j < 4; ++j) Gv[j] = *(const f32x4*)(gvec + 4 * F.lane + 256 * j);
    for (int rr = 0; rr < rpw; rr += 4) {
        unsigned long long w[4][4]; float ss[4];
#pragma unroll
        for (int i = 0; i < 4; ++i) { const unsigned char* xr = (const unsigned char*)xin + 8 * (F.lane & 1); ss[i] = ssq[row0 + rr + i];
#pragma unroll
            for (int j = 0; j < 4; ++j) w[i][j] = *(const GAS unsigned long long*)(xr + pg8::img_off(row0 + rr + i, (4 * F.lane + 256 * j) & ~7, D / 64, false)); }
#pragma unroll
        for (int i = 0; i < 4; ++i) { const float rstd = 1.0f / sqrtf(ss[i] * (1.0f / D) + RMS_EPS);
            GAS f32x4* o = (GAS f32x4*)(out + (size_t)(row0 + rr + i) * D) + F.lane;
#pragma unroll
            for (int j = 0; j < 4; ++j) { const unsigned wl = (unsigned)w[i][j], wh = (unsigned)(w[i][j] >> 32);
                const f32x4 v = {pg8::h_lo(wl), pg8::h_hi(wl), pg8::h_lo(wh), pg8::h_hi(wh)};
                __builtin_nontemporal_store(v * rstd * Gv[j], o + 64 * j); } }
    }
}

namespace mx {
typedef short bf16x8 __attribute__((ext_vector_type(8)));
typedef short s16x4 __attribute__((ext_vector_type(4)));
typedef float f32x16 __attribute__((ext_vector_type(16)));
typedef unsigned u32x4 __attribute__((ext_vector_type(4)));
typedef unsigned u32x2 __attribute__((ext_vector_type(2)));
typedef float f32x2_t __attribute__((ext_vector_type(2))); typedef __bf16 bf16x2_t __attribute__((ext_vector_type(2)));
constexpr float THR = 8.0f;
constexpr int POOL_PITCH = 544;
__device__ __forceinline__ unsigned cvtpk(float lo, float hi) { f32x2_t v = {lo, hi}; bf16x2_t b = __builtin_convertvector(v, bf16x2_t); return __builtin_bit_cast(unsigned, b); }
__device__ __forceinline__ float hswap_max(float v) { auto rr = __builtin_amdgcn_permlane32_swap(__float_as_uint(v), __float_as_uint(v), false, false); return fmaxf(__uint_as_float(rr[0]), __uint_as_float(rr[1])); }
__device__ __forceinline__ float hswap_sum(float v) { auto rr = __builtin_amdgcn_permlane32_swap(__float_as_uint(v), __float_as_uint(v), false, false); return __uint_as_float(rr[0]) + __uint_as_float(rr[1]); }
__device__ __forceinline__ s16x4 vtr(const LAS char* p) { return __builtin_bit_cast(s16x4, __builtin_amdgcn_ds_read_tr16_b64_v4i16((LAS s16x4*)p)); }
__device__ __forceinline__ f32x16 zero16_() { const float z = zero_(); return (f32x16){z, z, z, z, z, z, z, z, z, z, z, z, z, z, z, z}; }
__device__ __forceinline__ int kt_of(int i) { return (i & 1) ? -((i + 1) >> 1) : (i >> 1); }

template <int VAR>
__device__ __forceinline__ float scores(f32x16& t, const bf16x8 (&kf)[4], const bf16x8 (&qf)[4], float relf, float sl, float slope2, float Rf) {
    f32x16 s = {0.f, 0.f, 0.f, 0.f, 0.f, 0.f, 0.f, 0.f, 0.f, 0.f, 0.f, 0.f, 0.f, 0.f, 0.f, 0.f};
#pragma unroll
    for (int i = 0; i < 4; ++i) s = __builtin_amdgcn_mfma_f32_32x32x16_bf16(kf[i], qf[i], s, 0, 0, 0);
    if (VAR == 0) {
#pragma unroll
        for (int r = 0; r < 16; ++r) t[r] = __builtin_fmaf(-__builtin_fabsf(relf - (float)((r & 3) + 8 * (r >> 2))), slope2, s[r]);
        return 0.f;
    } else {
#pragma unroll
        for (int r = 0; r < 16; ++r) { const float c = (float)((r & 3) + 8 * (r >> 2)); float v = __builtin_fmaf(sl, c, s[r]); if (VAR == 2) v = __builtin_fabsf(relf - c) > Rf ? -INFINITY : v; t[r] = v; }
        return -sl * relf;
    }
}
__device__ __forceinline__ float lane_max(const f32x16& t) {
    float a = fmaxf(fmaxf(t[0], t[1]), fmaxf(t[2], t[3])), b = fmaxf(fmaxf(t[4], t[5]), fmaxf(t[6], t[7])), c = fmaxf(fmaxf(t[8], t[9]), fmaxf(t[10], t[11])), d = fmaxf(fmaxf(t[12], t[13]), fmaxf(t[14], t[15]));
    return fmaxf(fmaxf(a, b), fmaxf(c, d));
}
__device__ __forceinline__ float tile_max(const f32x16& t) {
    float a = fmaxf(fmaxf(t[0], t[1]), fmaxf(t[2], t[3])), b = fmaxf(fmaxf(t[4], t[5]), fmaxf(t[6], t[7])), c = fmaxf(fmaxf(t[8], t[9]), fmaxf(t[10], t[11])), d = fmaxf(fmaxf(t[12], t[13]), fmaxf(t[14], t[15]));
    return hswap_max(fmaxf(fmaxf(a, b), fmaxf(c, d)));
}
__device__ __forceinline__ void load_frag4(bf16x8 (&f)[4], const bf16* rowp, int hi) {
#pragma unroll
    for (int i = 0; i < 4; ++i) f[i] = *(const bf16x8*)(rowp + 16 * i + 8 * hi);
}
__device__ __forceinline__ void load_tile_frags(bf16x8 (&f)[4], const char* tile, int lane) {
#pragma unroll
    for (int s = 0; s < 4; ++s) f[s] = *(const bf16x8*)(tile + s * 1024 + lane * 16);
}
__device__ __forceinline__ void dma_tile(LAS char* dst, const char* tile, int lane) {
#pragma unroll
    for (int j = 0; j < 4; ++j) __builtin_amdgcn_global_load_lds((const unsigned*)(tile + j * 1024 + lane * 16), (LAS unsigned*)(dst + j * 1024), 16, 0, 0);
}
__device__ __forceinline__ void dma_v(LAS char* vb, const bf16* vrow0, long rs, int lane) {
#pragma unroll
    for (int j = 0; j < 4; ++j) __builtin_amdgcn_global_load_lds((const unsigned*)(vrow0 + (long)(16 * (j & 1) + (lane >> 2)) * rs + (4 * (j >> 1) + (lane & 3)) * 8), (LAS unsigned*)(vb + j * 1024), 16, 0, 0);
}
__device__ __forceinline__ void load_vfrags(bf16x8 (&vf)[2][2], const LAS char* vaddr) {
#pragma unroll
    for (int d0 = 0; d0 < 2; ++d0)
#pragma unroll
        for (int ks = 0; ks < 2; ++ks) { const s16x4 lo = vtr(vaddr + d0 * 2048 + ks * 1024), hh = vtr(vaddr + d0 * 2048 + ks * 1024 + 512);
            vf[d0][ks] = (bf16x8){lo[0], lo[1], lo[2], lo[3], hh[0], hh[1], hh[2], hh[3]}; }
}
__device__ __forceinline__ void pv_tile(f32x16 (&o)[2], const bf16x8 (&vf)[2][2], const f32x16& p) {
    u32x4 w0, w1;
    w0.x = cvtpk(p[0], p[1]); w0.y = cvtpk(p[2], p[3]); w0.z = cvtpk(p[4], p[5]); w0.w = cvtpk(p[6], p[7]);
    w1.x = cvtpk(p[8], p[9]); w1.y = cvtpk(p[10], p[11]); w1.z = cvtpk(p[12], p[13]); w1.w = cvtpk(p[14], p[15]);
    const bf16x8 pa0 = __builtin_bit_cast(bf16x8, w0), pa1 = __builtin_bit_cast(bf16x8, w1);
#pragma unroll
    for (int d0 = 0; d0 < 2; ++d0) { o[d0] = __builtin_amdgcn_mfma_f32_32x32x16_bf16(vf[d0][0], pa0, o[d0], 0, 0, 0); o[d0] = __builtin_amdgcn_mfma_f32_32x32x16_bf16(vf[d0][1], pa1, o[d0], 0, 0, 0); }
}
__device__ __forceinline__ void store_o(bf16* MIX, int row, int col, const f32x16 (&o)[2], float scale, int hi) {
#pragma unroll
    for (int d0 = 0; d0 < 2; ++d0)
#pragma unroll
        for (int g = 0; g < 4; g += 2) {
            const unsigned ax = cvtpk(o[d0][4 * g] * scale, o[d0][4 * g + 1] * scale), ay = cvtpk(o[d0][4 * g + 2] * scale, o[d0][4 * g + 3] * scale);
            const unsigned bx = cvtpk(o[d0][4 * g + 4] * scale, o[d0][4 * g + 5] * scale), by = cvtpk(o[d0][4 * g + 6] * scale, o[d0][4 * g + 7] * scale);
            const auto rx = __builtin_amdgcn_permlane32_swap(ax, bx, false, false); const auto ry = __builtin_amdgcn_permlane32_swap(ay, by, false, false);
            u32x4 w; w.x = rx[0]; w.y = ry[0]; w.z = rx[1]; w.w = ry[1];
            *(u32x4*)((unsigned char*)MIX + pg8::img_off(row, col + 32 * d0 + 8 * g + 8 * hi, D / 64, false)) = w; }
}
__device__ __forceinline__ void pack_o(u32x4 (&w)[4], const f32x16 (&o)[2], float scale) {
#pragma unroll
    for (int d0 = 0; d0 < 2; ++d0)
#pragma unroll
        for (int g = 0; g < 4; g += 2) {
            const unsigned ax = cvtpk(o[d0][4 * g] * scale, o[d0][4 * g + 1] * scale), ay = cvtpk(o[d0][4 * g + 2] * scale, o[d0][4 * g + 3] * scale);
            const unsigned bx = cvtpk(o[d0][4 * g + 4] * scale, o[d0][4 * g + 5] * scale), by = cvtpk(o[d0][4 * g + 6] * scale, o[d0][4 * g + 7] * scale);
            const auto rx = __builtin_amdgcn_permlane32_swap(ax, bx, false, false); const auto ry = __builtin_amdgcn_permlane32_swap(ay, by, false, false);
            w[2 * d0 + (g >> 1)] = (u32x4){rx[0], ry[0], rx[1], ry[1]}; }
}
__device__ __forceinline__ float alibi_slope(int k  ) { return __builtin_amdgcn_exp2f(-8.0f * (float)(k + 1) / 12.0f); }
__device__ __forceinline__ void scale_o(f32x16 (&o)[2], float f) {
#pragma unroll
    for (int r = 0; r < 16; ++r) { o[0][r] *= f; o[1][r] *= f; }
}

template <bool FIRST, bool WITH_O>
__device__ __forceinline__ void step_rest(f32x16 (&o)[2], float& m, float& l, f32x16& t, float off, const bf16x8 (&vf)[2][2]) {
    const float tm = hswap_max(lane_max(t) + off);
    if (FIRST) m = tm;
    else if (__any(tm - m > THR)) { const float dl = fmaxf(tm - m, 0.f), f = __builtin_amdgcn_exp2f(-dl); l *= f; if (WITH_O) scale_o(o, f); m += dl; }
    const float bm = off - m; f32x2_t ps = {0.f, 0.f}; const f32x2_t bm2 = {bm, bm};
#pragma unroll
    for (int r = 0; r < 16; r += 2) { const f32x2_t x = (f32x2_t){t[r], t[r + 1]} + bm2; t[r] = __builtin_amdgcn_exp2f(x.x); t[r + 1] = __builtin_amdgcn_exp2f(x.y); ps += (f32x2_t){t[r], t[r + 1]}; }
    l += ps.x + ps.y;
    if (WITH_O) pv_tile(o, vf, t);
}
template <int VAR, bool FIRST, bool WITH_O>
__device__ __forceinline__ void step(f32x16 (&o)[2], float& m, float& l, const bf16x8 (&kf)[4], const bf16x8 (&qf)[4], const bf16x8 (&vf)[2][2], float relf, float sl, float slope2, float Rf) {
    f32x16 t; const float off = scores<VAR>(t, kf, qf, relf, sl, slope2, Rf);
    step_rest<FIRST, WITH_O>(o, m, l, t, off, vf);
}

__device__ __forceinline__ void pair_rest(f32x16 (&o)[2], float& m, float& l, f32x16& tL, f32x16& tR, float offL, float offR, const LAS char* vL, const LAS char* vR) {
    const float tm = hswap_max(fmaxf(lane_max(tL) + offL, lane_max(tR) + offR));
    if (__any(tm - m > THR)) { const float dl = fmaxf(tm - m, 0.f), f = __builtin_amdgcn_exp2f(-dl); l *= f; scale_o(o, f); m += dl; }
    const float bL = offL - m, bR = offR - m; f32x2_t ps = {0.f, 0.f}; const f32x2_t bL2 = {bL, bL}, bR2 = {bR, bR};
#pragma unroll
    for (int r = 0; r < 16; r += 2) { const f32x2_t xL = (f32x2_t){tL[r], tL[r + 1]} + bL2, xR = (f32x2_t){tR[r], tR[r + 1]} + bR2;
        tL[r] = __builtin_amdgcn_exp2f(xL.x); tL[r + 1] = __builtin_amdgcn_exp2f(xL.y); tR[r] = __builtin_amdgcn_exp2f(xR.x); tR[r + 1] = __builtin_amdgcn_exp2f(xR.y);
        ps += (f32x2_t){tL[r], tL[r + 1]}; ps += (f32x2_t){tR[r], tR[r + 1]}; }
    l += ps.x + ps.y;
    { bf16x8 vf[2][2]; load_vfrags(vf, vL); pv_tile(o, vf, tL); }
    { bf16x8 vf[2][2]; load_vfrags(vf, vR); pv_tile(o, vf, tR); }
}
template <int VAR>
__device__ __forceinline__ void step_pair_lds(f32x16 (&o)[2], float& m, float& l, const LAS char* kL, const LAS char* kR, const LAS char* vL, const LAS char* vR, bf16x8 (&qf)[4],
                                              float relfL, float relfR, float slope2, float Rf, const char* qnext = nullptr, int lane = 0) {
    f32x16 tL, tR; float offL, offR;
    { bf16x8 kf[4];
#pragma unroll
      for (int s = 0; s < 4; ++s) kf[s] = *(const LAS bf16x8*)(kL + s * 1024);
      offL = scores<VAR>(tL, kf, qf, relfL, slope2, slope2, Rf); }
    { bf16x8 kf[4];
#pragma unroll
      for (int s = 0; s < 4; ++s) kf[s] = *(const LAS bf16x8*)(kR + s * 1024);
      offR = scores<VAR>(tR, kf, qf, relfR, -slope2, slope2, Rf); }
    if (qnext) load_tile_frags(qf, qnext, lane);
    pair_rest(o, m, l, tL, tR, offL, offR, vL, vR);
}
template <int VAR>
__device__ __forceinline__ void step_pair_regk(f32x16 (&o)[2], float& m, float& l, const bf16x8 (&kfL)[4], const bf16x8 (&kfR)[4], const LAS char* vL, const LAS char* vR, const bf16x8 (&qf)[4],
                                               float relfL, float relfR, float slope2, float Rf) {
    f32x16 tL, tR; const float offL = scores<VAR>(tL, kfL, qf, relfL, slope2, slope2, Rf), offR = scores<VAR>(tR, kfR, qf, relfR, -slope2, slope2, Rf);
    pair_rest(o, m, l, tL, tR, offL, offR, vL, vR);
}

__device__ __forceinline__ void dma_k(LAS char* kb, const bf16* krow0, long rs, int lane) {
#pragma unroll
    for (int s = 0; s < 4; ++s) __builtin_amdgcn_global_load_lds((const unsigned*)(krow0 + (long)(lane & 31) * rs + 16 * s + 8 * (lane >> 5)), (LAS unsigned*)(kb + s * 1024), 16, 0, 0);
}
struct BTile { const char* qb; const char* kb; const char* vb; int nt  , t0  , n0, head, d, r, tl; float slope2; };
__device__ __forceinline__ BTile b_decode(const char* ZB, int b, int c, int j, int qi, int q) {
    BTile t; const int g = qi >> 4, i = qi & 15, lg = 2 * g; t.d = 1 << lg;
    t.r = i >> (4 - lg); const int isub = i & ((16 >> lg) - 1); t.n0 = ((512 * c) >> lg) + 32 * isub; t.nt = 256 >> lg; t.t0 = t.n0 >> 5;
    t.head = 2 * g + j; t.slope2 = alibi_slope(6 + t.head) * (float)t.d * LOG2E;
    const size_t tb = (size_t)(t.head * 4 + b) * 256 + ((size_t)t.r << (8 - lg));
    t.qb = ZB + (tb << 12); t.kb = ZB + ((tb + 6 * 4 * 256) << 12); t.vb = ZB + ((tb + 2 * 6 * 4 * 256) << 12);
    t.tl = g * 512 + (32 * isub + q) * t.d + t.r;
    return t;
}
__device__ __forceinline__ void b_issue_qk(const BTile& t, bf16x8 (&qf)[4], bf16x8 (&kf)[5][4], bool (&val)[5], int (&kc)[5], int lane) {
    load_tile_frags(qf, t.qb + ((size_t)t.t0 << 12), lane);
#pragma unroll
    for (int i = 0; i < 5; ++i) { const int kt = t.t0 + kt_of(i); val[i] = kt >= 0 && kt < t.nt; kc[i] = kt < 0 ? 0 : (kt >= t.nt ? t.nt - 1 : kt);
        load_tile_frags(kf[i], t.kb + ((size_t)kc[i] << 12), lane); }
}
__device__ __forceinline__ void fill_ninf(f32x16& t) {
#pragma unroll
    for (int r = 0; r < 16; ++r) t[r] = -INFINITY;
}
__device__ __forceinline__ float b_qtile(f32x16 (&o)[2], const BTile& t, const BTile& tn, bool has_next, bf16x8 (&qf)[4], bf16x8 (&kf)[5][4], bool (&val)[5], int (&kc)[5], LAS char* vb, int lane) {
    const int q = lane & 31, hi = lane >> 5;
    const float slope2 = t.slope2;
    const LAS char* vaddr = vb + (4 * hi + ((lane & 15) >> 2)) * 64 + ((lane >> 4) & 1) * 32 + (lane & 3) * 8;
    float m = 0.f, l = 0.f;
    {
        bf16x8 vf[2][2]; load_vfrags(vf, vaddr);
        asm volatile("s_waitcnt lgkmcnt(0)" ::: "memory"); dma_tile(vb, t.vb + ((size_t)kc[4] << 12), lane);
        step<0, true, true>(o, m, l, kf[0], qf, vf, (float)(q - 4 * hi), slope2, slope2, 64.0f); }
    {
        f32x16 tL, tR; const float offL = scores<1>(tL, kf[1], qf, (float)(q + 32 - 4 * hi), slope2, slope2, 64.0f), offR = scores<1>(tR, kf[2], qf, (float)(q - 32 - 4 * hi), -slope2, slope2, 64.0f);
        if (!val[1]) fill_ninf(tL); if (!val[2]) fill_ninf(tR);
        pair_rest(o, m, l, tL, tR, offL, offR, vaddr + 4096, vaddr + 8192); }
    asm volatile("s_waitcnt vmcnt(0)" ::: "memory");
    {
        f32x16 tL, tR; const float offL = scores<2>(tL, kf[3], qf, (float)(q + 64 - 4 * hi), slope2, slope2, 64.0f), offR = scores<2>(tR, kf[4], qf, (float)(q - 64 - 4 * hi), -slope2, slope2, 64.0f);
        if (!val[3]) fill_ninf(tL); if (!val[4]) fill_ninf(tR);
        if (has_next) {
            asm volatile("s_waitcnt lgkmcnt(0)" ::: "memory");
            b_issue_qk(tn, qf, kf, val, kc, lane);
            dma_tile(vb + 4096, tn.vb + ((size_t)kc[1] << 12), lane); dma_tile(vb + 8192, tn.vb + ((size_t)kc[2] << 12), lane); }
        pair_rest(o, m, l, tL, tR, offL, offR, vaddr + 12288, vaddr);
        if (has_next) { asm volatile("s_waitcnt lgkmcnt(0)" ::: "memory");
            dma_tile(vb, tn.vb + ((size_t)kc[0] << 12), lane); dma_tile(vb + 12288, tn.vb + ((size_t)kc[3] << 12), lane); } }
    const float lt = hswap_sum(l);
    scale_o(o, 1.0f / lt);
    return m + __builtin_amdgcn_logf(lt);
}
__device__ __forceinline__ void b_unit(const char* ZB, bf16* MIX, char* SCR, int u, LAS char* lds, int wave, int lane) {
    const int b = u >> 5, c = (u >> 1) & 15, j = u & 1;
    LAS float* lseb = (LAS float*)(lds + LSEB_OFF);
    LAS char* vb = lds + wave * 16384;
    char* scr = SCR + ((size_t)(u * 8 + wave) * 6 << 12) + lane * 16;
    const int q = lane & 31, hi = lane >> 5;
    bf16x8 qf[4], kf[5][4]; bool val[5]; int kc[5];
    BTile t = b_decode(ZB, b, c, j, wave, q);
    b_issue_qk(t, qf, kf, val, kc, lane);
#pragma unroll
    for (int i = 0; i < 4; ++i) dma_tile(vb + i * 4096, t.vb + ((size_t)kc[i] << 12), lane);
#pragma unroll 1
    for (int it = 0; it < 6; ++it) { const bool has_next = it < 5; const BTile tn = b_decode(ZB, b, c, j, wave + 8 * (has_next ? it + 1 : it), q);
        if (it == 0) asm volatile("s_waitcnt vmcnt(0)" ::: "memory"); else asm volatile("s_waitcnt vmcnt(4)" ::: "memory");
        f32x16 o[2]; o[0] = zero16_(); o[1] = zero16_();
        const float lse = b_qtile(o, t, tn, has_next, qf, kf, val, kc, vb, lane);
        if (hi == 0) lseb[t.tl] = lse;
        u32x4 w[4]; pack_o(w, o, 1.0f);
#pragma unroll
        for (int k = 0; k < 4; ++k) *(u32x4*)(scr + ((size_t)it << 12) + k * 1024) = w[k];
        t = tn; }
    __syncthreads();
#pragma unroll 1
    for (int it0 = 0; it0 < 6; it0 += 3) { u32x4 w[3][4];
#pragma unroll
        for (int ii = 0; ii < 3; ++ii)
#pragma unroll
            for (int k = 0; k < 4; ++k) w[ii][k] = *(const u32x4*)(scr + ((size_t)(it0 + ii) << 12) + k * 1024);
#pragma unroll
        for (int ii = 0; ii < 3; ++ii) { const BTile tt = b_decode(ZB, b, c, j, wave + 8 * (it0 + ii), q);
            const int tk = tt.tl & 511; const float l0 = lseb[tk], l1 = lseb[512 + tk], l2 = lseb[1024 + tk], own = lseb[tt.tl]; const float mm = fmaxf(l0, fmaxf(l1, l2));
            const float a = __builtin_amdgcn_exp2f(own - mm) / (__builtin_amdgcn_exp2f(l0 - mm) + __builtin_amdgcn_exp2f(l1 - mm) + __builtin_amdgcn_exp2f(l2 - mm));
            const int orow = b * SEQ + (tt.n0 + q) * tt.d + tt.r, ocol = 256 + 64 * tt.head + 8 * hi;
#pragma unroll
            for (int k = 0; k < 4; ++k) { const u32x4 x = w[ii][k]; u32x4 y;
                y.x = cvtpk(__uint_as_float(x.x << 16) * a, __uint_as_float(x.x & 0xffff0000u) * a); y.y = cvtpk(__uint_as_float(x.y << 16) * a, __uint_as_float(x.y & 0xffff0000u) * a);
                y.z = cvtpk(__uint_as_float(x.z << 16) * a, __uint_as_float(x.z & 0xffff0000u) * a); y.w = cvtpk(__uint_as_float(x.w << 16) * a, __uint_as_float(x.w & 0xffff0000u) * a);
                *(u32x4*)((unsigned char*)MIX + pg8::img_off(orow, ocol + 32 * (k >> 1) + 16 * (k & 1), D / 64, false)) = y; } } }
    __syncthreads();
}
__device__ __forceinline__ void c_unit(const char* ZC, bf16* MIX, const float* sink, int u, LAS char* lds, int wave, int lane) {
    const int b = u >> 6, kvh = (u >> 5) & 1, q0 = 256 * (u & 31), n0 = q0 + 32 * wave;
    const int q = lane & 31, hi = lane >> 5;
    const char* kt0 = ZC + ((size_t)((6 + kvh) * 4 + b) * 256 << 12); const char* vt0 = ZC + ((size_t)((8 + kvh) * 4 + b) * 256 << 12);
#pragma unroll
    for (int tt = 0; tt < 2; ++tt) { const int t = 2 * wave + tt, T = (q0 >> 5) - 4 + t;
        if (T >= 0 && T < SEQ / 32) { dma_tile(lds + t * 8192, kt0 + ((size_t)T << 12), lane); dma_tile(lds + t * 8192 + 4096, vt0 + ((size_t)T << 12), lane); } }
    const char* qt0 = ZC + (((size_t)((3 * kvh) * 4 + b) * 256 + (n0 >> 5)) << 12);
    bf16x8 qf[4]; load_tile_frags(qf, qt0, lane);
    asm volatile("s_waitcnt vmcnt(0)" ::: "memory");
    __syncthreads();
    const LAS char* kbase = lds + lane * 16;
    const LAS char* vbase = lds + 4096 + (4 * hi + ((lane & 15) >> 2)) * 64 + ((lane >> 4) & 1) * 32 + (lane & 3) * 8;
#pragma unroll 1
    for (int hh = 0; hh < 3; ++hh) { const int head = 3 * kvh + hh;
        const char* qnext = hh < 2 ? qt0 + ((size_t)(hh + 1) * 4 * 256 << 12) : nullptr; bool reloaded = false;
        f32x16 o[2]; o[0] = zero16_(); o[1] = zero16_();
        float m = sink[head] * LOG2E, l = hi ? 0.f : 1.0f; const float slope2 = alibi_slope(head) * LOG2E;
        {
            const int t = wave + 4; bf16x8 kf[4];
#pragma unroll
            for (int s = 0; s < 4; ++s) kf[s] = *(const LAS bf16x8*)(kbase + t * 8192 + s * 1024);
            bf16x8 vf[2][2]; load_vfrags(vf, vbase + t * 8192);
            step<0, false, true>(o, m, l, kf, qf, vf, (float)(q - 4 * hi), slope2, slope2, 128.0f); }
#pragma unroll 1
        for (int k = 1; k <= 4; ++k) { const int tL = wave + 4 - k, tR = wave + 4 + k; const bool vL = n0 - 32 * k >= 0, vR = n0 + 32 * k < SEQ;
            const float relfL = (float)(q + 32 * k - 4 * hi), relfR = (float)(q - 32 * k - 4 * hi);
            if (vL && vR) {
                if (k < 4) step_pair_lds<1>(o, m, l, kbase + tL * 8192, kbase + tR * 8192, vbase + tL * 8192, vbase + tR * 8192, qf, relfL, relfR, slope2, 128.0f);
                else { step_pair_lds<2>(o, m, l, kbase + tL * 8192, kbase + tR * 8192, vbase + tL * 8192, vbase + tR * 8192, qf, relfL, relfR, slope2, 128.0f, qnext, lane); reloaded = true; } }
            else if (vL || vR) { const int t = vL ? tL : tR; bf16x8 kf[4];
#pragma unroll
                for (int s = 0; s < 4; ++s) kf[s] = *(const LAS bf16x8*)(kbase + t * 8192 + s * 1024);
                bf16x8 vf[2][2]; load_vfrags(vf, vbase + t * 8192);
                const float relf = vL ? relfL : relfR, sl = vL ? slope2 : -slope2;
                if (k < 4) step<1, false, true>(o, m, l, kf, qf, vf, relf, sl, slope2, 128.0f); else step<2, false, true>(o, m, l, kf, qf, vf, relf, sl, slope2, 128.0f); } }
        if (!reloaded && qnext) load_tile_frags(qf, qnext, lane);
        store_o(MIX, b * SEQ + n0 + q, 640 + 64 * head, o, 1.0f / hswap_sum(l), hi); }
    __syncthreads();
}
template <int G>
__device__ __forceinline__ void pool_wfrags(bf16x8 (&af)[2][4], f32x4 (&sc)[4], const bf16* wpt, const float* pscale, int kq, int lane) {
#pragma unroll
    for (int kb = 0; kb < 2; ++kb)
#pragma unroll
        for (int dt = 0; dt < 4; ++dt) af[kb][dt] = *(const bf16x8*)(wpt + (size_t)(G * 64 + dt * 16 + (lane & 15)) * 64 + kb * 32 + 8 * kq);
#pragma unroll
    for (int dt = 0; dt < 4; ++dt) sc[dt] = *(const f32x4*)(pscale + G * 64 + dt * 16 + 4 * kq);
}
template <int G>
__device__ __forceinline__ void pool_group(const LAS char* rows, bf16* MIX, const bf16* wpt, const float* pscale, int row0, int tok, int kq, int lane, const bf16x8 (&af)[2][4], bf16x8 (&afn)[2][4], const f32x4 (&sc)[4], f32x4 (&scn)[4]) {
    constexpr int R = 1 << G, W = 2 * R + 1;
    int lo = tok - R, hi2 = tok + R + 1; lo = lo < 0 ? 0 : lo; hi2 = hi2 > SEQ ? SEQ : hi2; const float inv = 1.0f / (float)(hi2 - lo);
    f32x4 acc[4];
#pragma unroll
    for (int dt = 0; dt < 4; ++dt) acc[dt] = zero4_();
    if constexpr (G < 3) pool_wfrags<G + 1>(afn, scn, wpt, pscale, kq, lane);
    asm volatile("" ::: "memory");
#pragma unroll
    for (int kb = 0; kb < 2; ++kb) { float s[8]; bf16x8 uc;
        const LAS char* rp = rows + ((lane & 15) + 8 - R) * POOL_PITCH + (8 * G + 4 * kb + kq) * 16;
#pragma unroll
        for (int e = 0; e < 8; ++e) s[e] = 0.f;
#pragma unroll
        for (int j = 0; j < W; ++j) { const int tt = tok + j - R; const float w = (tt >= 0 && tt < SEQ) ? 1.0f : 0.0f; const bf16x8 v = *(const LAS bf16x8*)(rp + j * POOL_PITCH); if (j == R) uc = v;
#pragma unroll
            for (int e = 0; e < 8; ++e) s[e] += w * bf2f((unsigned short)v[e]); }
        u32x4 pw; float pe[8];
#pragma unroll
        for (int e = 0; e < 8; ++e) pe[e] = s[e] * inv - bf2f((unsigned short)uc[e]);
        pw.x = cvtpk(pe[0], pe[1]); pw.y = cvtpk(pe[2], pe[3]); pw.z = cvtpk(pe[4], pe[5]); pw.w = cvtpk(pe[6], pe[7]);
        const bf16x8 bfrag = __builtin_bit_cast(bf16x8, pw);
#pragma unroll
        for (int dt = 0; dt < 4; ++dt) acc[dt] = __builtin_amdgcn_mfma_f32_16x16x32_bf16(af[kb][dt], bfrag, acc[dt], 0, 0, 0); }
#pragma unroll
    for (int dt = 0; dt < 4; ++dt) { const int dcol = G * 64 + dt * 16 + 4 * kq;
        u32x2 w; w.x = cvtpk(acc[dt][0] * sc[dt].x, acc[dt][1] * sc[dt].y); w.y = cvtpk(acc[dt][2] * sc[dt].z, acc[dt][3] * sc[dt].w);
        *(u32x2*)((unsigned char*)MIX + pg8::img_off(row0 + (lane & 15), dcol & ~7, D / 64, false) + 2 * (dcol & 7)) = w; }
}
__device__ __forceinline__ void pool_item(const bf16* Z, bf16* MIX, const bf16* wpt, const float* pscale, int item, LAS char* rows, int lane) {
    const int row0 = 16 * item, b = row0 / SEQ, t0 = row0 % SEQ;
    const int tok = t0 + (lane & 15), kq = lane >> 4;
    const bf16* zb = Z + (size_t)b * SEQ * 256;
    u32x4 st[16]; bf16x8 afa[2][4], afb[2][4]; f32x4 sca[4], scb[4];
    pool_wfrags<0>(afa, sca, wpt, pscale, kq, lane);
#pragma unroll
    for (int i = 0; i < 16; ++i) { const int idx = i * 64 + lane, r = idx >> 5, c = idx & 31; int tt = t0 - 8 + r; tt = (tt >= 0 && tt < SEQ) ? tt : t0; st[i] = *(const u32x4*)(zb + (size_t)tt * 256 + 8 * c); }
#pragma unroll
    for (int i = 0; i < 16; ++i) { const int idx = i * 64 + lane, r = idx >> 5, c = idx & 31; *(LAS u32x4*)(rows + r * POOL_PITCH + c * 16) = st[i]; }
    pool_group<0>(rows, MIX, wpt, pscale, row0, tok, kq, lane, afa, afb, sca, scb); pool_group<1>(rows, MIX, wpt, pscale, row0, tok, kq, lane, afb, afa, scb, sca);
    pool_group<2>(rows, MIX, wpt, pscale, row0, tok, kq, lane, afa, afb, sca, scb); pool_group<3>(rows, MIX, wpt, pscale, row0, tok, kq, lane, afb, afa, scb, sca);
}
constexpr int N_B_UNITS = 128, N_C_UNITS = 256, N_P_ITEMS = M / 16;
}

__device__ __forceinline__ void p_mixers(Frame& F, const float* const* in, unsigned char* ws, int lq, int sel  ) {
    const int l = lq & 1;
    const bf16* Z = (const bf16*)(ws + WS_Z); bf16* MIX = (bf16*)(ws + WS_MIX);
    LAS char* lds = (LAS char*)F.lds;
    const float* sink = in[9] + 6 * l;
    {
        const int nb = (F.G >= 2 * mx::N_B_UNITS) ? mx::N_B_UNITS : (F.G + 1) / 2;
        const bool xl = (F.G == 256);
        if ((int)blockIdx.x < nb) {
            if (sel & 1) {
#pragma unroll 1
                for (int u0 = blockIdx.x; u0 < mx::N_B_UNITS; u0 += nb) { const int u = xl ? ((u0 & 7) >> 1) * 32 + (u0 >> 3) * 2 + (u0 & 1) : u0;     unsigned z_; asm volatile("v_mov_b32 %0, 0" : "=v"(z_)); const int lane = (int)__builtin_amdgcn_mbcnt_hi(~0u, __builtin_amdgcn_mbcnt_lo(~0u, z_)); mx::b_unit((const char*)(ws + WS_ZB), MIX, (char*)(ws + WS_BSCR), u, lds, F.wave, lane); } }
        } else if (sel & 2) {
#pragma unroll 1
            for (int v = (int)blockIdx.x - nb, u0 = v, k = 0; u0 < mx::N_C_UNITS; u0 += F.G - nb, ++k) { const int u = xl ? (v & 7) * 32 + (v >> 3) * 2 + k : u0;     unsigned z_; asm volatile("v_mov_b32 %0, 0" : "=v"(z_)); const int lane = (int)__builtin_amdgcn_mbcnt_hi(~0u, __builtin_amdgcn_mbcnt_lo(~0u, z_)); mx::c_unit((const char*)(ws + WS_ZC), MIX, sink, u, lds, F.wave, lane); }
        }
        __syncthreads();
    }
    if (sel & 4) { const bf16* wpt = (const bf16*)(ws + WS_W + (size_t)l * W_LAYER + W_PT); const float* pscale = in[8] + 256 * l;
        for (int it = blockIdx.x * NWAVES + F.wave; it < mx::N_P_ITEMS; it += F.G * NWAVES) mx::pool_item(Z, MIX, wpt, pscale, it, lds + F.wave * (32 * mx::POOL_PITCH), F.lane); }
}

struct Args { const float* in[15]; float* out; unsigned char* ws; int ph_lo, ph_hi, li, dup; };
__global__ void __launch_bounds__(NWAVES * 64, 2) mk_fwd(Args args) {
    extern __shared__ __attribute__((aligned(16))) unsigned char lds[];
    Frame F;
    F.lds = (LAS unsigned char*)lds;
    F.MISC = (volatile LAS unsigned*)(F.lds + MISC_OFF);
    F.tid = threadIdx.x; F.lane = F.tid & 63; F.wave = __builtin_amdgcn_readfirstlane(F.tid >> 6);
    const int wave0 = F.wave;
    F.G = gridDim.x; { const int bx = blockIdx.x; F.vcu = (F.G % 8 == 0) ? (bx % 8) * (F.G / 8) + bx / 8 : bx; }
    unsigned char* ws = args.ws;
    F.ctl = (gu32*)(ws + WS_CTL);
    for (int u = F.tid; u < (LDS_BYTES - LDSCTL_OFF) / 4; u += NWAVES * 64) ((LAS unsigned*)(F.lds + LDSCTL_OFF))[u] = 0u;
    __syncthreads();
    XcdBarrier bar; bar.bar = (unsigned*)(F.ctl + CW_BAR) + args.li * XCD_BAR_WORDS; bar.x = 0; bar.st = nullptr;
    const int lo = args.ph_lo, hi = args.ph_hi;
    if (hi - lo > 1) bar = xcd_barrier_post((unsigned*)(F.ctl + CW_BAR) + args.li * XCD_BAR_WORDS, F.MISC + 8);
    const float* const* in = args.in;
    bf16* XS = (bf16*)(ws + WS_XS);
    bf16* H = (bf16*)(ws + WS_H);
    const float* MOD = (const float*)(ws + WS_MOD);
    float* SSQ = (float*)(ws + WS_SUMSQ);
    const float* GV = (const float*)(ws + WS_GV);

    const int dup = args.dup & 1, msel = ((args.dup >> 1) & 15) ? ((args.dup >> 1) & 15) : 7;
#pragma unroll 1
    for (int ph = lo; ph < hi; ++ph) {
        { unsigned z_; asm volatile("v_mov_b32 %0, 0" : "=v"(z_)); const int t_ = wave0 * 64 + (int)__builtin_amdgcn_mbcnt_hi(~0u, __builtin_amdgcn_mbcnt_lo(~0u, z_)); F.tid = t_; F.lane = t_ & 63; F.wave = wave0; }
        if (ph == PH_PRO) p_prologue(F, in, ws);
        else if (ph == PH_CONV) p_conv(F, in, ws);
        else if (ph == PH_FINAL) p_norm_final(F, XS, SSQ + (size_t)4 * M, args.out, in[14]);
        else {
            const int l = (ph - PH_L0) / PH_PER_LAYER, k = (ph - PH_L0) % PH_PER_LAYER;
            unsigned char* wl = ws + WS_W + (size_t)l * W_LAYER;
            const float* modl = MOD + (size_t)l * BATCH * NMOD * D;
            const float* biasl = (const float*)(ws + WS_BIAS + (size_t)l * BIAS_LAYER);
            if (k == 0) { pg8::Gemm g{H, (const bf16*)(wl + W_IN), M, INW, D}; pg8::StaticOrder S; S.init(M, INW, F.G, (int)blockIdx.x);
                pg8::EpiBf16Norm E{(bf16*)(ws + WS_Z), 256, SSQ + (size_t)(2 * l) * M, biasl, INW, ws + WS_ZB, ws + WS_ZC};
                pg8::gemm_phase<pg8::EpiBf16Norm, pg8::StaticOrder, true, true>(F.lds + RING_OFF, g, S, E, F.tid); }
            else if (k == 1) p_mixers(F, in, ws, l + 2 * dup, msel);
            else if (k == 2 && l == 0 && !dup) {
                pg8::Gemm g{(const bf16*)(ws + WS_MIX), (const bf16*)(wl + W_OUT), M, D, D}; pg8::StaticOrder S; S.init(M, D, F.G, (int)blockIdx.x);
                pg8::EpiGateResNormT<true> E{(const bf16*)in[0], XS, modl + 2 * D, NMOD * D, H, GV + (size_t)1 * BATCH * D, D, SSQ + (size_t)1 * M, D};
                pg8::gemm_phase<pg8::EpiGateResNormT<true>, pg8::StaticOrder, true, true>(F.lds + RING_OFF, g, S, E, F.tid); }
            else if (k == 2 || k == 4) { const bool dn = (k == 4); const bool last = dn && (l == DEPTH - 1);
                pg8::Gemm g{(const bf16*)(ws + (dn ? WS_HID : WS_MIX)), (const bf16*)(wl + (dn ? W_DN : W_OUT)), M, D, dn ? DFF : D}; pg8::StaticOrder S; S.init(M, D, F.G, (int)blockIdx.x);
                pg8::EpiGateResNorm E{XS, XS, dup ? (const float*)(F.ctl + CW_ZEROS) : modl + (dn ? 5 : 2) * D, dup ? 0 : NMOD * D,
                    (last || dup) ? (bf16*)nullptr : H, GV + (size_t)((dn ? 2 * (l + 1) : 2 * l + 1) % (2 * DEPTH)) * BATCH * D, D, SSQ + (size_t)(dup ? 5 : 2 * l + (dn ? 2 : 1)) * M, D};
                pg8::gemm_phase<pg8::EpiGateResNorm, pg8::StaticOrder, true, true>(F.lds + RING_OFF, g, S, E, F.tid); }
            else { pg8::Gemm g{H, (const bf16*)(wl + W_GU), M, 2 * DFF, D}; pg8::StaticOrder S; S.init(M, 2 * DFF, F.G, (int)blockIdx.x);
                pg8::EpiSwiGLUNorm E{(bf16*)(ws + WS_HID), DFF, SSQ + (size_t)(2 * l + 1) * M, biasl + BATCH * INW, 2 * DFF};
                pg8::gemm_phase<pg8::EpiSwiGLUNorm, pg8::StaticOrder, true, true>(F.lds + RING_OFF, g, S, E, F.tid); }
        }
        if (ph + 1 < hi) xcd_barrier(bar);
    }
}

extern "C" void kernel_launch(void* const* d_in, const int* in_sizes, int n_in, void* d_out, int out_size, void* d_ws, size_t ws_size, hipStream_t stream) {
    static int grid = 0;
    if (grid == 0) {
        if (n_in != 15 || in_sizes[0] != M * D || out_size != M * D || ws_size < WS_END) { fprintf(stderr, "kernel_launch: unexpected shapes (n_in %d, in0 %d, out %d, ws %zu); nothing launched\n", n_in, n_in > 0 ? in_sizes[0] : -1, out_size, ws_size); grid = -1; return; }
        int dev = 0, cus = 0, per_cu = 0;
        if (hipGetDevice(&dev) != hipSuccess || hipDeviceGetAttribute(&cus, hipDeviceAttributeMultiprocessorCount, dev) != hipSuccess) { grid = -1; return; }
        if (hipFuncSetAttribute((const void*)mk_fwd, hipFuncAttributeMaxDynamicSharedMemorySize, LDS_BYTES) != hipSuccess) { fprintf(stderr, "kernel_launch: hipFuncSetAttribute failed\n"); grid = -1; return; }
        if (hipOccupancyMaxActiveBlocksPerMultiprocessor(&per_cu, (const void*)mk_fwd, NWAVES * 64, LDS_BYTES) != hipSuccess || per_cu < 1) fprintf(stderr, "kernel_launch: occupancy query reports %d blocks per CU\n", per_cu);
        (void)hipGetLastError();
        grid = cus;
        if (grid != 256) fprintf(stderr, "kernel_launch: %d CUs; this kernel is laid out for 256\n", grid);
    }
    if (grid < 0) return;
    if (hipMemsetAsync((char*)d_ws + WS_CTL, 0, CTL_ZERO_BYTES, stream) != hipSuccess) return;
    Args a{};
    for (int i = 0; i < 15; ++i) a.in[i] = (const float*)d_in[i];
    a.out = (float*)d_out; a.ws = (unsigned char*)d_ws;
#if PROBE_DUP == 0 && PROBE_CUT == 0
    a.ph_lo = 0; a.ph_hi = NPHASES; a.li = 0; a.dup = 0;
    hipLaunchKernelGGL(mk_fwd, dim3(grid), dim3(NWAVES * 64), LDS_BYTES, stream, a);
#else
    { int lo = 0, li = 0;
      for (int ph = 0; ph < NPHASES; ++ph) { const bool cut = ((PROBE_CUT | PROBE_DUP) >> ph) & 1;
        if (cut || ph == NPHASES - 1) { a.ph_lo = lo; a.ph_hi = ph + 1; a.li = (ph + 1 - lo > 1) ? li++ : 0; a.dup = 0; hipLaunchKernelGGL(mk_fwd, dim3(grid), dim3(NWAVES * 64), LDS_BYTES, stream, a);
            if ((PROBE_DUP >> ph) & 1) { a.ph_lo = ph; a.ph_hi = ph + 1; a.li = 0; a.dup = 1 | (PROBE_MIXSEL << 1) | (PROBE_NOSTORE << 4); hipLaunchKernelGGL(mk_fwd, dim3(grid), dim3(NWAVES * 64), LDS_BYTES, stream, a); }
            lo = ph + 1; } } }
#endif
}
```

```cpp
#include <hip/hip_runtime.h>
#include <cstdio>
#include <cstdint>
namespace pg8 {
#define PG8_LAS __attribute__((address_space(3)))
typedef unsigned short bf16_t;
typedef short bf16x8 __attribute__((ext_vector_type(8)));
typedef float f32x4 __attribute__((ext_vector_type(4)));
typedef unsigned u32x4 __attribute__((ext_vector_type(4)));
constexpr int BM = 256, BK = 64, HALF = 128, HTB = HALF * BK * 2  , STAGE_BYTES = 8 * HTB, NXCD = 8, WGM = 8;

__host__ __device__ __forceinline__ int lds_byte(int r, int c) { const int st = (r >> 4) * 2 + (c >> 5), rr = r & 15, cc = c & 31, ob = rr * 64 + cc * 2; return st * 1024 + (ob ^ (((ob >> 9) & 1) << 5)); }
__host__ __device__ __forceinline__ void stage_rc(int b, int& R, int& C) { const int st = b / 1024, sb = b % 1024, swz = sb ^ (((sb >> 9) & 1) << 5); R = (st >> 1) * 16 + swz / 64; C = (st & 1) * 32 + (swz % 64) / 2; }
__host__ __device__ __forceinline__ int perm32(int rho) { const int n = rho >> 4, i = rho & 15; return 8 * (i >> 2) + 4 * n + (i & 3); }

__host__ __device__ __forceinline__ int perm32inv(int x) { return 16 * ((x >> 2) & 1) + 4 * (x >> 3) + (x & 3); }
__host__ __device__ __forceinline__ size_t img_off(int row, int col, int nt, bool wrow) { const int r = row & 127, rr = wrow ? (r & ~31) + perm32inv(r & 31) : r; return ((size_t)((row >> 7) * nt + (col >> 6)) << 14) + (size_t)lds_byte(rr, col & 63); }
constexpr bool IMG_A = true, IMG_B = true;
struct Unit { int pm, pn; };
struct Gemm { const bf16_t* A; const bf16_t* Bt; int M, N, K; };

struct StaticOrder {
    int nM, nN, nwg, G, c;
    __host__ __device__ void init(int M, int N, int G_, int c_) { nM = M / BM; nN = N / BM; nwg = nM * nN; G = G_; c = c_; }
    __host__ __device__ bool next(int i, Unit& u) const {
        const long L = (long)i * G + c; if (L >= nwg) return false;
        int wgid = (int)L; { const int q = nwg / NXCD, r = nwg % NXCD, xcd = wgid % NXCD, off = wgid / NXCD; wgid = (xcd < r ? xcd * (q + 1) : r * (q + 1) + (xcd - r) * q) + off; }
        const int nig = WGM * nN, gid = wgid / nig, fm = gid * WGM, gsz = (nM - fm) < WGM ? (nM - fm) : WGM;
        u.pm = fm + ((wgid % nig) % gsz); u.pn = (wgid % nig) / gsz; return true;
    }
    __device__ __forceinline__ void a_ready(const Unit&) const {}
    __device__ __forceinline__ void done(const Unit&) const {}
};

__device__ __forceinline__ unsigned cvt_pk_bf16(float lo, float hi) { unsigned r; asm volatile("v_cvt_pk_bf16_f32 %0, %1, %2" : "=v"(r) : "v"(lo), "v"(hi)); return r; }
constexpr float RMS_EPS_ = 1e-6f, INV_D_ = 1.0f / 1024.0f;
__device__ __forceinline__ void aux_dma(const float* src_lane, PG8_LAS unsigned char* dst_wave) { __builtin_amdgcn_global_load_lds((const unsigned*)src_lane, (PG8_LAS unsigned*)dst_wave, 4, 0, 0); }
typedef _Float16 h16x2 __attribute__((ext_vector_type(2)));
__device__ __forceinline__ unsigned pk_h2(float lo, float hi) { const h16x2 h = {(_Float16)lo, (_Float16)hi}; return __builtin_bit_cast(unsigned, h); }
__device__ __forceinline__ float h_lo(unsigned w) { return (float)__builtin_bit_cast(h16x2, w)[0]; }
__device__ __forceinline__ float h_hi(unsigned w) { return (float)__builtin_bit_cast(h16x2, w)[1]; }
struct EpiBf16Norm {
    static constexpr bool PERM = true, AFTER_DRAIN = false;
    bf16_t* O; int ldc; const float* sumsq; const float* bias; int bias_stride; unsigned char* zb; unsigned char* zc;
    __device__ __forceinline__ void prefetch(const Unit& u, PG8_LAS unsigned char* aux, int wid, int lane) const {
        if (wid < 4) aux_dma(sumsq + u.pm * BM + wid * 64 + lane, aux + wid * 256);
        else aux_dma(bias + (size_t)(u.pm >> 5) * bias_stride + u.pn * BM + (wid - 4) * 64 + lane, aux + 1024 + (wid - 4) * 256);
    }
    __device__ __forceinline__ void operator()(const f32x4 (&acc)[2][2][4][2], const Unit& u, int wr, int wc, int fr_, int fq_, PG8_LAS unsigned char* aux) const {
        unsigned z_; asm volatile("v_mov_b32 %0, 0" : "=v"(z_)); const int ln_ = (int)__builtin_amdgcn_mbcnt_hi(~0u, __builtin_amdgcn_mbcnt_lo(~0u, z_)); const int fr = ln_ & 15, fq = ln_ >> 4;
        const int row0 = u.pm * BM + wr * 64 + fr, col0 = u.pn * BM + wc * 32 + 8 * fq;
        const PG8_LAS float* ass = (const PG8_LAS float*)aux + wr * 64 + fr; const PG8_LAS float* ab = (const PG8_LAS float*)(aux + 1024) + wc * 32 + 8 * fq;
        f32x4 bv[2][2];
#pragma unroll
        for (int bj = 0; bj < 2; ++bj)
#pragma unroll
            for (int n = 0; n < 2; ++n) bv[bj][n] = *(const PG8_LAS f32x4*)(ab + bj * HALF + 4 * n);
#pragma unroll
        for (int ai = 0; ai < 2; ++ai)
#pragma unroll
            for (int m = 0; m < 4; ++m) { const int row = row0 + ai * HALF + m * 16; const float rs = __builtin_amdgcn_rsqf(ass[ai * HALF + m * 16] * INV_D_ + RMS_EPS_);
#pragma unroll
                for (int bj = 0; bj < 2; ++bj) { const f32x4 v0 = acc[ai][bj][m][0] * rs + bv[bj][0], v1 = acc[ai][bj][m][1] * rs + bv[bj][1];
                    u32x4 w; w.x = cvt_pk_bf16(v0[0], v0[1]); w.y = cvt_pk_bf16(v0[2], v0[3]); w.z = cvt_pk_bf16(v1[0], v1[1]); w.w = cvt_pk_bf16(v1[2], v1[3]);
                    const int cb = 2 * u.pn + bj;
                    if (zb != nullptr && cb >= 2 && cb <= 10) { const int t3 = (cb - 2) / 3, g = (cb - 2) % 3, lg = 2 * g, hd = 2 * g + (wc >> 1), c = (wc & 1) * 4 + fq;
                        const int t = row & 8191, b = row >> 13, r = t & ((1 << lg) - 1), n = t >> lg, ti = (r << (8 - lg)) + (n >> 5), key = n & 31;
                        const int off = t3 < 2 ? (c >> 1) * 1024 + (key + 32 * (c & 1)) * 16 : (c >> 2) * 2048 + (key >> 4) * 1024 + (key & 15) * 64 + (c & 3) * 16;
                        *(u32x4*)(zb + ((size_t)(((t3 * 6 + hd) * 4 + b) * 256 + ti) << 12) + off) = w; }
                    else if (zb != nullptr && cb >= 11) {
                        const int hx = cb <= 13 ? 2 * (cb - 11) + (wc >> 1) : (cb == 14 ? 6 : 8) + (wc >> 1), c = (wc & 1) * 4 + fq, t = row & 8191, b = row >> 13, key = t & 31;
                        const int off = cb < 15 ? (c >> 1) * 1024 + (key + 32 * (c & 1)) * 16 : (c >> 2) * 2048 + (key >> 4) * 1024 + (key & 15) * 64 + (c & 3) * 16;
                        *(u32x4*)(zc + ((size_t)((hx * 4 + b) * 256 + (t >> 5)) << 12) + off) = w; }
                    else *(u32x4*)(O + (size_t)row * ldc + col0 + bj * HALF) = w; } }
    }
};
struct EpiSwiGLUNorm {
    static constexpr bool PERM = true, AFTER_DRAIN = false;
    bf16_t* O; int ldc; const float* sumsq; const float* bias; int bias_stride;
    static __device__ __forceinline__ float silu_mul(float g, float u) { return g * u * __builtin_amdgcn_rcpf(1.0f + __builtin_amdgcn_exp2f(-1.4426950408889634f * g)); }
    __device__ __forceinline__ void prefetch(const Unit& u, PG8_LAS unsigned char* aux, int wid, int lane) const {
        if (wid < 4) aux_dma(sumsq + u.pm * BM + wid * 64 + lane, aux + wid * 256);
        else aux_dma(bias + (size_t)(u.pm >> 5) * bias_stride + u.pn * BM + (wid - 4) * 64 + lane, aux + 1024 + (wid - 4) * 256);
    }
    __device__ __forceinline__ void operator()(const f32x4 (&acc)[2][2][4][2], const Unit& u, int wr, int wc, int fr_, int fq_, PG8_LAS unsigned char* aux) const {
        unsigned z_; asm volatile("v_mov_b32 %0, 0" : "=v"(z_)); const int ln_ = (int)__builtin_amdgcn_mbcnt_hi(~0u, __builtin_amdgcn_mbcnt_lo(~0u, z_)); const int fr = ln_ & 15, fq = ln_ >> 4;
        const int row0 = u.pm * BM + wr * 64 + fr, col0 = u.pn * HALF + wc * 32 + 8 * fq;
        const PG8_LAS float* ass = (const PG8_LAS float*)aux + wr * 64 + fr; const PG8_LAS float* ab = (const PG8_LAS float*)(aux + 1024) + wc * 32 + 8 * fq;
        const f32x4 bg0 = *(const PG8_LAS f32x4*)(ab), bg1 = *(const PG8_LAS f32x4*)(ab + 4), bu0 = *(const PG8_LAS f32x4*)(ab + HALF), bu1 = *(const PG8_LAS f32x4*)(ab + HALF + 4);
#pragma unroll
        for (int ai = 0; ai < 2; ++ai)
#pragma unroll
            for (int m = 0; m < 4; ++m) { const int row = row0 + ai * HALF + m * 16; const float rs = __builtin_amdgcn_rsqf(ass[ai * HALF + m * 16] * INV_D_ + RMS_EPS_);
                unsigned char* rowp = (unsigned char*)O + img_off(row, col0, ldc / 64, false);
                const f32x4 g0 = acc[ai][0][m][0] * rs + bg0, g1 = acc[ai][0][m][1] * rs + bg1, u0 = acc[ai][1][m][0] * rs + bu0, u1 = acc[ai][1][m][1] * rs + bu1;
                f32x4 e0 = g0 * -1.4426950408889634f, e1 = g1 * -1.4426950408889634f;
#pragma unroll
                for (int i = 0; i < 4; ++i) { e0[i] = __builtin_amdgcn_exp2f(e0[i]); e1[i] = __builtin_amdgcn_exp2f(e1[i]); }
                e0 = e0 + 1.0f; e1 = e1 + 1.0f;
#pragma unroll
                for (int i = 0; i < 4; ++i) { e0[i] = __builtin_amdgcn_rcpf(e0[i]); e1[i] = __builtin_amdgcn_rcpf(e1[i]); }
                const f32x4 h0 = (g0 * u0) * e0, h1 = (g1 * u1) * e1;
                u32x4 w; w.x = cvt_pk_bf16(h0[0], h0[1]); w.y = cvt_pk_bf16(h0[2], h0[3]); w.z = cvt_pk_bf16(h1[0], h1[1]); w.w = cvt_pk_bf16(h1[2], h1[3]);
                *(u32x4*)rowp = w; }
    }
};
template <bool F32BASE>
struct EpiGateResNormT {
    static constexpr bool PERM = true, AFTER_DRAIN = false;
    const bf16_t* base; bf16_t* out; const float* gate; int gate_stride; bf16_t* Hn; const float* gn; int gn_stride; float* sumsq; int ldc;
    __device__ __forceinline__ void prefetch(const Unit& u, PG8_LAS unsigned char* aux, int wid, int lane) const {
        if (wid < 4) aux_dma(gate + (size_t)(u.pm >> 5) * gate_stride + u.pn * BM + wid * 64 + lane, aux + wid * 256);
        else aux_dma(gn + (size_t)(u.pm >> 5) * gn_stride + u.pn * BM + (wid - 4) * 64 + lane, aux + 1024 + (wid - 4) * 256);
    }
    __device__ __forceinline__ void operator()(const f32x4 (&acc)[2][2][4][2], const Unit& u, int wr, int wc, int fr_, int fq_, PG8_LAS unsigned char* aux) const {
        unsigned z_; asm volatile("v_mov_b32 %0, 0" : "=v"(z_)); const int ln_ = (int)__builtin_amdgcn_mbcnt_hi(~0u, __builtin_amdgcn_mbcnt_lo(~0u, z_)); const int fr = ln_ & 15, fq = ln_ >> 4;
        const int row0 = u.pm * BM + wr * 64 + fr, col0 = u.pn * BM + wc * 32 + 8 * fq;
        const PG8_LAS float* ag = (const PG8_LAS float*)aux + wc * 32 + 8 * fq; const PG8_LAS float* an = (const PG8_LAS float*)(aux + 1024) + wc * 32 + 8 * fq;
#pragma unroll
        for (int am = 0; am < 4; ++am) {
            u32x4 ld[2][2]; f32x4 lf[2][2][2];
#pragma unroll
            for (int mm = 0; mm < 2; ++mm)
#pragma unroll
                for (int bj = 0; bj < 2; ++bj) {
                    if constexpr (F32BASE) { const f32x4* px = (const f32x4*)((const float*)base + (size_t)(row0 + (am >> 1) * HALF + (2 * (am & 1) + mm) * 16) * ldc + col0 + bj * HALF); lf[mm][bj][0] = px[0]; lf[mm][bj][1] = px[1]; }
                    else ld[mm][bj] = *(const u32x4*)((const unsigned char*)base + img_off(row0 + (am >> 1) * HALF + (2 * (am & 1) + mm) * 16, col0 + bj * HALF, ldc / 64, false)); }
#pragma unroll
            for (int mm = 0; mm < 2; ++mm) { const int ai = am >> 1, m = 2 * (am & 1) + mm; const int row = row0 + ai * HALF + m * 16; const size_t off = (size_t)row * ldc + col0; float ss = 0.f;
#pragma unroll
                for (int bj = 0; bj < 2; ++bj) {
                    const f32x4 g0 = *(const PG8_LAS f32x4*)(ag + bj * HALF), g1 = *(const PG8_LAS f32x4*)(ag + bj * HALF + 4);
                    f32x4 b0, b1;
                    if constexpr (F32BASE) { b0 = lf[mm][bj][0]; b1 = lf[mm][bj][1]; }
                    else { const u32x4 bw = ld[mm][bj]; b0 = (f32x4){h_lo(bw.x), h_hi(bw.x), h_lo(bw.y), h_hi(bw.y)}; b1 = (f32x4){h_lo(bw.z), h_hi(bw.z), h_lo(bw.w), h_hi(bw.w)}; }
                    const f32x4 x0 = b0 + g0 * acc[ai][bj][m][0], x1 = b1 + g1 * acc[ai][bj][m][1];
                    u32x4 w; w.x = pk_h2(x0[0], x0[1]); w.y = pk_h2(x0[2], x0[3]); w.z = pk_h2(x1[0], x1[1]); w.w = pk_h2(x1[2], x1[3]);
                    *(u32x4*)((unsigned char*)out + img_off(row, col0 + bj * HALF, ldc / 64, false)) = w;
                    ss += (x0[0] * x0[0] + x0[1] * x0[1]) + (x0[2] * x0[2] + x0[3] * x0[3]) + (x1[0] * x1[0] + x1[1] * x1[1]) + (x1[2] * x1[2] + x1[3] * x1[3]);
                    if (Hn) { const f32x4 n0 = *(const PG8_LAS f32x4*)(an + bj * HALF), n1 = *(const PG8_LAS f32x4*)(an + bj * HALF + 4); const f32x4 h0 = x0 * n0, h1 = x1 * n1;
                        u32x4 hw; hw.x = cvt_pk_bf16(h0[0], h0[1]); hw.y = cvt_pk_bf16(h0[2], h0[3]); hw.z = cvt_pk_bf16(h1[0], h1[1]); hw.w = cvt_pk_bf16(h1[2], h1[3]);
                        *(u32x4*)((unsigned char*)Hn + img_off(row, col0 + bj * HALF, ldc / 64, false)) = hw; } }
                ss += __shfl_xor(ss, 16); ss += __shfl_xor(ss, 32);
                if (fq == 0) atomicAdd(sumsq + row, ss); }
            asm volatile("" ::: "memory"); }
    }
};
typedef EpiGateResNormT<false> EpiGateResNorm;

template <class Epi, class Sched, bool ALIGN_EPI = false, bool SP2 = false>
__device__ __forceinline__ void gemm_phase(PG8_LAS unsigned char* lds, const Gemm g, const Sched& S, const Epi& E, int tid_in) {
    int tid_ = tid_in; asm volatile("" : "+v"(tid_));
    const int tid = tid_, wid = __builtin_amdgcn_readfirstlane(tid >> 6), lane = tid & 63, wr = wid >> 2, wc = wid & 3, fr = lane & 15, fq = lane >> 4;
    const int K = g.K, nt = K / BK;
    unsigned voffA[2], voffB[2];
#pragma unroll
    for (int i = 0; i < 2; ++i) { int R, C; stage_rc(tid * 16 + i * 8192, R, C); const int Rb = Epi::PERM ? ((R & ~31) + perm32(R & 31)) : R;
        voffA[i] = IMG_A ? (unsigned)(tid * 16 + i * 8192) : (unsigned)(R * K + C) * 2u; voffB[i] = IMG_B ? (unsigned)(tid * 16 + i * 8192) : (unsigned)(Rb * K + C) * 2u; }
    const size_t kstepA = IMG_A ? (size_t)(HALF * BK * 2) : (size_t)(BK * 2), kstepB = IMG_B ? (size_t)(HALF * BK * 2) : (size_t)(BK * 2);
    const size_t hstep = (size_t)HALF * K * 2;
    const size_t tstep = 2 * hstep;
    const unsigned ldsw = (unsigned)wid * 1024u;
    const int aoff = lds_byte(wr * 64 + fr, fq * 8), boff = lds_byte(wc * 32 + fr, fq * 8);
#define PG8_SA(b, h) (((b) * 2 + (h)) * HTB)
#define PG8_SB(b, h) ((4 + (b) * 2 + (h)) * HTB)
#define PG8_STAGE(bufoff, gbase, voff) do { _Pragma("unroll") for (int _i = 0; _i < 2; ++_i) \
        __builtin_amdgcn_global_load_lds((const unsigned*)((const char*)(gbase) + (voff)[_i]), (PG8_LAS unsigned*)(lds + (bufoff) + ldsw + _i * 8192), 16, 0, 0); } while (0)
#define PG8_LDA(dst, b, h) do { _Pragma("unroll") for (int m = 0; m < 4; ++m) _Pragma("unroll") for (int k = 0; k < 2; ++k) dst[m][k] = *(const PG8_LAS bf16x8*)(lds + PG8_SA(b, h) + aoff + m * 2048 + k * 1024); } while (0)
#define PG8_LDB(dst, b, h) do { _Pragma("unroll") for (int n = 0; n < 2; ++n) _Pragma("unroll") for (int k = 0; k < 2; ++k) dst[n][k] = *(const PG8_LAS bf16x8*)(lds + PG8_SB(b, h) + boff + n * 2048 + k * 1024); } while (0)
#define PG8_MMA(ai, bj, At, Bt) do { __builtin_amdgcn_s_setprio(1); _Pragma("unroll") for (int m = 0; m < 4; ++m) _Pragma("unroll") for (int n = 0; n < 2; ++n) _Pragma("unroll") for (int k = 0; k < 2; ++k) \
        acc[ai][bj][m][n] = __builtin_amdgcn_mfma_f32_16x16x32_bf16(Bt[n][k], At[m][k], acc[ai][bj][m][n], 0, 0, 0); __builtin_amdgcn_s_setprio(0); } while (0)
#define PG8_WAIT_V(n) asm volatile("s_waitcnt vmcnt(" #n ")" ::: "memory")
#define PG8_WAIT_L(n) asm volatile("s_waitcnt lgkmcnt(" #n ")" ::: "memory")
#define PG8_BAR __builtin_amdgcn_s_barrier()
#define PG8_SCHED __builtin_amdgcn_sched_barrier(0)
    Unit cur, nxt; int ui = 0;
    if (!S.next(0, cur)) return;
    f32x4 acc[2][2][4][2];
#pragma unroll
    for (int a = 0; a < 2; ++a)
#pragma unroll
        for (int b = 0; b < 2; ++b)
#pragma unroll
            for (int m = 0; m < 4; ++m)
#pragma unroll
                for (int n = 0; n < 2; ++n) { float z_; asm volatile("v_mov_b32 %0, 0" : "=v"(z_)); acc[a][b][m][n] = (f32x4){z_, z_, z_, z_}; }
    bf16x8 At[4][2], B0[2][2], B1[2][2];
    const char* cA = (const char*)g.A + (size_t)cur.pm * tstep; const char* cB = (const char*)g.Bt + (size_t)cur.pn * tstep;
    S.a_ready(cur);
    if constexpr (SP2) {
        PG8_STAGE(PG8_SB(0, 0), cB, voffB); PG8_STAGE(PG8_SB(0, 1), cB + hstep, voffB); PG8_STAGE(PG8_SA(0, 0), cA, voffA); PG8_STAGE(PG8_SA(0, 1), cA + hstep, voffA);
        if (wr == 1) PG8_BAR;
        PG8_WAIT_V(2); PG8_BAR;
        PG8_STAGE(PG8_SB(1, 0), cB + kstepB, voffB); PG8_STAGE(PG8_SA(1, 0), cA + kstepA, voffA); PG8_STAGE(PG8_SB(1, 1), cB + hstep + kstepB, voffB);
        PG8_WAIT_V(6); PG8_BAR;
    } else {
        PG8_STAGE(PG8_SB(0, 0), cB, voffB); PG8_STAGE(PG8_SA(0, 0), cA, voffA); PG8_STAGE(PG8_SB(0, 1), cB + hstep, voffB); PG8_STAGE(PG8_SA(0, 1), cA + hstep, voffA);
        if (wr == 1) PG8_BAR;
        PG8_WAIT_V(4); PG8_BAR;
        PG8_STAGE(PG8_SB(1, 0), cB + kstepB, voffB); PG8_STAGE(PG8_SA(1, 0), cA + kstepA, voffA); PG8_STAGE(PG8_SB(1, 1), cB + hstep + kstepB, voffB);
        PG8_WAIT_V(6); PG8_BAR;
    }
    for (;;) {
        const bool has_next = S.next(ui + 1, nxt);
        const char* nA = has_next ? (const char*)g.A + (size_t)nxt.pm * tstep : cA; const char* nB = has_next ? (const char*)g.Bt + (size_t)nxt.pn * tstep : cB;
        for (int t = 0; t < nt; t += 2) {
            const bool last = (t == nt - 2);
            const char* a1 = cA + (size_t)(t + 1) * kstepA;
            const char* a2 = last ? nA : cA + (size_t)(t + 2) * kstepA; const char* b2 = last ? nB : cB + (size_t)(t + 2) * kstepB;
            const char* a3 = a2 + kstepA; const char* b3 = b2 + kstepB;
            if (last && has_next) S.a_ready(nxt);
            if (last) E.prefetch(cur, lds + STAGE_BYTES + 1024, wid, lane);
            if constexpr (SP2) {
            PG8_LDB(B0, 0, 0); PG8_LDB(B1, 0, 1); PG8_SCHED; PG8_LDA(At, 0, 0); PG8_STAGE(PG8_SA(1, 1), a1 + hstep, voffA);
            PG8_WAIT_V(8); PG8_WAIT_L(0); PG8_BAR; PG8_MMA(0, 0, At, B0); PG8_MMA(0, 1, At, B1); PG8_BAR; PG8_SCHED;
            PG8_LDA(At, 0, 1); PG8_STAGE(PG8_SB(0, 0), b2, voffB); PG8_STAGE(PG8_SB(0, 1), b2 + hstep, voffB); PG8_STAGE(PG8_SA(0, 0), a2, voffA);
            PG8_WAIT_V(8); PG8_WAIT_L(0); PG8_BAR; PG8_MMA(1, 0, At, B0); PG8_MMA(1, 1, At, B1); PG8_BAR; PG8_SCHED;
            PG8_LDB(B0, 1, 0); PG8_LDB(B1, 1, 1); PG8_SCHED; PG8_LDA(At, 1, 0); PG8_STAGE(PG8_SA(0, 1), a2 + hstep, voffA);
            PG8_WAIT_V(8); PG8_WAIT_L(0); PG8_BAR; PG8_MMA(0, 0, At, B0); PG8_MMA(0, 1, At, B1); PG8_BAR; PG8_SCHED;
            PG8_LDA(At, 1, 1); PG8_STAGE(PG8_SB(1, 0), b3, voffB); PG8_STAGE(PG8_SB(1, 1), b3 + hstep, voffB); PG8_STAGE(PG8_SA(1, 0), a3, voffA);
            PG8_WAIT_V(8); PG8_WAIT_L(0); PG8_BAR; PG8_MMA(1, 0, At, B0); PG8_MMA(1, 1, At, B1); PG8_BAR; PG8_SCHED;
            } else {
            PG8_LDB(B0, 0, 0); PG8_SCHED; PG8_LDA(At, 0, 0); PG8_STAGE(PG8_SA(1, 1), a1 + hstep, voffA);
            PG8_WAIT_L(8); PG8_BAR; PG8_WAIT_L(0); PG8_MMA(0, 0, At, B0); PG8_BAR; PG8_SCHED;
            PG8_LDB(B1, 0, 1); PG8_STAGE(PG8_SB(0, 0), b2, voffB);
            PG8_BAR; PG8_WAIT_L(0); PG8_MMA(0, 1, At, B1); PG8_BAR;
            PG8_LDA(At, 0, 1); PG8_STAGE(PG8_SA(0, 0), a2, voffA);
            PG8_BAR; PG8_WAIT_L(0); PG8_MMA(1, 0, At, B0); PG8_BAR; PG8_SCHED;
            PG8_STAGE(PG8_SB(0, 1), b2 + hstep, voffB);
            PG8_WAIT_V(6); PG8_BAR; PG8_MMA(1, 1, At, B1); PG8_BAR;
            PG8_LDB(B0, 1, 0); PG8_SCHED; PG8_LDA(At, 1, 0); PG8_STAGE(PG8_SA(0, 1), a2 + hstep, voffA);
            PG8_WAIT_L(8); PG8_BAR; PG8_WAIT_L(0); PG8_MMA(0, 0, At, B0); PG8_BAR; PG8_SCHED;
            PG8_LDB(B1, 1, 1); PG8_STAGE(PG8_SB(1, 0), b3, voffB);
            PG8_BAR; PG8_WAIT_L(0); PG8_MMA(0, 1, At, B1); PG8_BAR;
            PG8_LDA(At, 1, 1); PG8_STAGE(PG8_SA(1, 0), a3, voffA);
            PG8_BAR; PG8_WAIT_L(0); PG8_MMA(1, 0, At, B0); PG8_BAR; PG8_SCHED;
            PG8_STAGE(PG8_SB(1, 1), b3 + hstep, voffB);
            PG8_WAIT_V(6); PG8_BAR; PG8_MMA(1, 1, At, B1); PG8_BAR;
            }
        }
        if constexpr (ALIGN_EPI) { if (wr == 0) PG8_BAR; }
        if constexpr (!Epi::AFTER_DRAIN) { E(acc, cur, wr, wc, fr, fq, lds + STAGE_BYTES + 1024); S.done(cur); }
        if (!has_next) break;
#pragma unroll
        for (int a = 0; a < 2; ++a)
#pragma unroll
            for (int b = 0; b < 2; ++b)
#pragma unroll
                for (int m = 0; m < 4; ++m)
#pragma unroll
                    for (int n = 0; n < 2; ++n) { float z_; asm volatile("v_mov_b32 %0, 0" : "=v"(z_)); acc[a][b][m][n] = (f32x4){z_, z_, z_, z_}; }
        cur = nxt; cA = nA; cB = nB; ++ui;
        if constexpr (ALIGN_EPI) { if (wr == 1) PG8_BAR; }
    }
    PG8_WAIT_V(0);
    if constexpr (!ALIGN_EPI) { if (wr == 0) PG8_BAR; }
    PG8_BAR;
    if constexpr (Epi::AFTER_DRAIN) { E.fused(acc, cur, wr, wc, fr, fq, lds, wid, lane); S.done(cur); }
#undef PG8_SA
#undef PG8_SB
#undef PG8_STAGE
#undef PG8_LDA
#undef PG8_LDB
#undef PG8_MMA
#undef PG8_WAIT_V
#undef PG8_WAIT_L
#undef PG8_BAR
#undef PG8_SCHED
}
}
#define GAS __attribute__((address_space(1)))
#define LAS __attribute__((address_space(3)))
typedef unsigned short bf16;
typedef unsigned v4u __attribute__((ext_vector_type(4)));
typedef float f32x4 __attribute__((ext_vector_type(4)));
typedef short bf16x8 __attribute__((ext_vector_type(8)));
typedef GAS unsigned gu32;
typedef GAS unsigned long long gu64;
#define RLX_AGENT __ATOMIC_RELAXED, __HIP_MEMORY_SCOPE_AGENT
#define LDS_WAIT() asm volatile("s_waitcnt lgkmcnt(0)" ::: "memory")
#define VM_WAIT() asm volatile("s_waitcnt vmcnt(0)" ::: "memory")
__device__ __forceinline__ unsigned long long rt() { return __builtin_amdgcn_s_memrealtime(); }
__device__ __forceinline__ unsigned f2bf(float f) { unsigned u = __builtin_bit_cast(unsigned, f); return (u + 0x7fffu + ((u >> 16) & 1u)) >> 16; }
__device__ __forceinline__ unsigned pk2(float lo, float hi) { return f2bf(lo) | (f2bf(hi) << 16); }

#define XB_TMO      128
#define XB_XCNT(j)  (256  + 64 * (j))
#define XB_XSUB(j)  (1280 + 64 * (j))
#define XB_XGEN(j)  (2304 + 64 * (j))
#define XB_TOP      3328
#define XB_TOPGEN   3392
#define XCD_BAR_WORDS 3456
#define XB_SPIN_CAP (1u << 18)

__device__ __forceinline__ unsigned xb_ld(unsigned* p)              { return __hip_atomic_load(p, __ATOMIC_RELAXED, __HIP_MEMORY_SCOPE_AGENT); }
__device__ __forceinline__ unsigned xb_add(unsigned* p, unsigned v) { return __hip_atomic_fetch_add(p, v, __ATOMIC_RELAXED, __HIP_MEMORY_SCOPE_AGENT); }
__device__ __forceinline__ unsigned xb_xcc_id() { return (unsigned)__builtin_amdgcn_s_getreg((3 << 11) | 20) & 0xFu; }
#define XB_SPIN(cond, bar) do { unsigned _sp = 0; while (cond) { __builtin_amdgcn_s_sleep(1); \
    if ((++_sp & 255u) == 0u) { if (xb_ld(&(bar)[XB_TMO])) break; if (_sp > XB_SPIN_CAP) { atomicAdd(&(bar)[XB_TMO], 1u); break; } } } } while (0)

struct XcdBarrier {
    unsigned* bar; unsigned x;
    volatile LAS unsigned* st;
};

__device__ __forceinline__ XcdBarrier xcd_barrier_post(unsigned* bar, volatile LAS unsigned* st) {
    XcdBarrier b; b.bar = bar; b.x = xb_xcc_id(); b.st = st;
    if (threadIdx.x == 0) (void)xb_add(&bar[XB_XCNT(b.x)], 1u);
    return b;
}
__device__ __forceinline__ void xcd_barrier_complete(unsigned* bar, unsigned x, unsigned& nloc, unsigned& nx) {
    const unsigned G = gridDim.x * gridDim.y * gridDim.z;
    unsigned sum, cnt, mine, sp = 0u;
    for (;;) {
        sum = 0u; cnt = 0u; mine = 0u;
#pragma unroll
        for (unsigned j = 0; j < 16; ++j) { const unsigned c = xb_ld(&bar[XB_XCNT(j)]); sum += c; cnt += (c > 0u) ? 1u : 0u; mine = (j == x) ? c : mine; }
        if (sum == G) break;
        __builtin_amdgcn_s_sleep(1);
        if ((++sp & 255u) == 0u) { if (xb_ld(&bar[XB_TMO])) break; if (sp > XB_SPIN_CAP) { atomicAdd(&bar[XB_TMO], 1u); break; } }
    }
    nloc = mine > 0u ? mine : 1u; nx = cnt > 0u ? cnt : 1u;
}

__device__ __forceinline__ void xcd_barrier(const XcdBarrier& b, bool local = false) {
    asm volatile("s_waitcnt vmcnt(0)" ::: "memory");
    __syncthreads();
    if (threadIdx.x == 0) {
        unsigned* bar = b.bar;
        __builtin_amdgcn_s_waitcnt(0);
        unsigned nloc = b.st[0], nx = b.st[1];
        if (nloc == 0u) { xcd_barrier_complete(bar, b.x, nloc, nx); b.st[0] = nloc; b.st[1] = nx; }
        const unsigned old = xb_add(&bar[XB_XSUB(b.x)], 1u);
        const unsigned gen = old / nloc;
        if (old + 1u == (gen + 1u) * nloc) {
            if (!local) {
            __builtin_amdgcn_fence(__ATOMIC_RELEASE, "agent");
            asm volatile("s_waitcnt vmcnt(0)" ::: "memory");
            const unsigned og = xb_add(&bar[XB_TOP], 1u);
            const unsigned tg = og / nx;
            if (og + 1u == (tg + 1u) * nx) xb_add(&bar[XB_TOPGEN], 1u);
            else XB_SPIN(xb_ld(&bar[XB_TOPGEN]) == tg, bar);
            }
            __builtin_amdgcn_fence(__ATOMIC_ACQUIRE, "agent");
            xb_add(&bar[XB_XGEN(b.x)], 1u);
            asm volatile("s_waitcnt vmcnt(0)" ::: "memory");
        } else {
            XB_SPIN(xb_ld(&bar[XB_XGEN(b.x)]) == gen, bar);
            __builtin_amdgcn_fence(__ATOMIC_ACQUIRE, "agent");
            asm volatile("s_waitcnt vmcnt(0)" ::: "memory");
        }
    }
    __syncthreads();
}

constexpr int NWAVES = 8;
constexpr int BATCH = 4, SEQ = 8192, D = 1024, M = BATCH * SEQ, DEPTH = 2;
constexpr int INW = 2048, DFF = 2816, NMOD = 6;
constexpr int O_U = 0, O_QB = 256, O_KB = 640, O_VB = 1024, O_QC = 1408, O_KC = 1792, O_VC = 1920;
constexpr float RMS_EPS = 1e-6f;
constexpr float LOG2E = 1.4426950408889634f;
constexpr float QSCALE = 0.125f * LOG2E;

constexpr size_t MiB = 1u << 20;
constexpr size_t WS_CTL = 0, CTL_ZERO_BYTES = 131072;
constexpr size_t WS_MOD = 1 * MiB;
constexpr size_t WS_W = 2 * MiB, W_LAYER = 24 * MiB;
constexpr size_t W_IN = 0, W_OUT = 4 * MiB, W_GU = 6 * MiB, W_DN = 17 * MiB, W_PT = 23 * MiB;
constexpr size_t WS_H = 50 * MiB;
constexpr size_t WS_Z = 114 * MiB;
constexpr size_t WS_MIX = 436 * MiB;
constexpr size_t WS_HID = 114 * MiB;
constexpr size_t WS_XS = 306 * MiB;
constexpr size_t WS_AUX = 434 * MiB;
constexpr size_t WS_SUMSQ = WS_AUX;
constexpr size_t WS_GV = WS_AUX + 1 * MiB;
constexpr size_t WS_BIAS = WS_GV + 65536;
constexpr size_t BIAS_LAYER = (size_t)BATCH * (2048 + 5632) * 4;
constexpr size_t WS_BSCR = 370 * MiB;
constexpr size_t WS_ZC = 202 * MiB;
constexpr size_t WS_ZB = 130 * MiB;
constexpr size_t WS_END = 500 * MiB;
static_assert(WS_Z + (size_t)M * 256 * 2 <= WS_ZB && WS_ZB + 72 * MiB <= WS_ZC && WS_ZC + 40 * MiB <= WS_XS, "z region map");
static_assert(WS_HID + (size_t)M * DFF * 2 <= WS_XS && WS_MIX + (size_t)M * D * 2 <= WS_END && WS_AUX + 2 * MiB <= WS_MIX && WS_BSCR + 24 * MiB <= WS_AUX && WS_H + (size_t)M * D * 2 <= WS_Z, "ws map");
constexpr int CW_TMO = 0, CW_CODE = 1, CW_BAR = 4096  , CW_QUEUE = 20480, CW_GRP = 20480  , CW_GRPBAD = 20496  , CW_ZEROS = 24576  ;

constexpr int RING_OFF = 0, RING_BYTES = 131072;
constexpr int LDSCTL_OFF = RING_BYTES, MISC_OFF = 147456 - 256, LSEB_OFF = MISC_OFF - 6144;
constexpr int LDS_BYTES = 147456;

constexpr int PH_PRO = 0, PH_CONV = 1, PH_L0 = 2, PH_PER_LAYER = 5, PH_FINAL = PH_L0 + DEPTH * PH_PER_LAYER, NPHASES = PH_FINAL + 1;
#ifndef PROBE_DUP
#define PROBE_DUP 0
#endif
#ifndef PROBE_CUT
#define PROBE_CUT 0
#endif
#ifndef PROBE_MIXSEL
#define PROBE_MIXSEL 0
#endif
#ifndef PROBE_NOSTORE
#define PROBE_NOSTORE 0
#endif
#ifndef MK_ONE_LAUNCH
#define MK_ONE_LAUNCH 1
#endif

struct Frame {
    LAS unsigned char* lds;
    volatile LAS unsigned* MISC;
    gu32* ctl;
    int tid, lane, wave, G, vcu;
};

__device__ __forceinline__ float wave_sum(float v) {
#pragma unroll
    for (int o = 1; o < 64; o <<= 1) v += __shfl_xor(v, o);
    return v;
}
__device__ __forceinline__ float bf2f(unsigned short b) { return __uint_as_float((unsigned)b << 16); }
__device__ __forceinline__ float zero_() { float z; asm volatile("v_mov_b32 %0, 0" : "=v"(z)); return z; }
__device__ __forceinline__ f32x4 zero4_() { const float z = zero_(); return (f32x4){z, z, z, z}; }

__device__ __forceinline__ void tr_item(const float* W, int N, int k0, int n0, bf16* WT, int ldt, int drow0, float scale, LAS float* scr, int lane, bool img = true) {
#pragma unroll 8
    for (int i = 0; i < 32; ++i) { const int kk = 2 * i + (lane >> 5); scr[kk * 33 + (lane & 31)] = __builtin_nontemporal_load(W + (size_t)(k0 + kk) * N + n0 + (lane & 31)); }
    LDS_WAIT(); asm volatile("" ::: "memory");
    const int c = lane & 7;
#pragma unroll
    for (int j = 0; j < 4; ++j) { const int n = (lane >> 3) + 8 * j; const LAS float* s = scr + (8 * c) * 33 + n;
        v4u o; o.x = pk2(s[0 * 33] * scale, s[1 * 33] * scale); o.y = pk2(s[2 * 33] * scale, s[3 * 33] * scale); o.z = pk2(s[4 * 33] * scale, s[5 * 33] * scale); o.w = pk2(s[6 * 33] * scale, s[7 * 33] * scale);
        if (img) *(GAS v4u*)((unsigned char*)WT + pg8::img_off(drow0 + n, k0 + 8 * c, ldt / 64, true)) = o;
        else *(GAS v4u*)(WT + (size_t)(drow0 + n) * ldt + k0 + 8 * c) = o; }
    LDS_WAIT(); asm volatile("" ::: "memory");
}
constexpr int TI_IN = 16 * 64, TI_OUT = 16 * 32, TI_G = 16 * 88, TI_DN = 44 * 32, TI_P = 8, TI_LAYER = TI_IN + TI_OUT + 2 * TI_G + TI_DN + TI_P;
__device__ __forceinline__ void weight_item(const float* const* in, unsigned char* ws, int it, LAS float* scr, int lane) {
    const int l = it / TI_LAYER; int r = it % TI_LAYER;
    unsigned char* wl = ws + WS_W + (size_t)l * W_LAYER;
    if (r < TI_IN) { const int kb = r / 64, n0 = 32 * (r % 64); const bool isq = (n0 >= O_QB && n0 < O_KB) || (n0 >= O_QC && n0 < O_KC);
        tr_item(in[6] + (size_t)l * D * INW, INW, 64 * kb, n0, (bf16*)(wl + W_IN), D, n0, isq ? QSCALE : 1.0f, scr, lane); return; }
    r -= TI_IN;
    if (r < TI_OUT) { const int kb = r / 32, n0 = 32 * (r % 32); tr_item(in[10] + (size_t)l * D * D, D, 64 * kb, n0, (bf16*)(wl + W_OUT), D, n0, 1.0f, scr, lane); return; }
    r -= TI_OUT;
    if (r < 2 * TI_G) { const int up = r >= TI_G; if (up) r -= TI_G; const int kb = r / 88, n0 = 32 * (r % 88);
        tr_item(in[up ? 12 : 11] + (size_t)l * D * DFF, DFF, 64 * kb, n0, (bf16*)(wl + W_GU), D, 256 * (n0 >> 7) + 128 * up + (n0 & 127), 1.0f, scr, lane); return; }
    r -= 2 * TI_G;
    if (r < TI_DN) { const int kb = r / 32, n0 = 32 * (r % 32); tr_item(in[13] + (size_t)l * DFF * D, D, 64 * kb, n0, (bf16*)(wl + W_DN), DFF, n0, 1.0f, scr, lane); return; }
    r -= TI_DN;
    { const int g = r >> 1, n0 = 32 * (r & 1); tr_item(in[7] + (size_t)l * 16384 + g * 4096, 64, 0, n0, (bf16*)(wl + W_PT) + g * 4096, 64, n0, 1.0f, scr, lane, false); }
}
__device__ __forceinline__ void ada_item(Frame& F, const float* const* in, unsigned char* ws, int item) {
    LAS float* cact = (LAS float*)(F.lds);
    LAS float* red = (LAS float*)(F.lds + 16384);
    const int l = item / 96, cb = item % 96;
    const float* c = in[1];
    for (int i = F.tid; i < BATCH * D; i += NWAVES * 64) { const int b = i >> 10, k = i & 1023; const float v = c[i]; cact[k * 4 + b] = v / (1.0f + __expf(-v)); }
    __syncthreads();
    const float* W = in[4] + (size_t)l * D * (NMOD * D) + 64 * cb + F.lane;
    float a0 = 0.f, a1 = 0.f, a2 = 0.f, a3 = 0.f;
    const int kbeg = 128 * F.wave;
#pragma unroll 16
    for (int kk = 0; kk < 128; ++kk) { const float wv = __builtin_nontemporal_load(W + (size_t)(kbeg + kk) * (NMOD * D)); const f32x4 ca = *(const LAS f32x4*)(cact + (kbeg + kk) * 4);
        a0 += ca.x * wv; a1 += ca.y * wv; a2 += ca.z * wv; a3 += ca.w * wv; }
    red[(F.wave * 4 + 0) * 64 + F.lane] = a0; red[(F.wave * 4 + 1) * 64 + F.lane] = a1; red[(F.wave * 4 + 2) * 64 + F.lane] = a2; red[(F.wave * 4 + 3) * 64 + F.lane] = a3;
    __syncthreads();
    if (F.wave < 4) { float s = in[5][(size_t)l * NMOD * D + 64 * cb + F.lane];
#pragma unroll
        for (int w = 0; w < 8; ++w) s += red[(w * 4 + F.wave) * 64 + F.lane];
        ((float*)(ws + WS_MOD))[((size_t)l * BATCH + F.wave) * (NMOD * D) + 64 * cb + F.lane] = s; }
    __syncthreads();
}
__device__ __forceinline__ void p_prologue(Frame& F, const float* const* in, unsigned char* ws) {
    for (int item = blockIdx.x; item < DEPTH * 96; item += F.G) ada_item(F, in, ws, item);
    LAS float* scr = (LAS float*)(F.lds + RING_OFF + F.wave * 16384);
    const int gw = blockIdx.x * NWAVES + F.wave, NGW = F.G * NWAVES;
    for (int it = gw; it < DEPTH * TI_LAYER; it += NGW) weight_item(in, ws, it, scr, F.lane);
    { GAS f32x4* z = (GAS f32x4*)(ws + WS_SUMSQ) + M / 4; const int n4 = 4 * M / 4;
      for (int i = blockIdx.x * (NWAVES * 64) + F.tid; i < n4; i += F.G * NWAVES * 64) z[i] = zero4_(); }
}

__device__ __forceinline__ void p_conv(Frame& F, const float* const* in, unsigned char* ws) {
    const float* MOD = (const float*)(ws + WS_MOD);
    const int NGW = F.G * NWAVES, gw = blockIdx.x * NWAVES + F.wave, rpw = M / NGW;
    {
        const int row0 = gw * rpw, b = row0 / SEQ;
        const float* mb = MOD + (size_t)b * (NMOD * D);
        const float* xin = in[0]; bf16* hout = (bf16*)(ws + WS_H); float* ssq = (float*)(ws + WS_SUMSQ);
        f32x4 Gv[4];
#pragma unroll
        for (int j = 0; j < 4; ++j) { const int cidx = 4 * F.lane + 256 * j; const f32x4 g = *(const f32x4*)(in[2] + cidx), sc = *(const f32x4*)(mb + 1 * D + cidx); Gv[j] = g * (sc + 1.0f); }
        for (int rr = 0; rr < rpw; rr += 4) {
            f32x4 v[4][4];
#pragma unroll
            for (int i = 0; i < 4; ++i) { const GAS f32x4* xr = (const GAS f32x4*)(xin + (size_t)(row0 + rr + i) * D) + F.lane;
#pragma unroll
                for (int j = 0; j < 4; ++j) v[i][j] = __builtin_nontemporal_load(xr + 64 * j); }
#pragma unroll
            for (int i = 0; i < 4; ++i) { const size_t row = (size_t)(row0 + rr + i); float s = 0.f;
#pragma unroll
                for (int j = 0; j < 4; ++j) s += (v[i][j].x * v[i][j].x + v[i][j].y * v[i][j].y) + (v[i][j].z * v[i][j].z + v[i][j].w * v[i][j].w);
                s = wave_sum(s); if (F.lane == 0) ssq[row] = s;
                unsigned char* hb = (unsigned char*)hout + 8 * (F.lane & 1);
#pragma unroll
                for (int j = 0; j < 4; ++j) { const f32x4 o = v[i][j] * Gv[j]; *(GAS unsigned long long*)(hb + pg8::img_off((int)row, (4 * F.lane + 256 * j) & ~7, D / 64, false)) = (unsigned long long)pk2(o.x, o.y) | ((unsigned long long)pk2(o.z, o.w) << 32);
 } }
        }
    }
    {
        float* GV = (float*)(ws + WS_GV);
        for (int i = blockIdx.x * (NWAVES * 64) + F.tid; i < DEPTH * 2 * BATCH * D; i += F.G * NWAVES * 64) { const int col = i & (D - 1), b = (i >> 10) & 3, w = (i >> 12) & 1, l = i >> 13;
            GV[i] = in[w ? 3 : 2][l * D + col] * (1.0f + MOD[((size_t)l * BATCH + b) * (NMOD * D) + (w ? 4 : 1) * D + col]); }
    }
    {
        const int g0 = 8 * gw;
        if (g0 < DEPTH * (INW + 2 * DFF)) {
            const int l = g0 / (INW + 2 * DFF), rl = g0 % (INW + 2 * DFF), w = rl >= INW, n0 = w ? rl - INW : rl, N = w ? 2 * DFF : INW;
            const unsigned char* Bt = ws + WS_W + (size_t)l * W_LAYER + (w ? W_GU : W_IN);
            float* bias = (float*)(ws + WS_BIAS + (size_t)l * BIAS_LAYER) + (w ? BATCH * INW : 0);
            const float* shp = MOD + (size_t)l * BATCH * (NMOD * D) + (w ? 3 : 0) * D + 16 * F.lane;
            v4u wr[8][2];
#pragma unroll
            for (int i = 0; i < 8; ++i) { wr[i][0] = *(const GAS v4u*)(Bt + pg8::img_off(n0 + i, 16 * F.lane, D / 64, true)); wr[i][1] = *(const GAS v4u*)(Bt + pg8::img_off(n0 + i, 16 * F.lane + 8, D / 64, true)); }
            f32x4 sh[4][4];
#pragma unroll
            for (int b = 0; b < 4; ++b)
#pragma unroll
                for (int j = 0; j < 4; ++j) sh[b][j] = *(const f32x4*)(shp + (size_t)b * (NMOD * D) + 4 * j);
#pragma unroll
            for (int i = 0; i < 8; ++i) { const v4u w0 = wr[i][0], w1 = wr[i][1];
                float wf[16];
                wf[0] = __uint_as_float(w0.x << 16); wf[1] = __uint_as_float(w0.x & 0xffff0000u); wf[2] = __uint_as_float(w0.y << 16); wf[3] = __uint_as_float(w0.y & 0xffff0000u);
                wf[4] = __uint_as_float(w0.z << 16); wf[5] = __uint_as_float(w0.z & 0xffff0000u); wf[6] = __uint_as_float(w0.w << 16); wf[7] = __uint_as_float(w0.w & 0xffff0000u);
                wf[8] = __uint_as_float(w1.x << 16); wf[9] = __uint_as_float(w1.x & 0xffff0000u); wf[10] = __uint_as_float(w1.y << 16); wf[11] = __uint_as_float(w1.y & 0xffff0000u);
                wf[12] = __uint_as_float(w1.z << 16); wf[13] = __uint_as_float(w1.z & 0xffff0000u); wf[14] = __uint_as_float(w1.w << 16); wf[15] = __uint_as_float(w1.w & 0xffff0000u);
                float acc[4];
#pragma unroll
                for (int b = 0; b < 4; ++b) { float a = 0.f;
#pragma unroll
                    for (int j = 0; j < 4; ++j) a += (wf[4 * j] * sh[b][j].x + wf[4 * j + 1] * sh[b][j].y) + (wf[4 * j + 2] * sh[b][j].z + wf[4 * j + 3] * sh[b][j].w);
                    acc[b] = wave_sum(a); }
                if (F.lane < 4) bias[(size_t)F.lane * N + n0 + i] = F.lane == 0 ? acc[0] : F.lane == 1 ? acc[1] : F.lane == 2 ? acc[2] : acc[3]; }
        }
    }
}
__device__ __forceinline__ void p_norm_final(Frame& F, const bf16* xin, const float* ssq, float* out, const float* gvec) {
    const int NGW = F.G * NWAVES, gw = blockIdx.x * NWAVES + F.wave, rpw = M / NGW;
    const int row0 = gw * rpw;
    f32x4 Gv[4];
#pragma unroll
    for (int j = 0; j < 4; ++j) Gv[j] = *(const f32x4*)(gvec + 4 * F.lane + 256 * j);
    for (int rr = 0; rr < rpw; rr += 4) {
        unsigned long long w[4][4]; float ss[4];
#pragma unroll
        for (int i = 0; i < 4; ++i) { const unsigned char* xr = (const unsigned char*)xin + 8 * (F.lane & 1); ss[i] = ssq[row0 + rr + i];
#pragma unroll
            for (int j = 0; j < 4; ++j) w[i][j] = *(const GAS unsigned long long*)(xr + pg8::img_off(row0 + rr + i, (4 * F.lane + 256 * j) & ~7, D / 64, false)); }
#pragma unroll
        for (int i = 0; i < 4; ++i) { const float rstd = 1.0f / sqrtf(ss[i] * (1.0f / D) + RMS_EPS);
            GAS f32x4* o = (GAS f32x4*)(out + (size_t)(row0 + rr + i) * D) + F.lane;
#pragma unroll
            for (int j = 0; j < 4; ++j) { const unsigned wl = (unsigned)w[i][j], wh = (unsigned)(w[i][j] >> 32);
                const f32x4 v = {pg8::h_lo(wl), pg8::h_hi(wl), pg8::h_lo(wh), pg8::h_hi(wh)};
                __builtin_nontemporal_store(v * rstd * Gv[j], o + 64 * j); } }
    }
}

namespace mx {
typedef short bf16x8 __attribute__((ext_vector_type(8)));
typedef short s16x4 __attribute__((ext_vector_type(4)));
typedef float f32x16 __attribute__((ext_vector_type(16)));
typedef unsigned u32x4 __attribute__((ext_vector_type(4)));
typedef unsigned u32x2 __attribute__((ext_vector_type(2)));
typedef float f32x2_t __attribute__((ext_vector_type(2))); typedef __bf16 bf16x2_t __attribute__((ext_vector_type(2)));
constexpr float THR = 8.0f;
constexpr int POOL_PITCH = 544;
__device__ __forceinline__ unsigned cvtpk(float lo, float hi) { f32x2_t v = {lo, hi}; bf16x2_t b = __builtin_convertvector(v, bf16x2_t); return __builtin_bit_cast(unsigned, b); }
__device__ __forceinline__ float hswap_max(float v) { auto rr = __builtin_amdgcn_permlane32_swap(__float_as_uint(v), __float_as_uint(v), false, false); return fmaxf(__uint_as_float(rr[0]), __uint_as_float(rr[1])); }
__device__ __forceinline__ float hswap_sum(float v) { auto rr = __builtin_amdgcn_permlane32_swap(__float_as_uint(v), __float_as_uint(v), false, false); return __uint_as_float(rr[0]) + __uint_as_float(rr[1]); }
__device__ __forceinline__ s16x4 vtr(const LAS char* p) { return __builtin_bit_cast(s16x4, __builtin_amdgcn_ds_read_tr16_b64_v4i16((LAS s16x4*)p)); }
__device__ __forceinline__ f32x16 zero16_() { const float z = zero_(); return (f32x16){z, z, z, z, z, z, z, z, z, z, z, z, z, z, z, z}; }
__device__ __forceinline__ int kt_of(int i) { return (i & 1) ? -((i + 1) >> 1) : (i >> 1); }

template <int VAR>
__device__ __forceinline__ float scores(f32x16& t, const bf16x8 (&kf)[4], const bf16x8 (&qf)[4], float relf, float sl, float slope2, float Rf) {
    f32x16 s = {0.f, 0.f, 0.f, 0.f, 0.f, 0.f, 0.f, 0.f, 0.f, 0.f, 0.f, 0.f, 0.f, 0.f, 0.f, 0.f};
#pragma unroll
    for (int i = 0; i < 4; ++i) s = __builtin_amdgcn_mfma_f32_32x32x16_bf16(kf[i], qf[i], s, 0, 0, 0);
    if (VAR == 0) {
#pragma unroll
        for (int r = 0; r < 16; ++r) t[r] = __builtin_fmaf(-__builtin_fabsf(relf - (float)((r & 3) + 8 * (r >> 2))), slope2, s[r]);
        return 0.f;
    } else {
#pragma unroll
        for (int r = 0; r < 16; ++r) { const float c = (float)((r & 3) + 8 * (r >> 2)); float v = __builtin_fmaf(sl, c, s[r]); if (VAR == 2) v = __builtin_fabsf(relf - c) > Rf ? -INFINITY : v; t[r] = v; }
        return -sl * relf;
    }
}
__device__ __forceinline__ float lane_max(const f32x16& t) {
    float a = fmaxf(fmaxf(t[0], t[1]), fmaxf(t[2], t[3])), b = fmaxf(fmaxf(t[4], t[5]), fmaxf(t[6], t[7])), c = fmaxf(fmaxf(t[8], t[9]), fmaxf(t[10], t[11])), d = fmaxf(fmaxf(t[12], t[13]), fmaxf(t[14], t[15]));
    return fmaxf(fmaxf(a, b), fmaxf(c, d));
}
__device__ __forceinline__ float tile_max(const f32x16& t) {
    float a = fmaxf(fmaxf(t[0], t[1]), fmaxf(t[2], t[3])), b = fmaxf(fmaxf(t[4], t[5]), fmaxf(t[6], t[7])), c = fmaxf(fmaxf(t[8], t[9]), fmaxf(t[10], t[11])), d = fmaxf(fmaxf(t[12], t[13]), fmaxf(t[14], t[15]));
    return hswap_max(fmaxf(fmaxf(a, b), fmaxf(c, d)));
}
__device__ __forceinline__ void load_frag4(bf16x8 (&f)[4], const bf16* rowp, int hi) {
#pragma unroll
    for (int i = 0; i < 4; ++i) f[i] = *(const bf16x8*)(rowp + 16 * i + 8 * hi);
}
__device__ __forceinline__ void load_tile_frags(bf16x8 (&f)[4], const char* tile, int lane) {
#pragma unroll
    for (int s = 0; s < 4; ++s) f[s] = *(const bf16x8*)(tile + s * 1024 + lane * 16);
}
__device__ __forceinline__ void dma_tile(LAS char* dst, const char* tile, int lane) {
#pragma unroll
    for (int j = 0; j < 4; ++j) __builtin_amdgcn_global_load_lds((const unsigned*)(tile + j * 1024 + lane * 16), (LAS unsigned*)(dst + j * 1024), 16, 0, 0);
}
__device__ __forceinline__ void dma_v(LAS char* vb, const bf16* vrow0, long rs, int lane) {
#pragma unroll
    for (int j = 0; j < 4; ++j) __builtin_amdgcn_global_load_lds((const unsigned*)(vrow0 + (long)(16 * (j & 1) + (lane >> 2)) * rs + (4 * (j >> 1) + (lane & 3)) * 8), (LAS unsigned*)(vb + j * 1024), 16, 0, 0);
}
__device__ __forceinline__ void load_vfrags(bf16x8 (&vf)[2][2], const LAS char* vaddr) {
#pragma unroll
    for (int d0 = 0; d0 < 2; ++d0)
#pragma unroll
        for (int ks = 0; ks < 2; ++ks) { const s16x4 lo = vtr(vaddr + d0 * 2048 + ks * 1024), hh = vtr(vaddr + d0 * 2048 + ks * 1024 + 512);
            vf[d0][ks] = (bf16x8){lo[0], lo[1], lo[2], lo[3], hh[0], hh[1], hh[2], hh[3]}; }
}
__device__ __forceinline__ void pv_tile(f32x16 (&o)[2], const bf16x8 (&vf)[2][2], const f32x16& p) {
    u32x4 w0, w1;
    w0.x = cvtpk(p[0], p[1]); w0.y = cvtpk(p[2], p[3]); w0.z = cvtpk(p[4], p[5]); w0.w = cvtpk(p[6], p[7]);
    w1.x = cvtpk(p[8], p[9]); w1.y = cvtpk(p[10], p[11]); w1.z = cvtpk(p[12], p[13]); w1.w = cvtpk(p[14], p[15]);
    const bf16x8 pa0 = __builtin_bit_cast(bf16x8, w0), pa1 = __builtin_bit_cast(bf16x8, w1);
#pragma unroll
    for (int d0 = 0; d0 < 2; ++d0) { o[d0] = __builtin_amdgcn_mfma_f32_32x32x16_bf16(vf[d0][0], pa0, o[d0], 0, 0, 0); o[d0] = __builtin_amdgcn_mfma_f32_32x32x16_bf16(vf[d0][1], pa1, o[d0], 0, 0, 0); }
}
__device__ __forceinline__ void store_o(bf16* MIX, int row, int col, const f32x16 (&o)[2], float scale, int hi) {
#pragma unroll
    for (int d0 = 0; d0 < 2; ++d0)
#pragma unroll
        for (int g = 0; g < 4; g += 2) {
            const unsigned ax = cvtpk(o[d0][4 * g] * scale, o[d0][4 * g + 1] * scale), ay = cvtpk(o[d0][4 * g + 2] * scale, o[d0][4 * g + 3] * scale);
            const unsigned bx = cvtpk(o[d0][4 * g + 4] * scale, o[d0][4 * g + 5] * scale), by = cvtpk(o[d0][4 * g + 6] * scale, o[d0][4 * g + 7] * scale);
            const auto rx = __builtin_amdgcn_permlane32_swap(ax, bx, false, false); const auto ry = __builtin_amdgcn_permlane32_swap(ay, by, false, false);
            u32x4 w; w.x = rx[0]; w.y = ry[0]; w.z = rx[1]; w.w = ry[1];
            *(u32x4*)((unsigned char*)MIX + pg8::img_off(row, col + 32 * d0 + 8 * g + 8 * hi, D / 64, false)) = w; }
}
__device__ __forceinline__ void pack_o(u32x4 (&w)[4], const f32x16 (&o)[2], float scale) {
#pragma unroll
    for (int d0 = 0; d0 < 2; ++d0)
#pragma unroll
        for (int g = 0; g < 4; g += 2) {
            const unsigned ax = cvtpk(o[d0][4 * g] * scale, o[d0][4 * g + 1] * scale), ay = cvtpk(o[d0][4 * g + 2] * scale, o[d0][4 * g + 3] * scale);
            const unsigned bx = cvtpk(o[d0][4 * g + 4] * scale, o[d0][4 * g + 5] * scale), by = cvtpk(o[d0][4 * g + 6] * scale, o[d0][4 * g + 7] * scale);
            const auto rx = __builtin_amdgcn_permlane32_swap(ax, bx, false, false); const auto ry = __builtin_amdgcn_permlane32_swap(ay, by, false, false);
            w[2 * d0 + (g >> 1)] = (u32x4){rx[0], ry[0], rx[1], ry[1]}; }
}
__device__ __forceinline__ float alibi_slope(int k  ) { return __builtin_amdgcn_exp2f(-8.0f * (float)(k + 1) / 12.0f); }
__device__ __forceinline__ void scale_o(f32x16 (&o)[2], float f) {
#pragma unroll
    for (int r = 0; r < 16; ++r) { o[0][r] *= f; o[1][r] *= f; }
}

template <bool FIRST, bool WITH_O>
__device__ __forceinline__ void step_rest(f32x16 (&o)[2], float& m, float& l, f32x16& t, float off, const bf16x8 (&vf)[2][2]) {
    const float tm = hswap_max(lane_max(t) + off);
    if (FIRST) m = tm;
    else if (__any(tm - m > THR)) { const float dl = fmaxf(tm - m, 0.f), f = __builtin_amdgcn_exp2f(-dl); l *= f; if (WITH_O) scale_o(o, f); m += dl; }
    const float bm = off - m; f32x2_t ps = {0.f, 0.f}; const f32x2_t bm2 = {bm, bm};
#pragma unroll
    for (int r = 0; r < 16; r += 2) { const f32x2_t x = (f32x2_t){t[r], t[r + 1]} + bm2; t[r] = __builtin_amdgcn_exp2f(x.x); t[r + 1] = __builtin_amdgcn_exp2f(x.y); ps += (f32x2_t){t[r], t[r + 1]}; }
    l += ps.x + ps.y;
    if (WITH_O) pv_tile(o, vf, t);
}
template <int VAR, bool FIRST, bool WITH_O>
__device__ __forceinline__ void step(f32x16 (&o)[2], float& m, float& l, const bf16x8 (&kf)[4], const bf16x8 (&qf)[4], const bf16x8 (&vf)[2][2], float relf, float sl, float slope2, float Rf) {
    f32x16 t; const float off = scores<VAR>(t, kf, qf, relf, sl, slope2, Rf);
    step_rest<FIRST, WITH_O>(o, m, l, t, off, vf);
}

__device__ __forceinline__ void pair_rest(f32x16 (&o)[2], float& m, float& l, f32x16& tL, f32x16& tR, float offL, float offR, const LAS char* vL, const LAS char* vR) {
    const float tm = hswap_max(fmaxf(lane_max(tL) + offL, lane_max(tR) + offR));
    if (__any(tm - m > THR)) { const float dl = fmaxf(tm - m, 0.f), f = __builtin_amdgcn_exp2f(-dl); l *= f; scale_o(o, f); m += dl; }
    const float bL = offL - m, bR = offR - m; f32x2_t ps = {0.f, 0.f}; const f32x2_t bL2 = {bL, bL}, bR2 = {bR, bR};
#pragma unroll
    for (int r = 0; r < 16; r += 2) { const f32x2_t xL = (f32x2_t){tL[r], tL[r + 1]} + bL2, xR = (f32x2_t){tR[r], tR[r + 1]} + bR2;
        tL[r] = __builtin_amdgcn_exp2f(xL.x); tL[r + 1] = __builtin_amdgcn_exp2f(xL.y); tR[r] = __builtin_amdgcn_exp2f(xR.x); tR[r + 1] = __builtin_amdgcn_exp2f(xR.y);
        ps += (f32x2_t){tL[r], tL[r + 1]}; ps += (f32x2_t){tR[r], tR[r + 1]}; }
    l += ps.x + ps.y;
    { bf16x8 vf[2][2]; load_vfrags(vf, vL); pv_tile(o, vf, tL); }
    { bf16x8 vf[2][2]; load_vfrags(vf, vR); pv_tile(o, vf, tR); }
}
template <int VAR>
__device__ __forceinline__ void step_pair_lds(f32x16 (&o)[2], float& m, float& l, const LAS char* kL, const LAS char* kR, const LAS char* vL, const LAS char* vR, bf16x8 (&qf)[4],
                                              float relfL, float relfR, float slope2, float Rf, const char* qnext = nullptr, int lane = 0) {
    f32x16 tL, tR; float offL, offR;
    { bf16x8 kf[4];
#pragma unroll
      for (int s = 0; s < 4; ++s) kf[s] = *(const LAS bf16x8*)(kL + s * 1024);
      offL = scores<VAR>(tL, kf, qf, relfL, slope2, slope2, Rf); }
    { bf16x8 kf[4];
#pragma unroll
      for (int s = 0; s < 4; ++s) kf[s] = *(const LAS bf16x8*)(kR + s * 1024);
      offR = scores<VAR>(tR, kf, qf, relfR, -slope2, slope2, Rf); }
    if (qnext) load_tile_frags(qf, qnext, lane);
    pair_rest(o, m, l, tL, tR, offL, offR, vL, vR);
}
template <int VAR>
__device__ __forceinline__ void step_pair_regk(f32x16 (&o)[2], float& m, float& l, const bf16x8 (&kfL)[4], const bf16x8 (&kfR)[4], const LAS char* vL, const LAS char* vR, const bf16x8 (&qf)[4],
                                               float relfL, float relfR, float slope2, float Rf) {
    f32x16 tL, tR; const float offL = scores<VAR>(tL, kfL, qf, relfL, slope2, slope2, Rf), offR = scores<VAR>(tR, kfR, qf, relfR, -slope2, slope2, Rf);
    pair_rest(o, m, l, tL, tR, offL, offR, vL, vR);
}

__device__ __forceinline__ void dma_k(LAS char* kb, const bf16* krow0, long rs, int lane) {
#pragma unroll
    for (int s = 0; s < 4; ++s) __builtin_amdgcn_global_load_lds((const unsigned*)(krow0 + (long)(lane & 31) * rs + 16 * s + 8 * (lane >> 5)), (LAS unsigned*)(kb + s * 1024), 16, 0, 0);
}
struct BTile { const char* qb; const char* kb; const char* vb; int nt  , t0  , n0, head, d, r, tl; float slope2; };
__device__ __forceinline__ BTile b_decode(const char* ZB, int b, int c, int j, int qi, int q) {
    BTile t; const int g = qi >> 4, i = qi & 15, lg = 2 * g; t.d = 1 << lg;
    t.r = i >> (4 - lg); const int isub = i & ((16 >> lg) - 1); t.n0 = ((512 * c) >> lg) + 32 * isub; t.nt = 256 >> lg; t.t0 = t.n0 >> 5;
    t.head = 2 * g + j; t.slope2 = alibi_slope(6 + t.head) * (float)t.d * LOG2E;
    const size_t tb = (size_t)(t.head * 4 + b) * 256 + ((size_t)t.r << (8 - lg));
    t.qb = ZB + (tb << 12); t.kb = ZB + ((tb + 6 * 4 * 256) << 12); t.vb = ZB + ((tb + 2 * 6 * 4 * 256) << 12);
    t.tl = g * 512 + (32 * isub + q) * t.d + t.r;
    return t;
}
__device__ __forceinline__ void b_issue_qk(const BTile& t, bf16x8 (&qf)[4], bf16x8 (&kf)[5][4], bool (&val)[5], int (&kc)[5], int lane) {
    load_tile_frags(qf, t.qb + ((size_t)t.t0 << 12), lane);
#pragma unroll
    for (int i = 0; i < 5; ++i) { const int kt = t.t0 + kt_of(i); val[i] = kt >= 0 && kt < t.nt; kc[i] = kt < 0 ? 0 : (kt >= t.nt ? t.nt - 1 : kt);
        load_tile_frags(kf[i], t.kb + ((size_t)kc[i] << 12), lane); }
}
__device__ __forceinline__ void fill_ninf(f32x16& t) {
#pragma unroll
    for (int r = 0; r < 16; ++r) t[r] = -INFINITY;
}
__device__ __forceinline__ float b_qtile(f32x16 (&o)[2], const BTile& t, const BTile& tn, bool has_next, bf16x8 (&qf)[4], bf16x8 (&kf)[5][4], bool (&val)[5], int (&kc)[5], LAS char* vb, int lane) {
    const int q = lane & 31, hi = lane >> 5;
    const float slope2 = t.slope2;
    const LAS char* vaddr = vb + (4 * hi + ((lane & 15) >> 2)) * 64 + ((lane >> 4) & 1) * 32 + (lane & 3) * 8;
    float m = 0.f, l = 0.f;
    {
        bf16x8 vf[2][2]; load_vfrags(vf, vaddr);
        asm volatile("s_waitcnt lgkmcnt(0)" ::: "memory"); dma_tile(vb, t.vb + ((size_t)kc[4] << 12), lane);
        step<0, true, true>(o, m, l, kf[0], qf, vf, (float)(q - 4 * hi), slope2, slope2, 64.0f); }
    {
        f32x16 tL, tR; const float offL = scores<1>(tL, kf[1], qf, (float)(q + 32 - 4 * hi), slope2, slope2, 64.0f), offR = scores<1>(tR, kf[2], qf, (float)(q - 32 - 4 * hi), -slope2, slope2, 64.0f);
        if (!val[1]) fill_ninf(tL); if (!val[2]) fill_ninf(tR);
        pair_rest(o, m, l, tL, tR, offL, offR, vaddr + 4096, vaddr + 8192); }
    asm volatile("s_waitcnt vmcnt(0)" ::: "memory");
    {
        f32x16 tL, tR; const float offL = scores<2>(tL, kf[3], qf, (float)(q + 64 - 4 * hi), slope2, slope2, 64.0f), offR = scores<2>(tR, kf[4], qf, (float)(q - 64 - 4 * hi), -slope2, slope2, 64.0f);
        if (!val[3]) fill_ninf(tL); if (!val[4]) fill_ninf(tR);
        if (has_next) {
            asm volatile("s_waitcnt lgkmcnt(0)" ::: "memory");
            b_issue_qk(tn, qf, kf, val, kc, lane);
            dma_tile(vb + 4096, tn.vb + ((size_t)kc[1] << 12), lane); dma_tile(vb + 8192, tn.vb + ((size_t)kc[2] << 12), lane); }
        pair_rest(o, m, l, tL, tR, offL, offR, vaddr + 12288, vaddr);
        if (has_next) { asm volatile("s_waitcnt lgkmcnt(0)" ::: "memory");
            dma_tile(vb, tn.vb + ((size_t)kc[0] << 12), lane); dma_tile(vb + 12288, tn.vb + ((size_t)kc[3] << 12), lane); } }
    const float lt = hswap_sum(l);
    scale_o(o, 1.0f / lt);
    return m + __builtin_amdgcn_logf(lt);
}
__device__ __forceinline__ void b_unit(const char* ZB, bf16* MIX, char* SCR, int u, LAS char* lds, int wave, int lane) {
    const int b = u >> 5, c = (u >> 1) & 15, j = u & 1;
    LAS float* lseb = (LAS float*)(lds + LSEB_OFF);
    LAS char* vb = lds + wave * 16384;
    char* scr = SCR + ((size_t)(u * 8 + wave) * 6 << 12) + lane * 16;
    const int q = lane & 31, hi = lane >> 5;
    bf16x8 qf[4], kf[5][4]; bool val[5]; int kc[5];
    BTile t = b_decode(ZB, b, c, j, wave, q);
    b_issue_qk(t, qf, kf, val, kc, lane);
#pragma unroll
    for (int i = 0; i < 4; ++i) dma_tile(vb + i * 4096, t.vb + ((size_t)kc[i] << 12), lane);
#pragma unroll 1
    for (int it = 0; it < 6; ++it) { const bool has_next = it < 5; const BTile tn = b_decode(ZB, b, c, j, wave + 8 * (has_next ? it + 1 : it), q);
        if (it == 0) asm volatile("s_waitcnt vmcnt(0)" ::: "memory"); else asm volatile("s_waitcnt vmcnt(4)" ::: "memory");
        f32x16 o[2]; o[0] = zero16_(); o[1] = zero16_();
        const float lse = b_qtile(o, t, tn, has_next, qf, kf, val, kc, vb, lane);
        if (hi == 0) lseb[t.tl] = lse;
        u32x4 w[4]; pack_o(w, o, 1.0f);
#pragma unroll
        for (int k = 0; k < 4; ++k) *(u32x4*)(scr + ((size_t)it << 12) + k * 1024) = w[k];
        t = tn; }
    __syncthreads();
#pragma unroll 1
    for (int it0 = 0; it0 < 6; it0 += 3) { u32x4 w[3][4];
#pragma unroll
        for (int ii = 0; ii < 3; ++ii)
#pragma unroll
            for (int k = 0; k < 4; ++k) w[ii][k] = *(const u32x4*)(scr + ((size_t)(it0 + ii) << 12) + k * 1024);
#pragma unroll
        for (int ii = 0; ii < 3; ++ii) { const BTile tt = b_decode(ZB, b, c, j, wave + 8 * (it0 + ii), q);
            const int tk = tt.tl & 511; const float l0 = lseb[tk], l1 = lseb[512 + tk], l2 = lseb[1024 + tk], own = lseb[tt.tl]; const float mm = fmaxf(l0, fmaxf(l1, l2));
            const float a = __builtin_amdgcn_exp2f(own - mm) / (__builtin_amdgcn_exp2f(l0 - mm) + __builtin_amdgcn_exp2f(l1 - mm) + __builtin_amdgcn_exp2f(l2 - mm));
            const int orow = b * SEQ + (tt.n0 + q) * tt.d + tt.r, ocol = 256 + 64 * tt.head + 8 * hi;
#pragma unroll
            for (int k = 0; k < 4; ++k) { const u32x4 x = w[ii][k]; u32x4 y;
                y.x = cvtpk(__uint_as_float(x.x << 16) * a, __uint_as_float(x.x & 0xffff0000u) * a); y.y = cvtpk(__uint_as_float(x.y << 16) * a, __uint_as_float(x.y & 0xffff0000u) * a);
                y.z = cvtpk(__uint_as_float(x.z << 16) * a, __uint_as_float(x.z & 0xffff0000u) * a); y.w = cvtpk(__uint_as_float(x.w << 16) * a, __uint_as_float(x.w & 0xffff0000u) * a);
                *(u32x4*)((unsigned char*)MIX + pg8::img_off(orow, ocol + 32 * (k >> 1) + 16 * (k & 1), D / 64, false)) = y; } } }
    __syncthreads();
}
__device__ __forceinline__ void c_unit(const char* ZC, bf16* MIX, const float* sink, int u, LAS char* lds, int wave, int lane) {
    const int b = u >> 6, kvh = (u >> 5) & 1, q0 = 256 * (u & 31), n0 = q0 + 32 * wave;
    const int q = lane & 31, hi = lane >> 5;
    const char* kt0 = ZC + ((size_t)((6 + kvh) * 4 + b) * 256 << 12); const char* vt0 = ZC + ((size_t)((8 + kvh) * 4 + b) * 256 << 12);
#pragma unroll
    for (int tt = 0; tt < 2; ++tt) { const int t = 2 * wave + tt, T = (q0 >> 5) - 4 + t;
        if (T >= 0 && T < SEQ / 32) { dma_tile(lds + t * 8192, kt0 + ((size_t)T << 12), lane); dma_tile(lds + t * 8192 + 4096, vt0 + ((size_t)T << 12), lane); } }
    const char* qt0 = ZC + (((size_t)((3 * kvh) * 4 + b) * 256 + (n0 >> 5)) << 12);
    bf16x8 qf[4]; load_tile_frags(qf, qt0, lane);
    asm volatile("s_waitcnt vmcnt(0)" ::: "memory");
    __syncthreads();
    const LAS char* kbase = lds + lane * 16;
    const LAS char* vbase = lds + 4096 + (4 * hi + ((lane & 15) >> 2)) * 64 + ((lane >> 4) & 1) * 32 + (lane & 3) * 8;
#pragma unroll 1
    for (int hh = 0; hh < 3; ++hh) { const int head = 3 * kvh + hh;
        const char* qnext = hh < 2 ? qt0 + ((size_t)(hh + 1) * 4 * 256 << 12) : nullptr; bool reloaded = false;
        f32x16 o[2]; o[0] = zero16_(); o[1] = zero16_();
        float m = sink[head] * LOG2E, l = hi ? 0.f : 1.0f; const float slope2 = alibi_slope(head) * LOG2E;
        {
            const int t = wave + 4; bf16x8 kf[4];
#pragma unroll
            for (int s = 0; s < 4; ++s) kf[s] = *(const LAS bf16x8*)(kbase + t * 8192 + s * 1024);
            bf16x8 vf[2][2]; load_vfrags(vf, vbase + t * 8192);
            step<0, false, true>(o, m, l, kf, qf, vf, (float)(q - 4 * hi), slope2, slope2, 128.0f); }
#pragma unroll 1
        for (int k = 1; k <= 4; ++k) { const int tL = wave + 4 - k, tR = wave + 4 + k; const bool vL = n0 - 32 * k >= 0, vR = n0 + 32 * k < SEQ;
            const float relfL = (float)(q + 32 * k - 4 * hi), relfR = (float)(q - 32 * k - 4 * hi);
            if (vL && vR) {
                if (k < 4) step_pair_lds<1>(o, m, l, kbase + tL * 8192, kbase + tR * 8192, vbase + tL * 8192, vbase + tR * 8192, qf, relfL, relfR, slope2, 128.0f);
                else { step_pair_lds<2>(o, m, l, kbase + tL * 8192, kbase + tR * 8192, vbase + tL * 8192, vbase + tR * 8192, qf, relfL, relfR, slope2, 128.0f, qnext, lane); reloaded = true; } }
            else if (vL || vR) { const int t = vL ? tL : tR; bf16x8 kf[4];
#pragma unroll
                for (int s = 0; s < 4; ++s) kf[s] = *(const LAS bf16x8*)(kbase + t * 8192 + s * 1024);
                bf16x8 vf[2][2]; load_vfrags(vf, vbase + t * 8192);
                const float relf = vL ? relfL : relfR, sl = vL ? slope2 : -slope2;
                if (k < 4) step<1, false, true>(o, m, l, kf, qf, vf, relf, sl, slope2, 128.0f); else step<2, false, true>(o, m, l, kf, qf, vf, relf, sl, slope2, 128.0f); } }
        if (!reloaded && qnext) load_tile_frags(qf, qnext, lane);
        store_o(MIX, b * SEQ + n0 + q, 640 + 64 * head, o, 1.0f / hswap_sum(l), hi); }
    __syncthreads();
}
template <int G>
__device__ __forceinline__ void pool_group(const LAS char* rows, bf16* MIX, const bf16* wpt, const float* pscale, int row0, int tok, int kq, int lane) {
    constexpr int R = 1 << G, W = 2 * R + 1;
    int lo = tok - R, hi2 = tok + R + 1; lo = lo < 0 ? 0 : lo; hi2 = hi2 > SEQ ? SEQ : hi2; const float inv = 1.0f / (float)(hi2 - lo);
    f32x4 acc[4];
#pragma unroll
    for (int dt = 0; dt < 4; ++dt) acc[dt] = zero4_();
#pragma unroll
    for (int kb = 0; kb < 2; ++kb) { float s[8]; bf16x8 uc;
        const LAS char* rp = rows + ((lane & 15) + 8 - R) * POOL_PITCH + (8 * G + 4 * kb + kq) * 16;
#pragma unroll
        for (int e = 0; e < 8; ++e) s[e] = 0.f;
#pragma unroll
        for (int j = 0; j < W; ++j) { const int tt = tok + j - R; const float w = (tt >= 0 && tt < SEQ) ? 1.0f : 0.0f; const bf16x8 v = *(const LAS bf16x8*)(rp + j * POOL_PITCH); if (j == R) uc = v;
#pragma unroll
            for (int e = 0; e < 8; ++e) s[e] += w * bf2f((unsigned short)v[e]); }
        u32x4 pw; float pe[8];
#pragma unroll
        for (int e = 0; e < 8; ++e) pe[e] = s[e] * inv - bf2f((unsigned short)uc[e]);
        pw.x = cvtpk(pe[0], pe[1]); pw.y = cvtpk(pe[2], pe[3]); pw.z = cvtpk(pe[4], pe[5]); pw.w = cvtpk(pe[6], pe[7]);
        const bf16x8 bfrag = __builtin_bit_cast(bf16x8, pw);
#pragma unroll
        for (int dt = 0; dt < 4; ++dt) { const bf16x8 afrag = *(const bf16x8*)(wpt + (size_t)(G * 64 + dt * 16 + (lane & 15)) * 64 + kb * 32 + 8 * kq);
            acc[dt] = __builtin_amdgcn_mfma_f32_16x16x32_bf16(afrag, bfrag, acc[dt], 0, 0, 0); } }
#pragma unroll
    for (int dt = 0; dt < 4; ++dt) { const int dcol = G * 64 + dt * 16 + 4 * kq; const f32x4 sc = *(const f32x4*)(pscale + dcol);
        u32x2 w; w.x = cvtpk(acc[dt][0] * sc.x, acc[dt][1] * sc.y); w.y = cvtpk(acc[dt][2] * sc.z, acc[dt][3] * sc.w);
        *(u32x2*)((unsigned char*)MIX + pg8::img_off(row0 + (lane & 15), dcol & ~7, D / 64, false) + 2 * (dcol & 7)) = w; }
}
__device__ __forceinline__ void pool_item(const bf16* Z, bf16* MIX, const bf16* wpt, const float* pscale, int item, LAS char* rows, int lane) {
    const int row0 = 16 * item, b = row0 / SEQ, t0 = row0 % SEQ;
    const int tok = t0 + (lane & 15), kq = lane >> 4;
    const bf16* zb = Z + (size_t)b * SEQ * 256;
    u32x4 st[16];
#pragma unroll
    for (int i = 0; i < 16; ++i) { const int idx = i * 64 + lane, r = idx >> 5, c = idx & 31; int tt = t0 - 8 + r; tt = (tt >= 0 && tt < SEQ) ? tt : t0; st[i] = *(const u32x4*)(zb + (size_t)tt * 256 + 8 * c); }
#pragma unroll
    for (int i = 0; i < 16; ++i) { const int idx = i * 64 + lane, r = idx >> 5, c = idx & 31; *(LAS u32x4*)(rows + r * POOL_PITCH + c * 16) = st[i]; }
    pool_group<0>(rows, MIX, wpt, pscale, row0, tok, kq, lane); pool_group<1>(rows, MIX, wpt, pscale, row0, tok, kq, lane);
    pool_group<2>(rows, MIX, wpt, pscale, row0, tok, kq, lane); pool_group<3>(rows, MIX, wpt, pscale, row0, tok, kq, lane);
}
constexpr int N_B_UNITS = 128, N_C_UNITS = 256, N_P_ITEMS = M / 16;
}

__device__ __forceinline__ void p_mixers(Frame& F, const float* const* in, unsigned char* ws, int lq, int sel  ) {
    const int l = lq & 1;
    const bf16* Z = (const bf16*)(ws + WS_Z); bf16* MIX = (bf16*)(ws + WS_MIX);
    LAS char* lds = (LAS char*)F.lds;
    const float* sink = in[9] + 6 * l;
    {
        const int nb = (F.G >= 2 * mx::N_B_UNITS) ? mx::N_B_UNITS : (F.G + 1) / 2;
        const bool xl = (F.G == 256);
        if ((int)blockIdx.x < nb) {
            if (sel & 1) {
#pragma unroll 1
                for (int u0 = blockIdx.x; u0 < mx::N_B_UNITS; u0 += nb) { const int u = xl ? ((u0 & 7) >> 1) * 32 + (u0 >> 3) * 2 + (u0 & 1) : u0;     unsigned z_; asm volatile("v_mov_b32 %0, 0" : "=v"(z_)); const int lane = (int)__builtin_amdgcn_mbcnt_hi(~0u, __builtin_amdgcn_mbcnt_lo(~0u, z_)); mx::b_unit((const char*)(ws + WS_ZB), MIX, (char*)(ws + WS_BSCR), u, lds, F.wave, lane); } }
        } else if (sel & 2) {
#pragma unroll 1
            for (int v = (int)blockIdx.x - nb, u0 = v, k = 0; u0 < mx::N_C_UNITS; u0 += F.G - nb, ++k) { const int u = xl ? (v & 7) * 32 + (v >> 3) * 2 + k : u0;     unsigned z_; asm volatile("v_mov_b32 %0, 0" : "=v"(z_)); const int lane = (int)__builtin_amdgcn_mbcnt_hi(~0u, __builtin_amdgcn_mbcnt_lo(~0u, z_)); mx::c_unit((const char*)(ws + WS_ZC), MIX, sink, u, lds, F.wave, lane); }
        }
        __syncthreads();
    }
    if (sel & 4) { const bf16* wpt = (const bf16*)(ws + WS_W + (size_t)l * W_LAYER + W_PT); const float* pscale = in[8] + 256 * l;
        for (int it = blockIdx.x * NWAVES + F.wave; it < mx::N_P_ITEMS; it += F.G * NWAVES) mx::pool_item(Z, MIX, wpt, pscale, it, lds + F.wave * (32 * mx::POOL_PITCH), F.lane); }
}

struct Args { const float* in[15]; float* out; unsigned char* ws; int ph_lo, ph_hi, li, dup; };
__global__ void __launch_bounds__(NWAVES * 64, 2) mk_fwd(Args args) {
    extern __shared__ __attribute__((aligned(16))) unsigned char lds[];
    Frame F;
    F.lds = (LAS unsigned char*)lds;
    F.MISC = (volatile LAS unsigned*)(F.lds + MISC_OFF);
    F.tid = threadIdx.x; F.lane = F.tid & 63; F.wave = __builtin_amdgcn_readfirstlane(F.tid >> 6);
    const int wave0 = F.wave;
    F.G = gridDim.x; { const int bx = blockIdx.x; F.vcu = (F.G % 8 == 0) ? (bx % 8) * (F.G / 8) + bx / 8 : bx; }
    unsigned char* ws = args.ws;
    F.ctl = (gu32*)(ws + WS_CTL);
    for (int u = F.tid; u < (LDS_BYTES - LDSCTL_OFF) / 4; u += NWAVES * 64) ((LAS unsigned*)(F.lds + LDSCTL_OFF))[u] = 0u;
    __syncthreads();
    XcdBarrier bar; bar.bar = (unsigned*)(F.ctl + CW_BAR) + args.li * XCD_BAR_WORDS; bar.x = 0; bar.st = nullptr;
    const int lo = args.ph_lo, hi = args.ph_hi;
    if (hi - lo > 1) { bar = xcd_barrier_post((unsigned*)(F.ctl + CW_BAR) + args.li * XCD_BAR_WORDS, F.MISC + 8);
        if (F.tid == 0) { const unsigned v = bar.x + 1u; unsigned exp = 0u;
            if (!__hip_atomic_compare_exchange_strong((unsigned*)(F.ctl + CW_GRP) + (blockIdx.x & 7), &exp, v, __ATOMIC_RELAXED, __ATOMIC_RELAXED, __HIP_MEMORY_SCOPE_AGENT) && exp != v) __hip_atomic_fetch_or((unsigned*)(F.ctl + CW_GRPBAD), 1u, RLX_AGENT); } }
    const float* const* in = args.in;
    bf16* XS = (bf16*)(ws + WS_XS);
    bf16* H = (bf16*)(ws + WS_H);
    const float* MOD = (const float*)(ws + WS_MOD);
    float* SSQ = (float*)(ws + WS_SUMSQ);
    const float* GV = (const float*)(ws + WS_GV);

    const int dup = args.dup & 1, msel = ((args.dup >> 1) & 15) ? ((args.dup >> 1) & 15) : 7;
#pragma unroll 1
    for (int ph = lo; ph < hi; ++ph) {
        { unsigned z_; asm volatile("v_mov_b32 %0, 0" : "=v"(z_)); const int t_ = wave0 * 64 + (int)__builtin_amdgcn_mbcnt_hi(~0u, __builtin_amdgcn_mbcnt_lo(~0u, z_)); F.tid = t_; F.lane = t_ & 63; F.wave = wave0; }
        if (ph == PH_PRO) p_prologue(F, in, ws);
        else if (ph == PH_CONV) p_conv(F, in, ws);
        else if (ph == PH_FINAL) p_norm_final(F, XS, SSQ + (size_t)4 * M, args.out, in[14]);
        else {
            const int l = (ph - PH_L0) / PH_PER_LAYER, k = (ph - PH_L0) % PH_PER_LAYER;
            unsigned char* wl = ws + WS_W + (size_t)l * W_LAYER;
            const float* modl = MOD + (size_t)l * BATCH * NMOD * D;
            const float* biasl = (const float*)(ws + WS_BIAS + (size_t)l * BIAS_LAYER);
            if (k == 0) { pg8::Gemm g{H, (const bf16*)(wl + W_IN), M, INW, D}; pg8::StaticOrder S; S.init(M, INW, F.G, (int)blockIdx.x);
                pg8::EpiBf16Norm E{(bf16*)(ws + WS_Z), 256, SSQ + (size_t)(2 * l) * M, biasl, INW, ws + WS_ZB, ws + WS_ZC};
                pg8::gemm_phase<pg8::EpiBf16Norm, pg8::StaticOrder, true, true>(F.lds + RING_OFF, g, S, E, F.tid); }
            else if (k == 1) p_mixers(F, in, ws, l + 2 * dup, msel);
            else if (k == 2 && l == 0 && !dup) {
                pg8::Gemm g{(const bf16*)(ws + WS_MIX), (const bf16*)(wl + W_OUT), M, D, D}; pg8::StaticOrder S; S.init(M, D, F.G, (int)blockIdx.x);
                pg8::EpiGateResNormT<true> E{(const bf16*)in[0], XS, modl + 2 * D, NMOD * D, H, GV + (size_t)1 * BATCH * D, D, SSQ + (size_t)1 * M, D};
                pg8::gemm_phase<pg8::EpiGateResNormT<true>, pg8::StaticOrder, true, true>(F.lds + RING_OFF, g, S, E, F.tid); }
            else if (k == 2 || k == 4) { const bool dn = (k == 4); const bool last = dn && (l == DEPTH - 1);
                pg8::Gemm g{(const bf16*)(ws + (dn ? WS_HID : WS_MIX)), (const bf16*)(wl + (dn ? W_DN : W_OUT)), M, D, dn ? DFF : D}; pg8::StaticOrder S; S.init(M, D, F.G, (int)blockIdx.x);
                pg8::EpiGateResNorm E{XS, XS, dup ? (const float*)(F.ctl + CW_ZEROS) : modl + (dn ? 5 : 2) * D, dup ? 0 : NMOD * D,
                    (last || dup) ? (bf16*)nullptr : H, GV + (size_t)((dn ? 2 * (l + 1) : 2 * l + 1) % (2 * DEPTH)) * BATCH * D, D, SSQ + (size_t)(dup ? 5 : 2 * l + (dn ? 2 : 1)) * M, D};
                pg8::gemm_phase<pg8::EpiGateResNorm, pg8::StaticOrder, true, true>(F.lds + RING_OFF, g, S, E, F.tid); }
            else { pg8::Gemm g{H, (const bf16*)(wl + W_GU), M, 2 * DFF, D}; pg8::StaticOrder S; S.init(M, 2 * DFF, F.G, (int)blockIdx.x);
                pg8::EpiSwiGLUNorm E{(bf16*)(ws + WS_HID), DFF, SSQ + (size_t)(2 * l + 1) * M, biasl + BATCH * INW, 2 * DFF};
                pg8::gemm_phase<pg8::EpiSwiGLUNorm, pg8::StaticOrder, true, true>(F.lds + RING_OFF, g, S, E, F.tid); }
        }
        if (ph + 1 < hi) { const int kk = (ph >= PH_L0 && ph < PH_FINAL) ? (ph - PH_L0) % PH_PER_LAYER : -1;
            xcd_barrier(bar, F.MISC[17] != 0u && (kk == 2 || kk == 3));
            if (ph == PH_PRO && lo == 0) { if (F.tid == 0) F.MISC[17] = (F.G == 256 && xb_ld((unsigned*)(F.ctl + CW_GRPBAD)) == 0u) ? 1u : 0u; __syncthreads(); } }
    }
}

extern "C" void kernel_launch(void* const* d_in, const int* in_sizes, int n_in, void* d_out, int out_size, void* d_ws, size_t ws_size, hipStream_t stream) {
    static int grid = 0;
    if (grid == 0) {
        if (n_in != 15 || in_sizes[0] != M * D || out_size != M * D || ws_size < WS_END) { fprintf(stderr, "kernel_launch: unexpected shapes (n_in %d, in0 %d, out %d, ws %zu); nothing launched\n", n_in, n_in > 0 ? in_sizes[0] : -1, out_size, ws_size); grid = -1; return; }
        int dev = 0, cus = 0, per_cu = 0;
        if (hipGetDevice(&dev) != hipSuccess || hipDeviceGetAttribute(&cus, hipDeviceAttributeMultiprocessorCount, dev) != hipSuccess) { grid = -1; return; }
        if (hipFuncSetAttribute((const void*)mk_fwd, hipFuncAttributeMaxDynamicSharedMemorySize, LDS_BYTES) != hipSuccess) { fprintf(stderr, "kernel_launch: hipFuncSetAttribute failed\n"); grid = -1; return; }
        if (hipOccupancyMaxActiveBlocksPerMultiprocessor(&per_cu, (const void*)mk_fwd, NWAVES * 64, LDS_BYTES) != hipSuccess || per_cu < 1) fprintf(stderr, "kernel_launch: occupancy query reports %d blocks per CU\n", per_cu);
        (void)hipGetLastError();
        grid = cus;
        if (grid != 256) fprintf(stderr, "kernel_launch: %d CUs; this kernel is laid out for 256\n", grid);
    }
    if (grid < 0) return;
    if (hipMemsetAsync((char*)d_ws + WS_CTL, 0, CTL_ZERO_BYTES, stream) != hipSuccess) return;
    Args a{};
    for (int i = 0; i < 15; ++i) a.in[i] = (const float*)d_in[i];
    a.out = (float*)d_out; a.ws = (unsigned char*)d_ws;
#if PROBE_DUP == 0 && PROBE_CUT == 0
    a.ph_lo = 0; a.ph_hi = NPHASES; a.li = 0; a.dup = 0;
    hipLaunchKernelGGL(mk_fwd, dim3(grid), dim3(NWAVES * 64), LDS_BYTES, stream, a);
#else
    { int lo = 0, li = 0;
      for (int ph = 0; ph < NPHASES; ++ph) { const bool cut = ((PROBE_CUT | PROBE_DUP) >> ph) & 1;
        if (cut || ph == NPHASES - 1) { a.ph_lo = lo; a.ph_hi = ph + 1; a.li = (ph + 1 - lo > 1) ? li++ : 0; a.dup = 0; hipLaunchKernelGGL(mk_fwd, dim3(grid), dim3(NWAVES * 64), LDS_BYTES, stream, a);
            if ((PROBE_DUP >> ph) & 1) { a.ph_lo = ph; a.ph_hi = ph + 1; a.li = 0; a.dup = 1 | (PROBE_MIXSEL << 1) | (PROBE_NOSTORE << 4); hipLaunchKernelGGL(mk_fwd, dim3(grid), dim3(NWAVES * 64), LDS_BYTES, stream, a); }
            lo = ph + 1; } } }
#endif
}
```

```cpp
#include <hip/hip_runtime.h>
#include <cstdio>
#include <cstdint>
namespace pg8 {
#define PG8_LAS __attribute__((address_space(3)))
typedef unsigned short bf16_t;
typedef short bf16x8 __attribute__((ext_vector_type(8)));
typedef float f32x4 __attribute__((ext_vector_type(4)));
typedef unsigned u32x4 __attribute__((ext_vector_type(4)));
constexpr int BM = 256, BK = 64, HALF = 128, HTB = HALF * BK * 2  , STAGE_BYTES = 8 * HTB, NXCD = 8, WGM = 8;

__host__ __device__ __forceinline__ int lds_byte(int r, int c) { const int st = (r >> 4) * 2 + (c >> 5), rr = r & 15, cc = c & 31, ob = rr * 64 + cc * 2; return st * 1024 + (ob ^ (((ob >> 9) & 1) << 5)); }
__host__ __device__ __forceinline__ void stage_rc(int b, int& R, int& C) { const int st = b / 1024, sb = b % 1024, swz = sb ^ (((sb >> 9) & 1) << 5); R = (st >> 1) * 16 + swz / 64; C = (st & 1) * 32 + (swz % 64) / 2; }
__host__ __device__ __forceinline__ int perm32(int rho) { const int n = rho >> 4, i = rho & 15; return 8 * (i >> 2) + 4 * n + (i & 3); }

__host__ __device__ __forceinline__ int perm32inv(int x) { return 16 * ((x >> 2) & 1) + 4 * (x >> 3) + (x & 3); }
__host__ __device__ __forceinline__ size_t img_off(int row, int col, int nt, bool wrow) { const int r = row & 127, rr = wrow ? (r & ~31) + perm32inv(r & 31) : r; return ((size_t)((row >> 7) * nt + (col >> 6)) << 14) + (size_t)lds_byte(rr, col & 63); }
constexpr bool IMG_A = true, IMG_B = true;
struct Unit { int pm, pn; };
struct Gemm { const bf16_t* A; const bf16_t* Bt; int M, N, K; };

struct StaticOrder {
    int nM, nN, nwg, G, c;
    __host__ __device__ void init(int M, int N, int G_, int c_) { nM = M / BM; nN = N / BM; nwg = nM * nN; G = G_; c = c_; }
    __host__ __device__ bool next(int i, Unit& u) const {
        const long L = (long)i * G + c; if (L >= nwg) return false;
        int wgid = (int)L; { const int q = nwg / NXCD, r = nwg % NXCD, xcd = wgid % NXCD, off = wgid / NXCD; wgid = (xcd < r ? xcd * (q + 1) : r * (q + 1) + (xcd - r) * q) + off; }
        const int nig = WGM * nN, gid = wgid / nig, fm = gid * WGM, gsz = (nM - fm) < WGM ? (nM - fm) : WGM;
        u.pm = fm + ((wgid % nig) % gsz); u.pn = (wgid % nig) / gsz; return true;
    }
    __device__ __forceinline__ void a_ready(const Unit&) const {}
    __device__ __forceinline__ void done(const Unit&) const {}
};

__device__ __forceinline__ unsigned cvt_pk_bf16(float lo, float hi) { unsigned r; asm volatile("v_cvt_pk_bf16_f32 %0, %1, %2" : "=v"(r) : "v"(lo), "v"(hi)); return r; }
constexpr float RMS_EPS_ = 1e-6f, INV_D_ = 1.0f / 1024.0f;
__device__ __forceinline__ void aux_dma(const float* src_lane, PG8_LAS unsigned char* dst_wave) { __builtin_amdgcn_global_load_lds((const unsigned*)src_lane, (PG8_LAS unsigned*)dst_wave, 4, 0, 0); }
typedef _Float16 h16x2 __attribute__((ext_vector_type(2)));
__device__ __forceinline__ unsigned pk_h2(float lo, float hi) { const h16x2 h = {(_Float16)lo, (_Float16)hi}; return __builtin_bit_cast(unsigned, h); }
__device__ __forceinline__ float h_lo(unsigned w) { return (float)__builtin_bit_cast(h16x2, w)[0]; }
__device__ __forceinline__ float h_hi(unsigned w) { return (float)__builtin_bit_cast(h16x2, w)[1]; }
struct EpiBf16Norm {
    static constexpr bool PERM = true, AFTER_DRAIN = false;
    bf16_t* O; int ldc; const float* sumsq; const float* bias; int bias_stride; unsigned char* zb; unsigned char* zc;
    __device__ __forceinline__ void prefetch(const Unit& u, PG8_LAS unsigned char* aux, int wid, int lane) const {
        if (wid < 4) aux_dma(sumsq + u.pm * BM + wid * 64 + lane, aux + wid * 256);
        else aux_dma(bias + (size_t)(u.pm >> 5) * bias_stride + u.pn * BM + (wid - 4) * 64 + lane, aux + 1024 + (wid - 4) * 256);
    }
    __device__ __forceinline__ void operator()(const f32x4 (&acc)[2][2][4][2], const Unit& u, int wr, int wc, int fr_, int fq_, PG8_LAS unsigned char* aux) const {
        unsigned z_; asm volatile("v_mov_b32 %0, 0" : "=v"(z_)); const int ln_ = (int)__builtin_amdgcn_mbcnt_hi(~0u, __builtin_amdgcn_mbcnt_lo(~0u, z_)); const int fr = ln_ & 15, fq = ln_ >> 4;
        const int row0 = u.pm * BM + wr * 64 + fr, col0 = u.pn * BM + wc * 32 + 8 * fq;
        const PG8_LAS float* ass = (const PG8_LAS float*)aux + wr * 64 + fr; const PG8_LAS float* ab = (const PG8_LAS float*)(aux + 1024) + wc * 32 + 8 * fq;
        f32x4 bv[2][2];
#pragma unroll
        for (int bj = 0; bj < 2; ++bj)
#pragma unroll
            for (int n = 0; n < 2; ++n) bv[bj][n] = *(const PG8_LAS f32x4*)(ab + bj * HALF + 4 * n);
#pragma unroll
        for (int ai = 0; ai < 2; ++ai)
#pragma unroll
            for (int m = 0; m < 4; ++m) { const int row = row0 + ai * HALF + m * 16; const float rs = __builtin_amdgcn_rsqf(ass[ai * HALF + m * 16] * INV_D_ + RMS_EPS_);
#pragma unroll
                for (int bj = 0; bj < 2; ++bj) { const f32x4 v0 = acc[ai][bj][m][0] * rs + bv[bj][0], v1 = acc[ai][bj][m][1] * rs + bv[bj][1];
                    u32x4 w; w.x = cvt_pk_bf16(v0[0], v0[1]); w.y = cvt_pk_bf16(v0[2], v0[3]); w.z = cvt_pk_bf16(v1[0], v1[1]); w.w = cvt_pk_bf16(v1[2], v1[3]);
                    const int cb = 2 * u.pn + bj;
                    if (zb != nullptr && cb >= 2 && cb <= 10) { const int t3 = (cb - 2) / 3, g = (cb - 2) % 3, lg = 2 * g, hd = 2 * g + (wc >> 1), c = (wc & 1) * 4 + fq;
                        const int t = row & 8191, b = row >> 13, r = t & ((1 << lg) - 1), n = t >> lg, ti = (r << (8 - lg)) + (n >> 5), key = n & 31;
                        const int off = t3 < 2 ? (c >> 1) * 1024 + (key + 32 * (c & 1)) * 16 : (c >> 2) * 2048 + (key >> 4) * 1024 + (key & 15) * 64 + (c & 3) * 16;
                        *(u32x4*)(zb + ((size_t)(((t3 * 6 + hd) * 4 + b) * 256 + ti) << 12) + off) = w; }
                    else if (zb != nullptr && cb >= 11) {
                        const int hx = cb <= 13 ? 2 * (cb - 11) + (wc >> 1) : (cb == 14 ? 6 : 8) + (wc >> 1), c = (wc & 1) * 4 + fq, t = row & 8191, b = row >> 13, key = t & 31;
                        const int off = cb < 15 ? (c >> 1) * 1024 + (key + 32 * (c & 1)) * 16 : (c >> 2) * 2048 + (key >> 4) * 1024 + (key & 15) * 64 + (c & 3) * 16;
                        *(u32x4*)(zc + ((size_t)((hx * 4 + b) * 256 + (t >> 5)) << 12) + off) = w; }
                    else *(u32x4*)(O + (size_t)row * ldc + col0 + bj * HALF) = w; } }
    }
};
struct EpiSwiGLUNorm {
    static constexpr bool PERM = true, AFTER_DRAIN = false;
    bf16_t* O; int ldc; const float* sumsq; const float* bias; int bias_stride;
    static __device__ __forceinline__ float silu_mul(float g, float u) { return g * u * __builtin_amdgcn_rcpf(1.0f + __builtin_amdgcn_exp2f(-1.4426950408889634f * g)); }
    __device__ __forceinline__ void prefetch(const Unit& u, PG8_LAS unsigned char* aux, int wid, int lane) const {
        if (wid < 4) aux_dma(sumsq + u.pm * BM + wid * 64 + lane, aux + wid * 256);
        else aux_dma(bias + (size_t)(u.pm >> 5) * bias_stride + u.pn * BM + (wid - 4) * 64 + lane, aux + 1024 + (wid - 4) * 256);
    }
    __device__ __forceinline__ void operator()(const f32x4 (&acc)[2][2][4][2], const Unit& u, int wr, int wc, int fr_, int fq_, PG8_LAS unsigned char* aux) const {
        unsigned z_; asm volatile("v_mov_b32 %0, 0" : "=v"(z_)); const int ln_ = (int)__builtin_amdgcn_mbcnt_hi(~0u, __builtin_amdgcn_mbcnt_lo(~0u, z_)); const int fr = ln_ & 15, fq = ln_ >> 4;
        const int row0 = u.pm * BM + wr * 64 + fr, col0 = u.pn * HALF + wc * 32 + 8 * fq;
        const PG8_LAS float* ass = (const PG8_LAS float*)aux + wr * 64 + fr; const PG8_LAS float* ab = (const PG8_LAS float*)(aux + 1024) + wc * 32 + 8 * fq;
        const f32x4 bg0 = *(const PG8_LAS f32x4*)(ab), bg1 = *(const PG8_LAS f32x4*)(ab + 4), bu0 = *(const PG8_LAS f32x4*)(ab + HALF), bu1 = *(const PG8_LAS f32x4*)(ab + HALF + 4);
#pragma unroll
        for (int ai = 0; ai < 2; ++ai)
#pragma unroll
            for (int m = 0; m < 4; ++m) { const int row = row0 + ai * HALF + m * 16; const float rs = __builtin_amdgcn_rsqf(ass[ai * HALF + m * 16] * INV_D_ + RMS_EPS_);
                unsigned char* rowp = (unsigned char*)O + img_off(row, col0, ldc / 64, false);
                const f32x4 g0 = acc[ai][0][m][0] * rs + bg0, g1 = acc[ai][0][m][1] * rs + bg1, u0 = acc[ai][1][m][0] * rs + bu0, u1 = acc[ai][1][m][1] * rs + bu1;
                f32x4 e0 = g0 * -1.4426950408889634f, e1 = g1 * -1.4426950408889634f;
#pragma unroll
                for (int i = 0; i < 4; ++i) { e0[i] = __builtin_amdgcn_exp2f(e0[i]); e1[i] = __builtin_amdgcn_exp2f(e1[i]); }
                e0 = e0 + 1.0f; e1 = e1 + 1.0f;
#pragma unroll
                for (int i = 0; i < 4; ++i) { e0[i] = __builtin_amdgcn_rcpf(e0[i]); e1[i] = __builtin_amdgcn_rcpf(e1[i]); }
                const f32x4 h0 = (g0 * u0) * e0, h1 = (g1 * u1) * e1;
                u32x4 w; w.x = cvt_pk_bf16(h0[0], h0[1]); w.y = cvt_pk_bf16(h0[2], h0[3]); w.z = cvt_pk_bf16(h1[0], h1[1]); w.w = cvt_pk_bf16(h1[2], h1[3]);
                *(u32x4*)rowp = w; }
    }
};
template <bool F32BASE>
struct EpiGateResNormT {
    static constexpr bool PERM = true, AFTER_DRAIN = false;
    const bf16_t* base; bf16_t* out; const float* gate; int gate_stride; bf16_t* Hn; const float* gn; int gn_stride; float* sumsq; int ldc;
    __device__ __forceinline__ void prefetch(const Unit& u, PG8_LAS unsigned char* aux, int wid, int lane) const {
        if (wid < 4) aux_dma(gate + (size_t)(u.pm >> 5) * gate_stride + u.pn * BM + wid * 64 + lane, aux + wid * 256);
        else aux_dma(gn + (size_t)(u.pm >> 5) * gn_stride + u.pn * BM + (wid - 4) * 64 + lane, aux + 1024 + (wid - 4) * 256);
    }
    __device__ __forceinline__ void operator()(const f32x4 (&acc)[2][2][4][2], const Unit& u, int wr, int wc, int fr_, int fq_, PG8_LAS unsigned char* aux) const {
        unsigned z_; asm volatile("v_mov_b32 %0, 0" : "=v"(z_)); const int ln_ = (int)__builtin_amdgcn_mbcnt_hi(~0u, __builtin_amdgcn_mbcnt_lo(~0u, z_)); const int fr = ln_ & 15, fq = ln_ >> 4;
        const int row0 = u.pm * BM + wr * 64 + fr, col0 = u.pn * BM + wc * 32 + 8 * fq;
        const PG8_LAS float* ag = (const PG8_LAS float*)aux + wc * 32 + 8 * fq; const PG8_LAS float* an = (const PG8_LAS float*)(aux + 1024) + wc * 32 + 8 * fq;
#pragma unroll
        for (int am = 0; am < 4; ++am) {
            u32x4 ld[2][2]; f32x4 lf[2][2][2];
#pragma unroll
            for (int mm = 0; mm < 2; ++mm)
#pragma unroll
                for (int bj = 0; bj < 2; ++bj) {
                    if constexpr (F32BASE) { const f32x4* px = (const f32x4*)((const float*)base + (size_t)(row0 + (am >> 1) * HALF + (2 * (am & 1) + mm) * 16) * ldc + col0 + bj * HALF); lf[mm][bj][0] = px[0]; lf[mm][bj][1] = px[1]; }
                    else ld[mm][bj] = *(const u32x4*)((const unsigned char*)base + img_off(row0 + (am >> 1) * HALF + (2 * (am & 1) + mm) * 16, col0 + bj * HALF, ldc / 64, false)); }
#pragma unroll
            for (int mm = 0; mm < 2; ++mm) { const int ai = am >> 1, m = 2 * (am & 1) + mm; const int row = row0 + ai * HALF + m * 16; const size_t off = (size_t)row * ldc + col0; float ss = 0.f;
#pragma unroll
                for (int bj = 0; bj < 2; ++bj) {
                    const f32x4 g0 = *(const PG8_LAS f32x4*)(ag + bj * HALF), g1 = *(const PG8_LAS f32x4*)(ag + bj * HALF + 4);
                    f32x4 b0, b1;
                    if constexpr (F32BASE) { b0 = lf[mm][bj][0]; b1 = lf[mm][bj][1]; }
                    else { const u32x4 bw = ld[mm][bj]; b0 = (f32x4){h_lo(bw.x), h_hi(bw.x), h_lo(bw.y), h_hi(bw.y)}; b1 = (f32x4){h_lo(bw.z), h_hi(bw.z), h_lo(bw.w), h_hi(bw.w)}; }
                    const f32x4 x0 = b0 + g0 * acc[ai][bj][m][0], x1 = b1 + g1 * acc[ai][bj][m][1];
                    u32x4 w; w.x = pk_h2(x0[0], x0[1]); w.y = pk_h2(x0[2], x0[3]); w.z = pk_h2(x1[0], x1[1]); w.w = pk_h2(x1[2], x1[3]);
                    *(u32x4*)((unsigned char*)out + img_off(row, col0 + bj * HALF, ldc / 64, false)) = w;
                    ss += (x0[0] * x0[0] + x0[1] * x0[1]) + (x0[2] * x0[2] + x0[3] * x0[3]) + (x1[0] * x1[0] + x1[1] * x1[1]) + (x1[2] * x1[2] + x1[3] * x1[3]);
                    if (Hn) { const f32x4 n0 = *(const PG8_LAS f32x4*)(an + bj * HALF), n1 = *(const PG8_LAS f32x4*)(an + bj * HALF + 4); const f32x4 h0 = x0 * n0, h1 = x1 * n1;
                        u32x4 hw; hw.x = cvt_pk_bf16(h0[0], h0[1]); hw.y = cvt_pk_bf16(h0[2], h0[3]); hw.z = cvt_pk_bf16(h1[0], h1[1]); hw.w = cvt_pk_bf16(h1[2], h1[3]);
                        *(u32x4*)((unsigned char*)Hn + img_off(row, col0 + bj * HALF, ldc / 64, false)) = hw; } }
                ss += __shfl_xor(ss, 16); ss += __shfl_xor(ss, 32);
                if (fq == 0) atomicAdd(sumsq + row, ss); }
            asm volatile("" ::: "memory"); }
    }
};
typedef EpiGateResNormT<false> EpiGateResNorm;

template <class Epi, class Sched, bool ALIGN_EPI = false, bool SP2 = false>
__device__ __forceinline__ void gemm_phase(PG8_LAS unsigned char* lds, const Gemm g, const Sched& S, const Epi& E, int tid_in) {
    int tid_ = tid_in; asm volatile("" : "+v"(tid_));
    const int tid = tid_, wid = __builtin_amdgcn_readfirstlane(tid >> 6), lane = tid & 63, wr = wid >> 2, wc = wid & 3, fr = lane & 15, fq = lane >> 4;
    const int K = g.K, nt = K / BK;
    unsigned voffA[2], voffB[2];
#pragma unroll
    for (int i = 0; i < 2; ++i) { int R, C; stage_rc(tid * 16 + i * 8192, R, C); const int Rb = Epi::PERM ? ((R & ~31) + perm32(R & 31)) : R;
        voffA[i] = IMG_A ? (unsigned)(tid * 16 + i * 8192) : (unsigned)(R * K + C) * 2u; voffB[i] = IMG_B ? (unsigned)(tid * 16 + i * 8192) : (unsigned)(Rb * K + C) * 2u; }
    const size_t kstepA = IMG_A ? (size_t)(HALF * BK * 2) : (size_t)(BK * 2), kstepB = IMG_B ? (size_t)(HALF * BK * 2) : (size_t)(BK * 2);
    const size_t hstep = (size_t)HALF * K * 2;
    const size_t tstep = 2 * hstep;
    const unsigned ldsw = (unsigned)wid * 1024u;
    const int aoff = lds_byte(wr * 64 + fr, fq * 8), boff = lds_byte(wc * 32 + fr, fq * 8);
#define PG8_SA(b, h) (((b) * 2 + (h)) * HTB)
#define PG8_SB(b, h) ((4 + (b) * 2 + (h)) * HTB)
#define PG8_STAGE(bufoff, gbase, voff) do { _Pragma("unroll") for (int _i = 0; _i < 2; ++_i) \
        __builtin_amdgcn_global_load_lds((const unsigned*)((const char*)(gbase) + (voff)[_i]), (PG8_LAS unsigned*)(lds + (bufoff) + ldsw + _i * 8192), 16, 0, 0); } while (0)
#define PG8_LDA(dst, b, h) do { _Pragma("unroll") for (int m = 0; m < 4; ++m) _Pragma("unroll") for (int k = 0; k < 2; ++k) dst[m][k] = *(const PG8_LAS bf16x8*)(lds + PG8_SA(b, h) + aoff + m * 2048 + k * 1024); } while (0)
#define PG8_LDB(dst, b, h) do { _Pragma("unroll") for (int n = 0; n < 2; ++n) _Pragma("unroll") for (int k = 0; k < 2; ++k) dst[n][k] = *(const PG8_LAS bf16x8*)(lds + PG8_SB(b, h) + boff + n * 2048 + k * 1024); } while (0)
#define PG8_MMA(ai, bj, At, Bt) do { __builtin_amdgcn_s_setprio(1); _Pragma("unroll") for (int m = 0; m < 4; ++m) _Pragma("unroll") for (int n = 0; n < 2; ++n) _Pragma("unroll") for (int k = 0; k < 2; ++k) \
        acc[ai][bj][m][n] = __builtin_amdgcn_mfma_f32_16x16x32_bf16(Bt[n][k], At[m][k], acc[ai][bj][m][n], 0, 0, 0); __builtin_amdgcn_s_setprio(0); } while (0)
#define PG8_WAIT_V(n) asm volatile("s_waitcnt vmcnt(" #n ")" ::: "memory")
#define PG8_WAIT_L(n) asm volatile("s_waitcnt lgkmcnt(" #n ")" ::: "memory")
#define PG8_BAR __builtin_amdgcn_s_barrier()
#define PG8_SCHED __builtin_amdgcn_sched_barrier(0)
    Unit cur, nxt; int ui = 0;
    if (!S.next(0, cur)) return;
    f32x4 acc[2][2][4][2];
#pragma unroll
    for (int a = 0; a < 2; ++a)
#pragma unroll
        for (int b = 0; b < 2; ++b)
#pragma unroll
            for (int m = 0; m < 4; ++m)
#pragma unroll
                for (int n = 0; n < 2; ++n) { float z_; asm volatile("v_mov_b32 %0, 0" : "=v"(z_)); acc[a][b][m][n] = (f32x4){z_, z_, z_, z_}; }
    bf16x8 At[4][2], B0[2][2], B1[2][2];
    const char* cA = (const char*)g.A + (size_t)cur.pm * tstep; const char* cB = (const char*)g.Bt + (size_t)cur.pn * tstep;
    S.a_ready(cur);
    if constexpr (SP2) {
        PG8_STAGE(PG8_SB(0, 0), cB, voffB); PG8_STAGE(PG8_SB(0, 1), cB + hstep, voffB); PG8_STAGE(PG8_SA(0, 0), cA, voffA); PG8_STAGE(PG8_SA(0, 1), cA + hstep, voffA);
        if (wr == 1) PG8_BAR;
        PG8_WAIT_V(2); PG8_BAR;
        PG8_STAGE(PG8_SB(1, 0), cB + kstepB, voffB); PG8_STAGE(PG8_SA(1, 0), cA + kstepA, voffA); PG8_STAGE(PG8_SB(1, 1), cB + hstep + kstepB, voffB);
        PG8_WAIT_V(6); PG8_BAR;
    } else {
        PG8_STAGE(PG8_SB(0, 0), cB, voffB); PG8_STAGE(PG8_SA(0, 0), cA, voffA); PG8_STAGE(PG8_SB(0, 1), cB + hstep, voffB); PG8_STAGE(PG8_SA(0, 1), cA + hstep, voffA);
        if (wr == 1) PG8_BAR;
        PG8_WAIT_V(4); PG8_BAR;
        PG8_STAGE(PG8_SB(1, 0), cB + kstepB, voffB); PG8_STAGE(PG8_SA(1, 0), cA + kstepA, voffA); PG8_STAGE(PG8_SB(1, 1), cB + hstep + kstepB, voffB);
        PG8_WAIT_V(6); PG8_BAR;
    }
    for (;;) {
        const bool has_next = S.next(ui + 1, nxt);
        const char* nA = has_next ? (const char*)g.A + (size_t)nxt.pm * tstep : cA; const char* nB = has_next ? (const char*)g.Bt + (size_t)nxt.pn * tstep : cB;
        for (int t = 0; t < nt; t += 2) {
            const bool last = (t == nt - 2);
            const char* a1 = cA + (size_t)(t + 1) * kstepA;
            const char* a2 = last ? nA : cA + (size_t)(t + 2) * kstepA; const char* b2 = last ? nB : cB + (size_t)(t + 2) * kstepB;
            const char* a3 = a2 + kstepA; const char* b3 = b2 + kstepB;
            if (last && has_next) S.a_ready(nxt);
            if (last) E.prefetch(cur, lds + STAGE_BYTES + 1024, wid, lane);
            if constexpr (SP2) {
            PG8_LDB(B0, 0, 0); PG8_LDB(B1, 0, 1); PG8_SCHED; PG8_LDA(At, 0, 0); PG8_STAGE(PG8_SA(1, 1), a1 + hstep, voffA);
            PG8_WAIT_V(8); PG8_WAIT_L(0); PG8_BAR; PG8_MMA(0, 0, At, B0); PG8_MMA(0, 1, At, B1); PG8_BAR; PG8_SCHED;
            PG8_LDA(At, 0, 1); PG8_STAGE(PG8_SB(0, 0), b2, voffB); PG8_STAGE(PG8_SB(0, 1), b2 + hstep, voffB); PG8_STAGE(PG8_SA(0, 0), a2, voffA);
            PG8_WAIT_V(8); PG8_WAIT_L(0); PG8_BAR; PG8_MMA(1, 0, At, B0); PG8_MMA(1, 1, At, B1); PG8_BAR; PG8_SCHED;
            PG8_LDB(B0, 1, 0); PG8_LDB(B1, 1, 1); PG8_SCHED; PG8_LDA(At, 1, 0); PG8_STAGE(PG8_SA(0, 1), a2 + hstep, voffA);
            PG8_WAIT_V(8); PG8_WAIT_L(0); PG8_BAR; PG8_MMA(0, 0, At, B0); PG8_MMA(0, 1, At, B1); PG8_BAR; PG8_SCHED;
            PG8_LDA(At, 1, 1); PG8_STAGE(PG8_SB(1, 0), b3, voffB); PG8_STAGE(PG8_SB(1, 1), b3 + hstep, voffB); PG8_STAGE(PG8_SA(1, 0), a3, voffA);
            PG8_WAIT_V(8); PG8_WAIT_L(0); PG8_BAR; PG8_MMA(1, 0, At, B0); PG8_MMA(1, 1, At, B1); PG8_BAR; PG8_SCHED;
            } else {
            PG8_LDB(B0, 0, 0); PG8_SCHED; PG8_LDA(At, 0, 0); PG8_STAGE(PG8_SA(1, 1), a1 + hstep, voffA);
            PG8_WAIT_L(8); PG8_BAR; PG8_WAIT_L(0); PG8_MMA(0, 0, At, B0); PG8_BAR; PG8_SCHED;
            PG8_LDB(B1, 0, 1); PG8_STAGE(PG8_SB(0, 0), b2, voffB);
            PG8_BAR; PG8_WAIT_L(0); PG8_MMA(0, 1, At, B1); PG8_BAR;
            PG8_LDA(At, 0, 1); PG8_STAGE(PG8_SA(0, 0), a2, voffA);
            PG8_BAR; PG8_WAIT_L(0); PG8_MMA(1, 0, At, B0); PG8_BAR; PG8_SCHED;
            PG8_STAGE(PG8_SB(0, 1), b2 + hstep, voffB);
            PG8_WAIT_V(6); PG8_BAR; PG8_MMA(1, 1, At, B1); PG8_BAR;
            PG8_LDB(B0, 1, 0); PG8_SCHED; PG8_LDA(At, 1, 0); PG8_STAGE(PG8_SA(0, 1), a2 + hstep, voffA);
            PG8_WAIT_L(8); PG8_BAR; PG8_WAIT_L(0); PG8_MMA(0, 0, At, B0); PG8_BAR; PG8_SCHED;
            PG8_LDB(B1, 1, 1); PG8_STAGE(PG8_SB(1, 0), b3, voffB);
            PG8_BAR; PG8_WAIT_L(0); PG8_MMA(0, 1, At, B1); PG8_BAR;
            PG8_LDA(At, 1, 1); PG8_STAGE(PG8_SA(1, 0), a3, voffA);
            PG8_BAR; PG8_WAIT_L(0); PG8_MMA(1, 0, At, B0); PG8_BAR; PG8_SCHED;
            PG8_STAGE(PG8_SB(1, 1), b3 + hstep, voffB);
            PG8_WAIT_V(6); PG8_BAR; PG8_MMA(1, 1, At, B1); PG8_BAR;
            }
        }
        if constexpr (ALIGN_EPI) { if (wr == 0) PG8_BAR; }
        if constexpr (!Epi::AFTER_DRAIN) { E(acc, cur, wr, wc, fr, fq, lds + STAGE_BYTES + 1024); S.done(cur); }
        if (!has_next) break;
#pragma unroll
        for (int a = 0; a < 2; ++a)
#pragma unroll
            for (int b = 0; b < 2; ++b)
#pragma unroll
                for (int m = 0; m < 4; ++m)
#pragma unroll
                    for (int n = 0; n < 2; ++n) { float z_; asm volatile("v_mov_b32 %0, 0" : "=v"(z_)); acc[a][b][m][n] = (f32x4){z_, z_, z_, z_}; }
        cur = nxt; cA = nA; cB = nB; ++ui;
        if constexpr (ALIGN_EPI) { if (wr == 1) PG8_BAR; }
    }
    PG8_WAIT_V(0);
    if constexpr (!ALIGN_EPI) { if (wr == 0) PG8_BAR; }
    PG8_BAR;
    if constexpr (Epi::AFTER_DRAIN) { E.fused(acc, cur, wr, wc, fr, fq, lds, wid, lane); S.done(cur); }
#undef PG8_SA
#undef PG8_SB
#undef PG8_STAGE
#undef PG8_LDA
#undef PG8_LDB
#undef PG8_MMA
#undef PG8_WAIT_V
#undef PG8_WAIT_L
#undef PG8_BAR
#undef PG8_SCHED
}
}
#define GAS __attribute__((address_space(1)))
#define LAS __attribute__((address_space(3)))
typedef unsigned short bf16;
typedef unsigned v4u __attribute__((ext_vector_type(4)));
typedef float f32x4 __attribute__((ext_vector_type(4)));
typedef short bf16x8 __attribute__((ext_vector_type(8)));
typedef GAS unsigned gu32;
typedef GAS unsigned long long gu64;
#define RLX_AGENT __ATOMIC_RELAXED, __HIP_MEMORY_SCOPE_AGENT
#define LDS_WAIT() asm volatile("s_waitcnt lgkmcnt(0)" ::: "memory")
#define VM_WAIT() asm volatile("s_waitcnt vmcnt(0)" ::: "memory")
__device__ __forceinline__ unsigned long long rt() { return __builtin_amdgcn_s_memrealtime(); }
__device__ __forceinline__ unsigned f2bf(float f) { unsigned u = __builtin_bit_cast(unsigned, f); return (u + 0x7fffu + ((u >> 16) & 1u)) >> 16; }
__device__ __forceinline__ unsigned pk2(float lo, float hi) { return f2bf(lo) | (f2bf(hi) << 16); }

#define XB_TMO      128
#define XB_XCNT(j)  (256  + 64 * (j))
#define XB_XSUB(j)  (1280 + 64 * (j))
#define XB_XGEN(j)  (2304 + 64 * (j))
#define XB_TOP      3328
#define XB_TOPGEN   3392
#define XCD_BAR_WORDS 3456
#define XB_SPIN_CAP (1u << 18)

__device__ __forceinline__ unsigned xb_ld(unsigned* p)              { return __hip_atomic_load(p, __ATOMIC_RELAXED, __HIP_MEMORY_SCOPE_AGENT); }
__device__ __forceinline__ unsigned xb_add(unsigned* p, unsigned v) { return __hip_atomic_fetch_add(p, v, __ATOMIC_RELAXED, __HIP_MEMORY_SCOPE_AGENT); }
__device__ __forceinline__ unsigned xb_xcc_id() { return (unsigned)__builtin_amdgcn_s_getreg((3 << 11) | 20) & 0xFu; }
#define XB_SPIN(cond, bar) do { unsigned _sp = 0; while (cond) { __builtin_amdgcn_s_sleep(1); \
    if ((++_sp & 255u) == 0u) { if (xb_ld(&(bar)[XB_TMO])) break; if (_sp > XB_SPIN_CAP) { atomicAdd(&(bar)[XB_TMO], 1u); break; } } } } while (0)

struct XcdBarrier {
    unsigned* bar; unsigned x;
    volatile LAS unsigned* st;
};

__device__ __forceinline__ XcdBarrier xcd_barrier_post(unsigned* bar, volatile LAS unsigned* st) {
    XcdBarrier b; b.bar = bar; b.x = xb_xcc_id(); b.st = st;
    if (threadIdx.x == 0) (void)xb_add(&bar[XB_XCNT(b.x)], 1u);
    return b;
}
__device__ __forceinline__ void xcd_barrier_complete(unsigned* bar, unsigned x, unsigned& nloc, unsigned& nx) {
    const unsigned G = gridDim.x * gridDim.y * gridDim.z;
    unsigned sum, cnt, mine, sp = 0u;
    for (;;) {
        sum = 0u; cnt = 0u; mine = 0u;
#pragma unroll
        for (unsigned j = 0; j < 16; ++j) { const unsigned c = xb_ld(&bar[XB_XCNT(j)]); sum += c; cnt += (c > 0u) ? 1u : 0u; mine = (j == x) ? c : mine; }
        if (sum == G) break;
        __builtin_amdgcn_s_sleep(1);
        if ((++sp & 255u) == 0u) { if (xb_ld(&bar[XB_TMO])) break; if (sp > XB_SPIN_CAP) { atomicAdd(&bar[XB_TMO], 1u); break; } }
    }
    nloc = mine > 0u ? mine : 1u; nx = cnt > 0u ? cnt : 1u;
}

__device__ __forceinline__ void xcd_barrier(const XcdBarrier& b, bool local = false) {
    asm volatile("s_waitcnt vmcnt(0)" ::: "memory");
    __syncthreads();
    if (threadIdx.x == 0) {
        unsigned* bar = b.bar;
        __builtin_amdgcn_s_waitcnt(0);
        unsigned nloc = b.st[0], nx = b.st[1];
        if (nloc == 0u) { xcd_barrier_complete(bar, b.x, nloc, nx); b.st[0] = nloc; b.st[1] = nx; }
        const unsigned old = xb_add(&bar[XB_XSUB(b.x)], 1u);
        const unsigned gen = old / nloc;
        if (old + 1u == (gen + 1u) * nloc) {
            if (!local) {
            __builtin_amdgcn_fence(__ATOMIC_RELEASE, "agent");
            asm volatile("s_waitcnt vmcnt(0)" ::: "memory");
            const unsigned og = xb_add(&bar[XB_TOP], 1u);
            const unsigned tg = og / nx;
            if (og + 1u == (tg + 1u) * nx) xb_add(&bar[XB_TOPGEN], 1u);
            else XB_SPIN(xb_ld(&bar[XB_TOPGEN]) == tg, bar);
            }
            __builtin_amdgcn_fence(__ATOMIC_ACQUIRE, "agent");
            xb_add(&bar[XB_XGEN(b.x)], 1u);
            asm volatile("s_waitcnt vmcnt(0)" ::: "memory");
        } else {
            XB_SPIN(xb_ld(&bar[XB_XGEN(b.x)]) == gen, bar);
            __builtin_amdgcn_fence(__ATOMIC_ACQUIRE, "agent");
            asm volatile("s_waitcnt vmcnt(0)" ::: "memory");
        }
    }
    __syncthreads();
}

constexpr int NWAVES = 8;
constexpr int BATCH = 4, SEQ = 8192, D = 1024, M = BATCH * SEQ, DEPTH = 2;
constexpr int INW = 2048, DFF = 2816, NMOD = 6;
constexpr int O_U = 0, O_QB = 256, O_KB = 640, O_VB = 1024, O_QC = 1408, O_KC = 1792, O_VC = 1920;
constexpr float RMS_EPS = 1e-6f;
constexpr float LOG2E = 1.4426950408889634f;
constexpr float QSCALE = 0.125f * LOG2E;

constexpr size_t MiB = 1u << 20;
constexpr size_t WS_CTL = 0, CTL_ZERO_BYTES = 131072;
constexpr size_t WS_MOD = 1 * MiB;
constexpr size_t WS_W = 2 * MiB, W_LAYER = 24 * MiB;
constexpr size_t W_IN = 0, W_OUT = 4 * MiB, W_GU = 6 * MiB, W_DN = 17 * MiB, W_PT = 23 * MiB;
constexpr size_t WS_H = 50 * MiB;
constexpr size_t WS_Z = 114 * MiB;
constexpr size_t WS_MIX = 436 * MiB;
constexpr size_t WS_HID = 114 * MiB;
constexpr size_t WS_XS = 306 * MiB;
constexpr size_t WS_AUX = 434 * MiB;
constexpr size_t WS_SUMSQ = WS_AUX;
constexpr size_t WS_GV = WS_AUX + 1 * MiB;
constexpr size_t WS_BIAS = WS_GV + 65536;
constexpr size_t BIAS_LAYER = (size_t)BATCH * (2048 + 5632) * 4;
constexpr size_t WS_BSCR = 370 * MiB;
constexpr size_t WS_ZC = 202 * MiB;
constexpr size_t WS_ZB = 130 * MiB;
constexpr size_t WS_END = 500 * MiB;
static_assert(WS_Z + (size_t)M * 256 * 2 <= WS_ZB && WS_ZB + 72 * MiB <= WS_ZC && WS_ZC + 40 * MiB <= WS_XS, "z region map");
static_assert(WS_HID + (size_t)M * DFF * 2 <= WS_XS && WS_MIX + (size_t)M * D * 2 <= WS_END && WS_AUX + 2 * MiB <= WS_MIX && WS_BSCR + 24 * MiB <= WS_AUX && WS_H + (size_t)M * D * 2 <= WS_Z, "ws map");
constexpr int CW_TMO = 0, CW_CODE = 1, CW_BAR = 4096  , CW_QUEUE = 20480, CW_GRP = 20480  , CW_GRPBAD = 20496  , CW_ZEROS = 24576  ;

constexpr int RING_OFF = 0, RING_BYTES = 131072;
constexpr int LDSCTL_OFF = RING_BYTES, MISC_OFF = 147456 - 256, LSEB_OFF = MISC_OFF - 6144;
constexpr int LDS_BYTES = 147456;

constexpr int PH_PRO = 0, PH_CONV = 1, PH_L0 = 2, PH_PER_LAYER = 5, PH_FINAL = PH_L0 + DEPTH * PH_PER_LAYER, NPHASES = PH_FINAL + 1;
#ifndef PROBE_DUP
#define PROBE_DUP 0
#endif
#ifndef PROBE_CUT
#define PROBE_CUT 0
#endif
#ifndef PROBE_MIXSEL
#define PROBE_MIXSEL 0
#endif
#ifndef PROBE_NOSTORE
#define PROBE_NOSTORE 0
#endif
#ifndef MK_ONE_LAUNCH
#define MK_ONE_LAUNCH 1
#endif

struct Frame {
    LAS unsigned char* lds;
    volatile LAS unsigned* MISC;
    gu32* ctl;
    int tid, lane, wave, G, vcu;
};

__device__ __forceinline__ float wave_sum(float v) {
#pragma unroll
    for (int o = 1; o < 64; o <<= 1) v += __shfl_xor(v, o);
    return v;
}
__device__ __forceinline__ float bf2f(unsigned short b) { return __uint_as_float((unsigned)b << 16); }
__device__ __forceinline__ float zero_() { float z; asm volatile("v_mov_b32 %0, 0" : "=v"(z)); return z; }
__device__ __forceinline__ f32x4 zero4_() { const float z = zero_(); return (f32x4){z, z, z, z}; }

__device__ __forceinline__ void tr_item(const float* W, int N, int k0, int n0, bf16* WT, int ldt, int drow0, float scale, LAS float* scr, int lane, bool img = true) {
#pragma unroll 8
    for (int i = 0; i < 32; ++i) { const int kk = 2 * i + (lane >> 5); scr[kk * 33 + (lane & 31)] = __builtin_nontemporal_load(W + (size_t)(k0 + kk) * N + n0 + (lane & 31)); }
    LDS_WAIT(); asm volatile("" ::: "memory");
    const int c = lane & 7;
#pragma unroll
    for (int j = 0; j < 4; ++j) { const int n = (lane >> 3) + 8 * j; const LAS float* s = scr + (8 * c) * 33 + n;
        v4u o; o.x = pk2(s[0 * 33] * scale, s[1 * 33] * scale); o.y = pk2(s[2 * 33] * scale, s[3 * 33] * scale); o.z = pk2(s[4 * 33] * scale, s[5 * 33] * scale); o.w = pk2(s[6 * 33] * scale, s[7 * 33] * scale);
        if (img) *(GAS v4u*)((unsigned char*)WT + pg8::img_off(drow0 + n, k0 + 8 * c, ldt / 64, true)) = o;
        else *(GAS v4u*)(WT + (size_t)(drow0 + n) * ldt + k0 + 8 * c) = o; }
    LDS_WAIT(); asm volatile("" ::: "memory");
}
constexpr int TI_IN = 16 * 64, TI_OUT = 16 * 32, TI_G = 16 * 88, TI_DN = 44 * 32, TI_P = 8, TI_LAYER = TI_IN + TI_OUT + 2 * TI_G + TI_DN + TI_P;
__device__ __forceinline__ void weight_item(const float* const* in, unsigned char* ws, int it, LAS float* scr, int lane) {
    const int l = it / TI_LAYER; int r = it % TI_LAYER;
    unsigned char* wl = ws + WS_W + (size_t)l * W_LAYER;
    if (r < TI_IN) { const int kb = r / 64, n0 = 32 * (r % 64); const bool isq = (n0 >= O_QB && n0 < O_KB) || (n0 >= O_QC && n0 < O_KC);
        tr_item(in[6] + (size_t)l * D * INW, INW, 64 * kb, n0, (bf16*)(wl + W_IN), D, n0, isq ? QSCALE : 1.0f, scr, lane); return; }
    r -= TI_IN;
    if (r < TI_OUT) { const int kb = r / 32, n0 = 32 * (r % 32); tr_item(in[10] + (size_t)l * D * D, D, 64 * kb, n0, (bf16*)(wl + W_OUT), D, n0, 1.0f, scr, lane); return; }
    r -= TI_OUT;
    if (r < 2 * TI_G) { const int up = r >= TI_G; if (up) r -= TI_G; const int kb = r / 88, n0 = 32 * (r % 88);
        tr_item(in[up ? 12 : 11] + (size_t)l * D * DFF, DFF, 64 * kb, n0, (bf16*)(wl + W_GU), D, 256 * (n0 >> 7) + 128 * up + (n0 & 127), 1.0f, scr, lane); return; }
    r -= 2 * TI_G;
    if (r < TI_DN) { const int kb = r / 32, n0 = 32 * (r % 32); tr_item(in[13] + (size_t)l * DFF * D, D, 64 * kb, n0, (bf16*)(wl + W_DN), DFF, n0, 1.0f, scr, lane); return; }
    r -= TI_DN;
    { const int g = r >> 1, n0 = 32 * (r & 1); tr_item(in[7] + (size_t)l * 16384 + g * 4096, 64, 0, n0, (bf16*)(wl + W_PT) + g * 4096, 64, n0, 1.0f, scr, lane, false); }
}
__device__ __forceinline__ void ada_item(Frame& F, const float* const* in, unsigned char* ws, int item) {
    LAS float* cact = (LAS float*)(F.lds);
    LAS float* red = (LAS float*)(F.lds + 16384);
    const int l = item / 96, cb = item % 96;
    const float* c = in[1];
    for (int i = F.tid; i < BATCH * D; i += NWAVES * 64) { const int b = i >> 10, k = i & 1023; const float v = c[i]; cact[k * 4 + b] = v / (1.0f + __expf(-v)); }
    __syncthreads();
    const float* W = in[4] + (size_t)l * D * (NMOD * D) + 64 * cb + F.lane;
    float a0 = 0.f, a1 = 0.f, a2 = 0.f, a3 = 0.f;
    const int kbeg = 128 * F.wave;
#pragma unroll 16
    for (int kk = 0; kk < 128; ++kk) { const float wv = __builtin_nontemporal_load(W + (size_t)(kbeg + kk) * (NMOD * D)); const f32x4 ca = *(const LAS f32x4*)(cact + (kbeg + kk) * 4);
        a0 += ca.x * wv; a1 += ca.y * wv; a2 += ca.z * wv; a3 += ca.w * wv; }
    red[(F.wave * 4 + 0) * 64 + F.lane] = a0; red[(F.wave * 4 + 1) * 64 + F.lane] = a1; red[(F.wave * 4 + 2) * 64 + F.lane] = a2; red[(F.wave * 4 + 3) * 64 + F.lane] = a3;
    __syncthreads();
    if (F.wave < 4) { float s = in[5][(size_t)l * NMOD * D + 64 * cb + F.lane];
#pragma unroll
        for (int w = 0; w < 8; ++w) s += red[(w * 4 + F.wave) * 64 + F.lane];
        ((float*)(ws + WS_MOD))[((size_t)l * BATCH + F.wave) * (NMOD * D) + 64 * cb + F.lane] = s; }
    __syncthreads();
}
__device__ __forceinline__ void p_prologue(Frame& F, const float* const* in, unsigned char* ws) {
    for (int item = blockIdx.x; item < DEPTH * 96; item += F.G) ada_item(F, in, ws, item);
    LAS float* scr = (LAS float*)(F.lds + RING_OFF + F.wave * 16384);
    const int gw = blockIdx.x * NWAVES + F.wave, NGW = F.G * NWAVES;
    for (int it = gw; it < DEPTH * TI_LAYER; it += NGW) weight_item(in, ws, it, scr, F.lane);
    { GAS f32x4* z = (GAS f32x4*)(ws + WS_SUMSQ) + M / 4; const int n4 = 4 * M / 4;
      for (int i = blockIdx.x * (NWAVES * 64) + F.tid; i < n4; i += F.G * NWAVES * 64) z[i] = zero4_(); }
}

__device__ __forceinline__ void p_conv(Frame& F, const float* const* in, unsigned char* ws) {
    const float* MOD = (const float*)(ws + WS_MOD);
    const int NGW = F.G * NWAVES, gw = blockIdx.x * NWAVES + F.wave, rpw = M / NGW;
    {
        const int row0 = gw * rpw, b = row0 / SEQ;
        const float* mb = MOD + (size_t)b * (NMOD * D);
        const float* xin = in[0]; bf16* hout = (bf16*)(ws + WS_H); float* ssq = (float*)(ws + WS_SUMSQ);
        f32x4 Gv[4];
#pragma unroll
        for (int j = 0; j < 4; ++j) { const int cidx = 4 * F.lane + 256 * j; const f32x4 g = *(const f32x4*)(in[2] + cidx), sc = *(const f32x4*)(mb + 1 * D + cidx); Gv[j] = g * (sc + 1.0f); }
        for (int rr = 0; rr < rpw; rr += 4) {
            f32x4 v[4][4];
#pragma unroll
            for (int i = 0; i < 4; ++i) { const GAS f32x4* xr = (const GAS f32x4*)(xin + (size_t)(row0 + rr + i) * D) + F.lane;
#pragma unroll
                for (int j = 0; j < 4; ++j) v[i][j] = __builtin_nontemporal_load(xr + 64 * j); }
#pragma unroll
            for (int i = 0; i < 4; ++i) { const size_t row = (size_t)(row0 + rr + i); float s = 0.f;
#pragma unroll
                for (int j = 0; j < 4; ++j) s += (v[i][j].x * v[i][j].x + v[i][j].y * v[i][j].y) + (v[i][j].z * v[i][j].z + v[i][j].w * v[i][j].w);
                s = wave_sum(s); if (F.lane == 0) ssq[row] = s;
                unsigned char* hb = (unsigned char*)hout + 8 * (F.lane & 1);
#pragma unroll
                for (int j = 0; j < 4; ++j) { const f32x4 o = v[i][j] * Gv[j]; *(GAS unsigned long long*)(hb + pg8::img_off((int)row, (4 * F.lane + 256 * j) & ~7, D / 64, false)) = (unsigned long long)pk2(o.x, o.y) | ((unsigned long long)pk2(o.z, o.w) << 32);
 } }
        }
    }
    {
        float* GV = (float*)(ws + WS_GV);
        for (int i = blockIdx.x * (NWAVES * 64) + F.tid; i < DEPTH * 2 * BATCH * D; i += F.G * NWAVES * 64) { const int col = i & (D - 1), b = (i >> 10) & 3, w = (i >> 12) & 1, l = i >> 13;
            GV[i] = in[w ? 3 : 2][l * D + col] * (1.0f + MOD[((size_t)l * BATCH + b) * (NMOD * D) + (w ? 4 : 1) * D + col]); }
    }
    {
        const int g0 = 8 * gw;
        if (g0 < DEPTH * (INW + 2 * DFF)) {
            const int l = g0 / (INW + 2 * DFF), rl = g0 % (INW + 2 * DFF), w = rl >= INW, n0 = w ? rl - INW : rl, N = w ? 2 * DFF : INW;
            const unsigned char* Bt = ws + WS_W + (size_t)l * W_LAYER + (w ? W_GU : W_IN);
            float* bias = (float*)(ws + WS_BIAS + (size_t)l * BIAS_LAYER) + (w ? BATCH * INW : 0);
            const float* shp = MOD + (size_t)l * BATCH * (NMOD * D) + (w ? 3 : 0) * D + 16 * F.lane;
            v4u wr[8][2];
#pragma unroll
            for (int i = 0; i < 8; ++i) { wr[i][0] = *(const GAS v4u*)(Bt + pg8::img_off(n0 + i, 16 * F.lane, D / 64, true)); wr[i][1] = *(const GAS v4u*)(Bt + pg8::img_off(n0 + i, 16 * F.lane + 8, D / 64, true)); }
            f32x4 sh[4][4];
#pragma unroll
            for (int b = 0; b < 4; ++b)
#pragma unroll
                for (int j = 0; j < 4; ++j) sh[b][j] = *(const f32x4*)(shp + (size_t)b * (NMOD * D) + 4 * j);
#pragma unroll
            for (int i = 0; i < 8; ++i) { const v4u w0 = wr[i][0], w1 = wr[i][1];
                float wf[16];
                wf[0] = __uint_as_float(w0.x << 16); wf[1] = __uint_as_float(w0.x & 0xffff0000u); wf[2] = __uint_as_float(w0.y << 16); wf[3] = __uint_as_float(w0.y & 0xffff0000u);
                wf[4] = __uint_as_float(w0.z << 16); wf[5] = __uint_as_float(w0.z & 0xffff0000u); wf[6] = __uint_as_float(w0.w << 16); wf[7] = __uint_as_float(w0.w & 0xffff0000u);
                wf[8] = __uint_as_float(w1.x << 16); wf[9] = __uint_as_float(w1.x & 0xffff0000u); wf[10] = __uint_as_float(w1.y << 16); wf[11] = __uint_as_float(w1.y & 0xffff0000u);
                wf[12] = __uint_as_float(w1.z << 16); wf[13] = __uint_as_float(w1.z & 0xffff0000u); wf[14] = __uint_as_float(w1.w << 16); wf[15] = __uint_as_float(w1.w & 0xffff0000u);
                float acc[4];
#pragma unroll
                for (int b = 0; b < 4; ++b) { float a = 0.f;
#pragma unroll
                    for (int j = 0; j < 4; ++j) a += (wf[4 * j] * sh[b][j].x + wf[4 * j + 1] * sh[b][j].y) + (wf[4 * j + 2] * sh[b][j].z + wf[4 * j + 3] * sh[b][j].w);
                    acc[b] = wave_sum(a); }
                if (F.lane < 4) bias[(size_t)F.lane * N + n0 + i] = F.lane == 0 ? acc[0] : F.lane == 1 ? acc[1] : F.lane == 2 ? acc[2] : acc[3]; }
        }
    }
}
__device__ __forceinline__ void p_norm_final(Frame& F, const bf16* xin, const float* ssq, float* out, const float* gvec) {
    const int NGW = F.G * NWAVES, rpw = M / NGW;
    const int gw = (F.G == 256) ? (((int)blockIdx.x & 7) * 32 + ((int)blockIdx.x >> 3)) * NWAVES + F.wave : (int)blockIdx.x * NWAVES + F.wave;
    const int row0 = gw * rpw;
    f32x4 Gv[4];
#pragma unroll
    for (int j = 0; j < 4; ++j) Gv[j] = *(const f32x4*)(gvec + 4 * F.lane + 256 * j);
    for (int rr = 0; rr < rpw; rr += 4) {
        unsigned long long w[4][4]; float ss[4];
#pragma unroll
        for (int i = 0; i < 4; ++i) { const unsigned char* xr = (const unsigned char*)xin + 8 * (F.lane & 1); ss[i] = ssq[row0 + rr + i];
#pragma unroll
            for (int j = 0; j < 4; ++j) w[i][j] = *(const GAS unsigned long long*)(xr + pg8::img_off(row0 + rr + i, (4 * F.lane + 256 * j) & ~7, D / 64, false)); }
#pragma unroll
        for (int i = 0; i < 4; ++i) { const float rstd = 1.0f / sqrtf(ss[i] * (1.0f / D) + RMS_EPS);
            GAS f32x4* o = (GAS f32x4*)(out + (size_t)(row0 + rr + i) * D) + F.lane;
#pragma unroll
            for (int j = 0; j < 4; ++j) { const unsigned wl = (unsigned)w[i][j], wh = (unsigned)(w[i][j] >> 32);
                const f32x4 v = {pg8::h_lo(wl), pg8::h_hi(wl), pg8::h_lo(wh), pg8::h_hi(wh)};
                __builtin_nontemporal_store(v * rstd * Gv[j], o + 64 * j); } }
    }
}

namespace mx {
typedef short bf16x8 __attribute__((ext_vector_type(8)));
typedef short s16x4 __attribute__((ext_vector_type(4)));
typedef float f32x16 __attribute__((ext_vector_type(16)));
typedef unsigned u32x4 __attribute__((ext_vector_type(4)));
typedef unsigned u32x2 __attribute__((ext_vector_type(2)));
typedef float f32x2_t __attribute__((ext_vector_type(2))); typedef __bf16 bf16x2_t __attribute__((ext_vector_type(2)));
constexpr float THR = 8.0f;
constexpr int POOL_PITCH = 544;
__device__ __forceinline__ unsigned cvtpk(float lo, float hi) { f32x2_t v = {lo, hi}; bf16x2_t b = __builtin_convertvector(v, bf16x2_t); return __builtin_bit_cast(unsigned, b); }
__device__ __forceinline__ float hswap_max(float v) { auto rr = __builtin_amdgcn_permlane32_swap(__float_as_uint(v), __float_as_uint(v), false, false); return fmaxf(__uint_as_float(rr[0]), __uint_as_float(rr[1])); }
__device__ __forceinline__ float hswap_sum(float v) { auto rr = __builtin_amdgcn_permlane32_swap(__float_as_uint(v), __float_as_uint(v), false, false); return __uint_as_float(rr[0]) + __uint_as_float(rr[1]); }
__device__ __forceinline__ s16x4 vtr(const LAS char* p) { return __builtin_bit_cast(s16x4, __builtin_amdgcn_ds_read_tr16_b64_v4i16((LAS s16x4*)p)); }
__device__ __forceinline__ f32x16 zero16_() { const float z = zero_(); return (f32x16){z, z, z, z, z, z, z, z, z, z, z, z, z, z, z, z}; }
__device__ __forceinline__ int kt_of(int i) { return (i & 1) ? -((i + 1) >> 1) : (i >> 1); }

template <int VAR>
__device__ __forceinline__ float scores(f32x16& t, const bf16x8 (&kf)[4], const bf16x8 (&qf)[4], float relf, float sl, float slope2, float Rf) {
    f32x16 s = {0.f, 0.f, 0.f, 0.f, 0.f, 0.f, 0.f, 0.f, 0.f, 0.f, 0.f, 0.f, 0.f, 0.f, 0.f, 0.f};
#pragma unroll
    for (int i = 0; i < 4; ++i) s = __builtin_amdgcn_mfma_f32_32x32x16_bf16(kf[i], qf[i], s, 0, 0, 0);
    if (VAR == 0) {
#pragma unroll
        for (int r = 0; r < 16; ++r) t[r] = __builtin_fmaf(-__builtin_fabsf(relf - (float)((r & 3) + 8 * (r >> 2))), slope2, s[r]);
        return 0.f;
    } else {
#pragma unroll
        for (int r = 0; r < 16; ++r) { const float c = (float)((r & 3) + 8 * (r >> 2)); float v = __builtin_fmaf(sl, c, s[r]); if (VAR == 2) v = __builtin_fabsf(relf - c) > Rf ? -INFINITY : v; t[r] = v; }
        return -sl * relf;
    }
}
__device__ __forceinline__ float lane_max(const f32x16& t) {
    float a = fmaxf(fmaxf(t[0], t[1]), fmaxf(t[2], t[3])), b = fmaxf(fmaxf(t[4], t[5]), fmaxf(t[6], t[7])), c = fmaxf(fmaxf(t[8], t[9]), fmaxf(t[10], t[11])), d = fmaxf(fmaxf(t[12], t[13]), fmaxf(t[14], t[15]));
    return fmaxf(fmaxf(a, b), fmaxf(c, d));
}
__device__ __forceinline__ float tile_max(const f32x16& t) {
    float a = fmaxf(fmaxf(t[0], t[1]), fmaxf(t[2], t[3])), b = fmaxf(fmaxf(t[4], t[5]), fmaxf(t[6], t[7])), c = fmaxf(fmaxf(t[8], t[9]), fmaxf(t[10], t[11])), d = fmaxf(fmaxf(t[12], t[13]), fmaxf(t[14], t[15]));
    return hswap_max(fmaxf(fmaxf(a, b), fmaxf(c, d)));
}
__device__ __forceinline__ void load_frag4(bf16x8 (&f)[4], const bf16* rowp, int hi) {
#pragma unroll
    for (int i = 0; i < 4; ++i) f[i] = *(const bf16x8*)(rowp + 16 * i + 8 * hi);
}
__device__ __forceinline__ void load_tile_frags(bf16x8 (&f)[4], const char* tile, int lane) {
#pragma unroll
    for (int s = 0; s < 4; ++s) f[s] = *(const bf16x8*)(tile + s * 1024 + lane * 16);
}
__device__ __forceinline__ void dma_tile(LAS char* dst, const char* tile, int lane) {
#pragma unroll
    for (int j = 0; j < 4; ++j) __builtin_amdgcn_global_load_lds((const unsigned*)(tile + j * 1024 + lane * 16), (LAS unsigned*)(dst + j * 1024), 16, 0, 0);
}
__device__ __forceinline__ void dma_v(LAS char* vb, const bf16* vrow0, long rs, int lane) {
#pragma unroll
    for (int j = 0; j < 4; ++j) __builtin_amdgcn_global_load_lds((const unsigned*)(vrow0 + (long)(16 * (j & 1) + (lane >> 2)) * rs + (4 * (j >> 1) + (lane & 3)) * 8), (LAS unsigned*)(vb + j * 1024), 16, 0, 0);
}
__device__ __forceinline__ void load_vfrags(bf16x8 (&vf)[2][2], const LAS char* vaddr) {
#pragma unroll
    for (int d0 = 0; d0 < 2; ++d0)
#pragma unroll
        for (int ks = 0; ks < 2; ++ks) { const s16x4 lo = vtr(vaddr + d0 * 2048 + ks * 1024), hh = vtr(vaddr + d0 * 2048 + ks * 1024 + 512);
            vf[d0][ks] = (bf16x8){lo[0], lo[1], lo[2], lo[3], hh[0], hh[1], hh[2], hh[3]}; }
}
__device__ __forceinline__ void pv_tile(f32x16 (&o)[2], const bf16x8 (&vf)[2][2], const f32x16& p) {
    u32x4 w0, w1;
    w0.x = cvtpk(p[0], p[1]); w0.y = cvtpk(p[2], p[3]); w0.z = cvtpk(p[4], p[5]); w0.w = cvtpk(p[6], p[7]);
    w1.x = cvtpk(p[8], p[9]); w1.y = cvtpk(p[10], p[11]); w1.z = cvtpk(p[12], p[13]); w1.w = cvtpk(p[14], p[15]);
    const bf16x8 pa0 = __builtin_bit_cast(bf16x8, w0), pa1 = __builtin_bit_cast(bf16x8, w1);
#pragma unroll
    for (int d0 = 0; d0 < 2; ++d0) { o[d0] = __builtin_amdgcn_mfma_f32_32x32x16_bf16(vf[d0][0], pa0, o[d0], 0, 0, 0); o[d0] = __builtin_amdgcn_mfma_f32_32x32x16_bf16(vf[d0][1], pa1, o[d0], 0, 0, 0); }
}
__device__ __forceinline__ void store_o(bf16* MIX, int row, int col, const f32x16 (&o)[2], float scale, int hi) {
#pragma unroll
    for (int d0 = 0; d0 < 2; ++d0)
#pragma unroll
        for (int g = 0; g < 4; g += 2) {
            const unsigned ax = cvtpk(o[d0][4 * g] * scale, o[d0][4 * g + 1] * scale), ay = cvtpk(o[d0][4 * g + 2] * scale, o[d0][4 * g + 3] * scale);
            const unsigned bx = cvtpk(o[d0][4 * g + 4] * scale, o[d0][4 * g + 5] * scale), by = cvtpk(o[d0][4 * g + 6] * scale, o[d0][4 * g + 7] * scale);
            const auto rx = __builtin_amdgcn_permlane32_swap(ax, bx, false, false); const auto ry = __builtin_amdgcn_permlane32_swap(ay, by, false, false);
            u32x4 w; w.x = rx[0]; w.y = ry[0]; w.z = rx[1]; w.w = ry[1];
            *(u32x4*)((unsigned char*)MIX + pg8::img_off(row, col + 32 * d0 + 8 * g + 8 * hi, D / 64, false)) = w; }
}
__device__ __forceinline__ void pack_o(u32x4 (&w)[4], const f32x16 (&o)[2], float scale) {
#pragma unroll
    for (int d0 = 0; d0 < 2; ++d0)
#pragma unroll
        for (int g = 0; g < 4; g += 2) {
            const unsigned ax = cvtpk(o[d0][4 * g] * scale, o[d0][4 * g + 1] * scale), ay = cvtpk(o[d0][4 * g + 2] * scale, o[d0][4 * g + 3] * scale);
            const unsigned bx = cvtpk(o[d0][4 * g + 4] * scale, o[d0][4 * g + 5] * scale), by = cvtpk(o[d0][4 * g + 6] * scale, o[d0][4 * g + 7] * scale);
            const auto rx = __builtin_amdgcn_permlane32_swap(ax, bx, false, false); const auto ry = __builtin_amdgcn_permlane32_swap(ay, by, false, false);
            w[2 * d0 + (g >> 1)] = (u32x4){rx[0], ry[0], rx[1], ry[1]}; }
}
__device__ __forceinline__ float alibi_slope(int k  ) { return __builtin_amdgcn_exp2f(-8.0f * (float)(k + 1) / 12.0f); }
__device__ __forceinline__ void scale_o(f32x16 (&o)[2], float f) {
#pragma unroll
    for (int r = 0; r < 16; ++r) { o[0][r] *= f; o[1][r] *= f; }
}

template <bool FIRST, bool WITH_O>
__device__ __forceinline__ void step_rest(f32x16 (&o)[2], float& m, float& l, f32x16& t, float off, const bf16x8 (&vf)[2][2]) {
    const float tm = hswap_max(lane_max(t) + off);
    if (FIRST) m = tm;
    else if (__any(tm - m > THR)) { const float dl = fmaxf(tm - m, 0.f), f = __builtin_amdgcn_exp2f(-dl); l *= f; if (WITH_O) scale_o(o, f); m += dl; }
    const float bm = off - m; f32x2_t ps = {0.f, 0.f}; const f32x2_t bm2 = {bm, bm};
#pragma unroll
    for (int r = 0; r < 16; r += 2) { const f32x2_t x = (f32x2_t){t[r], t[r + 1]} + bm2; t[r] = __builtin_amdgcn_exp2f(x.x); t[r + 1] = __builtin_amdgcn_exp2f(x.y); ps += (f32x2_t){t[r], t[r + 1]}; }
    l += ps.x + ps.y;
    if (WITH_O) pv_tile(o, vf, t);
}
template <int VAR, bool FIRST, bool WITH_O>
__device__ __forceinline__ void step(f32x16 (&o)[2], float& m, float& l, const bf16x8 (&kf)[4], const bf16x8 (&qf)[4], const bf16x8 (&vf)[2][2], float relf, float sl, float slope2, float Rf) {
    f32x16 t; const float off = scores<VAR>(t, kf, qf, relf, sl, slope2, Rf);
    step_rest<FIRST, WITH_O>(o, m, l, t, off, vf);
}

__device__ __forceinline__ void pair_rest(f32x16 (&o)[2], float& m, float& l, f32x16& tL, f32x16& tR, float offL, float offR, const LAS char* vL, const LAS char* vR) {
    const float tm = hswap_max(fmaxf(lane_max(tL) + offL, lane_max(tR) + offR));
    if (__any(tm - m > THR)) { const float dl = fmaxf(tm - m, 0.f), f = __builtin_amdgcn_exp2f(-dl); l *= f; scale_o(o, f); m += dl; }
    const float bL = offL - m, bR = offR - m; f32x2_t ps = {0.f, 0.f}; const f32x2_t bL2 = {bL, bL}, bR2 = {bR, bR};
#pragma unroll
    for (int r = 0; r < 16; r += 2) { const f32x2_t xL = (f32x2_t){tL[r], tL[r + 1]} + bL2, xR = (f32x2_t){tR[r], tR[r + 1]} + bR2;
        tL[r] = __builtin_amdgcn_exp2f(xL.x); tL[r + 1] = __builtin_amdgcn_exp2f(xL.y); tR[r] = __builtin_amdgcn_exp2f(xR.x); tR[r + 1] = __builtin_amdgcn_exp2f(xR.y);
        ps += (f32x2_t){tL[r], tL[r + 1]}; ps += (f32x2_t){tR[r], tR[r + 1]}; }
    l += ps.x + ps.y;
    { bf16x8 vf[2][2]; load_vfrags(vf, vL); pv_tile(o, vf, tL); }
    { bf16x8 vf[2][2]; load_vfrags(vf, vR); pv_tile(o, vf, tR); }
}
template <int VAR>
__device__ __forceinline__ void step_pair_lds(f32x16 (&o)[2], float& m, float& l, const LAS char* kL, const LAS char* kR, const LAS char* vL, const LAS char* vR, bf16x8 (&qf)[4],
                                              float relfL, float relfR, float slope2, float Rf, const char* qnext = nullptr, int lane = 0) {
    f32x16 tL, tR; float offL, offR;
    { bf16x8 kf[4];
#pragma unroll
      for (int s = 0; s < 4; ++s) kf[s] = *(const LAS bf16x8*)(kL + s * 1024);
      offL = scores<VAR>(tL, kf, qf, relfL, slope2, slope2, Rf); }
    { bf16x8 kf[4];
#pragma unroll
      for (int s = 0; s < 4; ++s) kf[s] = *(const LAS bf16x8*)(kR + s * 1024);
      offR = scores<VAR>(tR, kf, qf, relfR, -slope2, slope2, Rf); }
    if (qnext) load_tile_frags(qf, qnext, lane);
    pair_rest(o, m, l, tL, tR, offL, offR, vL, vR);
}
template <int VAR>
__device__ __forceinline__ void step_pair_regk(f32x16 (&o)[2], float& m, float& l, const bf16x8 (&kfL)[4], const bf16x8 (&kfR)[4], const LAS char* vL, const LAS char* vR, const bf16x8 (&qf)[4],
                                               float relfL, float relfR, float slope2, float Rf) {
    f32x16 tL, tR; const float offL = scores<VAR>(tL, kfL, qf, relfL, slope2, slope2, Rf), offR = scores<VAR>(tR, kfR, qf, relfR, -slope2, slope2, Rf);
    pair_rest(o, m, l, tL, tR, offL, offR, vL, vR);
}

__device__ __forceinline__ void dma_k(LAS char* kb, const bf16* krow0, long rs, int lane) {
#pragma unroll
    for (int s = 0; s < 4; ++s) __builtin_amdgcn_global_load_lds((const unsigned*)(krow0 + (long)(lane & 31) * rs + 16 * s + 8 * (lane >> 5)), (LAS unsigned*)(kb + s * 1024), 16, 0, 0);
}
struct BTile { const char* qb; const char* kb; const char* vb; int nt  , t0  , n0, head, d, r, tl; float slope2; };
__device__ __forceinline__ BTile b_decode(const char* ZB, int b, int c, int j, int qi, int q) {
    BTile t; const int g = qi >> 4, i = qi & 15, lg = 2 * g; t.d = 1 << lg;
    t.r = i >> (4 - lg); const int isub = i & ((16 >> lg) - 1); t.n0 = ((512 * c) >> lg) + 32 * isub; t.nt = 256 >> lg; t.t0 = t.n0 >> 5;
    t.head = 2 * g + j; t.slope2 = alibi_slope(6 + t.head) * (float)t.d * LOG2E;
    const size_t tb = (size_t)(t.head * 4 + b) * 256 + ((size_t)t.r << (8 - lg));
    t.qb = ZB + (tb << 12); t.kb = ZB + ((tb + 6 * 4 * 256) << 12); t.vb = ZB + ((tb + 2 * 6 * 4 * 256) << 12);
    t.tl = g * 512 + (32 * isub + q) * t.d + t.r;
    return t;
}
__device__ __forceinline__ void b_issue_qk(const BTile& t, bf16x8 (&qf)[4], bf16x8 (&kf)[5][4], bool (&val)[5], int (&kc)[5], int lane) {
    load_tile_frags(qf, t.qb + ((size_t)t.t0 << 12), lane);
#pragma unroll
    for (int i = 0; i < 5; ++i) { const int kt = t.t0 + kt_of(i); val[i] = kt >= 0 && kt < t.nt; kc[i] = kt < 0 ? 0 : (kt >= t.nt ? t.nt - 1 : kt);
        load_tile_frags(kf[i], t.kb + ((size_t)kc[i] << 12), lane); }
}
__device__ __forceinline__ void fill_ninf(f32x16& t) {
#pragma unroll
    for (int r = 0; r < 16; ++r) t[r] = -INFINITY;
}
__device__ __forceinline__ float b_qtile(f32x16 (&o)[2], const BTile& t, const BTile& tn, bool has_next, bf16x8 (&qf)[4], bf16x8 (&kf)[5][4], bool (&val)[5], int (&kc)[5], LAS char* vb, int lane) {
    const int q = lane & 31, hi = lane >> 5;
    const float slope2 = t.slope2;
    const LAS char* vaddr = vb + (4 * hi + ((lane & 15) >> 2)) * 64 + ((lane >> 4) & 1) * 32 + (lane & 3) * 8;
    float m = 0.f, l = 0.f;
    {
        bf16x8 vf[2][2]; load_vfrags(vf, vaddr);
        asm volatile("s_waitcnt lgkmcnt(0)" ::: "memory"); dma_tile(vb, t.vb + ((size_t)kc[4] << 12), lane);
        step<0, true, true>(o, m, l, kf[0], qf, vf, (float)(q - 4 * hi), slope2, slope2, 64.0f); }
    {
        f32x16 tL, tR; const float offL = scores<1>(tL, kf[1], qf, (float)(q + 32 - 4 * hi), slope2, slope2, 64.0f), offR = scores<1>(tR, kf[2], qf, (float)(q - 32 - 4 * hi), -slope2, slope2, 64.0f);
        if (!val[1]) fill_ninf(tL); if (!val[2]) fill_ninf(tR);
        pair_rest(o, m, l, tL, tR, offL, offR, vaddr + 4096, vaddr + 8192); }
    asm volatile("s_waitcnt vmcnt(0)" ::: "memory");
    {
        f32x16 tL, tR; const float offL = scores<2>(tL, kf[3], qf, (float)(q + 64 - 4 * hi), slope2, slope2, 64.0f), offR = scores<2>(tR, kf[4], qf, (float)(q - 64 - 4 * hi), -slope2, slope2, 64.0f);
        if (!val[3]) fill_ninf(tL); if (!val[4]) fill_ninf(tR);
        if (has_next) {
            asm volatile("s_waitcnt lgkmcnt(0)" ::: "memory");
            b_issue_qk(tn, qf, kf, val, kc, lane);
            dma_tile(vb + 4096, tn.vb + ((size_t)kc[1] << 12), lane); dma_tile(vb + 8192, tn.vb + ((size_t)kc[2] << 12), lane); }
        pair_rest(o, m, l, tL, tR, offL, offR, vaddr + 12288, vaddr);
        if (has_next) { asm volatile("s_waitcnt lgkmcnt(0)" ::: "memory");
            dma_tile(vb, tn.vb + ((size_t)kc[0] << 12), lane); dma_tile(vb + 12288, tn.vb + ((size_t)kc[3] << 12), lane); } }
    const float lt = hswap_sum(l);
    scale_o(o, 1.0f / lt);
    return m + __builtin_amdgcn_logf(lt);
}
__device__ __forceinline__ void b_unit(const char* ZB, bf16* MIX, char* SCR, int u, LAS char* lds, int wave, int lane) {
    const int b = u >> 5, c = (u >> 1) & 15, j = u & 1;
    LAS float* lseb = (LAS float*)(lds + LSEB_OFF);
    LAS char* vb = lds + wave * 16384;
    char* scr = SCR + ((size_t)(u * 8 + wave) * 6 << 12) + lane * 16;
    const int q = lane & 31, hi = lane >> 5;
    bf16x8 qf[4], kf[5][4]; bool val[5]; int kc[5];
    BTile t = b_decode(ZB, b, c, j, wave, q);
    b_issue_qk(t, qf, kf, val, kc, lane);
#pragma unroll
    for (int i = 0; i < 4; ++i) dma_tile(vb + i * 4096, t.vb + ((size_t)kc[i] << 12), lane);
#pragma unroll 1
    for (int it = 0; it < 6; ++it) { const bool has_next = it < 5; const BTile tn = b_decode(ZB, b, c, j, wave + 8 * (has_next ? it + 1 : it), q);
        if (it == 0) asm volatile("s_waitcnt vmcnt(0)" ::: "memory"); else asm volatile("s_waitcnt vmcnt(4)" ::: "memory");
        f32x16 o[2]; o[0] = zero16_(); o[1] = zero16_();
        const float lse = b_qtile(o, t, tn, has_next, qf, kf, val, kc, vb, lane);
        if (hi == 0) lseb[t.tl] = lse;
        u32x4 w[4]; pack_o(w, o, 1.0f);
#pragma unroll
        for (int k = 0; k < 4; ++k) *(u32x4*)(scr + ((size_t)it << 12) + k * 1024) = w[k];
        t = tn; }
    __syncthreads();
#pragma unroll 1
    for (int it0 = 0; it0 < 6; it0 += 3) { u32x4 w[3][4];
#pragma unroll
        for (int ii = 0; ii < 3; ++ii)
#pragma unroll
            for (int k = 0; k < 4; ++k) w[ii][k] = *(const u32x4*)(scr + ((size_t)(it0 + ii) << 12) + k * 1024);
#pragma unroll
        for (int ii = 0; ii < 3; ++ii) { const BTile tt = b_decode(ZB, b, c, j, wave + 8 * (it0 + ii), q);
            const int tk = tt.tl & 511; const float l0 = lseb[tk], l1 = lseb[512 + tk], l2 = lseb[1024 + tk], own = lseb[tt.tl]; const float mm = fmaxf(l0, fmaxf(l1, l2));
            const float a = __builtin_amdgcn_exp2f(own - mm) / (__builtin_amdgcn_exp2f(l0 - mm) + __builtin_amdgcn_exp2f(l1 - mm) + __builtin_amdgcn_exp2f(l2 - mm));
            const int orow = b * SEQ + (tt.n0 + q) * tt.d + tt.r, ocol = 256 + 64 * tt.head + 8 * hi;
#pragma unroll
            for (int k = 0; k < 4; ++k) { const u32x4 x = w[ii][k]; u32x4 y;
                y.x = cvtpk(__uint_as_float(x.x << 16) * a, __uint_as_float(x.x & 0xffff0000u) * a); y.y = cvtpk(__uint_as_float(x.y << 16) * a, __uint_as_float(x.y & 0xffff0000u) * a);
                y.z = cvtpk(__uint_as_float(x.z << 16) * a, __uint_as_float(x.z & 0xffff0000u) * a); y.w = cvtpk(__uint_as_float(x.w << 16) * a, __uint_as_float(x.w & 0xffff0000u) * a);
                *(u32x4*)((unsigned char*)MIX + pg8::img_off(orow, ocol + 32 * (k >> 1) + 16 * (k & 1), D / 64, false)) = y; } } }
    __syncthreads();
}
__device__ __forceinline__ void c_unit(const char* ZC, bf16* MIX, const float* sink, int u, LAS char* lds, int wave, int lane) {
    const int b = u >> 6, kvh = (u >> 5) & 1, q0 = 256 * (u & 31), n0 = q0 + 32 * wave;
    const int q = lane & 31, hi = lane >> 5;
    const char* kt0 = ZC + ((size_t)((6 + kvh) * 4 + b) * 256 << 12); const char* vt0 = ZC + ((size_t)((8 + kvh) * 4 + b) * 256 << 12);
#pragma unroll
    for (int tt = 0; tt < 2; ++tt) { const int t = 2 * wave + tt, T = (q0 >> 5) - 4 + t;
        if (T >= 0 && T < SEQ / 32) { dma_tile(lds + t * 8192, kt0 + ((size_t)T << 12), lane); dma_tile(lds + t * 8192 + 4096, vt0 + ((size_t)T << 12), lane); } }
    const char* qt0 = ZC + (((size_t)((3 * kvh) * 4 + b) * 256 + (n0 >> 5)) << 12);
    bf16x8 qf[4]; load_tile_frags(qf, qt0, lane);
    asm volatile("s_waitcnt vmcnt(0)" ::: "memory");
    __syncthreads();
    const LAS char* kbase = lds + lane * 16;
    const LAS char* vbase = lds + 4096 + (4 * hi + ((lane & 15) >> 2)) * 64 + ((lane >> 4) & 1) * 32 + (lane & 3) * 8;
#pragma unroll 1
    for (int hh = 0; hh < 3; ++hh) { const int head = 3 * kvh + hh;
        const char* qnext = hh < 2 ? qt0 + ((size_t)(hh + 1) * 4 * 256 << 12) : nullptr; bool reloaded = false;
        f32x16 o[2]; o[0] = zero16_(); o[1] = zero16_();
        float m = sink[head] * LOG2E, l = hi ? 0.f : 1.0f; const float slope2 = alibi_slope(head) * LOG2E;
        {
            const int t = wave + 4; bf16x8 kf[4];
#pragma unroll
            for (int s = 0; s < 4; ++s) kf[s] = *(const LAS bf16x8*)(kbase + t * 8192 + s * 1024);
            bf16x8 vf[2][2]; load_vfrags(vf, vbase + t * 8192);
            step<0, false, true>(o, m, l, kf, qf, vf, (float)(q - 4 * hi), slope2, slope2, 128.0f); }
#pragma unroll 1
        for (int k = 1; k <= 4; ++k) { const int tL = wave + 4 - k, tR = wave + 4 + k; const bool vL = n0 - 32 * k >= 0, vR = n0 + 32 * k < SEQ;
            const float relfL = (float)(q + 32 * k - 4 * hi), relfR = (float)(q - 32 * k - 4 * hi);
            if (vL && vR) {
                if (k < 4) step_pair_lds<1>(o, m, l, kbase + tL * 8192, kbase + tR * 8192, vbase + tL * 8192, vbase + tR * 8192, qf, relfL, relfR, slope2, 128.0f);
                else { step_pair_lds<2>(o, m, l, kbase + tL * 8192, kbase + tR * 8192, vbase + tL * 8192, vbase + tR * 8192, qf, relfL, relfR, slope2, 128.0f, qnext, lane); reloaded = true; } }
            else if (vL || vR) { const int t = vL ? tL : tR; bf16x8 kf[4];
#pragma unroll
                for (int s = 0; s < 4; ++s) kf[s] = *(const LAS bf16x8*)(kbase + t * 8192 + s * 1024);
                bf16x8 vf[2][2]; load_vfrags(vf, vbase + t * 8192);
                const float relf = vL ? relfL : relfR, sl = vL ? slope2 : -slope2;
                if (k < 4) step<1, false, true>(o, m, l, kf, qf, vf, relf, sl, slope2, 128.0f); else step<2, false, true>(o, m, l, kf, qf, vf, relf, sl, slope2, 128.0f); } }
        if (!reloaded && qnext) load_tile_frags(qf, qnext, lane);
        store_o(MIX, b * SEQ + n0 + q, 640 + 64 * head, o, 1.0f / hswap_sum(l), hi); }
    __syncthreads();
}
template <int G>
__device__ __forceinline__ void pool_group(const LAS char* rows, bf16* MIX, const bf16* wpt, const float* pscale, int row0, int tok, int kq, int lane) {
    constexpr int R = 1 << G, W = 2 * R + 1;
    int lo = tok - R, hi2 = tok + R + 1; lo = lo < 0 ? 0 : lo; hi2 = hi2 > SEQ ? SEQ : hi2; const float inv = 1.0f / (float)(hi2 - lo);
    f32x4 acc[4];
#pragma unroll
    for (int dt = 0; dt < 4; ++dt) acc[dt] = zero4_();
#pragma unroll
    for (int kb = 0; kb < 2; ++kb) { float s[8]; bf16x8 uc;
        const LAS char* rp = rows + ((lane & 15) + 8 - R) * POOL_PITCH + (8 * G + 4 * kb + kq) * 16;
#pragma unroll
        for (int e = 0; e < 8; ++e) s[e] = 0.f;
#pragma unroll
        for (int j = 0; j < W; ++j) { const int tt = tok + j - R; const float w = (tt >= 0 && tt < SEQ) ? 1.0f : 0.0f; const bf16x8 v = *(const LAS bf16x8*)(rp + j * POOL_PITCH); if (j == R) uc = v;
#pragma unroll
            for (int e = 0; e < 8; ++e) s[e] += w * bf2f((unsigned short)v[e]); }
        u32x4 pw; float pe[8];
#pragma unroll
        for (int e = 0; e < 8; ++e) pe[e] = s[e] * inv - bf2f((unsigned short)uc[e]);
        pw.x = cvtpk(pe[0], pe[1]); pw.y = cvtpk(pe[2], pe[3]); pw.z = cvtpk(pe[4], pe[5]); pw.w = cvtpk(pe[6], pe[7]);
        const bf16x8 bfrag = __builtin_bit_cast(bf16x8, pw);
#pragma unroll
        for (int dt = 0; dt < 4; ++dt) { const bf16x8 afrag = *(const bf16x8*)(wpt + (size_t)(G * 64 + dt * 16 + (lane & 15)) * 64 + kb * 32 + 8 * kq);
            acc[dt] = __builtin_amdgcn_mfma_f32_16x16x32_bf16(afrag, bfrag, acc[dt], 0, 0, 0); } }
#pragma unroll
    for (int dt = 0; dt < 4; ++dt) { const int dcol = G * 64 + dt * 16 + 4 * kq; const f32x4 sc = *(const f32x4*)(pscale + dcol);
        u32x2 w; w.x = cvtpk(acc[dt][0] * sc.x, acc[dt][1] * sc.y); w.y = cvtpk(acc[dt][2] * sc.z, acc[dt][3] * sc.w);
        *(u32x2*)((unsigned char*)MIX + pg8::img_off(row0 + (lane & 15), dcol & ~7, D / 64, false) + 2 * (dcol & 7)) = w; }
}
__device__ __forceinline__ void pool_item(const bf16* Z, bf16* MIX, const bf16* wpt, const float* pscale, int item, LAS char* rows, int lane) {
    const int row0 = 16 * item, b = row0 / SEQ, t0 = row0 % SEQ;
    const int tok = t0 + (lane & 15), kq = lane >> 4;
    const bf16* zb = Z + (size_t)b * SEQ * 256;
    u32x4 st[16];
#pragma unroll
    for (int i = 0; i < 16; ++i) { const int idx = i * 64 + lane, r = idx >> 5, c = idx & 31; int tt = t0 - 8 + r; tt = (tt >= 0 && tt < SEQ) ? tt : t0; st[i] = *(const u32x4*)(zb + (size_t)tt * 256 + 8 * c); }
#pragma unroll
    for (int i = 0; i < 16; ++i) { const int idx = i * 64 + lane, r = idx >> 5, c = idx & 31; *(LAS u32x4*)(rows + r * POOL_PITCH + c * 16) = st[i]; }
    pool_group<0>(rows, MIX, wpt, pscale, row0, tok, kq, lane); pool_group<1>(rows, MIX, wpt, pscale, row0, tok, kq, lane);
    pool_group<2>(rows, MIX, wpt, pscale, row0, tok, kq, lane); pool_group<3>(rows, MIX, wpt, pscale, row0, tok, kq, lane);
}
constexpr int N_B_UNITS = 128, N_C_UNITS = 256, N_P_ITEMS = M / 16;
}

__device__ __forceinline__ void p_mixers(Frame& F, const float* const* in, unsigned char* ws, int lq, int sel  ) {
    const int l = lq & 1;
    const bf16* Z = (const bf16*)(ws + WS_Z); bf16* MIX = (bf16*)(ws + WS_MIX);
    LAS char* lds = (LAS char*)F.lds;
    const float* sink = in[9] + 6 * l;
    {
        const int nb = (F.G >= 2 * mx::N_B_UNITS) ? mx::N_B_UNITS : (F.G + 1) / 2;
        const bool xl = (F.G == 256);
        if ((int)blockIdx.x < nb) {
            if (sel & 1) {
#pragma unroll 1
                for (int u0 = blockIdx.x; u0 < mx::N_B_UNITS; u0 += nb) { const int u = xl ? ((u0 & 7) >> 1) * 32 + (u0 >> 3) * 2 + (u0 & 1) : u0;     unsigned z_; asm volatile("v_mov_b32 %0, 0" : "=v"(z_)); const int lane = (int)__builtin_amdgcn_mbcnt_hi(~0u, __builtin_amdgcn_mbcnt_lo(~0u, z_)); mx::b_unit((const char*)(ws + WS_ZB), MIX, (char*)(ws + WS_BSCR), u, lds, F.wave, lane); } }
        } else if (sel & 2) {
#pragma unroll 1
            for (int v = (int)blockIdx.x - nb, u0 = v, k = 0; u0 < mx::N_C_UNITS; u0 += F.G - nb, ++k) { const int u = xl ? (v & 7) * 32 + (v >> 3) * 2 + k : u0;     unsigned z_; asm volatile("v_mov_b32 %0, 0" : "=v"(z_)); const int lane = (int)__builtin_amdgcn_mbcnt_hi(~0u, __builtin_amdgcn_mbcnt_lo(~0u, z_)); mx::c_unit((const char*)(ws + WS_ZC), MIX, sink, u, lds, F.wave, lane); }
        }
        __syncthreads();
    }
    if (sel & 4) { const bf16* wpt = (const bf16*)(ws + WS_W + (size_t)l * W_LAYER + W_PT); const float* pscale = in[8] + 256 * l;
        for (int it = blockIdx.x * NWAVES + F.wave; it < mx::N_P_ITEMS; it += F.G * NWAVES) mx::pool_item(Z, MIX, wpt, pscale, it, lds + F.wave * (32 * mx::POOL_PITCH), F.lane); }
}

struct Args { const float* in[15]; float* out; unsigned char* ws; int ph_lo, ph_hi, li, dup; };
__global__ void __launch_bounds__(NWAVES * 64, 2) mk_fwd(Args args) {
    extern __shared__ __attribute__((aligned(16))) unsigned char lds[];
    Frame F;
    F.lds = (LAS unsigned char*)lds;
    F.MISC = (volatile LAS unsigned*)(F.lds + MISC_OFF);
    F.tid = threadIdx.x; F.lane = F.tid & 63; F.wave = __builtin_amdgcn_readfirstlane(F.tid >> 6);
    const int wave0 = F.wave;
    F.G = gridDim.x; { const int bx = blockIdx.x; F.vcu = (F.G % 8 == 0) ? (bx % 8) * (F.G / 8) + bx / 8 : bx; }
    unsigned char* ws = args.ws;
    F.ctl = (gu32*)(ws + WS_CTL);
    for (int u = F.tid; u < (LDS_BYTES - LDSCTL_OFF) / 4; u += NWAVES * 64) ((LAS unsigned*)(F.lds + LDSCTL_OFF))[u] = 0u;
    __syncthreads();
    XcdBarrier bar; bar.bar = (unsigned*)(F.ctl + CW_BAR) + args.li * XCD_BAR_WORDS; bar.x = 0; bar.st = nullptr;
    const int lo = args.ph_lo, hi = args.ph_hi;
    if (hi - lo > 1) { bar = xcd_barrier_post((unsigned*)(F.ctl + CW_BAR) + args.li * XCD_BAR_WORDS, F.MISC + 8);
        if (F.tid == 0) { const unsigned v = bar.x + 1u; unsigned exp = 0u;
            if (!__hip_atomic_compare_exchange_strong((unsigned*)(F.ctl + CW_GRP) + (blockIdx.x & 7), &exp, v, __ATOMIC_RELAXED, __ATOMIC_RELAXED, __HIP_MEMORY_SCOPE_AGENT) && exp != v) __hip_atomic_fetch_or((unsigned*)(F.ctl + CW_GRPBAD), 1u, RLX_AGENT); } }
    const float* const* in = args.in;
    bf16* XS = (bf16*)(ws + WS_XS);
    bf16* H = (bf16*)(ws + WS_H);
    const float* MOD = (const float*)(ws + WS_MOD);
    float* SSQ = (float*)(ws + WS_SUMSQ);
    const float* GV = (const float*)(ws + WS_GV);

    const int dup = args.dup & 1, msel = ((args.dup >> 1) & 15) ? ((args.dup >> 1) & 15) : 7;
#pragma unroll 1
    for (int ph = lo; ph < hi; ++ph) {
        { unsigned z_; asm volatile("v_mov_b32 %0, 0" : "=v"(z_)); const int t_ = wave0 * 64 + (int)__builtin_amdgcn_mbcnt_hi(~0u, __builtin_amdgcn_mbcnt_lo(~0u, z_)); F.tid = t_; F.lane = t_ & 63; F.wave = wave0; }
        if (ph == PH_PRO) p_prologue(F, in, ws);
        else if (ph == PH_CONV) p_conv(F, in, ws);
        else if (ph == PH_FINAL) p_norm_final(F, XS, SSQ + (size_t)4 * M, args.out, in[14]);
        else {
            const int l = (ph - PH_L0) / PH_PER_LAYER, k = (ph - PH_L0) % PH_PER_LAYER;
            unsigned char* wl = ws + WS_W + (size_t)l * W_LAYER;
            const float* modl = MOD + (size_t)l * BATCH * NMOD * D;
            const float* biasl = (const float*)(ws + WS_BIAS + (size_t)l * BIAS_LAYER);
            if (k == 0) { pg8::Gemm g{H, (const bf16*)(wl + W_IN), M, INW, D}; pg8::StaticOrder S; S.init(M, INW, F.G, (int)blockIdx.x);
                pg8::EpiBf16Norm E{(bf16*)(ws + WS_Z), 256, SSQ + (size_t)(2 * l) * M, biasl, INW, ws + WS_ZB, ws + WS_ZC};
                pg8::gemm_phase<pg8::EpiBf16Norm, pg8::StaticOrder, true, true>(F.lds + RING_OFF, g, S, E, F.tid); }
            else if (k == 1) p_mixers(F, in, ws, l + 2 * dup, msel);
            else if (k == 2 && l == 0 && !dup) {
                pg8::Gemm g{(const bf16*)(ws + WS_MIX), (const bf16*)(wl + W_OUT), M, D, D}; pg8::StaticOrder S; S.init(M, D, F.G, (int)blockIdx.x);
                pg8::EpiGateResNormT<true> E{(const bf16*)in[0], XS, modl + 2 * D, NMOD * D, H, GV + (size_t)1 * BATCH * D, D, SSQ + (size_t)1 * M, D};
                pg8::gemm_phase<pg8::EpiGateResNormT<true>, pg8::StaticOrder, true, true>(F.lds + RING_OFF, g, S, E, F.tid); }
            else if (k == 2 || k == 4) { const bool dn = (k == 4); const bool last = dn && (l == DEPTH - 1);
                pg8::Gemm g{(const bf16*)(ws + (dn ? WS_HID : WS_MIX)), (const bf16*)(wl + (dn ? W_DN : W_OUT)), M, D, dn ? DFF : D}; pg8::StaticOrder S; S.init(M, D, F.G, (int)blockIdx.x);
                pg8::EpiGateResNorm E{XS, XS, dup ? (const float*)(F.ctl + CW_ZEROS) : modl + (dn ? 5 : 2) * D, dup ? 0 : NMOD * D,
                    (last || dup) ? (bf16*)nullptr : H, GV + (size_t)((dn ? 2 * (l + 1) : 2 * l + 1) % (2 * DEPTH)) * BATCH * D, D, SSQ + (size_t)(dup ? 5 : 2 * l + (dn ? 2 : 1)) * M, D};
                pg8::gemm_phase<pg8::EpiGateResNorm, pg8::StaticOrder, true, true>(F.lds + RING_OFF, g, S, E, F.tid); }
            else { pg8::Gemm g{H, (const bf16*)(wl + W_GU), M, 2 * DFF, D}; pg8::StaticOrder S; S.init(M, 2 * DFF, F.G, (int)blockIdx.x);
                pg8::EpiSwiGLUNorm E{(bf16*)(ws + WS_HID), DFF, SSQ + (size_t)(2 * l + 1) * M, biasl + BATCH * INW, 2 * DFF};
                pg8::gemm_phase<pg8::EpiSwiGLUNorm, pg8::StaticOrder, true, true>(F.lds + RING_OFF, g, S, E, F.tid); }
        }
        if (ph + 1 < hi) { const int kk = (ph >= PH_L0 && ph < PH_FINAL) ? (ph - PH_L0) % PH_PER_LAYER : -1;
            xcd_barrier(bar, F.MISC[17] != 0u && (kk == 2 || kk == 3 || (kk == 4 && ph + 1 == PH_FINAL)));
            if (ph == PH_PRO && lo == 0) { if (F.tid == 0) F.MISC[17] = (F.G == 256 && xb_ld((unsigned*)(F.ctl + CW_GRPBAD)) == 0u) ? 1u : 0u; __syncthreads(); } }
    }
}

extern "C" void kernel_launch(void* const* d_in, const int* in_sizes, int n_in, void* d_out, int out_size, void* d_ws, size_t ws_size, hipStream_t stream) {
    static int grid = 0;
    if (grid == 0) {
        if (n_in != 15 || in_sizes[0] != M * D || out_size != M * D || ws_size < WS_END) { fprintf(stderr, "kernel_launch: unexpected shapes (n_in %d, in0 %d, out %d, ws %zu); nothing launched\n", n_in, n_in > 0 ? in_sizes[0] : -1, out_size, ws_size); grid = -1; return; }
        int dev = 0, cus = 0, per_cu = 0;
        if (hipGetDevice(&dev) != hipSuccess || hipDeviceGetAttribute(&cus, hipDeviceAttributeMultiprocessorCount, dev) != hipSuccess) { grid = -1; return; }
        if (hipFuncSetAttribute((const void*)mk_fwd, hipFuncAttributeMaxDynamicSharedMemorySize, LDS_BYTES) != hipSuccess) { fprintf(stderr, "kernel_launch: hipFuncSetAttribute failed\n"); grid = -1; return; }
        if (hipOccupancyMaxActiveBlocksPerMultiprocessor(&per_cu, (const void*)mk_fwd, NWAVES * 64, LDS_BYTES) != hipSuccess || per_cu < 1) fprintf(stderr, "kernel_launch: occupancy query reports %d blocks per CU\n", per_cu);
        (void)hipGetLastError();
        grid = cus;
        if (grid != 256) fprintf(stderr, "kernel_launch: %d CUs; this kernel is laid out for 256\n", grid);
    }
    if (grid < 0) return;
    if (hipMemsetAsync((char*)d_ws + WS_CTL, 0, CTL_ZERO_BYTES, stream) != hipSuccess) return;
    Args a{};
    for (int i = 0; i < 15; ++i) a.in[i] = (const float*)d_in[i];
    a.out = (float*)d_out; a.ws = (unsigned char*)d_ws;
#if PROBE_DUP == 0 && PROBE_CUT == 0
    a.ph_lo = 0; a.ph_hi = NPHASES; a.li = 0; a.dup = 0;
    hipLaunchKernelGGL(mk_fwd, dim3(grid), dim3(NWAVES * 64), LDS_BYTES, stream, a);
#else
    { int lo = 0, li = 0;
      for (int ph = 0; ph < NPHASES; ++ph) { const bool cut = ((PROBE_CUT | PROBE_DUP) >> ph) & 1;
        if (cut || ph == NPHASES - 1) { a.ph_lo = lo; a.ph_hi = ph + 1; a.li = (ph + 1 - lo > 1) ? li++ : 0; a.dup = 0; hipLaunchKernelGGL(mk_fwd, dim3(grid), dim3(NWAVES * 64), LDS_BYTES, stream, a);
            if ((PROBE_DUP >> ph) & 1) { a.ph_lo = ph; a.ph_hi = ph + 1; a.li = 0; a.dup = 1 | (PROBE_MIXSEL << 1) | (PROBE_NOSTORE << 4); hipLaunchKernelGGL(mk_fwd, dim3(grid), dim3(NWAVES * 64), LDS_BYTES, stream, a); }
            lo = ph + 1; } } }
#endif
}
```

```cpp
#include <hip/hip_runtime.h>
#include <cstdio>
#include <cstdint>
namespace pg8 {
#define PG8_LAS __attribute__((address_space(3)))
typedef unsigned short bf16_t;
typedef short bf16x8 __attribute__((ext_vector_type(8)));
typedef float f32x4 __attribute__((ext_vector_type(4)));
typedef unsigned u32x4 __attribute__((ext_vector_type(4)));
constexpr int BM = 256, BK = 64, HALF = 128, HTB = HALF * BK * 2  , STAGE_BYTES = 8 * HTB, NXCD = 8, WGM = 8;

__host__ __device__ __forceinline__ int lds_byte(int r, int c) { const int st = (r >> 4) * 2 + (c >> 5), rr = r & 15, cc = c & 31, ob = rr * 64 + cc * 2; return st * 1024 + (ob ^ (((ob >> 9) & 1) << 5)); }
__host__ __device__ __forceinline__ void stage_rc(int b, int& R, int& C) { const int st = b / 1024, sb = b % 1024, swz = sb ^ (((sb >> 9) & 1) << 5); R = (st >> 1) * 16 + swz / 64; C = (st & 1) * 32 + (swz % 64) / 2; }
__host__ __device__ __forceinline__ int perm32(int rho) { const int n = rho >> 4, i = rho & 15; return 8 * (i >> 2) + 4 * n + (i & 3); }

__host__ __device__ __forceinline__ int perm32inv(int x) { return 16 * ((x >> 2) & 1) + 4 * (x >> 3) + (x & 3); }
__host__ __device__ __forceinline__ size_t img_off(int row, int col, int nt, bool wrow) { const int r = row & 127, rr = wrow ? (r & ~31) + perm32inv(r & 31) : r; return ((size_t)((row >> 7) * nt + (col >> 6)) << 14) + (size_t)lds_byte(rr, col & 63); }
constexpr bool IMG_A = true, IMG_B = true;
struct Unit { int pm, pn; };
struct Gemm { const bf16_t* A; const bf16_t* Bt; int M, N, K; };

struct StaticOrder {
    int nM, nN, nwg, G, c;
    __host__ __device__ void init(int M, int N, int G_, int c_) { nM = M / BM; nN = N / BM; nwg = nM * nN; G = G_; c = c_; }
    __host__ __device__ bool next(int i, Unit& u) const {
        const long L = (long)i * G + c; if (L >= nwg) return false;
        int wgid = (int)L; { const int q = nwg / NXCD, r = nwg % NXCD, xcd = wgid % NXCD, off = wgid / NXCD; wgid = (xcd < r ? xcd * (q + 1) : r * (q + 1) + (xcd - r) * q) + off; }
        const int nig = WGM * nN, gid = wgid / nig, fm = gid * WGM, gsz = (nM - fm) < WGM ? (nM - fm) : WGM;
        u.pm = fm + ((wgid % nig) % gsz); u.pn = (wgid % nig) / gsz; return true;
    }
    __device__ __forceinline__ void a_ready(const Unit&) const {}
    __device__ __forceinline__ void done(const Unit&) const {}
};

__device__ __forceinline__ unsigned cvt_pk_bf16(float lo, float hi) { unsigned r; asm volatile("v_cvt_pk_bf16_f32 %0, %1, %2" : "=v"(r) : "v"(lo), "v"(hi)); return r; }
constexpr float RMS_EPS_ = 1e-6f, INV_D_ = 1.0f / 1024.0f;
__device__ __forceinline__ void aux_dma(const float* src_lane, PG8_LAS unsigned char* dst_wave) { __builtin_amdgcn_global_load_lds((const unsigned*)src_lane, (PG8_LAS unsigned*)dst_wave, 4, 0, 0); }
typedef _Float16 h16x2 __attribute__((ext_vector_type(2)));
__device__ __forceinline__ unsigned pk_h2(float lo, float hi) { const h16x2 h = {(_Float16)lo, (_Float16)hi}; return __builtin_bit_cast(unsigned, h); }
__device__ __forceinline__ float h_lo(unsigned w) { return (float)__builtin_bit_cast(h16x2, w)[0]; }
__device__ __forceinline__ float h_hi(unsigned w) { return (float)__builtin_bit_cast(h16x2, w)[1]; }
struct EpiBf16Norm {
    static constexpr bool PERM = true, AFTER_DRAIN = false;
    bf16_t* O; int ldc; const float* sumsq; const float* bias; int bias_stride; unsigned char* zb; unsigned char* zc;
    __device__ __forceinline__ void prefetch(const Unit& u, PG8_LAS unsigned char* aux, int wid, int lane) const {
        if (wid < 4) aux_dma(sumsq + u.pm * BM + wid * 64 + lane, aux + wid * 256);
        else aux_dma(bias + (size_t)(u.pm >> 5) * bias_stride + u.pn * BM + (wid - 4) * 64 + lane, aux + 1024 + (wid - 4) * 256);
    }
    __device__ __forceinline__ void operator()(const f32x4 (&acc)[2][2][4][2], const Unit& u, int wr, int wc, int fr_, int fq_, PG8_LAS unsigned char* aux) const {
        unsigned z_; asm volatile("v_mov_b32 %0, 0" : "=v"(z_)); const int ln_ = (int)__builtin_amdgcn_mbcnt_hi(~0u, __builtin_amdgcn_mbcnt_lo(~0u, z_)); const int fr = ln_ & 15, fq = ln_ >> 4;
        const int row0 = u.pm * BM + wr * 64 + fr, col0 = u.pn * BM + wc * 32 + 8 * fq;
        const PG8_LAS float* ass = (const PG8_LAS float*)aux + wr * 64 + fr; const PG8_LAS float* ab = (const PG8_LAS float*)(aux + 1024) + wc * 32 + 8 * fq;
        f32x4 bv[2][2];
#pragma unroll
        for (int bj = 0; bj < 2; ++bj)
#pragma unroll
            for (int n = 0; n < 2; ++n) bv[bj][n] = *(const PG8_LAS f32x4*)(ab + bj * HALF + 4 * n);
#pragma unroll
        for (int ai = 0; ai < 2; ++ai)
#pragma unroll
            for (int m = 0; m < 4; ++m) { const int row = row0 + ai * HALF + m * 16; const float rs = __builtin_amdgcn_rsqf(ass[ai * HALF + m * 16] * INV_D_ + RMS_EPS_);
#pragma unroll
                for (int bj = 0; bj < 2; ++bj) { const f32x4 v0 = acc[ai][bj][m][0] * rs + bv[bj][0], v1 = acc[ai][bj][m][1] * rs + bv[bj][1];
                    u32x4 w; w.x = cvt_pk_bf16(v0[0], v0[1]); w.y = cvt_pk_bf16(v0[2], v0[3]); w.z = cvt_pk_bf16(v1[0], v1[1]); w.w = cvt_pk_bf16(v1[2], v1[3]);
                    const int cb = 2 * u.pn + bj;
                    if (zb != nullptr && cb >= 2 && cb <= 10) { const int t3 = (cb - 2) / 3, g = (cb - 2) % 3, lg = 2 * g, hd = 2 * g + (wc >> 1), c = (wc & 1) * 4 + fq;
                        const int t = row & 8191, b = row >> 13, r = t & ((1 << lg) - 1), n = t >> lg, ti = (r << (8 - lg)) + (n >> 5), key = n & 31;
                        const int off = t3 < 2 ? (c >> 1) * 1024 + (key + 32 * (c & 1)) * 16 : (c >> 2) * 2048 + (key >> 4) * 1024 + (key & 15) * 64 + (c & 3) * 16;
                        *(u32x4*)(zb + ((size_t)(((t3 * 6 + hd) * 4 + b) * 256 + ti) << 12) + off) = w; }
                    else if (zb != nullptr && cb >= 11) {
                        const int hx = cb <= 13 ? 2 * (cb - 11) + (wc >> 1) : (cb == 14 ? 6 : 8) + (wc >> 1), c = (wc & 1) * 4 + fq, t = row & 8191, b = row >> 13, key = t & 31;
                        const int off = cb < 15 ? (c >> 1) * 1024 + (key + 32 * (c & 1)) * 16 : (c >> 2) * 2048 + (key >> 4) * 1024 + (key & 15) * 64 + (c & 3) * 16;
                        *(u32x4*)(zc + ((size_t)((hx * 4 + b) * 256 + (t >> 5)) << 12) + off) = w; }
                    else *(u32x4*)(O + (size_t)row * ldc + col0 + bj * HALF) = w; } }
    }
};
struct EpiSwiGLUNorm {
    static constexpr bool PERM = true, AFTER_DRAIN = false;
    bf16_t* O; int ldc; const float* sumsq; const float* bias; int bias_stride;
    static __device__ __forceinline__ float silu_mul(float g, float u) { return g * u * __builtin_amdgcn_rcpf(1.0f + __builtin_amdgcn_exp2f(-1.4426950408889634f * g)); }
    __device__ __forceinline__ void prefetch(const Unit& u, PG8_LAS unsigned char* aux, int wid, int lane) const {
        if (wid < 4) aux_dma(sumsq + u.pm * BM + wid * 64 + lane, aux + wid * 256);
        else aux_dma(bias + (size_t)(u.pm >> 5) * bias_stride + u.pn * BM + (wid - 4) * 64 + lane, aux + 1024 + (wid - 4) * 256);
    }
    __device__ __forceinline__ void operator()(const f32x4 (&acc)[2][2][4][2], const Unit& u, int wr, int wc, int fr_, int fq_, PG8_LAS unsigned char* aux) const {
        unsigned z_; asm volatile("v_mov_b32 %0, 0" : "=v"(z_)); const int ln_ = (int)__builtin_amdgcn_mbcnt_hi(~0u, __builtin_amdgcn_mbcnt_lo(~0u, z_)); const int fr = ln_ & 15, fq = ln_ >> 4;
        const int row0 = u.pm * BM + wr * 64 + fr, col0 = u.pn * HALF + wc * 32 + 8 * fq;
        const PG8_LAS float* ass = (const PG8_LAS float*)aux + wr * 64 + fr; const PG8_LAS float* ab = (const PG8_LAS float*)(aux + 1024) + wc * 32 + 8 * fq;
        const f32x4 bg0 = *(const PG8_LAS f32x4*)(ab), bg1 = *(const PG8_LAS f32x4*)(ab + 4), bu0 = *(const PG8_LAS f32x4*)(ab + HALF), bu1 = *(const PG8_LAS f32x4*)(ab + HALF + 4);
#pragma unroll
        for (int ai = 0; ai < 2; ++ai)
#pragma unroll
            for (int m = 0; m < 4; ++m) { const int row = row0 + ai * HALF + m * 16; const float rs = __builtin_amdgcn_rsqf(ass[ai * HALF + m * 16] * INV_D_ + RMS_EPS_);
                unsigned char* rowp = (unsigned char*)O + img_off(row, col0, ldc / 64, false);
                const f32x4 g0 = acc[ai][0][m][0] * rs + bg0, g1 = acc[ai][0][m][1] * rs + bg1, u0 = acc[ai][1][m][0] * rs + bu0, u1 = acc[ai][1][m][1] * rs + bu1;
                f32x4 e0 = g0 * -1.4426950408889634f, e1 = g1 * -1.4426950408889634f;
#pragma unroll
                for (int i = 0; i < 4; ++i) { e0[i] = __builtin_amdgcn_exp2f(e0[i]); e1[i] = __builtin_amdgcn_exp2f(e1[i]); }
                e0 = e0 + 1.0f; e1 = e1 + 1.0f;
#pragma unroll
                for (int i = 0; i < 4; ++i) { e0[i] = __builtin_amdgcn_rcpf(e0[i]); e1[i] = __builtin_amdgcn_rcpf(e1[i]); }
                const f32x4 h0 = (g0 * u0) * e0, h1 = (g1 * u1) * e1;
                u32x4 w; w.x = cvt_pk_bf16(h0[0], h0[1]); w.y = cvt_pk_bf16(h0[2], h0[3]); w.z = cvt_pk_bf16(h1[0], h1[1]); w.w = cvt_pk_bf16(h1[2], h1[3]);
                *(u32x4*)rowp = w; }
    }
};
template <bool F32BASE>
struct EpiGateResNormT {
    static constexpr bool PERM = true, AFTER_DRAIN = false;
    const bf16_t* base; bf16_t* out; const float* gate; int gate_stride; bf16_t* Hn; const float* gn; int gn_stride; float* sumsq; int ldc;
    __device__ __forceinline__ void prefetch(const Unit& u, PG8_LAS unsigned char* aux, int wid, int lane) const {
        if (wid < 4) aux_dma(gate + (size_t)(u.pm >> 5) * gate_stride + u.pn * BM + wid * 64 + lane, aux + wid * 256);
        else aux_dma(gn + (size_t)(u.pm >> 5) * gn_stride + u.pn * BM + (wid - 4) * 64 + lane, aux + 1024 + (wid - 4) * 256);
    }
    __device__ __forceinline__ void operator()(const f32x4 (&acc)[2][2][4][2], const Unit& u, int wr, int wc, int fr_, int fq_, PG8_LAS unsigned char* aux) const {
        unsigned z_; asm volatile("v_mov_b32 %0, 0" : "=v"(z_)); const int ln_ = (int)__builtin_amdgcn_mbcnt_hi(~0u, __builtin_amdgcn_mbcnt_lo(~0u, z_)); const int fr = ln_ & 15, fq = ln_ >> 4;
        const int row0 = u.pm * BM + wr * 64 + fr, col0 = u.pn * BM + wc * 32 + 8 * fq;
        const PG8_LAS float* ag = (const PG8_LAS float*)aux + wc * 32 + 8 * fq; const PG8_LAS float* an = (const PG8_LAS float*)(aux + 1024) + wc * 32 + 8 * fq;
#pragma unroll
        for (int am = 0; am < 4; ++am) {
            u32x4 ld[2][2]; f32x4 lf[2][2][2];
#pragma unroll
            for (int mm = 0; mm < 2; ++mm)
#pragma unroll
                for (int bj = 0; bj < 2; ++bj) {
                    if constexpr (F32BASE) { const f32x4* px = (const f32x4*)((const float*)base + (size_t)(row0 + (am >> 1) * HALF + (2 * (am & 1) + mm) * 16) * ldc + col0 + bj * HALF); lf[mm][bj][0] = px[0]; lf[mm][bj][1] = px[1]; }
                    else ld[mm][bj] = *(const u32x4*)((const unsigned char*)base + img_off(row0 + (am >> 1) * HALF + (2 * (am & 1) + mm) * 16, col0 + bj * HALF, ldc / 64, false)); }
#pragma unroll
            for (int mm = 0; mm < 2; ++mm) { const int ai = am >> 1, m = 2 * (am & 1) + mm; const int row = row0 + ai * HALF + m * 16; const size_t off = (size_t)row * ldc + col0; float ss = 0.f;
#pragma unroll
                for (int bj = 0; bj < 2; ++bj) {
                    const f32x4 g0 = *(const PG8_LAS f32x4*)(ag + bj * HALF), g1 = *(const PG8_LAS f32x4*)(ag + bj * HALF + 4);
                    f32x4 b0, b1;
                    if constexpr (F32BASE) { b0 = lf[mm][bj][0]; b1 = lf[mm][bj][1]; }
                    else { const u32x4 bw = ld[mm][bj]; b0 = (f32x4){h_lo(bw.x), h_hi(bw.x), h_lo(bw.y), h_hi(bw.y)}; b1 = (f32x4){h_lo(bw.z), h_hi(bw.z), h_lo(bw.w), h_hi(bw.w)}; }
                    const f32x4 x0 = b0 + g0 * acc[ai][bj][m][0], x1 = b1 + g1 * acc[ai][bj][m][1];
                    u32x4 w; w.x = pk_h2(x0[0], x0[1]); w.y = pk_h2(x0[2], x0[3]); w.z = pk_h2(x1[0], x1[1]); w.w = pk_h2(x1[2], x1[3]);
                    *(u32x4*)((unsigned char*)out + img_off(row, col0 + bj * HALF, ldc / 64, false)) = w;
                    ss += (x0[0] * x0[0] + x0[1] * x0[1]) + (x0[2] * x0[2] + x0[3] * x0[3]) + (x1[0] * x1[0] + x1[1] * x1[1]) + (x1[2] * x1[2] + x1[3] * x1[3]);
                    if (Hn) { const f32x4 n0 = *(const PG8_LAS f32x4*)(an + bj * HALF), n1 = *(const PG8_LAS f32x4*)(an + bj * HALF + 4); const f32x4 h0 = x0 * n0, h1 = x1 * n1;
                        u32x4 hw; hw.x = cvt_pk_bf16(h0[0], h0[1]); hw.y = cvt_pk_bf16(h0[2], h0[3]); hw.z = cvt_pk_bf16(h1[0], h1[1]); hw.w = cvt_pk_bf16(h1[2], h1[3]);
                        *(u32x4*)((unsigned char*)Hn + img_off(row, col0 + bj * HALF, ldc / 64, false)) = hw; } }
                ss += __shfl_xor(ss, 16); ss += __shfl_xor(ss, 32);
                if (fq == 0) atomicAdd(sumsq + row, ss); }
            asm volatile("" ::: "memory"); }
    }
};
typedef EpiGateResNormT<false> EpiGateResNorm;

template <class Epi, class Sched, bool ALIGN_EPI = false, bool SP2 = false>
__device__ __forceinline__ void gemm_phase(PG8_LAS unsigned char* lds, const Gemm g, const Sched& S, const Epi& E, int tid_in) {
    int tid_ = tid_in; asm volatile("" : "+v"(tid_));
    const int tid = tid_, wid = __builtin_amdgcn_readfirstlane(tid >> 6), lane = tid & 63, wr = wid >> 2, wc = wid & 3, fr = lane & 15, fq = lane >> 4;
    const int K = g.K, nt = K / BK;
    unsigned voffA[2], voffB[2];
#pragma unroll
    for (int i = 0; i < 2; ++i) { int R, C; stage_rc(tid * 16 + i * 8192, R, C); const int Rb = Epi::PERM ? ((R & ~31) + perm32(R & 31)) : R;
        voffA[i] = IMG_A ? (unsigned)(tid * 16 + i * 8192) : (unsigned)(R * K + C) * 2u; voffB[i] = IMG_B ? (unsigned)(tid * 16 + i * 8192) : (unsigned)(Rb * K + C) * 2u; }
    const size_t kstepA = IMG_A ? (size_t)(HALF * BK * 2) : (size_t)(BK * 2), kstepB = IMG_B ? (size_t)(HALF * BK * 2) : (size_t)(BK * 2);
    const size_t hstep = (size_t)HALF * K * 2;
    const size_t tstep = 2 * hstep;
    const unsigned ldsw = (unsigned)wid * 1024u;
    const int aoff = lds_byte(wr * 64 + fr, fq * 8), boff = lds_byte(wc * 32 + fr, fq * 8);
#define PG8_SA(b, h) (((b) * 2 + (h)) * HTB)
#define PG8_SB(b, h) ((4 + (b) * 2 + (h)) * HTB)
#define PG8_STAGE(bufoff, gbase, voff) do { _Pragma("unroll") for (int _i = 0; _i < 2; ++_i) \
        __builtin_amdgcn_global_load_lds((const unsigned*)((const char*)(gbase) + (voff)[_i]), (PG8_LAS unsigned*)(lds + (bufoff) + ldsw + _i * 8192), 16, 0, 0); } while (0)
#define PG8_LDA(dst, b, h) do { _Pragma("unroll") for (int m = 0; m < 4; ++m) _Pragma("unroll") for (int k = 0; k < 2; ++k) dst[m][k] = *(const PG8_LAS bf16x8*)(lds + PG8_SA(b, h) + aoff + m * 2048 + k * 1024); } while (0)
#define PG8_LDB(dst, b, h) do { _Pragma("unroll") for (int n = 0; n < 2; ++n) _Pragma("unroll") for (int k = 0; k < 2; ++k) dst[n][k] = *(const PG8_LAS bf16x8*)(lds + PG8_SB(b, h) + boff + n * 2048 + k * 1024); } while (0)
#define PG8_MMA(ai, bj, At, Bt) do { __builtin_amdgcn_s_setprio(1); _Pragma("unroll") for (int m = 0; m < 4; ++m) _Pragma("unroll") for (int n = 0; n < 2; ++n) _Pragma("unroll") for (int k = 0; k < 2; ++k) \
        acc[ai][bj][m][n] = __builtin_amdgcn_mfma_f32_16x16x32_bf16(Bt[n][k], At[m][k], acc[ai][bj][m][n], 0, 0, 0); __builtin_amdgcn_s_setprio(0); } while (0)
#define PG8_WAIT_V(n) asm volatile("s_waitcnt vmcnt(" #n ")" ::: "memory")
#define PG8_WAIT_L(n) asm volatile("s_waitcnt lgkmcnt(" #n ")" ::: "memory")
#define PG8_BAR __builtin_amdgcn_s_barrier()
#define PG8_SCHED __builtin_amdgcn_sched_barrier(0)
    Unit cur, nxt; int ui = 0;
    if (!S.next(0, cur)) return;
    f32x4 acc[2][2][4][2];
#pragma unroll
    for (int a = 0; a < 2; ++a)
#pragma unroll
        for (int b = 0; b < 2; ++b)
#pragma unroll
            for (int m = 0; m < 4; ++m)
#pragma unroll
                for (int n = 0; n < 2; ++n) { float z_; asm volatile("v_mov_b32 %0, 0" : "=v"(z_)); acc[a][b][m][n] = (f32x4){z_, z_, z_, z_}; }
    bf16x8 At[4][2], B0[2][2], B1[2][2];
    const char* cA = (const char*)g.A + (size_t)cur.pm * tstep; const char* cB = (const char*)g.Bt + (size_t)cur.pn * tstep;
    S.a_ready(cur);
    if constexpr (SP2) {
        PG8_STAGE(PG8_SB(0, 0), cB, voffB); PG8_STAGE(PG8_SB(0, 1), cB + hstep, voffB); PG8_STAGE(PG8_SA(0, 0), cA, voffA); PG8_STAGE(PG8_SA(0, 1), cA + hstep, voffA);
        if (wr == 1) PG8_BAR;
        PG8_WAIT_V(2); PG8_BAR;
        PG8_STAGE(PG8_SB(1, 0), cB + kstepB, voffB); PG8_STAGE(PG8_SA(1, 0), cA + kstepA, voffA); PG8_STAGE(PG8_SB(1, 1), cB + hstep + kstepB, voffB);
        PG8_WAIT_V(6); PG8_BAR;
    } else {
        PG8_STAGE(PG8_SB(0, 0), cB, voffB); PG8_STAGE(PG8_SA(0, 0), cA, voffA); PG8_STAGE(PG8_SB(0, 1), cB + hstep, voffB); PG8_STAGE(PG8_SA(0, 1), cA + hstep, voffA);
        if (wr == 1) PG8_BAR;
        PG8_WAIT_V(4); PG8_BAR;
        PG8_STAGE(PG8_SB(1, 0), cB + kstepB, voffB); PG8_STAGE(PG8_SA(1, 0), cA + kstepA, voffA); PG8_STAGE(PG8_SB(1, 1), cB + hstep + kstepB, voffB);
        PG8_WAIT_V(6); PG8_BAR;
    }
    for (;;) {
        const bool has_next = S.next(ui + 1, nxt);
        const char* nA = has_next ? (const char*)g.A + (size_t)nxt.pm * tstep : cA; const char* nB = has_next ? (const char*)g.Bt + (size_t)nxt.pn * tstep : cB;
        for (int t = 0; t < nt; t += 2) {
            const bool last = (t == nt - 2);
            const char* a1 = cA + (size_t)(t + 1) * kstepA;
            const char* a2 = last ? nA : cA + (size_t)(t + 2) * kstepA; const char* b2 = last ? nB : cB + (size_t)(t + 2) * kstepB;
            const char* a3 = a2 + kstepA; const char* b3 = b2 + kstepB;
            if (last && has_next) S.a_ready(nxt);
            if (last) E.prefetch(cur, lds + STAGE_BYTES + 1024, wid, lane);
            if constexpr (SP2) {
            PG8_LDB(B0, 0, 0); PG8_LDB(B1, 0, 1); PG8_SCHED; PG8_LDA(At, 0, 0); PG8_STAGE(PG8_SA(1, 1), a1 + hstep, voffA);
            PG8_WAIT_V(8); PG8_WAIT_L(0); PG8_BAR; PG8_MMA(0, 0, At, B0); PG8_MMA(0, 1, At, B1); PG8_BAR; PG8_SCHED;
            PG8_LDA(At, 0, 1); PG8_STAGE(PG8_SB(0, 0), b2, voffB); PG8_STAGE(PG8_SB(0, 1), b2 + hstep, voffB); PG8_STAGE(PG8_SA(0, 0), a2, voffA);
            PG8_WAIT_V(8); PG8_WAIT_L(0); PG8_BAR; PG8_MMA(1, 0, At, B0); PG8_MMA(1, 1, At, B1); PG8_BAR; PG8_SCHED;
            PG8_LDB(B0, 1, 0); PG8_LDB(B1, 1, 1); PG8_SCHED; PG8_LDA(At, 1, 0); PG8_STAGE(PG8_SA(0, 1), a2 + hstep, voffA);
            PG8_WAIT_V(8); PG8_WAIT_L(0); PG8_BAR; PG8_MMA(0, 0, At, B0); PG8_MMA(0, 1, At, B1); PG8_BAR; PG8_SCHED;
            PG8_LDA(At, 1, 1); PG8_STAGE(PG8_SB(1, 0), b3, voffB); PG8_STAGE(PG8_SB(1, 1), b3 + hstep, voffB); PG8_STAGE(PG8_SA(1, 0), a3, voffA);
            PG8_WAIT_V(8); PG8_WAIT_L(0); PG8_BAR; PG8_MMA(1, 0, At, B0); PG8_MMA(1, 1, At, B1); PG8_BAR; PG8_SCHED;
            } else {
            PG8_LDB(B0, 0, 0); PG8_SCHED; PG8_LDA(At, 0, 0); PG8_STAGE(PG8_SA(1, 1), a1 + hstep, voffA);
            PG8_WAIT_L(8); PG8_BAR; PG8_WAIT_L(0); PG8_MMA(0, 0, At, B0); PG8_BAR; PG8_SCHED;
            PG8_LDB(B1, 0, 1); PG8_STAGE(PG8_SB(0, 0), b2, voffB);
            PG8_BAR; PG8_WAIT_L(0); PG8_MMA(0, 1, At, B1); PG8_BAR;
            PG8_LDA(At, 0, 1); PG8_STAGE(PG8_SA(0, 0), a2, voffA);
            PG8_BAR; PG8_WAIT_L(0); PG8_MMA(1, 0, At, B0); PG8_BAR; PG8_SCHED;
            PG8_STAGE(PG8_SB(0, 1), b2 + hstep, voffB);
            PG8_WAIT_V(6); PG8_BAR; PG8_MMA(1, 1, At, B1); PG8_BAR;
            PG8_LDB(B0, 1, 0); PG8_SCHED; PG8_LDA(At, 1, 0); PG8_STAGE(PG8_SA(0, 1), a2 + hstep, voffA);
            PG8_WAIT_L(8); PG8_BAR; PG8_WAIT_L(0); PG8_MMA(0, 0, At, B0); PG8_BAR; PG8_SCHED;
            PG8_LDB(B1, 1, 1); PG8_STAGE(PG8_SB(1, 0), b3, voffB);
            PG8_BAR; PG8_WAIT_L(0); PG8_MMA(0, 1, At, B1); PG8_BAR;
            PG8_LDA(At, 1, 1); PG8_STAGE(PG8_SA(1, 0), a3, voffA);
            PG8_BAR; PG8_WAIT_L(0); PG8_MMA(1, 0, At, B0); PG8_BAR; PG8_SCHED;
            PG8_STAGE(PG8_SB(1, 1), b3 + hstep, voffB);
            PG8_WAIT_V(6); PG8_BAR; PG8_MMA(1, 1, At, B1); PG8_BAR;
            }
        }
        if constexpr (ALIGN_EPI) { if (wr == 0) PG8_BAR; }
        if constexpr (!Epi::AFTER_DRAIN) { E(acc, cur, wr, wc, fr, fq, lds + STAGE_BYTES + 1024); S.done(cur); }
        if (!has_next) break;
#pragma unroll
        for (int a = 0; a < 2; ++a)
#pragma unroll
            for (int b = 0; b < 2; ++b)
#pragma unroll
                for (int m = 0; m < 4; ++m)
#pragma unroll
                    for (int n = 0; n < 2; ++n) { float z_; asm volatile("v_mov_b32 %0, 0" : "=v"(z_)); acc[a][b][m][n] = (f32x4){z_, z_, z_, z_}; }
        cur = nxt; cA = nA; cB = nB; ++ui;
        if constexpr (ALIGN_EPI) { if (wr == 1) PG8_BAR; }
    }
    PG8_WAIT_V(0);
    if constexpr (!ALIGN_EPI) { if (wr == 0) PG8_BAR; }
    PG8_BAR;
    if constexpr (Epi::AFTER_DRAIN) { E.fused(acc, cur, wr, wc, fr, fq, lds, wid, lane); S.done(cur); }
#undef PG8_SA
#undef PG8_SB
#undef PG8_STAGE
#undef PG8_LDA
#undef PG8_LDB
#undef PG8_MMA
#undef PG8_WAIT_V
#undef PG8_WAIT_L
#undef PG8_BAR
#undef PG8_SCHED
}
}
#define GAS __attribute__((address_space(1)))
#define LAS __attribute__((address_space(3)))
typedef unsigned short bf16;
typedef unsigned v4u __attribute__((ext_vector_type(4)));
typedef float f32x4 __attribute__((ext_vector_type(4)));
typedef short bf16x8 __attribute__((ext_vector_type(8)));
typedef GAS unsigned gu32;
typedef GAS unsigned long long gu64;
#define RLX_AGENT __ATOMIC_RELAXED, __HIP_MEMORY_SCOPE_AGENT
#define LDS_WAIT() asm volatile("s_waitcnt lgkmcnt(0)" ::: "memory")
#define VM_WAIT() asm volatile("s_waitcnt vmcnt(0)" ::: "memory")
__device__ __forceinline__ unsigned long long rt() { return __builtin_amdgcn_s_memrealtime(); }
__device__ __forceinline__ unsigned f2bf(float f) { unsigned u = __builtin_bit_cast(unsigned, f); return (u + 0x7fffu + ((u >> 16) & 1u)) >> 16; }
__device__ __forceinline__ unsigned pk2(float lo, float hi) { return f2bf(lo) | (f2bf(hi) << 16); }

#define XB_TMO      128
#define XB_XCNT(j)  (256  + 64 * (j))
#define XB_XSUB(j)  (1280 + 64 * (j))
#define XB_XGEN(j)  (2304 + 64 * (j))
#define XB_TOP      3328
#define XB_TOPGEN   3392
#define XCD_BAR_WORDS 3456
#define XB_SPIN_CAP (1u << 18)

__device__ __forceinline__ unsigned xb_ld(unsigned* p)              { return __hip_atomic_load(p, __ATOMIC_RELAXED, __HIP_MEMORY_SCOPE_AGENT); }
__device__ __forceinline__ unsigned xb_add(unsigned* p, unsigned v) { return __hip_atomic_fetch_add(p, v, __ATOMIC_RELAXED, __HIP_MEMORY_SCOPE_AGENT); }
__device__ __forceinline__ unsigned xb_xcc_id() { return (unsigned)__builtin_amdgcn_s_getreg((3 << 11) | 20) & 0xFu; }
#define XB_SPIN(cond, bar) do { unsigned _sp = 0; while (cond) { __builtin_amdgcn_s_sleep(1); \
    if ((++_sp & 255u) == 0u) { if (xb_ld(&(bar)[XB_TMO])) break; if (_sp > XB_SPIN_CAP) { atomicAdd(&(bar)[XB_TMO], 1u); break; } } } } while (0)

struct XcdBarrier {
    unsigned* bar; unsigned x;
    volatile LAS unsigned* st;
};

__device__ __forceinline__ XcdBarrier xcd_barrier_post(unsigned* bar, volatile LAS unsigned* st) {
    XcdBarrier b; b.bar = bar; b.x = xb_xcc_id(); b.st = st;
    if (threadIdx.x == 0) (void)xb_add(&bar[XB_XCNT(b.x)], 1u);
    return b;
}
__device__ __forceinline__ void xcd_barrier_complete(unsigned* bar, unsigned x, unsigned& nloc, unsigned& nx) {
    const unsigned G = gridDim.x * gridDim.y * gridDim.z;
    unsigned sum, cnt, mine, sp = 0u;
    for (;;) {
        sum = 0u; cnt = 0u; mine = 0u;
#pragma unroll
        for (unsigned j = 0; j < 16; ++j) { const unsigned c = xb_ld(&bar[XB_XCNT(j)]); sum += c; cnt += (c > 0u) ? 1u : 0u; mine = (j == x) ? c : mine; }
        if (sum == G) break;
        __builtin_amdgcn_s_sleep(1);
        if ((++sp & 255u) == 0u) { if (xb_ld(&bar[XB_TMO])) break; if (sp > XB_SPIN_CAP) { atomicAdd(&bar[XB_TMO], 1u); break; } }
    }
    nloc = mine > 0u ? mine : 1u; nx = cnt > 0u ? cnt : 1u;
}

__device__ __forceinline__ void xcd_barrier(const XcdBarrier& b, bool local = false) {
    asm volatile("s_waitcnt vmcnt(0)" ::: "memory");
    __syncthreads();
    if (threadIdx.x == 0) {
        unsigned* bar = b.bar;
        __builtin_amdgcn_s_waitcnt(0);
        unsigned nloc = b.st[0], nx = b.st[1];
        if (nloc == 0u) { xcd_barrier_complete(bar, b.x, nloc, nx); b.st[0] = nloc; b.st[1] = nx; }
        const unsigned old = xb_add(&bar[XB_XSUB(b.x)], 1u);
        const unsigned gen = old / nloc;
        if (old + 1u == (gen + 1u) * nloc) {
            if (!local) {
            __builtin_amdgcn_fence(__ATOMIC_RELEASE, "agent");
            asm volatile("s_waitcnt vmcnt(0)" ::: "memory");
            const unsigned og = xb_add(&bar[XB_TOP], 1u);
            const unsigned tg = og / nx;
            if (og + 1u == (tg + 1u) * nx) xb_add(&bar[XB_TOPGEN], 1u);
            else XB_SPIN(xb_ld(&bar[XB_TOPGEN]) == tg, bar);
            }
            __builtin_amdgcn_fence(__ATOMIC_ACQUIRE, "agent");
            xb_add(&bar[XB_XGEN(b.x)], 1u);
            asm volatile("s_waitcnt vmcnt(0)" ::: "memory");
        } else {
            XB_SPIN(xb_ld(&bar[XB_XGEN(b.x)]) == gen, bar);
            __builtin_amdgcn_fence(__ATOMIC_ACQUIRE, "agent");
            asm volatile("s_waitcnt vmcnt(0)" ::: "memory");
        }
    }
    __syncthreads();
}

constexpr int NWAVES = 8;
constexpr int BATCH = 4, SEQ = 8192, D = 1024, M = BATCH * SEQ, DEPTH = 2;
constexpr int INW = 2048, DFF = 2816, NMOD = 6;
constexpr int O_U = 0, O_QB = 256, O_KB = 640, O_VB = 1024, O_QC = 1408, O_KC = 1792, O_VC = 1920;
constexpr float RMS_EPS = 1e-6f;
constexpr float LOG2E = 1.4426950408889634f;
constexpr float QSCALE = 0.125f * LOG2E;

constexpr size_t MiB = 1u << 20;
constexpr size_t WS_CTL = 0, CTL_ZERO_BYTES = 131072;
constexpr size_t WS_MOD = 1 * MiB;
constexpr size_t WS_W = 2 * MiB, W_LAYER = 24 * MiB;
constexpr size_t W_IN = 0, W_OUT = 4 * MiB, W_GU = 6 * MiB, W_DN = 17 * MiB, W_PT = 23 * MiB;
constexpr size_t WS_H = 50 * MiB;
constexpr size_t WS_Z = 114 * MiB;
constexpr size_t WS_MIX = 436 * MiB;
constexpr size_t WS_HID = 114 * MiB;
constexpr size_t WS_XS = 306 * MiB;
constexpr size_t WS_AUX = 434 * MiB;
constexpr size_t WS_SUMSQ = WS_AUX;
constexpr size_t WS_GV = WS_AUX + 1 * MiB;
constexpr size_t WS_BIAS = WS_GV + 65536;
constexpr size_t BIAS_LAYER = (size_t)BATCH * (2048 + 5632) * 4;
constexpr size_t WS_BSCR = 370 * MiB;
constexpr size_t WS_ZC = 202 * MiB;
constexpr size_t WS_ZB = 130 * MiB;
constexpr size_t WS_END = 500 * MiB;
static_assert(WS_Z + (size_t)M * 256 * 2 <= WS_ZB && WS_ZB + 72 * MiB <= WS_ZC && WS_ZC + 40 * MiB <= WS_XS, "z region map");
static_assert(WS_HID + (size_t)M * DFF * 2 <= WS_XS && WS_MIX + (size_t)M * D * 2 <= WS_END && WS_AUX + 2 * MiB <= WS_MIX && WS_BSCR + 24 * MiB <= WS_AUX && WS_H + (size_t)M * D * 2 <= WS_Z, "ws map");
constexpr int CW_TMO = 0, CW_CODE = 1, CW_BAR = 4096  , CW_QUEUE = 20480, CW_GRP = 20480  , CW_GRPBAD = 20496  , CW_ZEROS = 24576  ;

constexpr int RING_OFF = 0, RING_BYTES = 131072;
constexpr int LDSCTL_OFF = RING_BYTES, MISC_OFF = 147456 - 256, LSEB_OFF = MISC_OFF - 6144;
constexpr int LDS_BYTES = 147456;

constexpr int PH_PRO = 0, PH_CONV = 1, PH_L0 = 2, PH_PER_LAYER = 5, PH_FINAL = PH_L0 + DEPTH * PH_PER_LAYER, NPHASES = PH_FINAL + 1;
#ifndef PROBE_DUP
#define PROBE_DUP 0
#endif
#ifndef PROBE_CUT
#define PROBE_CUT 0
#endif
#ifndef PROBE_MIXSEL
#define PROBE_MIXSEL 0
#endif
#ifndef PROBE_NOSTORE
#define PROBE_NOSTORE 0
#endif
#ifndef MK_ONE_LAUNCH
#define MK_ONE_LAUNCH 1
#endif

struct Frame {
    LAS unsigned char* lds;
    volatile LAS unsigned* MISC;
    gu32* ctl;
    int tid, lane, wave, G, vcu;
};

__device__ __forceinline__ float wave_sum(float v) {
#pragma unroll
    for (int o = 1; o < 64; o <<= 1) v += __shfl_xor(v, o);
    return v;
}
__device__ __forceinline__ float bf2f(unsigned short b) { return __uint_as_float((unsigned)b << 16); }
__device__ __forceinline__ float zero_() { float z; asm volatile("v_mov_b32 %0, 0" : "=v"(z)); return z; }
__device__ __forceinline__ f32x4 zero4_() { const float z = zero_(); return (f32x4){z, z, z, z}; }

__device__ __forceinline__ void tr_item(const float* W, int N, int k0, int n0, bf16* WT, int ldt, int drow0, float scale, LAS float* scr, int lane, bool img = true) {
#pragma unroll 8
    for (int i = 0; i < 32; ++i) { const int kk = 2 * i + (lane >> 5); scr[kk * 33 + (lane & 31)] = __builtin_nontemporal_load(W + (size_t)(k0 + kk) * N + n0 + (lane & 31)); }
    LDS_WAIT(); asm volatile("" ::: "memory");
    const int c = lane & 7;
#pragma unroll
    for (int j = 0; j < 4; ++j) { const int n = (lane >> 3) + 8 * j; const LAS float* s = scr + (8 * c) * 33 + n;
        v4u o; o.x = pk2(s[0 * 33] * scale, s[1 * 33] * scale); o.y = pk2(s[2 * 33] * scale, s[3 * 33] * scale); o.z = pk2(s[4 * 33] * scale, s[5 * 33] * scale); o.w = pk2(s[6 * 33] * scale, s[7 * 33] * scale);
        if (img) *(GAS v4u*)((unsigned char*)WT + pg8::img_off(drow0 + n, k0 + 8 * c, ldt / 64, true)) = o;
        else *(GAS v4u*)(WT + (size_t)(drow0 + n) * ldt + k0 + 8 * c) = o; }
    LDS_WAIT(); asm volatile("" ::: "memory");
}
constexpr int TI_IN = 16 * 64, TI_OUT = 16 * 32, TI_G = 16 * 88, TI_DN = 44 * 32, TI_P = 8, TI_LAYER = TI_IN + TI_OUT + 2 * TI_G + TI_DN + TI_P;
__device__ __forceinline__ void weight_item(const float* const* in, unsigned char* ws, int it, LAS float* scr, int lane) {
    const int l = it / TI_LAYER; int r = it % TI_LAYER;
    unsigned char* wl = ws + WS_W + (size_t)l * W_LAYER;
    if (r < TI_IN) { const int kb = r / 64, n0 = 32 * (r % 64); const bool isq = (n0 >= O_QB && n0 < O_KB) || (n0 >= O_QC && n0 < O_KC);
        tr_item(in[6] + (size_t)l * D * INW, INW, 64 * kb, n0, (bf16*)(wl + W_IN), D, n0, isq ? QSCALE : 1.0f, scr, lane); return; }
    r -= TI_IN;
    if (r < TI_OUT) { const int kb = r / 32, n0 = 32 * (r % 32); tr_item(in[10] + (size_t)l * D * D, D, 64 * kb, n0, (bf16*)(wl + W_OUT), D, n0, 1.0f, scr, lane); return; }
    r -= TI_OUT;
    if (r < 2 * TI_G) { const int up = r >= TI_G; if (up) r -= TI_G; const int kb = r / 88, n0 = 32 * (r % 88);
        tr_item(in[up ? 12 : 11] + (size_t)l * D * DFF, DFF, 64 * kb, n0, (bf16*)(wl + W_GU), D, 256 * (n0 >> 7) + 128 * up + (n0 & 127), 1.0f, scr, lane); return; }
    r -= 2 * TI_G;
    if (r < TI_DN) { const int kb = r / 32, n0 = 32 * (r % 32); tr_item(in[13] + (size_t)l * DFF * D, D, 64 * kb, n0, (bf16*)(wl + W_DN), DFF, n0, 1.0f, scr, lane); return; }
    r -= TI_DN;
    { const int g = r >> 1, n0 = 32 * (r & 1); tr_item(in[7] + (size_t)l * 16384 + g * 4096, 64, 0, n0, (bf16*)(wl + W_PT) + g * 4096, 64, n0, 1.0f, scr, lane, false); }
}
__device__ __forceinline__ void ada_item(Frame& F, const float* const* in, unsigned char* ws, int item) {
    LAS float* cact = (LAS float*)(F.lds);
    LAS float* red = (LAS float*)(F.lds + 16384);
    const int l = item / 96, cb = item % 96;
    const float* c = in[1];
    for (int i = F.tid; i < BATCH * D; i += NWAVES * 64) { const int b = i >> 10, k = i & 1023; const float v = c[i]; cact[k * 4 + b] = v / (1.0f + __expf(-v)); }
    __syncthreads();
    const float* W = in[4] + (size_t)l * D * (NMOD * D) + 64 * cb + F.lane;
    float a0 = 0.f, a1 = 0.f, a2 = 0.f, a3 = 0.f;
    const int kbeg = 128 * F.wave;
#pragma unroll 16
    for (int kk = 0; kk < 128; ++kk) { const float wv = __builtin_nontemporal_load(W + (size_t)(kbeg + kk) * (NMOD * D)); const f32x4 ca = *(const LAS f32x4*)(cact + (kbeg + kk) * 4);
        a0 += ca.x * wv; a1 += ca.y * wv; a2 += ca.z * wv; a3 += ca.w * wv; }
    red[(F.wave * 4 + 0) * 64 + F.lane] = a0; red[(F.wave * 4 + 1) * 64 + F.lane] = a1; red[(F.wave * 4 + 2) * 64 + F.lane] = a2; red[(F.wave * 4 + 3) * 64 + F.lane] = a3;
    __syncthreads();
    if (F.wave < 4) { float s = in[5][(size_t)l * NMOD * D + 64 * cb + F.lane];
#pragma unroll
        for (int w = 0; w < 8; ++w) s += red[(w * 4 + F.wave) * 64 + F.lane];
        ((float*)(ws + WS_MOD))[((size_t)l * BATCH + F.wave) * (NMOD * D) + 64 * cb + F.lane] = s; }
    __syncthreads();
}
__device__ __forceinline__ void p_prologue(Frame& F, const float* const* in, unsigned char* ws) {
    for (int item = blockIdx.x; item < DEPTH * 96; item += F.G) ada_item(F, in, ws, item);
    LAS float* scr = (LAS float*)(F.lds + RING_OFF + F.wave * 16384);
    const int gw = blockIdx.x * NWAVES + F.wave, NGW = F.G * NWAVES;
    for (int it = gw; it < DEPTH * TI_LAYER; it += NGW) weight_item(in, ws, it, scr, F.lane);
    { GAS f32x4* z = (GAS f32x4*)(ws + WS_SUMSQ) + M / 4; const int n4 = 4 * M / 4;
      for (int i = blockIdx.x * (NWAVES * 64) + F.tid; i < n4; i += F.G * NWAVES * 64) z[i] = zero4_(); }
}

__device__ __forceinline__ void p_conv(Frame& F, const float* const* in, unsigned char* ws) {
    const float* MOD = (const float*)(ws + WS_MOD);
    const int NGW = F.G * NWAVES, rpw = M / NGW;
    const int gw = (F.G == 256) ? (((int)blockIdx.x & 7) * 32 + ((int)blockIdx.x >> 3)) * NWAVES + F.wave : (int)blockIdx.x * NWAVES + F.wave;
    {
        const int row0 = gw * rpw, b = row0 / SEQ;
        const float* mb = MOD + (size_t)b * (NMOD * D);
        const float* xin = in[0]; bf16* hout = (bf16*)(ws + WS_H); float* ssq = (float*)(ws + WS_SUMSQ);
        f32x4 Gv[4];
#pragma unroll
        for (int j = 0; j < 4; ++j) { const int cidx = 4 * F.lane + 256 * j; const f32x4 g = *(const f32x4*)(in[2] + cidx), sc = *(const f32x4*)(mb + 1 * D + cidx); Gv[j] = g * (sc + 1.0f); }
        for (int rr = 0; rr < rpw; rr += 4) {
            f32x4 v[4][4];
#pragma unroll
            for (int i = 0; i < 4; ++i) { const GAS f32x4* xr = (const GAS f32x4*)(xin + (size_t)(row0 + rr + i) * D) + F.lane;
#pragma unroll
                for (int j = 0; j < 4; ++j) v[i][j] = __builtin_nontemporal_load(xr + 64 * j); }
#pragma unroll
            for (int i = 0; i < 4; ++i) { const size_t row = (size_t)(row0 + rr + i); float s = 0.f;
#pragma unroll
                for (int j = 0; j < 4; ++j) s += (v[i][j].x * v[i][j].x + v[i][j].y * v[i][j].y) + (v[i][j].z * v[i][j].z + v[i][j].w * v[i][j].w);
                s = wave_sum(s); if (F.lane == 0) ssq[row] = s;
                unsigned char* hb = (unsigned char*)hout + 8 * (F.lane & 1);
#pragma unroll
                for (int j = 0; j < 4; ++j) { const f32x4 o = v[i][j] * Gv[j]; *(GAS unsigned long long*)(hb + pg8::img_off((int)row, (4 * F.lane + 256 * j) & ~7, D / 64, false)) = (unsigned long long)pk2(o.x, o.y) | ((unsigned long long)pk2(o.z, o.w) << 32);
 } }
        }
    }
    {
        float* GV = (float*)(ws + WS_GV);
        for (int i = blockIdx.x * (NWAVES * 64) + F.tid; i < DEPTH * 2 * BATCH * D; i += F.G * NWAVES * 64) { const int col = i & (D - 1), b = (i >> 10) & 3, w = (i >> 12) & 1, l = i >> 13;
            GV[i] = in[w ? 3 : 2][l * D + col] * (1.0f + MOD[((size_t)l * BATCH + b) * (NMOD * D) + (w ? 4 : 1) * D + col]); }
    }
    {
        const int g0 = 8 * gw;
        if (g0 < DEPTH * (INW + 2 * DFF)) {
            const int l = g0 / (INW + 2 * DFF), rl = g0 % (INW + 2 * DFF), w = rl >= INW, n0 = w ? rl - INW : rl, N = w ? 2 * DFF : INW;
            const unsigned char* Bt = ws + WS_W + (size_t)l * W_LAYER + (w ? W_GU : W_IN);
            float* bias = (float*)(ws + WS_BIAS + (size_t)l * BIAS_LAYER) + (w ? BATCH * INW : 0);
            const float* shp = MOD + (size_t)l * BATCH * (NMOD * D) + (w ? 3 : 0) * D + 16 * F.lane;
            v4u wr[8][2];
#pragma unroll
            for (int i = 0; i < 8; ++i) { wr[i][0] = *(const GAS v4u*)(Bt + pg8::img_off(n0 + i, 16 * F.lane, D / 64, true)); wr[i][1] = *(const GAS v4u*)(Bt + pg8::img_off(n0 + i, 16 * F.lane + 8, D / 64, true)); }
            f32x4 sh[4][4];
#pragma unroll
            for (int b = 0; b < 4; ++b)
#pragma unroll
                for (int j = 0; j < 4; ++j) sh[b][j] = *(const f32x4*)(shp + (size_t)b * (NMOD * D) + 4 * j);
#pragma unroll
            for (int i = 0; i < 8; ++i) { const v4u w0 = wr[i][0], w1 = wr[i][1];
                float wf[16];
                wf[0] = __uint_as_float(w0.x << 16); wf[1] = __uint_as_float(w0.x & 0xffff0000u); wf[2] = __uint_as_float(w0.y << 16); wf[3] = __uint_as_float(w0.y & 0xffff0000u);
                wf[4] = __uint_as_float(w0.z << 16); wf[5] = __uint_as_float(w0.z & 0xffff0000u); wf[6] = __uint_as_float(w0.w << 16); wf[7] = __uint_as_float(w0.w & 0xffff0000u);
                wf[8] = __uint_as_float(w1.x << 16); wf[9] = __uint_as_float(w1.x & 0xffff0000u); wf[10] = __uint_as_float(w1.y << 16); wf[11] = __uint_as_float(w1.y & 0xffff0000u);
                wf[12] = __uint_as_float(w1.z << 16); wf[13] = __uint_as_float(w1.z & 0xffff0000u); wf[14] = __uint_as_float(w1.w << 16); wf[15] = __uint_as_float(w1.w & 0xffff0000u);
                float acc[4];
#pragma unroll
                for (int b = 0; b < 4; ++b) { float a = 0.f;
#pragma unroll
                    for (int j = 0; j < 4; ++j) a += (wf[4 * j] * sh[b][j].x + wf[4 * j + 1] * sh[b][j].y) + (wf[4 * j + 2] * sh[b][j].z + wf[4 * j + 3] * sh[b][j].w);
                    acc[b] = wave_sum(a); }
                if (F.lane < 4) bias[(size_t)F.lane * N + n0 + i] = F.lane == 0 ? acc[0] : F.lane == 1 ? acc[1] : F.lane == 2 ? acc[2] : acc[3]; }
        }
    }
}
__device__ __forceinline__ void p_norm_final(Frame& F, const bf16* xin, const float* ssq, float* out, const float* gvec) {
    const int NGW = F.G * NWAVES, rpw = M / NGW;
    const int gw = (F.G == 256) ? (((int)blockIdx.x & 7) * 32 + ((int)blockIdx.x >> 3)) * NWAVES + F.wave : (int)blockIdx.x * NWAVES + F.wave;
    const int row0 = gw * rpw;
    f32x4 Gv[4];
#pragma unroll
    for (int j = 0; j < 4; ++j) Gv[j] = *(const f32x4*)(gvec + 4 * F.lane + 256 * j);
    for (int rr = 0; rr < rpw; rr += 4) {
        unsigned long long w[4][4]; float ss[4];
#pragma unroll
        for (int i = 0; i < 4; ++i) { const unsigned char* xr = (const unsigned char*)xin + 8 * (F.lane & 1); ss[i] = ssq[row0 + rr + i];
#pragma unroll
            for (int j = 0; j < 4; ++j) w[i][j] = *(const GAS unsigned long long*)(xr + pg8::img_off(row0 + rr + i, (4 * F.lane + 256 * j) & ~7, D / 64, false)); }
#pragma unroll
        for (int i = 0; i < 4; ++i) { const float rstd = 1.0f / sqrtf(ss[i] * (1.0f / D) + RMS_EPS);
            GAS f32x4* o = (GAS f32x4*)(out + (size_t)(row0 + rr + i) * D) + F.lane;
#pragma unroll
            for (int j = 0; j < 4; ++j) { const unsigned wl = (unsigned)w[i][j], wh = (unsigned)(w[i][j] >> 32);
                const f32x4 v = {pg8::h_lo(wl), pg8::h_hi(wl), pg8::h_lo(wh), pg8::h_hi(wh)};
                __builtin_nontemporal_store(v * rstd * Gv[j], o + 64 * j); } }
    }
}

namespace mx {
typedef short bf16x8 __attribute__((ext_vector_type(8)));
typedef short s16x4 __attribute__((ext_vector_type(4)));
typedef float f32x16 __attribute__((ext_vector_type(16)));
typedef unsigned u32x4 __attribute__((ext_vector_type(4)));
typedef unsigned u32x2 __attribute__((ext_vector_type(2)));
typedef float f32x2_t __attribute__((ext_vector_type(2))); typedef __bf16 bf16x2_t __attribute__((ext_vector_type(2)));
constexpr float THR = 8.0f;
constexpr int POOL_PITCH = 544;
__device__ __forceinline__ unsigned cvtpk(float lo, float hi) { f32x2_t v = {lo, hi}; bf16x2_t b = __builtin_convertvector(v, bf16x2_t); return __builtin_bit_cast(unsigned, b); }
__device__ __forceinline__ float hswap_max(float v) { auto rr = __builtin_amdgcn_permlane32_swap(__float_as_uint(v), __float_as_uint(v), false, false); return fmaxf(__uint_as_float(rr[0]), __uint_as_float(rr[1])); }
__device__ __forceinline__ float hswap_sum(float v) { auto rr = __builtin_amdgcn_permlane32_swap(__float_as_uint(v), __float_as_uint(v), false, false); return __uint_as_float(rr[0]) + __uint_as_float(rr[1]); }
__device__ __forceinline__ s16x4 vtr(const LAS char* p) { return __builtin_bit_cast(s16x4, __builtin_amdgcn_ds_read_tr16_b64_v4i16((LAS s16x4*)p)); }
__device__ __forceinline__ f32x16 zero16_() { const float z = zero_(); return (f32x16){z, z, z, z, z, z, z, z, z, z, z, z, z, z, z, z}; }
__device__ __forceinline__ int kt_of(int i) { return (i & 1) ? -((i + 1) >> 1) : (i >> 1); }

template <int VAR>
__device__ __forceinline__ float scores(f32x16& t, const bf16x8 (&kf)[4], const bf16x8 (&qf)[4], float relf, float sl, float slope2, float Rf) {
    f32x16 s = {0.f, 0.f, 0.f, 0.f, 0.f, 0.f, 0.f, 0.f, 0.f, 0.f, 0.f, 0.f, 0.f, 0.f, 0.f, 0.f};
#pragma unroll
    for (int i = 0; i < 4; ++i) s = __builtin_amdgcn_mfma_f32_32x32x16_bf16(kf[i], qf[i], s, 0, 0, 0);
    if (VAR == 0) {
#pragma unroll
        for (int r = 0; r < 16; ++r) t[r] = __builtin_fmaf(-__builtin_fabsf(relf - (float)((r & 3) + 8 * (r >> 2))), slope2, s[r]);
        return 0.f;
    } else {
#pragma unroll
        for (int r = 0; r < 16; ++r) { const float c = (float)((r & 3) + 8 * (r >> 2)); float v = __builtin_fmaf(sl, c, s[r]); if (VAR == 2) v = __builtin_fabsf(relf - c) > Rf ? -INFINITY : v; t[r] = v; }
        return -sl * relf;
    }
}
__device__ __forceinline__ float lane_max(const f32x16& t) {
    float a = fmaxf(fmaxf(t[0], t[1]), fmaxf(t[2], t[3])), b = fmaxf(fmaxf(t[4], t[5]), fmaxf(t[6], t[7])), c = fmaxf(fmaxf(t[8], t[9]), fmaxf(t[10], t[11])), d = fmaxf(fmaxf(t[12], t[13]), fmaxf(t[14], t[15]));
    return fmaxf(fmaxf(a, b), fmaxf(c, d));
}
__device__ __forceinline__ float tile_max(const f32x16& t) {
    float a = fmaxf(fmaxf(t[0], t[1]), fmaxf(t[2], t[3])), b = fmaxf(fmaxf(t[4], t[5]), fmaxf(t[6], t[7])), c = fmaxf(fmaxf(t[8], t[9]), fmaxf(t[10], t[11])), d = fmaxf(fmaxf(t[12], t[13]), fmaxf(t[14], t[15]));
    return hswap_max(fmaxf(fmaxf(a, b), fmaxf(c, d)));
}
__device__ __forceinline__ void load_frag4(bf16x8 (&f)[4], const bf16* rowp, int hi) {
#pragma unroll
    for (int i = 0; i < 4; ++i) f[i] = *(const bf16x8*)(rowp + 16 * i + 8 * hi);
}
__device__ __forceinline__ void load_tile_frags(bf16x8 (&f)[4], const char* tile, int lane) {
#pragma unroll
    for (int s = 0; s < 4; ++s) f[s] = *(const bf16x8*)(tile + s * 1024 + lane * 16);
}
__device__ __forceinline__ void dma_tile(LAS char* dst, const char* tile, int lane) {
#pragma unroll
    for (int j = 0; j < 4; ++j) __builtin_amdgcn_global_load_lds((const unsigned*)(tile + j * 1024 + lane * 16), (LAS unsigned*)(dst + j * 1024), 16, 0, 0);
}
__device__ __forceinline__ void dma_v(LAS char* vb, const bf16* vrow0, long rs, int lane) {
#pragma unroll
    for (int j = 0; j < 4; ++j) __builtin_amdgcn_global_load_lds((const unsigned*)(vrow0 + (long)(16 * (j & 1) + (lane >> 2)) * rs + (4 * (j >> 1) + (lane & 3)) * 8), (LAS unsigned*)(vb + j * 1024), 16, 0, 0);
}
__device__ __forceinline__ void load_vfrags(bf16x8 (&vf)[2][2], const LAS char* vaddr) {
#pragma unroll
    for (int d0 = 0; d0 < 2; ++d0)
#pragma unroll
        for (int ks = 0; ks < 2; ++ks) { const s16x4 lo = vtr(vaddr + d0 * 2048 + ks * 1024), hh = vtr(vaddr + d0 * 2048 + ks * 1024 + 512);
            vf[d0][ks] = (bf16x8){lo[0], lo[1], lo[2], lo[3], hh[0], hh[1], hh[2], hh[3]}; }
}
__device__ __forceinline__ void pv_tile(f32x16 (&o)[2], const bf16x8 (&vf)[2][2], const f32x16& p) {
    u32x4 w0, w1;
    w0.x = cvtpk(p[0], p[1]); w0.y = cvtpk(p[2], p[3]); w0.z = cvtpk(p[4], p[5]); w0.w = cvtpk(p[6], p[7]);
    w1.x = cvtpk(p[8], p[9]); w1.y = cvtpk(p[10], p[11]); w1.z = cvtpk(p[12], p[13]); w1.w = cvtpk(p[14], p[15]);
    const bf16x8 pa0 = __builtin_bit_cast(bf16x8, w0), pa1 = __builtin_bit_cast(bf16x8, w1);
#pragma unroll
    for (int d0 = 0; d0 < 2; ++d0) { o[d0] = __builtin_amdgcn_mfma_f32_32x32x16_bf16(vf[d0][0], pa0, o[d0], 0, 0, 0); o[d0] = __builtin_amdgcn_mfma_f32_32x32x16_bf16(vf[d0][1], pa1, o[d0], 0, 0, 0); }
}
__device__ __forceinline__ void store_o(bf16* MIX, int row, int col, const f32x16 (&o)[2], float scale, int hi) {
#pragma unroll
    for (int d0 = 0; d0 < 2; ++d0)
#pragma unroll
        for (int g = 0; g < 4; g += 2) {
            const unsigned ax = cvtpk(o[d0][4 * g] * scale, o[d0][4 * g + 1] * scale), ay = cvtpk(o[d0][4 * g + 2] * scale, o[d0][4 * g + 3] * scale);
            const unsigned bx = cvtpk(o[d0][4 * g + 4] * scale, o[d0][4 * g + 5] * scale), by = cvtpk(o[d0][4 * g + 6] * scale, o[d0][4 * g + 7] * scale);
            const auto rx = __builtin_amdgcn_permlane32_swap(ax, bx, false, false); const auto ry = __builtin_amdgcn_permlane32_swap(ay, by, false, false);
            u32x4 w; w.x = rx[0]; w.y = ry[0]; w.z = rx[1]; w.w = ry[1];
            *(u32x4*)((unsigned char*)MIX + pg8::img_off(row, col + 32 * d0 + 8 * g + 8 * hi, D / 64, false)) = w; }
}
__device__ __forceinline__ void pack_o(u32x4 (&w)[4], const f32x16 (&o)[2], float scale) {
#pragma unroll
    for (int d0 = 0; d0 < 2; ++d0)
#pragma unroll
        for (int g = 0; g < 4; g += 2) {
            const unsigned ax = cvtpk(o[d0][4 * g] * scale, o[d0][4 * g + 1] * scale), ay = cvtpk(o[d0][4 * g + 2] * scale, o[d0][4 * g + 3] * scale);
            const unsigned bx = cvtpk(o[d0][4 * g + 4] * scale, o[d0][4 * g + 5] * scale), by = cvtpk(o[d0][4 * g + 6] * scale, o[d0][4 * g + 7] * scale);
            const auto rx = __builtin_amdgcn_permlane32_swap(ax, bx, false, false); const auto ry = __builtin_amdgcn_permlane32_swap(ay, by, false, false);
            w[2 * d0 + (g >> 1)] = (u32x4){rx[0], ry[0], rx[1], ry[1]}; }
}
__device__ __forceinline__ float alibi_slope(int k  ) { return __builtin_amdgcn_exp2f(-8.0f * (float)(k + 1) / 12.0f); }
__device__ __forceinline__ void scale_o(f32x16 (&o)[2], float f) {
#pragma unroll
    for (int r = 0; r < 16; ++r) { o[0][r] *= f; o[1][r] *= f; }
}

template <bool FIRST, bool WITH_O>
__device__ __forceinline__ void step_rest(f32x16 (&o)[2], float& m, float& l, f32x16& t, float off, const bf16x8 (&vf)[2][2]) {
    const float tm = hswap_max(lane_max(t) + off);
    if (FIRST) m = tm;
    else if (__any(tm - m > THR)) { const float dl = fmaxf(tm - m, 0.f), f = __builtin_amdgcn_exp2f(-dl); l *= f; if (WITH_O) scale_o(o, f); m += dl; }
    const float bm = off - m; f32x2_t ps = {0.f, 0.f}; const f32x2_t bm2 = {bm, bm};
#pragma unroll
    for (int r = 0; r < 16; r += 2) { const f32x2_t x = (f32x2_t){t[r], t[r + 1]} + bm2; t[r] = __builtin_amdgcn_exp2f(x.x); t[r + 1] = __builtin_amdgcn_exp2f(x.y); ps += (f32x2_t){t[r], t[r + 1]}; }
    l += ps.x + ps.y;
    if (WITH_O) pv_tile(o, vf, t);
}
template <int VAR, bool FIRST, bool WITH_O>
__device__ __forceinline__ void step(f32x16 (&o)[2], float& m, float& l, const bf16x8 (&kf)[4], const bf16x8 (&qf)[4], const bf16x8 (&vf)[2][2], float relf, float sl, float slope2, float Rf) {
    f32x16 t; const float off = scores<VAR>(t, kf, qf, relf, sl, slope2, Rf);
    step_rest<FIRST, WITH_O>(o, m, l, t, off, vf);
}

__device__ __forceinline__ void pair_rest(f32x16 (&o)[2], float& m, float& l, f32x16& tL, f32x16& tR, float offL, float offR, const LAS char* vL, const LAS char* vR) {
    const float tm = hswap_max(fmaxf(lane_max(tL) + offL, lane_max(tR) + offR));
    if (__any(tm - m > THR)) { const float dl = fmaxf(tm - m, 0.f), f = __builtin_amdgcn_exp2f(-dl); l *= f; scale_o(o, f); m += dl; }
    const float bL = offL - m, bR = offR - m; f32x2_t ps = {0.f, 0.f}; const f32x2_t bL2 = {bL, bL}, bR2 = {bR, bR};
#pragma unroll
    for (int r = 0; r < 16; r += 2) { const f32x2_t xL = (f32x2_t){tL[r], tL[r + 1]} + bL2, xR = (f32x2_t){tR[r], tR[r + 1]} + bR2;
        tL[r] = __builtin_amdgcn_exp2f(xL.x); tL[r + 1] = __builtin_amdgcn_exp2f(xL.y); tR[r] = __builtin_amdgcn_exp2f(xR.x); tR[r + 1] = __builtin_amdgcn_exp2f(xR.y);
        ps += (f32x2_t){tL[r], tL[r + 1]}; ps += (f32x2_t){tR[r], tR[r + 1]}; }
    l += ps.x + ps.y;
    { bf16x8 vf[2][2]; load_vfrags(vf, vL); pv_tile(o, vf, tL); }
    { bf16x8 vf[2][2]; load_vfrags(vf, vR); pv_tile(o, vf, tR); }
}
template <int VAR>
__device__ __forceinline__ void step_pair_lds(f32x16 (&o)[2], float& m, float& l, const LAS char* kL, const LAS char* kR, const LAS char* vL, const LAS char* vR, bf16x8 (&qf)[4],
                                              float relfL, float relfR, float slope2, float Rf, const char* qnext = nullptr, int lane = 0) {
    f32x16 tL, tR; float offL, offR;
    { bf16x8 kf[4];
#pragma unroll
      for (int s = 0; s < 4; ++s) kf[s] = *(const LAS bf16x8*)(kL + s * 1024);
      offL = scores<VAR>(tL, kf, qf, relfL, slope2, slope2, Rf); }
    { bf16x8 kf[4];
#pragma unroll
      for (int s = 0; s < 4; ++s) kf[s] = *(const LAS bf16x8*)(kR + s * 1024);
      offR = scores<VAR>(tR, kf, qf, relfR, -slope2, slope2, Rf); }
    if (qnext) load_tile_frags(qf, qnext, lane);
    pair_rest(o, m, l, tL, tR, offL, offR, vL, vR);
}
template <int VAR>
__device__ __forceinline__ void step_pair_regk(f32x16 (&o)[2], float& m, float& l, const bf16x8 (&kfL)[4], const bf16x8 (&kfR)[4], const LAS char* vL, const LAS char* vR, const bf16x8 (&qf)[4],
                                               float relfL, float relfR, float slope2, float Rf) {
    f32x16 tL, tR; const float offL = scores<VAR>(tL, kfL, qf, relfL, slope2, slope2, Rf), offR = scores<VAR>(tR, kfR, qf, relfR, -slope2, slope2, Rf);
    pair_rest(o, m, l, tL, tR, offL, offR, vL, vR);
}

__device__ __forceinline__ void dma_k(LAS char* kb, const bf16* krow0, long rs, int lane) {
#pragma unroll
    for (int s = 0; s < 4; ++s) __builtin_amdgcn_global_load_lds((const unsigned*)(krow0 + (long)(lane & 31) * rs + 16 * s + 8 * (lane >> 5)), (LAS unsigned*)(kb + s * 1024), 16, 0, 0);
}
struct BTile { const char* qb; const char* kb; const char* vb; int nt  , t0  , n0, head, d, r, tl; float slope2; };
__device__ __forceinline__ BTile b_decode(const char* ZB, int b, int c, int j, int qi, int q) {
    BTile t; const int g = qi >> 4, i = qi & 15, lg = 2 * g; t.d = 1 << lg;
    t.r = i >> (4 - lg); const int isub = i & ((16 >> lg) - 1); t.n0 = ((512 * c) >> lg) + 32 * isub; t.nt = 256 >> lg; t.t0 = t.n0 >> 5;
    t.head = 2 * g + j; t.slope2 = alibi_slope(6 + t.head) * (float)t.d * LOG2E;
    const size_t tb = (size_t)(t.head * 4 + b) * 256 + ((size_t)t.r << (8 - lg));
    t.qb = ZB + (tb << 12); t.kb = ZB + ((tb + 6 * 4 * 256) << 12); t.vb = ZB + ((tb + 2 * 6 * 4 * 256) << 12);
    t.tl = g * 512 + (32 * isub + q) * t.d + t.r;
    return t;
}
__device__ __forceinline__ void b_issue_qk(const BTile& t, bf16x8 (&qf)[4], bf16x8 (&kf)[5][4], bool (&val)[5], int (&kc)[5], int lane) {
    load_tile_frags(qf, t.qb + ((size_t)t.t0 << 12), lane);
#pragma unroll
    for (int i = 0; i < 5; ++i) { const int kt = t.t0 + kt_of(i); val[i] = kt >= 0 && kt < t.nt; kc[i] = kt < 0 ? 0 : (kt >= t.nt ? t.nt - 1 : kt);
        load_tile_frags(kf[i], t.kb + ((size_t)kc[i] << 12), lane); }
}
__device__ __forceinline__ void fill_ninf(f32x16& t) {
#pragma unroll
    for (int r = 0; r < 16; ++r) t[r] = -INFINITY;
}
__device__ __forceinline__ float b_qtile(f32x16 (&o)[2], const BTile& t, const BTile& tn, bool has_next, bf16x8 (&qf)[4], bf16x8 (&kf)[5][4], bool (&val)[5], int (&kc)[5], LAS char* vb, int lane) {
    const int q = lane & 31, hi = lane >> 5;
    const float slope2 = t.slope2;
    const LAS char* vaddr = vb + (4 * hi + ((lane & 15) >> 2)) * 64 + ((lane >> 4) & 1) * 32 + (lane & 3) * 8;
    float m = 0.f, l = 0.f;
    {
        bf16x8 vf[2][2]; load_vfrags(vf, vaddr);
        asm volatile("s_waitcnt lgkmcnt(0)" ::: "memory"); dma_tile(vb, t.vb + ((size_t)kc[4] << 12), lane);
        step<0, true, true>(o, m, l, kf[0], qf, vf, (float)(q - 4 * hi), slope2, slope2, 64.0f); }
    {
        f32x16 tL, tR; const float offL = scores<1>(tL, kf[1], qf, (float)(q + 32 - 4 * hi), slope2, slope2, 64.0f), offR = scores<1>(tR, kf[2], qf, (float)(q - 32 - 4 * hi), -slope2, slope2, 64.0f);
        if (!val[1]) fill_ninf(tL); if (!val[2]) fill_ninf(tR);
        pair_rest(o, m, l, tL, tR, offL, offR, vaddr + 4096, vaddr + 8192); }
    asm volatile("s_waitcnt vmcnt(0)" ::: "memory");
    {
        f32x16 tL, tR; const float offL = scores<2>(tL, kf[3], qf, (float)(q + 64 - 4 * hi), slope2, slope2, 64.0f), offR = scores<2>(tR, kf[4], qf, (float)(q - 64 - 4 * hi), -slope2, slope2, 64.0f);
        if (!val[3]) fill_ninf(tL); if (!val[4]) fill_ninf(tR);
        if (has_next) {
            asm volatile("s_waitcnt lgkmcnt(0)" ::: "memory");
            b_issue_qk(tn, qf, kf, val, kc, lane);
            dma_tile(vb + 4096, tn.vb + ((size_t)kc[1] << 12), lane); dma_tile(vb + 8192, tn.vb + ((size_t)kc[2] << 12), lane); }
        pair_rest(o, m, l, tL, tR, offL, offR, vaddr + 12288, vaddr);
        if (has_next) { asm volatile("s_waitcnt lgkmcnt(0)" ::: "memory");
            dma_tile(vb, tn.vb + ((size_t)kc[0] << 12), lane); dma_tile(vb + 12288, tn.vb + ((size_t)kc[3] << 12), lane); } }
    const float lt = hswap_sum(l);
    scale_o(o, 1.0f / lt);
    return m + __builtin_amdgcn_logf(lt);
}
__device__ __forceinline__ void b_unit(const char* ZB, bf16* MIX, char* SCR, int u, LAS char* lds, int wave, int lane) {
    const int b = u >> 5, c = (u >> 1) & 15, j = u & 1;
    LAS float* lseb = (LAS float*)(lds + LSEB_OFF);
    LAS char* vb = lds + wave * 16384;
    char* scr = SCR + ((size_t)(u * 8 + wave) * 6 << 12) + lane * 16;
    const int q = lane & 31, hi = lane >> 5;
    bf16x8 qf[4], kf[5][4]; bool val[5]; int kc[5];
    BTile t = b_decode(ZB, b, c, j, wave, q);
    b_issue_qk(t, qf, kf, val, kc, lane);
#pragma unroll
    for (int i = 0; i < 4; ++i) dma_tile(vb + i * 4096, t.vb + ((size_t)kc[i] << 12), lane);
#pragma unroll 1
    for (int it = 0; it < 6; ++it) { const bool has_next = it < 5; const BTile tn = b_decode(ZB, b, c, j, wave + 8 * (has_next ? it + 1 : it), q);
        if (it == 0) asm volatile("s_waitcnt vmcnt(0)" ::: "memory"); else asm volatile("s_waitcnt vmcnt(4)" ::: "memory");
        f32x16 o[2]; o[0] = zero16_(); o[1] = zero16_();
        const float lse = b_qtile(o, t, tn, has_next, qf, kf, val, kc, vb, lane);
        if (hi == 0) lseb[t.tl] = lse;
        u32x4 w[4]; pack_o(w, o, 1.0f);
#pragma unroll
        for (int k = 0; k < 4; ++k) *(u32x4*)(scr + ((size_t)it << 12) + k * 1024) = w[k];
        t = tn; }
    __syncthreads();
#pragma unroll 1
    for (int it0 = 0; it0 < 6; it0 += 3) { u32x4 w[3][4];
#pragma unroll
        for (int ii = 0; ii < 3; ++ii)
#pragma unroll
            for (int k = 0; k < 4; ++k) w[ii][k] = *(const u32x4*)(scr + ((size_t)(it0 + ii) << 12) + k * 1024);
#pragma unroll
        for (int ii = 0; ii < 3; ++ii) { const BTile tt = b_decode(ZB, b, c, j, wave + 8 * (it0 + ii), q);
            const int tk = tt.tl & 511; const float l0 = lseb[tk], l1 = lseb[512 + tk], l2 = lseb[1024 + tk], own = lseb[tt.tl]; const float mm = fmaxf(l0, fmaxf(l1, l2));
            const float a = __builtin_amdgcn_exp2f(own - mm) / (__builtin_amdgcn_exp2f(l0 - mm) + __builtin_amdgcn_exp2f(l1 - mm) + __builtin_amdgcn_exp2f(l2 - mm));
            const int orow = b * SEQ + (tt.n0 + q) * tt.d + tt.r, ocol = 256 + 64 * tt.head + 8 * hi;
#pragma unroll
            for (int k = 0; k < 4; ++k) { const u32x4 x = w[ii][k]; u32x4 y;
                y.x = cvtpk(__uint_as_float(x.x << 16) * a, __uint_as_float(x.x & 0xffff0000u) * a); y.y = cvtpk(__uint_as_float(x.y << 16) * a, __uint_as_float(x.y & 0xffff0000u) * a);
                y.z = cvtpk(__uint_as_float(x.z << 16) * a, __uint_as_float(x.z & 0xffff0000u) * a); y.w = cvtpk(__uint_as_float(x.w << 16) * a, __uint_as_float(x.w & 0xffff0000u) * a);
                *(u32x4*)((unsigned char*)MIX + pg8::img_off(orow, ocol + 32 * (k >> 1) + 16 * (k & 1), D / 64, false)) = y; } } }
    __syncthreads();
}
__device__ __forceinline__ void c_unit(const char* ZC, bf16* MIX, const float* sink, int u, LAS char* lds, int wave, int lane) {
    const int b = u >> 6, kvh = (u >> 5) & 1, q0 = 256 * (u & 31), n0 = q0 + 32 * wave;
    const int q = lane & 31, hi = lane >> 5;
    const char* kt0 = ZC + ((size_t)((6 + kvh) * 4 + b) * 256 << 12); const char* vt0 = ZC + ((size_t)((8 + kvh) * 4 + b) * 256 << 12);
#pragma unroll
    for (int tt = 0; tt < 2; ++tt) { const int t = 2 * wave + tt, T = (q0 >> 5) - 4 + t;
        if (T >= 0 && T < SEQ / 32) { dma_tile(lds + t * 8192, kt0 + ((size_t)T << 12), lane); dma_tile(lds + t * 8192 + 4096, vt0 + ((size_t)T << 12), lane); } }
    const char* qt0 = ZC + (((size_t)((3 * kvh) * 4 + b) * 256 + (n0 >> 5)) << 12);
    bf16x8 qf[4]; load_tile_frags(qf, qt0, lane);
    asm volatile("s_waitcnt vmcnt(0)" ::: "memory");
    __syncthreads();
    const LAS char* kbase = lds + lane * 16;
    const LAS char* vbase = lds + 4096 + (4 * hi + ((lane & 15) >> 2)) * 64 + ((lane >> 4) & 1) * 32 + (lane & 3) * 8;
#pragma unroll 1
    for (int hh = 0; hh < 3; ++hh) { const int head = 3 * kvh + hh;
        const char* qnext = hh < 2 ? qt0 + ((size_t)(hh + 1) * 4 * 256 << 12) : nullptr; bool reloaded = false;
        f32x16 o[2]; o[0] = zero16_(); o[1] = zero16_();
        float m = sink[head] * LOG2E, l = hi ? 0.f : 1.0f; const float slope2 = alibi_slope(head) * LOG2E;
        {
            const int t = wave + 4; bf16x8 kf[4];
#pragma unroll
            for (int s = 0; s < 4; ++s) kf[s] = *(const LAS bf16x8*)(kbase + t * 8192 + s * 1024);
            bf16x8 vf[2][2]; load_vfrags(vf, vbase + t * 8192);
            step<0, false, true>(o, m, l, kf, qf, vf, (float)(q - 4 * hi), slope2, slope2, 128.0f); }
#pragma unroll 1
        for (int k = 1; k <= 4; ++k) { const int tL = wave + 4 - k, tR = wave + 4 + k; const bool vL = n0 - 32 * k >= 0, vR = n0 + 32 * k < SEQ;
            const float relfL = (float)(q + 32 * k - 4 * hi), relfR = (float)(q - 32 * k - 4 * hi);
            if (vL && vR) {
                if (k < 4) step_pair_lds<1>(o, m, l, kbase + tL * 8192, kbase + tR * 8192, vbase + tL * 8192, vbase + tR * 8192, qf, relfL, relfR, slope2, 128.0f);
                else { step_pair_lds<2>(o, m, l, kbase + tL * 8192, kbase + tR * 8192, vbase + tL * 8192, vbase + tR * 8192, qf, relfL, relfR, slope2, 128.0f, qnext, lane); reloaded = true; } }
            else if (vL || vR) { const int t = vL ? tL : tR; bf16x8 kf[4];
#pragma unroll
                for (int s = 0; s < 4; ++s) kf[s] = *(const LAS bf16x8*)(kbase + t * 8192 + s * 1024);
                bf16x8 vf[2][2]; load_vfrags(vf, vbase + t * 8192);
                const float relf = vL ? relfL : relfR, sl = vL ? slope2 : -slope2;
                if (k < 4) step<1, false, true>(o, m, l, kf, qf, vf, relf, sl, slope2, 128.0f); else step<2, false, true>(o, m, l, kf, qf, vf, relf, sl, slope2, 128.0f); } }
        if (!reloaded && qnext) load_tile_frags(qf, qnext, lane);
        store_o(MIX, b * SEQ + n0 + q, 640 + 64 * head, o, 1.0f / hswap_sum(l), hi); }
    __syncthreads();
}
template <int G>
__device__ __forceinline__ void pool_group(const LAS char* rows, bf16* MIX, const bf16* wpt, const float* pscale, int row0, int tok, int kq, int lane) {
    constexpr int R = 1 << G, W = 2 * R + 1;
    int lo = tok - R, hi2 = tok + R + 1; lo = lo < 0 ? 0 : lo; hi2 = hi2 > SEQ ? SEQ : hi2; const float inv = 1.0f / (float)(hi2 - lo);
    f32x4 acc[4];
#pragma unroll
    for (int dt = 0; dt < 4; ++dt) acc[dt] = zero4_();
#pragma unroll
    for (int kb = 0; kb < 2; ++kb) { float s[8]; bf16x8 uc;
        const LAS char* rp = rows + ((lane & 15) + 8 - R) * POOL_PITCH + (8 * G + 4 * kb + kq) * 16;
#pragma unroll
        for (int e = 0; e < 8; ++e) s[e] = 0.f;
#pragma unroll
        for (int j = 0; j < W; ++j) { const int tt = tok + j - R; const float w = (tt >= 0 && tt < SEQ) ? 1.0f : 0.0f; const bf16x8 v = *(const LAS bf16x8*)(rp + j * POOL_PITCH); if (j == R) uc = v;
#pragma unroll
            for (int e = 0; e < 8; ++e) s[e] += w * bf2f((unsigned short)v[e]); }
        u32x4 pw; float pe[8];
#pragma unroll
        for (int e = 0; e < 8; ++e) pe[e] = s[e] * inv - bf2f((unsigned short)uc[e]);
        pw.x = cvtpk(pe[0], pe[1]); pw.y = cvtpk(pe[2], pe[3]); pw.z = cvtpk(pe[4], pe[5]); pw.w = cvtpk(pe[6], pe[7]);
        const bf16x8 bfrag = __builtin_bit_cast(bf16x8, pw);
#pragma unroll
        for (int dt = 0; dt < 4; ++dt) { const bf16x8 afrag = *(const bf16x8*)(wpt + (size_t)(G * 64 + dt * 16 + (lane & 15)) * 64 + kb * 32 + 8 * kq);
            acc[dt] = __builtin_amdgcn_mfma_f32_16x16x32_bf16(afrag, bfrag, acc[dt], 0, 0, 0); } }
#pragma unroll
    for (int dt = 0; dt < 4; ++dt) { const int dcol = G * 64 + dt * 16 + 4 * kq; const f32x4 sc = *(const f32x4*)(pscale + dcol);
        u32x2 w; w.x = cvtpk(acc[dt][0] * sc.x, acc[dt][1] * sc.y); w.y = cvtpk(acc[dt][2] * sc.z, acc[dt][3] * sc.w);
        *(u32x2*)((unsigned char*)MIX + pg8::img_off(row0 + (lane & 15), dcol & ~7, D / 64, false) + 2 * (dcol & 7)) = w; }
}
__device__ __forceinline__ void pool_item(const bf16* Z, bf16* MIX, const bf16* wpt, const float* pscale, int item, LAS char* rows, int lane) {
    const int row0 = 16 * item, b = row0 / SEQ, t0 = row0 % SEQ;
    const int tok = t0 + (lane & 15), kq = lane >> 4;
    const bf16* zb = Z + (size_t)b * SEQ * 256;
    u32x4 st[16];
#pragma unroll
    for (int i = 0; i < 16; ++i) { const int idx = i * 64 + lane, r = idx >> 5, c = idx & 31; int tt = t0 - 8 + r; tt = (tt >= 0 && tt < SEQ) ? tt : t0; st[i] = *(const u32x4*)(zb + (size_t)tt * 256 + 8 * c); }
#pragma unroll
    for (int i = 0; i < 16; ++i) { const int idx = i * 64 + lane, r = idx >> 5, c = idx & 31; *(LAS u32x4*)(rows + r * POOL_PITCH + c * 16) = st[i]; }
    pool_group<0>(rows, MIX, wpt, pscale, row0, tok, kq, lane); pool_group<1>(rows, MIX, wpt, pscale, row0, tok, kq, lane);
    pool_group<2>(rows, MIX, wpt, pscale, row0, tok, kq, lane); pool_group<3>(rows, MIX, wpt, pscale, row0, tok, kq, lane);
}
constexpr int N_B_UNITS = 128, N_C_UNITS = 256, N_P_ITEMS = M / 16;
}

__device__ __forceinline__ void p_mixers(Frame& F, const float* const* in, unsigned char* ws, int lq, int sel  ) {
    const int l = lq & 1;
    const bf16* Z = (const bf16*)(ws + WS_Z); bf16* MIX = (bf16*)(ws + WS_MIX);
    LAS char* lds = (LAS char*)F.lds;
    const float* sink = in[9] + 6 * l;
    {
        const int nb = (F.G >= 2 * mx::N_B_UNITS) ? mx::N_B_UNITS : (F.G + 1) / 2;
        const bool xl = (F.G == 256);
        if ((int)blockIdx.x < nb) {
            if (sel & 1) {
#pragma unroll 1
                for (int u0 = blockIdx.x; u0 < mx::N_B_UNITS; u0 += nb) { const int u = xl ? ((u0 & 7) >> 1) * 32 + (8 * (u0 & 1) + (u0 >> 4)) * 2 + ((u0 >> 3) & 1) : u0;     unsigned z_; asm volatile("v_mov_b32 %0, 0" : "=v"(z_)); const int lane = (int)__builtin_amdgcn_mbcnt_hi(~0u, __builtin_amdgcn_mbcnt_lo(~0u, z_)); mx::b_unit((const char*)(ws + WS_ZB), MIX, (char*)(ws + WS_BSCR), u, lds, F.wave, lane); } }
        } else if (sel & 2) {
#pragma unroll 1
            for (int v = (int)blockIdx.x - nb, u0 = v, k = 0; u0 < mx::N_C_UNITS; u0 += F.G - nb, ++k) { const int u = xl ? ((v & 7) >> 1) * 64 + ((((v >> 3) * 2 + k) >> 4) * 32) + 16 * (v & 1) + (((v >> 3) * 2 + k) & 15) : u0;     unsigned z_; asm volatile("v_mov_b32 %0, 0" : "=v"(z_)); const int lane = (int)__builtin_amdgcn_mbcnt_hi(~0u, __builtin_amdgcn_mbcnt_lo(~0u, z_)); mx::c_unit((const char*)(ws + WS_ZC), MIX, sink, u, lds, F.wave, lane); }
        }
        __syncthreads();
    }
    if (sel & 4) { const bf16* wpt = (const bf16*)(ws + WS_W + (size_t)l * W_LAYER + W_PT); const float* pscale = in[8] + 256 * l;
        for (int it0 = blockIdx.x * NWAVES + F.wave; it0 < mx::N_P_ITEMS; it0 += F.G * NWAVES) { const int it = (F.G == 256) ? (((int)blockIdx.x & 7) * 32 + ((int)blockIdx.x >> 3)) * NWAVES + F.wave : it0;     mx::pool_item(Z, MIX, wpt, pscale, it, lds + F.wave * (32 * mx::POOL_PITCH), F.lane); } }
}

struct Args { const float* in[15]; float* out; unsigned char* ws; int ph_lo, ph_hi, li, dup; };
__global__ void __launch_bounds__(NWAVES * 64, 2) mk_fwd(Args args) {
    extern __shared__ __attribute__((aligned(16))) unsigned char lds[];
    Frame F;
    F.lds = (LAS unsigned char*)lds;
    F.MISC = (volatile LAS unsigned*)(F.lds + MISC_OFF);
    F.tid = threadIdx.x; F.lane = F.tid & 63; F.wave = __builtin_amdgcn_readfirstlane(F.tid >> 6);
    const int wave0 = F.wave;
    F.G = gridDim.x; { const int bx = blockIdx.x; F.vcu = (F.G % 8 == 0) ? (bx % 8) * (F.G / 8) + bx / 8 : bx; }
    unsigned char* ws = args.ws;
    F.ctl = (gu32*)(ws + WS_CTL);
    for (int u = F.tid; u < (LDS_BYTES - LDSCTL_OFF) / 4; u += NWAVES * 64) ((LAS unsigned*)(F.lds + LDSCTL_OFF))[u] = 0u;
    __syncthreads();
    XcdBarrier bar; bar.bar = (unsigned*)(F.ctl + CW_BAR) + args.li * XCD_BAR_WORDS; bar.x = 0; bar.st = nullptr;
    const int lo = args.ph_lo, hi = args.ph_hi;
    if (hi - lo > 1) { bar = xcd_barrier_post((unsigned*)(F.ctl + CW_BAR) + args.li * XCD_BAR_WORDS, F.MISC + 8);
        if (F.tid == 0) { const unsigned v = bar.x + 1u; unsigned exp = 0u;
            if (!__hip_atomic_compare_exchange_strong((unsigned*)(F.ctl + CW_GRP) + (blockIdx.x & 7), &exp, v, __ATOMIC_RELAXED, __ATOMIC_RELAXED, __HIP_MEMORY_SCOPE_AGENT) && exp != v) __hip_atomic_fetch_or((unsigned*)(F.ctl + CW_GRPBAD), 1u, RLX_AGENT); } }
    const float* const* in = args.in;
    bf16* XS = (bf16*)(ws + WS_XS);
    bf16* H = (bf16*)(ws + WS_H);
    const float* MOD = (const float*)(ws + WS_MOD);
    float* SSQ = (float*)(ws + WS_SUMSQ);
    const float* GV = (const float*)(ws + WS_GV);

    const int dup = args.dup & 1, msel = ((args.dup >> 1) & 15) ? ((args.dup >> 1) & 15) : 7;
#pragma unroll 1
    for (int ph = lo; ph < hi; ++ph) {
        { unsigned z_; asm volatile("v_mov_b32 %0, 0" : "=v"(z_)); const int t_ = wave0 * 64 + (int)__builtin_amdgcn_mbcnt_hi(~0u, __builtin_amdgcn_mbcnt_lo(~0u, z_)); F.tid = t_; F.lane = t_ & 63; F.wave = wave0; }
        if (ph == PH_PRO) p_prologue(F, in, ws);
        else if (ph == PH_CONV) p_conv(F, in, ws);
        else if (ph == PH_FINAL) p_norm_final(F, XS, SSQ + (size_t)4 * M, args.out, in[14]);
        else {
            const int l = (ph - PH_L0) / PH_PER_LAYER, k = (ph - PH_L0) % PH_PER_LAYER;
            unsigned char* wl = ws + WS_W + (size_t)l * W_LAYER;
            const float* modl = MOD + (size_t)l * BATCH * NMOD * D;
            const float* biasl = (const float*)(ws + WS_BIAS + (size_t)l * BIAS_LAYER);
            if (k == 0) { pg8::Gemm g{H, (const bf16*)(wl + W_IN), M, INW, D}; pg8::StaticOrder S; S.init(M, INW, F.G, (int)blockIdx.x);
                pg8::EpiBf16Norm E{(bf16*)(ws + WS_Z), 256, SSQ + (size_t)(2 * l) * M, biasl, INW, ws + WS_ZB, ws + WS_ZC};
                pg8::gemm_phase<pg8::EpiBf16Norm, pg8::StaticOrder, true, true>(F.lds + RING_OFF, g, S, E, F.tid); }
            else if (k == 1) p_mixers(F, in, ws, l + 2 * dup, msel);
            else if (k == 2 && l == 0 && !dup) {
                pg8::Gemm g{(const bf16*)(ws + WS_MIX), (const bf16*)(wl + W_OUT), M, D, D}; pg8::StaticOrder S; S.init(M, D, F.G, (int)blockIdx.x);
                pg8::EpiGateResNormT<true> E{(const bf16*)in[0], XS, modl + 2 * D, NMOD * D, H, GV + (size_t)1 * BATCH * D, D, SSQ + (size_t)1 * M, D};
                pg8::gemm_phase<pg8::EpiGateResNormT<true>, pg8::StaticOrder, true, true>(F.lds + RING_OFF, g, S, E, F.tid); }
            else if (k == 2 || k == 4) { const bool dn = (k == 4); const bool last = dn && (l == DEPTH - 1);
                pg8::Gemm g{(const bf16*)(ws + (dn ? WS_HID : WS_MIX)), (const bf16*)(wl + (dn ? W_DN : W_OUT)), M, D, dn ? DFF : D}; pg8::StaticOrder S; S.init(M, D, F.G, (int)blockIdx.x);
                pg8::EpiGateResNorm E{XS, XS, dup ? (const float*)(F.ctl + CW_ZEROS) : modl + (dn ? 5 : 2) * D, dup ? 0 : NMOD * D,
                    (last || dup) ? (bf16*)nullptr : H, GV + (size_t)((dn ? 2 * (l + 1) : 2 * l + 1) % (2 * DEPTH)) * BATCH * D, D, SSQ + (size_t)(dup ? 5 : 2 * l + (dn ? 2 : 1)) * M, D};
                pg8::gemm_phase<pg8::EpiGateResNorm, pg8::StaticOrder, true, true>(F.lds + RING_OFF, g, S, E, F.tid); }
            else { pg8::Gemm g{H, (const bf16*)(wl + W_GU), M, 2 * DFF, D}; pg8::StaticOrder S; S.init(M, 2 * DFF, F.G, (int)blockIdx.x);
                pg8::EpiSwiGLUNorm E{(bf16*)(ws + WS_HID), DFF, SSQ + (size_t)(2 * l + 1) * M, biasl + BATCH * INW, 2 * DFF};
                pg8::gemm_phase<pg8::EpiSwiGLUNorm, pg8::StaticOrder, true, true>(F.lds + RING_OFF, g, S, E, F.tid); }
        }
        if (ph + 1 < hi) { const int kk = (ph >= PH_L0 && ph < PH_FINAL) ? (ph - PH_L0) % PH_PER_LAYER : -1;
            xcd_barrier(bar, F.MISC[17] != 0u && (kk == 2 || kk == 3 || (kk == 4 && ph + 1 == PH_FINAL)));
            if (ph == PH_PRO && lo == 0) { if (F.tid == 0) F.MISC[17] = (F.G == 256 && xb_ld((unsigned*)(F.ctl + CW_GRPBAD)) == 0u) ? 1u : 0u; __syncthreads(); } }
    }
}

extern "C" void kernel_launch(void* const* d_in, const int* in_sizes, int n_in, void* d_out, int out_size, void* d_ws, size_t ws_size, hipStream_t stream) {
    static int grid = 0;
    if (grid == 0) {
        if (n_in != 15 || in_sizes[0] != M * D || out_size != M * D || ws_size < WS_END) { fprintf(stderr, "kernel_launch: unexpected shapes (n_in %d, in0 %d, out %d, ws %zu); nothing launched\n", n_in, n_in > 0 ? in_sizes[0] : -1, out_size, ws_size); grid = -1; return; }
        int dev = 0, cus = 0, per_cu = 0;
        if (hipGetDevice(&dev) != hipSuccess || hipDeviceGetAttribute(&cus, hipDeviceAttributeMultiprocessorCount, dev) != hipSuccess) { grid = -1; return; }
        if (hipFuncSetAttribute((const void*)mk_fwd, hipFuncAttributeMaxDynamicSharedMemorySize, LDS_BYTES) != hipSuccess) { fprintf(stderr, "kernel_launch: hipFuncSetAttribute failed\n"); grid = -1; return; }
        if (hipOccupancyMaxActiveBlocksPerMultiprocessor(&per_cu, (const void*)mk_fwd, NWAVES * 64, LDS_BYTES) != hipSuccess || per_cu < 1) fprintf(stderr, "kernel_launch: occupancy query reports %d blocks per CU\n", per_cu);
        (void)hipGetLastError();
        grid = cus;
        if (grid != 256) fprintf(stderr, "kernel_launch: %d CUs; this kernel is laid out for 256\n", grid);
    }
    if (grid < 0) return;
    if (hipMemsetAsync((char*)d_ws + WS_CTL, 0, CTL_ZERO_BYTES, stream) != hipSuccess) return;
    Args a{};
    for (int i = 0; i < 15; ++i) a.in[i] = (const float*)d_in[i];
    a.out = (float*)d_out; a.ws = (unsigned char*)d_ws;
#if PROBE_DUP == 0 && PROBE_CUT == 0
    a.ph_lo = 0; a.ph_hi = NPHASES; a.li = 0; a.dup = 0;
    hipLaunchKernelGGL(mk_fwd, dim3(grid), dim3(NWAVES * 64), LDS_BYTES, stream, a);
#else
    { int lo = 0, li = 0;
      for (int ph = 0; ph < NPHASES; ++ph) { const bool cut = ((PROBE_CUT | PROBE_DUP) >> ph) & 1;
        if (cut || ph == NPHASES - 1) { a.ph_lo = lo; a.ph_hi = ph + 1; a.li = (ph + 1 - lo > 1) ? li++ : 0; a.dup = 0; hipLaunchKernelGGL(mk_fwd, dim3(grid), dim3(NWAVES * 64), LDS_BYTES, stream, a);
            if ((PROBE_DUP >> ph) & 1) { a.ph_lo = ph; a.ph_hi = ph + 1; a.li = 0; a.dup = 1 | (PROBE_MIXSEL << 1) | (PROBE_NOSTORE << 4); hipLaunchKernelGGL(mk_fwd, dim3(grid), dim3(NWAVES * 64), LDS_BYTES, stream, a); }
            lo = ph + 1; } } }
#endif
}
```

```cpp
#include <hip/hip_runtime.h>
#include <cstdio>
#include <cstdint>
namespace pg8 {
#define PG8_LAS __attribute__((address_space(3)))
typedef unsigned short bf16_t;
typedef short bf16x8 __attribute__((ext_vector_type(8)));
typedef float f32x4 __attribute__((ext_vector_type(4)));
typedef unsigned u32x4 __attribute__((ext_vector_type(4)));
constexpr int BM = 256, BK = 64, HALF = 128, HTB = HALF * BK * 2  , STAGE_BYTES = 8 * HTB, NXCD = 8, WGM = 8;

__host__ __device__ __forceinline__ int lds_byte(int r, int c) { const int st = (r >> 4) * 2 + (c >> 5), rr = r & 15, cc = c & 31, ob = rr * 64 + cc * 2; return st * 1024 + (ob ^ (((ob >> 9) & 1) << 5)); }
__host__ __device__ __forceinline__ void stage_rc(int b, int& R, int& C) { const int st = b / 1024, sb = b % 1024, swz = sb ^ (((sb >> 9) & 1) << 5); R = (st >> 1) * 16 + swz / 64; C = (st & 1) * 32 + (swz % 64) / 2; }
__host__ __device__ __forceinline__ int perm32(int rho) { const int n = rho >> 4, i = rho & 15; return 8 * (i >> 2) + 4 * n + (i & 3); }

__host__ __device__ __forceinline__ int perm32inv(int x) { return 16 * ((x >> 2) & 1) + 4 * (x >> 3) + (x & 3); }
__host__ __device__ __forceinline__ size_t img_off(int row, int col, int nt, bool wrow) { const int r = row & 127, rr = wrow ? (r & ~31) + perm32inv(r & 31) : r; return ((size_t)((row >> 7) * nt + (col >> 6)) << 14) + (size_t)lds_byte(rr, col & 63); }
constexpr bool IMG_A = true, IMG_B = true;
struct Unit { int pm, pn; };
struct Gemm { const bf16_t* A; const bf16_t* Bt; int M, N, K; };

struct StaticOrder {
    int nM, nN, nwg, G, c;
    __host__ __device__ void init(int M, int N, int G_, int c_) { nM = M / BM; nN = N / BM; nwg = nM * nN; G = G_; c = c_; }
    __host__ __device__ bool next(int i, Unit& u) const {
        const long L = (long)i * G + c; if (L >= nwg) return false;
        int wgid = (int)L; { const int q = nwg / NXCD, r = nwg % NXCD, xcd = wgid % NXCD, off = wgid / NXCD; wgid = (xcd < r ? xcd * (q + 1) : r * (q + 1) + (xcd - r) * q) + off; }
        const int nig = WGM * nN, gid = wgid / nig, fm = gid * WGM, gsz = (nM - fm) < WGM ? (nM - fm) : WGM;
        u.pm = fm + ((wgid % nig) % gsz); u.pn = (wgid % nig) / gsz; return true;
    }
    __device__ __forceinline__ void a_ready(const Unit&) const {}
    __device__ __forceinline__ void done(const Unit&) const {}
};

__device__ __forceinline__ unsigned cvt_pk_bf16(float lo, float hi) { unsigned r; asm volatile("v_cvt_pk_bf16_f32 %0, %1, %2" : "=v"(r) : "v"(lo), "v"(hi)); return r; }
constexpr float RMS_EPS_ = 1e-6f, INV_D_ = 1.0f / 1024.0f;
__device__ __forceinline__ void aux_dma(const float* src_lane, PG8_LAS unsigned char* dst_wave) { __builtin_amdgcn_global_load_lds((const unsigned*)src_lane, (PG8_LAS unsigned*)dst_wave, 4, 0, 0); }
typedef _Float16 h16x2 __attribute__((ext_vector_type(2)));
__device__ __forceinline__ unsigned pk_h2(float lo, float hi) { const h16x2 h = {(_Float16)lo, (_Float16)hi}; return __builtin_bit_cast(unsigned, h); }
__device__ __forceinline__ float h_lo(unsigned w) { return (float)__builtin_bit_cast(h16x2, w)[0]; }
__device__ __forceinline__ float h_hi(unsigned w) { return (float)__builtin_bit_cast(h16x2, w)[1]; }
struct EpiBf16Norm {
    static constexpr bool PERM = true, AFTER_DRAIN = false;
    bf16_t* O; int ldc; const float* sumsq; const float* bias; int bias_stride; unsigned char* zb; unsigned char* zc;
    __device__ __forceinline__ void prefetch(const Unit& u, PG8_LAS unsigned char* aux, int wid, int lane) const {
        if (wid < 4) aux_dma(sumsq + u.pm * BM + wid * 64 + lane, aux + wid * 256);
        else aux_dma(bias + (size_t)(u.pm >> 5) * bias_stride + u.pn * BM + (wid - 4) * 64 + lane, aux + 1024 + (wid - 4) * 256);
    }
    __device__ __forceinline__ void operator()(const f32x4 (&acc)[2][2][4][2], const Unit& u, int wr, int wc, int fr_, int fq_, PG8_LAS unsigned char* aux) const {
        unsigned z_; asm volatile("v_mov_b32 %0, 0" : "=v"(z_)); const int ln_ = (int)__builtin_amdgcn_mbcnt_hi(~0u, __builtin_amdgcn_mbcnt_lo(~0u, z_)); const int fr = ln_ & 15, fq = ln_ >> 4;
        const int row0 = u.pm * BM + wr * 64 + fr, col0 = u.pn * BM + wc * 32 + 8 * fq;
        const PG8_LAS float* ass = (const PG8_LAS float*)aux + wr * 64 + fr; const PG8_LAS float* ab = (const PG8_LAS float*)(aux + 1024) + wc * 32 + 8 * fq;
        f32x4 bv[2][2];
#pragma unroll
        for (int bj = 0; bj < 2; ++bj)
#pragma unroll
            for (int n = 0; n < 2; ++n) bv[bj][n] = *(const PG8_LAS f32x4*)(ab + bj * HALF + 4 * n);
#pragma unroll
        for (int ai = 0; ai < 2; ++ai)
#pragma unroll
            for (int m = 0; m < 4; ++m) { const int row = row0 + ai * HALF + m * 16; const float rs = __builtin_amdgcn_rsqf(ass[ai * HALF + m * 16] * INV_D_ + RMS_EPS_);
#pragma unroll
                for (int bj = 0; bj < 2; ++bj) { const f32x4 v0 = acc[ai][bj][m][0] * rs + bv[bj][0], v1 = acc[ai][bj][m][1] * rs + bv[bj][1];
                    u32x4 w; w.x = cvt_pk_bf16(v0[0], v0[1]); w.y = cvt_pk_bf16(v0[2], v0[3]); w.z = cvt_pk_bf16(v1[0], v1[1]); w.w = cvt_pk_bf16(v1[2], v1[3]);
                    const int cb = 2 * u.pn + bj;
                    if (zb != nullptr && cb >= 2 && cb <= 10) { const int t3 = (cb - 2) / 3, g = (cb - 2) % 3, lg = 2 * g, hd = 2 * g + (wc >> 1), c = (wc & 1) * 4 + fq;
                        const int t = row & 8191, b = row >> 13, r = t & ((1 << lg) - 1), n = t >> lg, ti = (r << (8 - lg)) + (n >> 5), key = n & 31;
                        const int off = t3 < 2 ? (c >> 1) * 1024 + (key + 32 * (c & 1)) * 16 : (c >> 2) * 2048 + (key >> 4) * 1024 + (key & 15) * 64 + (c & 3) * 16;
                        *(u32x4*)(zb + ((size_t)(((t3 * 6 + hd) * 4 + b) * 256 + ti) << 12) + off) = w; }
                    else if (zb != nullptr && cb >= 11) {
                        const int hx = cb <= 13 ? 2 * (cb - 11) + (wc >> 1) : (cb == 14 ? 6 : 8) + (wc >> 1), c = (wc & 1) * 4 + fq, t = row & 8191, b = row >> 13, key = t & 31;
                        const int off = cb < 15 ? (c >> 1) * 1024 + (key + 32 * (c & 1)) * 16 : (c >> 2) * 2048 + (key >> 4) * 1024 + (key & 15) * 64 + (c & 3) * 16;
                        *(u32x4*)(zc + ((size_t)((hx * 4 + b) * 256 + (t >> 5)) << 12) + off) = w; }
                    else *(u32x4*)(O + (size_t)row * ldc + col0 + bj * HALF) = w; } }
    }
};
struct EpiSwiGLUNorm {
    static constexpr bool PERM = true, AFTER_DRAIN = false;
    bf16_t* O; int ldc; const float* sumsq; const float* bias; int bias_stride;
    static __device__ __forceinline__ float silu_mul(float g, float u) { return g * u * __builtin_amdgcn_rcpf(1.0f + __builtin_amdgcn_exp2f(-1.4426950408889634f * g)); }
    __device__ __forceinline__ void prefetch(const Unit& u, PG8_LAS unsigned char* aux, int wid, int lane) const {
        if (wid < 4) aux_dma(sumsq + u.pm * BM + wid * 64 + lane, aux + wid * 256);
        else aux_dma(bias + (size_t)(u.pm >> 5) * bias_stride + u.pn * BM + (wid - 4) * 64 + lane, aux + 1024 + (wid - 4) * 256);
    }
    __device__ __forceinline__ void operator()(const f32x4 (&acc)[2][2][4][2], const Unit& u, int wr, int wc, int fr_, int fq_, PG8_LAS unsigned char* aux) const {
        unsigned z_; asm volatile("v_mov_b32 %0, 0" : "=v"(z_)); const int ln_ = (int)__builtin_amdgcn_mbcnt_hi(~0u, __builtin_amdgcn_mbcnt_lo(~0u, z_)); const int fr = ln_ & 15, fq = ln_ >> 4;
        const int row0 = u.pm * BM + wr * 64 + fr, col0 = u.pn * HALF + wc * 32 + 8 * fq;
        const PG8_LAS float* ass = (const PG8_LAS float*)aux + wr * 64 + fr; const PG8_LAS float* ab = (const PG8_LAS float*)(aux + 1024) + wc * 32 + 8 * fq;
        const f32x4 bg0 = *(const PG8_LAS f32x4*)(ab), bg1 = *(const PG8_LAS f32x4*)(ab + 4), bu0 = *(const PG8_LAS f32x4*)(ab + HALF), bu1 = *(const PG8_LAS f32x4*)(ab + HALF + 4);
#pragma unroll
        for (int ai = 0; ai < 2; ++ai)
#pragma unroll
            for (int m = 0; m < 4; ++m) { const int row = row0 + ai * HALF + m * 16; const float rs = __builtin_amdgcn_rsqf(ass[ai * HALF + m * 16] * INV_D_ + RMS_EPS_);
                unsigned char* rowp = (unsigned char*)O + img_off(row, col0, ldc / 64, false);
                const f32x4 g0 = acc[ai][0][m][0] * rs + bg0, g1 = acc[ai][0][m][1] * rs + bg1, u0 = acc[ai][1][m][0] * rs + bu0, u1 = acc[ai][1][m][1] * rs + bu1;
                f32x4 e0 = g0 * -1.4426950408889634f, e1 = g1 * -1.4426950408889634f;
#pragma unroll
                for (int i = 0; i < 4; ++i) { e0[i] = __builtin_amdgcn_exp2f(e0[i]); e1[i] = __builtin_amdgcn_exp2f(e1[i]); }
                e0 = e0 + 1.0f; e1 = e1 + 1.0f;
#pragma unroll
                for (int i = 0; i < 4; ++i) { e0[i] = __builtin_amdgcn_rcpf(e0[i]); e1[i] = __builtin_amdgcn_rcpf(e1[i]); }
                const f32x4 h0 = (g0 * u0) * e0, h1 = (g1 * u1) * e1;
                u32x4 w; w.x = cvt_pk_bf16(h0[0], h0[1]); w.y = cvt_pk_bf16(h0[2], h0[3]); w.z = cvt_pk_bf16(h1[0], h1[1]); w.w = cvt_pk_bf16(h1[2], h1[3]);
                *(u32x4*)rowp = w; }
    }
};
template <bool F32BASE>
struct EpiGateResNormT {
    static constexpr bool PERM = true, AFTER_DRAIN = false;
    const bf16_t* base; bf16_t* out; const float* gate; int gate_stride; bf16_t* Hn; const float* gn; int gn_stride; float* sumsq; int ldc;
    __device__ __forceinline__ void prefetch(const Unit& u, PG8_LAS unsigned char* aux, int wid, int lane) const {
        if (wid < 4) aux_dma(gate + (size_t)(u.pm >> 5) * gate_stride + u.pn * BM + wid * 64 + lane, aux + wid * 256);
        else aux_dma(gn + (size_t)(u.pm >> 5) * gn_stride + u.pn * BM + (wid - 4) * 64 + lane, aux + 1024 + (wid - 4) * 256);
    }
    __device__ __forceinline__ void operator()(const f32x4 (&acc)[2][2][4][2], const Unit& u, int wr, int wc, int fr_, int fq_, PG8_LAS unsigned char* aux) const {
        unsigned z_; asm volatile("v_mov_b32 %0, 0" : "=v"(z_)); const int ln_ = (int)__builtin_amdgcn_mbcnt_hi(~0u, __builtin_amdgcn_mbcnt_lo(~0u, z_)); const int fr = ln_ & 15, fq = ln_ >> 4;
        const int row0 = u.pm * BM + wr * 64 + fr, col0 = u.pn * BM + wc * 32 + 8 * fq;
        const PG8_LAS float* ag = (const PG8_LAS float*)aux + wc * 32 + 8 * fq; const PG8_LAS float* an = (const PG8_LAS float*)(aux + 1024) + wc * 32 + 8 * fq;
#pragma unroll
        for (int am = 0; am < 4; ++am) {
            u32x4 ld[2][2]; f32x4 lf[2][2][2];
#pragma unroll
            for (int mm = 0; mm < 2; ++mm)
#pragma unroll
                for (int bj = 0; bj < 2; ++bj) {
                    if constexpr (F32BASE) { const f32x4* px = (const f32x4*)((const float*)base + (size_t)(row0 + (am >> 1) * HALF + (2 * (am & 1) + mm) * 16) * ldc + col0 + bj * HALF); lf[mm][bj][0] = px[0]; lf[mm][bj][1] = px[1]; }
                    else ld[mm][bj] = *(const u32x4*)((const unsigned char*)base + img_off(row0 + (am >> 1) * HALF + (2 * (am & 1) + mm) * 16, col0 + bj * HALF, ldc / 64, false)); }
#pragma unroll
            for (int mm = 0; mm < 2; ++mm) { const int ai = am >> 1, m = 2 * (am & 1) + mm; const int row = row0 + ai * HALF + m * 16; const size_t off = (size_t)row * ldc + col0; float ss = 0.f;
#pragma unroll
                for (int bj = 0; bj < 2; ++bj) {
                    const f32x4 g0 = *(const PG8_LAS f32x4*)(ag + bj * HALF), g1 = *(const PG8_LAS f32x4*)(ag + bj * HALF + 4);
                    f32x4 b0, b1;
                    if constexpr (F32BASE) { b0 = lf[mm][bj][0]; b1 = lf[mm][bj][1]; }
                    else { const u32x4 bw = ld[mm][bj]; b0 = (f32x4){h_lo(bw.x), h_hi(bw.x), h_lo(bw.y), h_hi(bw.y)}; b1 = (f32x4){h_lo(bw.z), h_hi(bw.z), h_lo(bw.w), h_hi(bw.w)}; }
                    const f32x4 x0 = b0 + g0 * acc[ai][bj][m][0], x1 = b1 + g1 * acc[ai][bj][m][1];
                    u32x4 w; w.x = pk_h2(x0[0], x0[1]); w.y = pk_h2(x0[2], x0[3]); w.z = pk_h2(x1[0], x1[1]); w.w = pk_h2(x1[2], x1[3]);
                    *(u32x4*)((unsigned char*)out + img_off(row, col0 + bj * HALF, ldc / 64, false)) = w;
                    ss += (x0[0] * x0[0] + x0[1] * x0[1]) + (x0[2] * x0[2] + x0[3] * x0[3]) + (x1[0] * x1[0] + x1[1] * x1[1]) + (x1[2] * x1[2] + x1[3] * x1[3]);
                    if (Hn) { const f32x4 n0 = *(const PG8_LAS f32x4*)(an + bj * HALF), n1 = *(const PG8_LAS f32x4*)(an + bj * HALF + 4); const f32x4 h0 = x0 * n0, h1 = x1 * n1;
                        u32x4 hw; hw.x = cvt_pk_bf16(h0[0], h0[1]); hw.y = cvt_pk_bf16(h0[2], h0[3]); hw.z = cvt_pk_bf16(h1[0], h1[1]); hw.w = cvt_pk_bf16(h1[2], h1[3]);
                        *(u32x4*)((unsigned char*)Hn + img_off(row, col0 + bj * HALF, ldc / 64, false)) = hw; } }
                ss += __shfl_xor(ss, 16); ss += __shfl_xor(ss, 32);
                if (fq == 0) atomicAdd(sumsq + row, ss); }
            asm volatile("" ::: "memory"); }
    }
};
typedef EpiGateResNormT<false> EpiGateResNorm;

template <class Epi, class Sched, bool ALIGN_EPI = false, bool SP2 = false>
__device__ __forceinline__ void gemm_phase(PG8_LAS unsigned char* lds, const Gemm g, const Sched& S, const Epi& E, int tid_in) {
    int tid_ = tid_in; asm volatile("" : "+v"(tid_));
    const int tid = tid_, wid = __builtin_amdgcn_readfirstlane(tid >> 6), lane = tid & 63, wr = wid >> 2, wc = wid & 3, fr = lane & 15, fq = lane >> 4;
    const int K = g.K, nt = K / BK;
    unsigned voffA[2], voffB[2];
#pragma unroll
    for (int i = 0; i < 2; ++i) { int R, C; stage_rc(tid * 16 + i * 8192, R, C); const int Rb = Epi::PERM ? ((R & ~31) + perm32(R & 31)) : R;
        voffA[i] = IMG_A ? (unsigned)(tid * 16 + i * 8192) : (unsigned)(R * K + C) * 2u; voffB[i] = IMG_B ? (unsigned)(tid * 16 + i * 8192) : (unsigned)(Rb * K + C) * 2u; }
    const size_t kstepA = IMG_A ? (size_t)(HALF * BK * 2) : (size_t)(BK * 2), kstepB = IMG_B ? (size_t)(HALF * BK * 2) : (size_t)(BK * 2);
    const size_t hstep = (size_t)HALF * K * 2;
    const size_t tstep = 2 * hstep;
    const unsigned ldsw = (unsigned)wid * 1024u;
    const int aoff = lds_byte(wr * 64 + fr, fq * 8), boff = lds_byte(wc * 32 + fr, fq * 8);
#define PG8_SA(b, h) (((b) * 2 + (h)) * HTB)
#define PG8_SB(b, h) ((4 + (b) * 2 + (h)) * HTB)
#define PG8_STAGE(bufoff, gbase, voff) do { _Pragma("unroll") for (int _i = 0; _i < 2; ++_i) \
        __builtin_amdgcn_global_load_lds((const unsigned*)((const char*)(gbase) + (voff)[_i]), (PG8_LAS unsigned*)(lds + (bufoff) + ldsw + _i * 8192), 16, 0, 0); } while (0)
#define PG8_LDA(dst, b, h) do { _Pragma("unroll") for (int m = 0; m < 4; ++m) _Pragma("unroll") for (int k = 0; k < 2; ++k) dst[m][k] = *(const PG8_LAS bf16x8*)(lds + PG8_SA(b, h) + aoff + m * 2048 + k * 1024); } while (0)
#define PG8_LDB(dst, b, h) do { _Pragma("unroll") for (int n = 0; n < 2; ++n) _Pragma("unroll") for (int k = 0; k < 2; ++k) dst[n][k] = *(const PG8_LAS bf16x8*)(lds + PG8_SB(b, h) + boff + n * 2048 + k * 1024); } while (0)
#define PG8_MMA(ai, bj, At, Bt) do { __builtin_amdgcn_s_setprio(1); _Pragma("unroll") for (int m = 0; m < 4; ++m) _Pragma("unroll") for (int n = 0; n < 2; ++n) _Pragma("unroll") for (int k = 0; k < 2; ++k) \
        acc[ai][bj][m][n] = __builtin_amdgcn_mfma_f32_16x16x32_bf16(Bt[n][k], At[m][k], acc[ai][bj][m][n], 0, 0, 0); __builtin_amdgcn_s_setprio(0); } while (0)
#define PG8_WAIT_V(n) asm volatile("s_waitcnt vmcnt(" #n ")" ::: "memory")
#define PG8_WAIT_L(n) asm volatile("s_waitcnt lgkmcnt(" #n ")" ::: "memory")
#define PG8_BAR __builtin_amdgcn_s_barrier()
#define PG8_SCHED __builtin_amdgcn_sched_barrier(0)
    Unit cur, nxt; int ui = 0;
    if (!S.next(0, cur)) return;
    f32x4 acc[2][2][4][2];
#pragma unroll
    for (int a = 0; a < 2; ++a)
#pragma unroll
        for (int b = 0; b < 2; ++b)
#pragma unroll
            for (int m = 0; m < 4; ++m)
#pragma unroll
                for (int n = 0; n < 2; ++n) { float z_; asm volatile("v_mov_b32 %0, 0" : "=v"(z_)); acc[a][b][m][n] = (f32x4){z_, z_, z_, z_}; }
    bf16x8 At[4][2], B0[2][2], B1[2][2];
    const char* cA = (const char*)g.A + (size_t)cur.pm * tstep; const char* cB = (const char*)g.Bt + (size_t)cur.pn * tstep;
    S.a_ready(cur);
    if constexpr (SP2) {
        PG8_STAGE(PG8_SB(0, 0), cB, voffB); PG8_STAGE(PG8_SB(0, 1), cB + hstep, voffB); PG8_STAGE(PG8_SA(0, 0), cA, voffA); PG8_STAGE(PG8_SA(0, 1), cA + hstep, voffA);
        if (wr == 1) PG8_BAR;
        PG8_WAIT_V(2); PG8_BAR;
        PG8_STAGE(PG8_SB(1, 0), cB + kstepB, voffB); PG8_STAGE(PG8_SA(1, 0), cA + kstepA, voffA); PG8_STAGE(PG8_SB(1, 1), cB + hstep + kstepB, voffB);
        PG8_WAIT_V(6); PG8_BAR;
    } else {
        PG8_STAGE(PG8_SB(0, 0), cB, voffB); PG8_STAGE(PG8_SA(0, 0), cA, voffA); PG8_STAGE(PG8_SB(0, 1), cB + hstep, voffB); PG8_STAGE(PG8_SA(0, 1), cA + hstep, voffA);
        if (wr == 1) PG8_BAR;
        PG8_WAIT_V(4); PG8_BAR;
        PG8_STAGE(PG8_SB(1, 0), cB + kstepB, voffB); PG8_STAGE(PG8_SA(1, 0), cA + kstepA, voffA); PG8_STAGE(PG8_SB(1, 1), cB + hstep + kstepB, voffB);
        PG8_WAIT_V(6); PG8_BAR;
    }
    for (;;) {
        const bool has_next = S.next(ui + 1, nxt);
        const char* nA = has_next ? (const char*)g.A + (size_t)nxt.pm * tstep : cA; const char* nB = has_next ? (const char*)g.Bt + (size_t)nxt.pn * tstep : cB;
        for (int t = 0; t < nt; t += 2) {
            const bool last = (t == nt - 2);
            const char* a1 = cA + (size_t)(t + 1) * kstepA;
            const char* a2 = last ? nA : cA + (size_t)(t + 2) * kstepA; const char* b2 = last ? nB : cB + (size_t)(t + 2) * kstepB;
            const char* a3 = a2 + kstepA; const char* b3 = b2 + kstepB;
            if (last && has_next) S.a_ready(nxt);
            if (last) E.prefetch(cur, lds + STAGE_BYTES + 1024, wid, lane);
            if constexpr (SP2) {
            PG8_LDB(B0, 0, 0); PG8_LDB(B1, 0, 1); PG8_SCHED; PG8_LDA(At, 0, 0); PG8_STAGE(PG8_SA(1, 1), a1 + hstep, voffA);
            PG8_WAIT_V(8); PG8_WAIT_L(0); PG8_BAR; PG8_MMA(0, 0, At, B0); PG8_MMA(0, 1, At, B1); PG8_BAR; PG8_SCHED;
            PG8_LDA(At, 0, 1); PG8_STAGE(PG8_SB(0, 0), b2, voffB); PG8_STAGE(PG8_SB(0, 1), b2 + hstep, voffB); PG8_STAGE(PG8_SA(0, 0), a2, voffA);
            PG8_WAIT_V(8); PG8_WAIT_L(0); PG8_BAR; PG8_MMA(1, 0, At, B0); PG8_MMA(1, 1, At, B1); PG8_BAR; PG8_SCHED;
            PG8_LDB(B0, 1, 0); PG8_LDB(B1, 1, 1); PG8_SCHED; PG8_LDA(At, 1, 0); PG8_STAGE(PG8_SA(0, 1), a2 + hstep, voffA);
            PG8_WAIT_V(8); PG8_WAIT_L(0); PG8_BAR; PG8_MMA(0, 0, At, B0); PG8_MMA(0, 1, At, B1); PG8_BAR; PG8_SCHED;
            PG8_LDA(At, 1, 1); PG8_STAGE(PG8_SB(1, 0), b3, voffB); PG8_STAGE(PG8_SB(1, 1), b3 + hstep, voffB); PG8_STAGE(PG8_SA(1, 0), a3, voffA);
            PG8_WAIT_V(8); PG8_WAIT_L(0); PG8_BAR; PG8_MMA(1, 0, At, B0); PG8_MMA(1, 1, At, B1); PG8_BAR; PG8_SCHED;
            } else {
            PG8_LDB(B0, 0, 0); PG8_SCHED; PG8_LDA(At, 0, 0); PG8_STAGE(PG8_SA(1, 1), a1 + hstep, voffA);
            PG8_WAIT_L(8); PG8_BAR; PG8_WAIT_L(0); PG8_MMA(0, 0, At, B0); PG8_BAR; PG8_SCHED;
            PG8_LDB(B1, 0, 1); PG8_STAGE(PG8_SB(0, 0), b2, voffB);
            PG8_BAR; PG8_WAIT_L(0); PG8_MMA(0, 1, At, B1); PG8_BAR;
            PG8_LDA(At, 0, 1); PG8_STAGE(PG8_SA(0, 0), a2, voffA);
            PG8_BAR; PG8_WAIT_L(0); PG8_MMA(1, 0, At, B0); PG8_BAR; PG8_SCHED;
            PG8_STAGE(PG8_SB(0, 1), b2 + hstep, voffB);
            PG8_WAIT_V(6); PG8_BAR; PG8_MMA(1, 1, At, B1); PG8_BAR;
            PG8_LDB(B0, 1, 0); PG8_SCHED; PG8_LDA(At, 1, 0); PG8_STAGE(PG8_SA(0, 1), a2 + hstep, voffA);
            PG8_WAIT_L(8); PG8_BAR; PG8_WAIT_L(0); PG8_MMA(0, 0, At, B0); PG8_BAR; PG8_SCHED;
            PG8_LDB(B1, 1, 1); PG8_STAGE(PG8_SB(1, 0), b3, voffB);
            PG8_BAR; PG8_WAIT_L(0); PG8_MMA(0, 1, At, B1); PG8_BAR;
            PG8_LDA(At, 1, 1); PG8_STAGE(PG8_SA(1, 0), a3, voffA);
            PG8_BAR; PG8_WAIT_L(0); PG8_MMA(1, 0, At, B0); PG8_BAR; PG8_SCHED;
            PG8_STAGE(PG8_SB(1, 1), b3 + hstep, voffB);
            PG8_WAIT_V(6); PG8_BAR; PG8_MMA(1, 1, At, B1); PG8_BAR;
            }
        }
        if constexpr (ALIGN_EPI) { if (wr == 0) PG8_BAR; }
        if constexpr (!Epi::AFTER_DRAIN) { E(acc, cur, wr, wc, fr, fq, lds + STAGE_BYTES + 1024); S.done(cur); }
        if (!has_next) break;
#pragma unroll
        for (int a = 0; a < 2; ++a)
#pragma unroll
            for (int b = 0; b < 2; ++b)
#pragma unroll
                for (int m = 0; m < 4; ++m)
#pragma unroll
                    for (int n = 0; n < 2; ++n) { float z_; asm volatile("v_mov_b32 %0, 0" : "=v"(z_)); acc[a][b][m][n] = (f32x4){z_, z_, z_, z_}; }
        cur = nxt; cA = nA; cB = nB; ++ui;
        if constexpr (ALIGN_EPI) { if (wr == 1) PG8_BAR; }
    }
    PG8_WAIT_V(0);
    if constexpr (!ALIGN_EPI) { if (wr == 0) PG8_BAR; }
    PG8_BAR;
    if constexpr (Epi::AFTER_DRAIN) { E.fused(acc, cur, wr, wc, fr, fq, lds, wid, lane); S.done(cur); }
#undef PG8_SA
#undef PG8_SB
#undef PG8_STAGE
#undef PG8_LDA
#undef PG8_LDB
#undef PG8_MMA
#undef PG8_WAIT_V
#undef PG8_WAIT_L
#undef PG8_BAR
#undef PG8_SCHED
}
}
#define GAS __attribute__((address_space(1)))
#define LAS __attribute__((address_space(3)))
typedef unsigned short bf16;
typedef unsigned v4u __attribute__((ext_vector_type(4)));
typedef float f32x4 __attribute__((ext_vector_type(4)));
typedef short bf16x8 __attribute__((ext_vector_type(8)));
typedef GAS unsigned gu32;
typedef GAS unsigned long long gu64;
#define RLX_AGENT __ATOMIC_RELAXED, __HIP_MEMORY_SCOPE_AGENT
#define LDS_WAIT() asm volatile("s_waitcnt lgkmcnt(0)" ::: "memory")
#define VM_WAIT() asm volatile("s_waitcnt vmcnt(0)" ::: "memory")
__device__ __forceinline__ unsigned long long rt() { return __builtin_amdgcn_s_memrealtime(); }
__device__ __forceinline__ unsigned f2bf(float f) { unsigned u = __builtin_bit_cast(unsigned, f); return (u + 0x7fffu + ((u >> 16) & 1u)) >> 16; }
__device__ __forceinline__ unsigned pk2(float lo, float hi) { return f2bf(lo) | (f2bf(hi) << 16); }

#define XB_TMO      128
#define XB_XCNT(j)  (256  + 64 * (j))
#define XB_XSUB(j)  (1280 + 64 * (j))
#define XB_XGEN(j)  (2304 + 64 * (j))
#define XB_TOP      3328
#define XB_TOPGEN   3392
#define XCD_BAR_WORDS 3456
#define XB_SPIN_CAP (1u << 18)

__device__ __forceinline__ unsigned xb_ld(unsigned* p)              { return __hip_atomic_load(p, __ATOMIC_RELAXED, __HIP_MEMORY_SCOPE_AGENT); }
__device__ __forceinline__ unsigned xb_add(unsigned* p, unsigned v) { return __hip_atomic_fetch_add(p, v, __ATOMIC_RELAXED, __HIP_MEMORY_SCOPE_AGENT); }
__device__ __forceinline__ unsigned xb_xcc_id() { return (unsigned)__builtin_amdgcn_s_getreg((3 << 11) | 20) & 0xFu; }
#define XB_SPIN(cond, bar) do { unsigned _sp = 0; while (cond) { __builtin_amdgcn_s_sleep(1); \
    if ((++_sp & 255u) == 0u) { if (xb_ld(&(bar)[XB_TMO])) break; if (_sp > XB_SPIN_CAP) { atomicAdd(&(bar)[XB_TMO], 1u); break; } } } } while (0)

struct XcdBarrier {
    unsigned* bar; unsigned x;
    volatile LAS unsigned* st;
};

__device__ __forceinline__ XcdBarrier xcd_barrier_post(unsigned* bar, volatile LAS unsigned* st) {
    XcdBarrier b; b.bar = bar; b.x = xb_xcc_id(); b.st = st;
    if (threadIdx.x == 0) (void)xb_add(&bar[XB_XCNT(b.x)], 1u);
    return b;
}
__device__ __forceinline__ void xcd_barrier_complete(unsigned* bar, unsigned x, unsigned& nloc, unsigned& nx) {
    const unsigned G = gridDim.x * gridDim.y * gridDim.z;
    unsigned sum, cnt, mine, sp = 0u;
    for (;;) {
        sum = 0u; cnt = 0u; mine = 0u;
#pragma unroll
        for (unsigned j = 0; j < 16; ++j) { const unsigned c = xb_ld(&bar[XB_XCNT(j)]); sum += c; cnt += (c > 0u) ? 1u : 0u; mine = (j == x) ? c : mine; }
        if (sum == G) break;
        __builtin_amdgcn_s_sleep(1);
        if ((++sp & 255u) == 0u) { if (xb_ld(&bar[XB_TMO])) break; if (sp > XB_SPIN_CAP) { atomicAdd(&bar[XB_TMO], 1u); break; } }
    }
    nloc = mine > 0u ? mine : 1u; nx = cnt > 0u ? cnt : 1u;
}

__device__ __forceinline__ void xcd_barrier(const XcdBarrier& b, bool local = false) {
    asm volatile("s_waitcnt vmcnt(0)" ::: "memory");
    __syncthreads();
    if (threadIdx.x == 0) {
        unsigned* bar = b.bar;
        __builtin_amdgcn_s_waitcnt(0);
        unsigned nloc = b.st[0], nx = b.st[1];
        if (nloc == 0u) { xcd_barrier_complete(bar, b.x, nloc, nx); b.st[0] = nloc; b.st[1] = nx; }
        const unsigned old = xb_add(&bar[XB_XSUB(b.x)], 1u);
        const unsigned gen = old / nloc;
        if (old + 1u == (gen + 1u) * nloc) {
            if (!local) {
            __builtin_amdgcn_fence(__ATOMIC_RELEASE, "agent");
            asm volatile("s_waitcnt vmcnt(0)" ::: "memory");
            const unsigned og = xb_add(&bar[XB_TOP], 1u);
            const unsigned tg = og / nx;
            if (og + 1u == (tg + 1u) * nx) xb_add(&bar[XB_TOPGEN], 1u);
            else XB_SPIN(xb_ld(&bar[XB_TOPGEN]) == tg, bar);
            }
            __builtin_amdgcn_fence(__ATOMIC_ACQUIRE, "agent");
            xb_add(&bar[XB_XGEN(b.x)], 1u);
            asm volatile("s_waitcnt vmcnt(0)" ::: "memory");
        } else {
            if (local) __builtin_amdgcn_fence(__ATOMIC_ACQUIRE, "agent");
            XB_SPIN(xb_ld(&bar[XB_XGEN(b.x)]) == gen, bar);
            if (!local) __builtin_amdgcn_fence(__ATOMIC_ACQUIRE, "agent");
            asm volatile("s_waitcnt vmcnt(0)" ::: "memory");
        }
    }
    __syncthreads();
}

constexpr int NWAVES = 8;
constexpr int BATCH = 4, SEQ = 8192, D = 1024, M = BATCH * SEQ, DEPTH = 2;
constexpr int INW = 2048, DFF = 2816, NMOD = 6;
constexpr int O_U = 0, O_QB = 256, O_KB = 640, O_VB = 1024, O_QC = 1408, O_KC = 1792, O_VC = 1920;
constexpr float RMS_EPS = 1e-6f;
constexpr float LOG2E = 1.4426950408889634f;
constexpr float QSCALE = 0.125f * LOG2E;

constexpr size_t MiB = 1u << 20;
constexpr size_t WS_CTL = 0, CTL_ZERO_BYTES = 131072;
constexpr size_t WS_MOD = 1 * MiB;
constexpr size_t WS_W = 2 * MiB, W_LAYER = 24 * MiB;
constexpr size_t W_IN = 0, W_OUT = 4 * MiB, W_GU = 6 * MiB, W_DN = 17 * MiB, W_PT = 23 * MiB;
constexpr size_t WS_H = 50 * MiB;
constexpr size_t WS_Z = 114 * MiB;
constexpr size_t WS_MIX = 436 * MiB;
constexpr size_t WS_HID = 114 * MiB;
constexpr size_t WS_XS = 306 * MiB;
constexpr size_t WS_AUX = 434 * MiB;
constexpr size_t WS_SUMSQ = WS_AUX;
constexpr size_t WS_GV = WS_AUX + 1 * MiB;
constexpr size_t WS_BIAS = WS_GV + 65536;
constexpr size_t BIAS_LAYER = (size_t)BATCH * (2048 + 5632) * 4;
constexpr size_t WS_BSCR = 370 * MiB;
constexpr size_t WS_ZC = 202 * MiB;
constexpr size_t WS_ZB = 130 * MiB;
constexpr size_t WS_END = 500 * MiB;
static_assert(WS_Z + (size_t)M * 256 * 2 <= WS_ZB && WS_ZB + 72 * MiB <= WS_ZC && WS_ZC + 40 * MiB <= WS_XS, "z region map");
static_assert(WS_HID + (size_t)M * DFF * 2 <= WS_XS && WS_MIX + (size_t)M * D * 2 <= WS_END && WS_AUX + 2 * MiB <= WS_MIX && WS_BSCR + 24 * MiB <= WS_AUX && WS_H + (size_t)M * D * 2 <= WS_Z, "ws map");
constexpr int CW_TMO = 0, CW_CODE = 1, CW_BAR = 4096  , CW_QUEUE = 20480, CW_GRP = 20480  , CW_GRPBAD = 20496  , CW_ZEROS = 24576  ;

constexpr int RING_OFF = 0, RING_BYTES = 131072;
constexpr int LDSCTL_OFF = RING_BYTES, MISC_OFF = 147456 - 256, LSEB_OFF = MISC_OFF - 6144;
constexpr int LDS_BYTES = 147456;

constexpr int PH_PRO = 0, PH_CONV = 1, PH_L0 = 2, PH_PER_LAYER = 5, PH_FINAL = PH_L0 + DEPTH * PH_PER_LAYER, NPHASES = PH_FINAL + 1;
#ifndef PROBE_DUP
#define PROBE_DUP 0
#endif
#ifndef PROBE_CUT
#define PROBE_CUT 0
#endif
#ifndef PROBE_MIXSEL
#define PROBE_MIXSEL 0
#endif
#ifndef PROBE_NOSTORE
#define PROBE_NOSTORE 0
#endif
#ifndef MK_ONE_LAUNCH
#define MK_ONE_LAUNCH 1
#endif

struct Frame {
    LAS unsigned char* lds;
    volatile LAS unsigned* MISC;
    gu32* ctl;
    int tid, lane, wave, G, vcu;
};

__device__ __forceinline__ float wave_sum(float v) {
#pragma unroll
    for (int o = 1; o < 64; o <<= 1) v += __shfl_xor(v, o);
    return v;
}
__device__ __forceinline__ float bf2f(unsigned short b) { return __uint_as_float((unsigned)b << 16); }
__device__ __forceinline__ float zero_() { float z; asm volatile("v_mov_b32 %0, 0" : "=v"(z)); return z; }
__device__ __forceinline__ f32x4 zero4_() { const float z = zero_(); return (f32x4){z, z, z, z}; }

__device__ __forceinline__ void tr_item(const float* W, int N, int k0, int n0, bf16* WT, int ldt, int drow0, float scale, LAS float* scr, int lane, bool img = true) {
#pragma unroll 8
    for (int i = 0; i < 32; ++i) { const int kk = 2 * i + (lane >> 5); scr[kk * 33 + (lane & 31)] = __builtin_nontemporal_load(W + (size_t)(k0 + kk) * N + n0 + (lane & 31)); }
    LDS_WAIT(); asm volatile("" ::: "memory");
    const int c = lane & 7;
#pragma unroll
    for (int j = 0; j < 4; ++j) { const int n = (lane >> 3) + 8 * j; const LAS float* s = scr + (8 * c) * 33 + n;
        v4u o; o.x = pk2(s[0 * 33] * scale, s[1 * 33] * scale); o.y = pk2(s[2 * 33] * scale, s[3 * 33] * scale); o.z = pk2(s[4 * 33] * scale, s[5 * 33] * scale); o.w = pk2(s[6 * 33] * scale, s[7 * 33] * scale);
        if (img) *(GAS v4u*)((unsigned char*)WT + pg8::img_off(drow0 + n, k0 + 8 * c, ldt / 64, true)) = o;
        else *(GAS v4u*)(WT + (size_t)(drow0 + n) * ldt + k0 + 8 * c) = o; }
    LDS_WAIT(); asm volatile("" ::: "memory");
}
constexpr int TI_IN = 16 * 64, TI_OUT = 16 * 32, TI_G = 16 * 88, TI_DN = 44 * 32, TI_P = 8, TI_LAYER = TI_IN + TI_OUT + 2 * TI_G + TI_DN + TI_P;
__device__ __forceinline__ void weight_item(const float* const* in, unsigned char* ws, int it, LAS float* scr, int lane) {
    const int l = it / TI_LAYER; int r = it % TI_LAYER;
    unsigned char* wl = ws + WS_W + (size_t)l * W_LAYER;
    if (r < TI_IN) { const int kb = r / 64, n0 = 32 * (r % 64); const bool isq = (n0 >= O_QB && n0 < O_KB) || (n0 >= O_QC && n0 < O_KC);
        tr_item(in[6] + (size_t)l * D * INW, INW, 64 * kb, n0, (bf16*)(wl + W_IN), D, n0, isq ? QSCALE : 1.0f, scr, lane); return; }
    r -= TI_IN;
    if (r < TI_OUT) { const int kb = r / 32, n0 = 32 * (r % 32); tr_item(in[10] + (size_t)l * D * D, D, 64 * kb, n0, (bf16*)(wl + W_OUT), D, n0, 1.0f, scr, lane); return; }
    r -= TI_OUT;
    if (r < 2 * TI_G) { const int up = r >= TI_G; if (up) r -= TI_G; const int kb = r / 88, n0 = 32 * (r % 88);
        tr_item(in[up ? 12 : 11] + (size_t)l * D * DFF, DFF, 64 * kb, n0, (bf16*)(wl + W_GU), D, 256 * (n0 >> 7) + 128 * up + (n0 & 127), 1.0f, scr, lane); return; }
    r -= 2 * TI_G;
    if (r < TI_DN) { const int kb = r / 32, n0 = 32 * (r % 32); tr_item(in[13] + (size_t)l * DFF * D, D, 64 * kb, n0, (bf16*)(wl + W_DN), DFF, n0, 1.0f, scr, lane); return; }
    r -= TI_DN;
    { const int g = r >> 1, n0 = 32 * (r & 1); tr_item(in[7] + (size_t)l * 16384 + g * 4096, 64, 0, n0, (bf16*)(wl + W_PT) + g * 4096, 64, n0, 1.0f, scr, lane, false); }
}
__device__ __forceinline__ void ada_item(Frame& F, const float* const* in, unsigned char* ws, int item) {
    LAS float* cact = (LAS float*)(F.lds);
    LAS float* red = (LAS float*)(F.lds + 16384);
    const int l = item / 96, cb = item % 96;
    const float* c = in[1];
    for (int i = F.tid; i < BATCH * D; i += NWAVES * 64) { const int b = i >> 10, k = i & 1023; const float v = c[i]; cact[k * 4 + b] = v / (1.0f + __expf(-v)); }
    __syncthreads();
    const float* W = in[4] + (size_t)l * D * (NMOD * D) + 64 * cb + F.lane;
    float a0 = 0.f, a1 = 0.f, a2 = 0.f, a3 = 0.f;
    const int kbeg = 128 * F.wave;
#pragma unroll 16
    for (int kk = 0; kk < 128; ++kk) { const float wv = __builtin_nontemporal_load(W + (size_t)(kbeg + kk) * (NMOD * D)); const f32x4 ca = *(const LAS f32x4*)(cact + (kbeg + kk) * 4);
        a0 += ca.x * wv; a1 += ca.y * wv; a2 += ca.z * wv; a3 += ca.w * wv; }
    red[(F.wave * 4 + 0) * 64 + F.lane] = a0; red[(F.wave * 4 + 1) * 64 + F.lane] = a1; red[(F.wave * 4 + 2) * 64 + F.lane] = a2; red[(F.wave * 4 + 3) * 64 + F.lane] = a3;
    __syncthreads();
    if (F.wave < 4) { float s = in[5][(size_t)l * NMOD * D + 64 * cb + F.lane];
#pragma unroll
        for (int w = 0; w < 8; ++w) s += red[(w * 4 + F.wave) * 64 + F.lane];
        ((float*)(ws + WS_MOD))[((size_t)l * BATCH + F.wave) * (NMOD * D) + 64 * cb + F.lane] = s; }
    __syncthreads();
}
__device__ __forceinline__ void p_prologue(Frame& F, const float* const* in, unsigned char* ws) {
    for (int item = blockIdx.x; item < DEPTH * 96; item += F.G) ada_item(F, in, ws, item);
    LAS float* scr = (LAS float*)(F.lds + RING_OFF + F.wave * 16384);
    const int gw = blockIdx.x * NWAVES + F.wave, NGW = F.G * NWAVES;
    for (int it = gw; it < DEPTH * TI_LAYER; it += NGW) weight_item(in, ws, it, scr, F.lane);
    { GAS f32x4* z = (GAS f32x4*)(ws + WS_SUMSQ) + M / 4; const int n4 = 4 * M / 4;
      for (int i = blockIdx.x * (NWAVES * 64) + F.tid; i < n4; i += F.G * NWAVES * 64) z[i] = zero4_(); }
}

__device__ __forceinline__ void p_conv(Frame& F, const float* const* in, unsigned char* ws) {
    const float* MOD = (const float*)(ws + WS_MOD);
    const int NGW = F.G * NWAVES, rpw = M / NGW;
    const int gw = (F.G == 256) ? (((int)blockIdx.x & 7) * 32 + ((int)blockIdx.x >> 3)) * NWAVES + F.wave : (int)blockIdx.x * NWAVES + F.wave;
    {
        const int row0 = gw * rpw, b = row0 / SEQ;
        const float* mb = MOD + (size_t)b * (NMOD * D);
        const float* xin = in[0]; bf16* hout = (bf16*)(ws + WS_H); float* ssq = (float*)(ws + WS_SUMSQ);
        f32x4 Gv[4];
#pragma unroll
        for (int j = 0; j < 4; ++j) { const int cidx = 4 * F.lane + 256 * j; const f32x4 g = *(const f32x4*)(in[2] + cidx), sc = *(const f32x4*)(mb + 1 * D + cidx); Gv[j] = g * (sc + 1.0f); }
        for (int rr = 0; rr < rpw; rr += 4) {
            f32x4 v[4][4];
#pragma unroll
            for (int i = 0; i < 4; ++i) { const GAS f32x4* xr = (const GAS f32x4*)(xin + (size_t)(row0 + rr + i) * D) + F.lane;
#pragma unroll
                for (int j = 0; j < 4; ++j) v[i][j] = __builtin_nontemporal_load(xr + 64 * j); }
#pragma unroll
            for (int i = 0; i < 4; ++i) { const size_t row = (size_t)(row0 + rr + i); float s = 0.f;
#pragma unroll
                for (int j = 0; j < 4; ++j) s += (v[i][j].x * v[i][j].x + v[i][j].y * v[i][j].y) + (v[i][j].z * v[i][j].z + v[i][j].w * v[i][j].w);
                s = wave_sum(s); if (F.lane == 0) ssq[row] = s;
                unsigned char* hb = (unsigned char*)hout + 8 * (F.lane & 1);
#pragma unroll
                for (int j = 0; j < 4; ++j) { const f32x4 o = v[i][j] * Gv[j]; *(GAS unsigned long long*)(hb + pg8::img_off((int)row, (4 * F.lane + 256 * j) & ~7, D / 64, false)) = (unsigned long long)pk2(o.x, o.y) | ((unsigned long long)pk2(o.z, o.w) << 32);
 } }
        }
    }
    {
        float* GV = (float*)(ws + WS_GV);
        for (int i = blockIdx.x * (NWAVES * 64) + F.tid; i < DEPTH * 2 * BATCH * D; i += F.G * NWAVES * 64) { const int col = i & (D - 1), b = (i >> 10) & 3, w = (i >> 12) & 1, l = i >> 13;
            GV[i] = in[w ? 3 : 2][l * D + col] * (1.0f + MOD[((size_t)l * BATCH + b) * (NMOD * D) + (w ? 4 : 1) * D + col]); }
    }
    {
        const int g0 = 8 * gw;
        if (g0 < DEPTH * (INW + 2 * DFF)) {
            const int l = g0 / (INW + 2 * DFF), rl = g0 % (INW + 2 * DFF), w = rl >= INW, n0 = w ? rl - INW : rl, N = w ? 2 * DFF : INW;
            const unsigned char* Bt = ws + WS_W + (size_t)l * W_LAYER + (w ? W_GU : W_IN);
            float* bias = (float*)(ws + WS_BIAS + (size_t)l * BIAS_LAYER) + (w ? BATCH * INW : 0);
            const float* shp = MOD + (size_t)l * BATCH * (NMOD * D) + (w ? 3 : 0) * D + 16 * F.lane;
            v4u wr[8][2];
#pragma unroll
            for (int i = 0; i < 8; ++i) { wr[i][0] = *(const GAS v4u*)(Bt + pg8::img_off(n0 + i, 16 * F.lane, D / 64, true)); wr[i][1] = *(const GAS v4u*)(Bt + pg8::img_off(n0 + i, 16 * F.lane + 8, D / 64, true)); }
            f32x4 sh[4][4];
#pragma unroll
            for (int b = 0; b < 4; ++b)
#pragma unroll
                for (int j = 0; j < 4; ++j) sh[b][j] = *(const f32x4*)(shp + (size_t)b * (NMOD * D) + 4 * j);
#pragma unroll
            for (int i = 0; i < 8; ++i) { const v4u w0 = wr[i][0], w1 = wr[i][1];
                float wf[16];
                wf[0] = __uint_as_float(w0.x << 16); wf[1] = __uint_as_float(w0.x & 0xffff0000u); wf[2] = __uint_as_float(w0.y << 16); wf[3] = __uint_as_float(w0.y & 0xffff0000u);
                wf[4] = __uint_as_float(w0.z << 16); wf[5] = __uint_as_float(w0.z & 0xffff0000u); wf[6] = __uint_as_float(w0.w << 16); wf[7] = __uint_as_float(w0.w & 0xffff0000u);
                wf[8] = __uint_as_float(w1.x << 16); wf[9] = __uint_as_float(w1.x & 0xffff0000u); wf[10] = __uint_as_float(w1.y << 16); wf[11] = __uint_as_float(w1.y & 0xffff0000u);
                wf[12] = __uint_as_float(w1.z << 16); wf[13] = __uint_as_float(w1.z & 0xffff0000u); wf[14] = __uint_as_float(w1.w << 16); wf[15] = __uint_as_float(w1.w & 0xffff0000u);
                float acc[4];
#pragma unroll
                for (int b = 0; b < 4; ++b) { float a = 0.f;
#pragma unroll
                    for (int j = 0; j < 4; ++j) a += (wf[4 * j] * sh[b][j].x + wf[4 * j + 1] * sh[b][j].y) + (wf[4 * j + 2] * sh[b][j].z + wf[4 * j + 3] * sh[b][j].w);
                    acc[b] = wave_sum(a); }
                if (F.lane < 4) bias[(size_t)F.lane * N + n0 + i] = F.lane == 0 ? acc[0] : F.lane == 1 ? acc[1] : F.lane == 2 ? acc[2] : acc[3]; }
        }
    }
}
__device__ __forceinline__ void p_norm_final(Frame& F, const bf16* xin, const float* ssq, float* out, const float* gvec) {
    const int NGW = F.G * NWAVES, rpw = M / NGW;
    const int gw = (F.G == 256) ? (((int)blockIdx.x & 7) * 32 + ((int)blockIdx.x >> 3)) * NWAVES + F.wave : (int)blockIdx.x * NWAVES + F.wave;
    const int row0 = gw * rpw;
    f32x4 Gv[4];
#pragma unroll
    for (int j = 0; j < 4; ++j) Gv[j] = *(const f32x4*)(gvec + 4 * F.lane + 256 * j);
    for (int rr = 0; rr < rpw; rr += 4) {
        unsigned long long w[4][4]; float ss[4];
#pragma unroll
        for (int i = 0; i < 4; ++i) { const unsigned char* xr = (const unsigned char*)xin + 8 * (F.lane & 1); ss[i] = ssq[row0 + rr + i];
#pragma unroll
            for (int j = 0; j < 4; ++j) w[i][j] = *(const GAS unsigned long long*)(xr + pg8::img_off(row0 + rr + i, (4 * F.lane + 256 * j) & ~7, D / 64, false)); }
#pragma unroll
        for (int i = 0; i < 4; ++i) { const float rstd = 1.0f / sqrtf(ss[i] * (1.0f / D) + RMS_EPS);
            GAS f32x4* o = (GAS f32x4*)(out + (size_t)(row0 + rr + i) * D) + F.lane;
#pragma unroll
            for (int j = 0; j < 4; ++j) { const unsigned wl = (unsigned)w[i][j], wh = (unsigned)(w[i][j] >> 32);
                const f32x4 v = {pg8::h_lo(wl), pg8::h_hi(wl), pg8::h_lo(wh), pg8::h_hi(wh)};
                __builtin_nontemporal_store(v * rstd * Gv[j], o + 64 * j); } }
    }
}

namespace mx {
typedef short bf16x8 __attribute__((ext_vector_type(8)));
typedef short s16x4 __attribute__((ext_vector_type(4)));
typedef float f32x16 __attribute__((ext_vector_type(16)));
typedef unsigned u32x4 __attribute__((ext_vector_type(4)));
typedef unsigned u32x2 __attribute__((ext_vector_type(2)));
typedef float f32x2_t __attribute__((ext_vector_type(2))); typedef __bf16 bf16x2_t __attribute__((ext_vector_type(2)));
constexpr float THR = 8.0f;
constexpr int POOL_PITCH = 544;
__device__ __forceinline__ unsigned cvtpk(float lo, float hi) { f32x2_t v = {lo, hi}; bf16x2_t b = __builtin_convertvector(v, bf16x2_t); return __builtin_bit_cast(unsigned, b); }
__device__ __forceinline__ float hswap_max(float v) { auto rr = __builtin_amdgcn_permlane32_swap(__float_as_uint(v), __float_as_uint(v), false, false); return fmaxf(__uint_as_float(rr[0]), __uint_as_float(rr[1])); }
__device__ __forceinline__ float hswap_sum(float v) { auto rr = __builtin_amdgcn_permlane32_swap(__float_as_uint(v), __float_as_uint(v), false, false); return __uint_as_float(rr[0]) + __uint_as_float(rr[1]); }
__device__ __forceinline__ s16x4 vtr(const LAS char* p) { return __builtin_bit_cast(s16x4, __builtin_amdgcn_ds_read_tr16_b64_v4i16((LAS s16x4*)p)); }
__device__ __forceinline__ f32x16 zero16_() { const float z = zero_(); return (f32x16){z, z, z, z, z, z, z, z, z, z, z, z, z, z, z, z}; }
__device__ __forceinline__ int kt_of(int i) { return (i & 1) ? -((i + 1) >> 1) : (i >> 1); }

template <int VAR>
__device__ __forceinline__ float scores(f32x16& t, const bf16x8 (&kf)[4], const bf16x8 (&qf)[4], float relf, float sl, float slope2, float Rf) {
    f32x16 s = {0.f, 0.f, 0.f, 0.f, 0.f, 0.f, 0.f, 0.f, 0.f, 0.f, 0.f, 0.f, 0.f, 0.f, 0.f, 0.f};
#pragma unroll
    for (int i = 0; i < 4; ++i) s = __builtin_amdgcn_mfma_f32_32x32x16_bf16(kf[i], qf[i], s, 0, 0, 0);
    if (VAR == 0) {
#pragma unroll
        for (int r = 0; r < 16; ++r) t[r] = __builtin_fmaf(-__builtin_fabsf(relf - (float)((r & 3) + 8 * (r >> 2))), slope2, s[r]);
        return 0.f;
    } else {
#pragma unroll
        for (int r = 0; r < 16; ++r) { const float c = (float)((r & 3) + 8 * (r >> 2)); float v = __builtin_fmaf(sl, c, s[r]); if (VAR == 2) v = __builtin_fabsf(relf - c) > Rf ? -INFINITY : v; t[r] = v; }
        return -sl * relf;
    }
}
__device__ __forceinline__ float lane_max(const f32x16& t) {
    float a = fmaxf(fmaxf(t[0], t[1]), fmaxf(t[2], t[3])), b = fmaxf(fmaxf(t[4], t[5]), fmaxf(t[6], t[7])), c = fmaxf(fmaxf(t[8], t[9]), fmaxf(t[10], t[11])), d = fmaxf(fmaxf(t[12], t[13]), fmaxf(t[14], t[15]));
    return fmaxf(fmaxf(a, b), fmaxf(c, d));
}
__device__ __forceinline__ float tile_max(const f32x16& t) {
    float a = fmaxf(fmaxf(t[0], t[1]), fmaxf(t[2], t[3])), b = fmaxf(fmaxf(t[4], t[5]), fmaxf(t[6], t[7])), c = fmaxf(fmaxf(t[8], t[9]), fmaxf(t[10], t[11])), d = fmaxf(fmaxf(t[12], t[13]), fmaxf(t[14], t[15]));
    return hswap_max(fmaxf(fmaxf(a, b), fmaxf(c, d)));
}
__device__ __forceinline__ void load_frag4(bf16x8 (&f)[4], const bf16* rowp, int hi) {
#pragma unroll
    for (int i = 0; i < 4; ++i) f[i] = *(const bf16x8*)(rowp + 16 * i + 8 * hi);
}
__device__ __forceinline__ void load_tile_frags(bf16x8 (&f)[4], const char* tile, int lane) {
#pragma unroll
    for (int s = 0; s < 4; ++s) f[s] = *(const bf16x8*)(tile + s * 1024 + lane * 16);
}
__device__ __forceinline__ void dma_tile(LAS char* dst, const char* tile, int lane) {
#pragma unroll
    for (int j = 0; j < 4; ++j) __builtin_amdgcn_global_load_lds((const unsigned*)(tile + j * 1024 + lane * 16), (LAS unsigned*)(dst + j * 1024), 16, 0, 0);
}
__device__ __forceinline__ void dma_v(LAS char* vb, const bf16* vrow0, long rs, int lane) {
#pragma unroll
    for (int j = 0; j < 4; ++j) __builtin_amdgcn_global_load_lds((const unsigned*)(vrow0 + (long)(16 * (j & 1) + (lane >> 2)) * rs + (4 * (j >> 1) + (lane & 3)) * 8), (LAS unsigned*)(vb + j * 1024), 16, 0, 0);
}
__device__ __forceinline__ void load_vfrags(bf16x8 (&vf)[2][2], const LAS char* vaddr) {
#pragma unroll
    for (int d0 = 0; d0 < 2; ++d0)
#pragma unroll
        for (int ks = 0; ks < 2; ++ks) { const s16x4 lo = vtr(vaddr + d0 * 2048 + ks * 1024), hh = vtr(vaddr + d0 * 2048 + ks * 1024 + 512);
            vf[d0][ks] = (bf16x8){lo[0], lo[1], lo[2], lo[3], hh[0], hh[1], hh[2], hh[3]}; }
}
__device__ __forceinline__ void pv_tile(f32x16 (&o)[2], const bf16x8 (&vf)[2][2], const f32x16& p) {
    u32x4 w0, w1;
    w0.x = cvtpk(p[0], p[1]); w0.y = cvtpk(p[2], p[3]); w0.z = cvtpk(p[4], p[5]); w0.w = cvtpk(p[6], p[7]);
    w1.x = cvtpk(p[8], p[9]); w1.y = cvtpk(p[10], p[11]); w1.z = cvtpk(p[12], p[13]); w1.w = cvtpk(p[14], p[15]);
    const bf16x8 pa0 = __builtin_bit_cast(bf16x8, w0), pa1 = __builtin_bit_cast(bf16x8, w1);
#pragma unroll
    for (int d0 = 0; d0 < 2; ++d0) { o[d0] = __builtin_amdgcn_mfma_f32_32x32x16_bf16(vf[d0][0], pa0, o[d0], 0, 0, 0); o[d0] = __builtin_amdgcn_mfma_f32_32x32x16_bf16(vf[d0][1], pa1, o[d0], 0, 0, 0); }
}
__device__ __forceinline__ void store_o(bf16* MIX, int row, int col, const f32x16 (&o)[2], float scale, int hi) {
#pragma unroll
    for (int d0 = 0; d0 < 2; ++d0)
#pragma unroll
        for (int g = 0; g < 4; g += 2) {
            const unsigned ax = cvtpk(o[d0][4 * g] * scale, o[d0][4 * g + 1] * scale), ay = cvtpk(o[d0][4 * g + 2] * scale, o[d0][4 * g + 3] * scale);
            const unsigned bx = cvtpk(o[d0][4 * g + 4] * scale, o[d0][4 * g + 5] * scale), by = cvtpk(o[d0][4 * g + 6] * scale, o[d0][4 * g + 7] * scale);
            const auto rx = __builtin_amdgcn_permlane32_swap(ax, bx, false, false); const auto ry = __builtin_amdgcn_permlane32_swap(ay, by, false, false);
            u32x4 w; w.x = rx[0]; w.y = ry[0]; w.z = rx[1]; w.w = ry[1];
            *(u32x4*)((unsigned char*)MIX + pg8::img_off(row, col + 32 * d0 + 8 * g + 8 * hi, D / 64, false)) = w; }
}
__device__ __forceinline__ void pack_o(u32x4 (&w)[4], const f32x16 (&o)[2], float scale) {
#pragma unroll
    for (int d0 = 0; d0 < 2; ++d0)
#pragma unroll
        for (int g = 0; g < 4; g += 2) {
            const unsigned ax = cvtpk(o[d0][4 * g] * scale, o[d0][4 * g + 1] * scale), ay = cvtpk(o[d0][4 * g + 2] * scale, o[d0][4 * g + 3] * scale);
            const unsigned bx = cvtpk(o[d0][4 * g + 4] * scale, o[d0][4 * g + 5] * scale), by = cvtpk(o[d0][4 * g + 6] * scale, o[d0][4 * g + 7] * scale);
            const auto rx = __builtin_amdgcn_permlane32_swap(ax, bx, false, false); const auto ry = __builtin_amdgcn_permlane32_swap(ay, by, false, false);
            w[2 * d0 + (g >> 1)] = (u32x4){rx[0], ry[0], rx[1], ry[1]}; }
}
__device__ __forceinline__ float alibi_slope(int k  ) { return __builtin_amdgcn_exp2f(-8.0f * (float)(k + 1) / 12.0f); }
__device__ __forceinline__ void scale_o(f32x16 (&o)[2], float f) {
#pragma unroll
    for (int r = 0; r < 16; ++r) { o[0][r] *= f; o[1][r] *= f; }
}

template <bool FIRST, bool WITH_O>
__device__ __forceinline__ void step_rest(f32x16 (&o)[2], float& m, float& l, f32x16& t, float off, const bf16x8 (&vf)[2][2]) {
    const float tm = hswap_max(lane_max(t) + off);
    if (FIRST) m = tm;
    else if (__any(tm - m > THR)) { const float dl = fmaxf(tm - m, 0.f), f = __builtin_amdgcn_exp2f(-dl); l *= f; if (WITH_O) scale_o(o, f); m += dl; }
    const float bm = off - m; f32x2_t ps = {0.f, 0.f}; const f32x2_t bm2 = {bm, bm};
#pragma unroll
    for (int r = 0; r < 16; r += 2) { const f32x2_t x = (f32x2_t){t[r], t[r + 1]} + bm2; t[r] = __builtin_amdgcn_exp2f(x.x); t[r + 1] = __builtin_amdgcn_exp2f(x.y); ps += (f32x2_t){t[r], t[r + 1]}; }
    l += ps.x + ps.y;
    if (WITH_O) pv_tile(o, vf, t);
}
template <int VAR, bool FIRST, bool WITH_O>
__device__ __forceinline__ void step(f32x16 (&o)[2], float& m, float& l, const bf16x8 (&kf)[4], const bf16x8 (&qf)[4], const bf16x8 (&vf)[2][2], float relf, float sl, float slope2, float Rf) {
    f32x16 t; const float off = scores<VAR>(t, kf, qf, relf, sl, slope2, Rf);
    step_rest<FIRST, WITH_O>(o, m, l, t, off, vf);
}

__device__ __forceinline__ void pair_rest(f32x16 (&o)[2], float& m, float& l, f32x16& tL, f32x16& tR, float offL, float offR, const LAS char* vL, const LAS char* vR) {
    const float tm = hswap_max(fmaxf(lane_max(tL) + offL, lane_max(tR) + offR));
    if (__any(tm - m > THR)) { const float dl = fmaxf(tm - m, 0.f), f = __builtin_amdgcn_exp2f(-dl); l *= f; scale_o(o, f); m += dl; }
    const float bL = offL - m, bR = offR - m; f32x2_t ps = {0.f, 0.f}; const f32x2_t bL2 = {bL, bL}, bR2 = {bR, bR};
#pragma unroll
    for (int r = 0; r < 16; r += 2) { const f32x2_t xL = (f32x2_t){tL[r], tL[r + 1]} + bL2, xR = (f32x2_t){tR[r], tR[r + 1]} + bR2;
        tL[r] = __builtin_amdgcn_exp2f(xL.x); tL[r + 1] = __builtin_amdgcn_exp2f(xL.y); tR[r] = __builtin_amdgcn_exp2f(xR.x); tR[r + 1] = __builtin_amdgcn_exp2f(xR.y);
        ps += (f32x2_t){tL[r], tL[r + 1]}; ps += (f32x2_t){tR[r], tR[r + 1]}; }
    l += ps.x + ps.y;
    { bf16x8 vf[2][2]; load_vfrags(vf, vL); pv_tile(o, vf, tL); }
    { bf16x8 vf[2][2]; load_vfrags(vf, vR); pv_tile(o, vf, tR); }
}
template <int VAR>
__device__ __forceinline__ void step_pair_lds(f32x16 (&o)[2], float& m, float& l, const LAS char* kL, const LAS char* kR, const LAS char* vL, const LAS char* vR, bf16x8 (&qf)[4],
                                              float relfL, float relfR, float slope2, float Rf, const char* qnext = nullptr, int lane = 0) {
    f32x16 tL, tR; float offL, offR;
    { bf16x8 kf[4];
#pragma unroll
      for (int s = 0; s < 4; ++s) kf[s] = *(const LAS bf16x8*)(kL + s * 1024);
      offL = scores<VAR>(tL, kf, qf, relfL, slope2, slope2, Rf); }
    { bf16x8 kf[4];
#pragma unroll
      for (int s = 0; s < 4; ++s) kf[s] = *(const LAS bf16x8*)(kR + s * 1024);
      offR = scores<VAR>(tR, kf, qf, relfR, -slope2, slope2, Rf); }
    if (qnext) load_tile_frags(qf, qnext, lane);
    pair_rest(o, m, l, tL, tR, offL, offR, vL, vR);
}
template <int VAR>
__device__ __forceinline__ void step_pair_regk(f32x16 (&o)[2], float& m, float& l, const bf16x8 (&kfL)[4], const bf16x8 (&kfR)[4], const LAS char* vL, const LAS char* vR, const bf16x8 (&qf)[4],
                                               float relfL, float relfR, float slope2, float Rf) {
    f32x16 tL, tR; const float offL = scores<VAR>(tL, kfL, qf, relfL, slope2, slope2, Rf), offR = scores<VAR>(tR, kfR, qf, relfR, -slope2, slope2, Rf);
    pair_rest(o, m, l, tL, tR, offL, offR, vL, vR);
}

__device__ __forceinline__ void dma_k(LAS char* kb, const bf16* krow0, long rs, int lane) {
#pragma unroll
    for (int s = 0; s < 4; ++s) __builtin_amdgcn_global_load_lds((const unsigned*)(krow0 + (long)(lane & 31) * rs + 16 * s + 8 * (lane >> 5)), (LAS unsigned*)(kb + s * 1024), 16, 0, 0);
}
struct BTile { const char* qb; const char* kb; const char* vb; int nt  , t0  , n0, head, d, r, tl; float slope2; };
__device__ __forceinline__ BTile b_decode(const char* ZB, int b, int c, int j, int qi, int q) {
    BTile t; const int g = qi >> 4, i = qi & 15, lg = 2 * g; t.d = 1 << lg;
    t.r = i >> (4 - lg); const int isub = i & ((16 >> lg) - 1); t.n0 = ((512 * c) >> lg) + 32 * isub; t.nt = 256 >> lg; t.t0 = t.n0 >> 5;
    t.head = 2 * g + j; t.slope2 = alibi_slope(6 + t.head) * (float)t.d * LOG2E;
    const size_t tb = (size_t)(t.head * 4 + b) * 256 + ((size_t)t.r << (8 - lg));
    t.qb = ZB + (tb << 12); t.kb = ZB + ((tb + 6 * 4 * 256) << 12); t.vb = ZB + ((tb + 2 * 6 * 4 * 256) << 12);
    t.tl = g * 512 + (32 * isub + q) * t.d + t.r;
    return t;
}
__device__ __forceinline__ void b_issue_qk(const BTile& t, bf16x8 (&qf)[4], bf16x8 (&kf)[5][4], bool (&val)[5], int (&kc)[5], int lane) {
    load_tile_frags(qf, t.qb + ((size_t)t.t0 << 12), lane);
#pragma unroll
    for (int i = 0; i < 5; ++i) { const int kt = t.t0 + kt_of(i); val[i] = kt >= 0 && kt < t.nt; kc[i] = kt < 0 ? 0 : (kt >= t.nt ? t.nt - 1 : kt);
        load_tile_frags(kf[i], t.kb + ((size_t)kc[i] << 12), lane); }
}
__device__ __forceinline__ void fill_ninf(f32x16& t) {
#pragma unroll
    for (int r = 0; r < 16; ++r) t[r] = -INFINITY;
}
__device__ __forceinline__ float b_qtile(f32x16 (&o)[2], const BTile& t, const BTile& tn, bool has_next, bf16x8 (&qf)[4], bf16x8 (&kf)[5][4], bool (&val)[5], int (&kc)[5], LAS char* vb, int lane) {
    const int q = lane & 31, hi = lane >> 5;
    const float slope2 = t.slope2;
    const LAS char* vaddr = vb + (4 * hi + ((lane & 15) >> 2)) * 64 + ((lane >> 4) & 1) * 32 + (lane & 3) * 8;
    float m = 0.f, l = 0.f;
    {
        bf16x8 vf[2][2]; load_vfrags(vf, vaddr);
        asm volatile("s_waitcnt lgkmcnt(0)" ::: "memory"); dma_tile(vb, t.vb + ((size_t)kc[4] << 12), lane);
        step<0, true, true>(o, m, l, kf[0], qf, vf, (float)(q - 4 * hi), slope2, slope2, 64.0f); }
    {
        f32x16 tL, tR; const float offL = scores<1>(tL, kf[1], qf, (float)(q + 32 - 4 * hi), slope2, slope2, 64.0f), offR = scores<1>(tR, kf[2], qf, (float)(q - 32 - 4 * hi), -slope2, slope2, 64.0f);
        if (!val[1]) fill_ninf(tL); if (!val[2]) fill_ninf(tR);
        pair_rest(o, m, l, tL, tR, offL, offR, vaddr + 4096, vaddr + 8192); }
    asm volatile("s_waitcnt vmcnt(0)" ::: "memory");
    {
        f32x16 tL, tR; const float offL = scores<2>(tL, kf[3], qf, (float)(q + 64 - 4 * hi), slope2, slope2, 64.0f), offR = scores<2>(tR, kf[4], qf, (float)(q - 64 - 4 * hi), -slope2, slope2, 64.0f);
        if (!val[3]) fill_ninf(tL); if (!val[4]) fill_ninf(tR);
        if (has_next) {
            asm volatile("s_waitcnt lgkmcnt(0)" ::: "memory");
            b_issue_qk(tn, qf, kf, val, kc, lane);
            dma_tile(vb + 4096, tn.vb + ((size_t)kc[1] << 12), lane); dma_tile(vb + 8192, tn.vb + ((size_t)kc[2] << 12), lane); }
        pair_rest(o, m, l, tL, tR, offL, offR, vaddr + 12288, vaddr);
        if (has_next) { asm volatile("s_waitcnt lgkmcnt(0)" ::: "memory");
            dma_tile(vb, tn.vb + ((size_t)kc[0] << 12), lane); dma_tile(vb + 12288, tn.vb + ((size_t)kc[3] << 12), lane); } }
    const float lt = hswap_sum(l);
    scale_o(o, 1.0f / lt);
    return m + __builtin_amdgcn_logf(lt);
}
__device__ __forceinline__ void b_unit(const char* ZB, bf16* MIX, char* SCR, int u, LAS char* lds, int wave, int lane) {
    const int b = u >> 5, c = (u >> 1) & 15, j = u & 1;
    LAS float* lseb = (LAS float*)(lds + LSEB_OFF);
    LAS char* vb = lds + wave * 16384;
    char* scr = SCR + ((size_t)(u * 8 + wave) * 6 << 12) + lane * 16;
    const int q = lane & 31, hi = lane >> 5;
    bf16x8 qf[4], kf[5][4]; bool val[5]; int kc[5];
    BTile t = b_decode(ZB, b, c, j, wave, q);
    b_issue_qk(t, qf, kf, val, kc, lane);
#pragma unroll
    for (int i = 0; i < 4; ++i) dma_tile(vb + i * 4096, t.vb + ((size_t)kc[i] << 12), lane);
#pragma unroll 1
    for (int it = 0; it < 6; ++it) { const bool has_next = it < 5; const BTile tn = b_decode(ZB, b, c, j, wave + 8 * (has_next ? it + 1 : it), q);
        if (it == 0) asm volatile("s_waitcnt vmcnt(0)" ::: "memory"); else asm volatile("s_waitcnt vmcnt(4)" ::: "memory");
        f32x16 o[2]; o[0] = zero16_(); o[1] = zero16_();
        const float lse = b_qtile(o, t, tn, has_next, qf, kf, val, kc, vb, lane);
        if (hi == 0) lseb[t.tl] = lse;
        u32x4 w[4]; pack_o(w, o, 1.0f);
#pragma unroll
        for (int k = 0; k < 4; ++k) *(u32x4*)(scr + ((size_t)it << 12) + k * 1024) = w[k];
        t = tn; }
    __syncthreads();
#pragma unroll 1
    for (int it0 = 0; it0 < 6; it0 += 3) { u32x4 w[3][4];
#pragma unroll
        for (int ii = 0; ii < 3; ++ii)
#pragma unroll
            for (int k = 0; k < 4; ++k) w[ii][k] = *(const u32x4*)(scr + ((size_t)(it0 + ii) << 12) + k * 1024);
#pragma unroll
        for (int ii = 0; ii < 3; ++ii) { const BTile tt = b_decode(ZB, b, c, j, wave + 8 * (it0 + ii), q);
            const int tk = tt.tl & 511; const float l0 = lseb[tk], l1 = lseb[512 + tk], l2 = lseb[1024 + tk], own = lseb[tt.tl]; const float mm = fmaxf(l0, fmaxf(l1, l2));
            const float a = __builtin_amdgcn_exp2f(own - mm) / (__builtin_amdgcn_exp2f(l0 - mm) + __builtin_amdgcn_exp2f(l1 - mm) + __builtin_amdgcn_exp2f(l2 - mm));
            const int orow = b * SEQ + (tt.n0 + q) * tt.d + tt.r, ocol = 256 + 64 * tt.head + 8 * hi;
#pragma unroll
            for (int k = 0; k < 4; ++k) { const u32x4 x = w[ii][k]; u32x4 y;
                y.x = cvtpk(__uint_as_float(x.x << 16) * a, __uint_as_float(x.x & 0xffff0000u) * a); y.y = cvtpk(__uint_as_float(x.y << 16) * a, __uint_as_float(x.y & 0xffff0000u) * a);
                y.z = cvtpk(__uint_as_float(x.z << 16) * a, __uint_as_float(x.z & 0xffff0000u) * a); y.w = cvtpk(__uint_as_float(x.w << 16) * a, __uint_as_float(x.w & 0xffff0000u) * a);
                *(u32x4*)((unsigned char*)MIX + pg8::img_off(orow, ocol + 32 * (k >> 1) + 16 * (k & 1), D / 64, false)) = y; } } }
    __syncthreads();
}
__device__ __forceinline__ void c_unit(const char* ZC, bf16* MIX, const float* sink, int u, LAS char* lds, int wave, int lane) {
    const int b = u >> 6, kvh = (u >> 5) & 1, q0 = 256 * (u & 31), n0 = q0 + 32 * wave;
    const int q = lane & 31, hi = lane >> 5;
    const char* kt0 = ZC + ((size_t)((6 + kvh) * 4 + b) * 256 << 12); const char* vt0 = ZC + ((size_t)((8 + kvh) * 4 + b) * 256 << 12);
#pragma unroll
    for (int tt = 0; tt < 2; ++tt) { const int t = 2 * wave + tt, T = (q0 >> 5) - 4 + t;
        if (T >= 0 && T < SEQ / 32) { dma_tile(lds + t * 8192, kt0 + ((size_t)T << 12), lane); dma_tile(lds + t * 8192 + 4096, vt0 + ((size_t)T << 12), lane); } }
    const char* qt0 = ZC + (((size_t)((3 * kvh) * 4 + b) * 256 + (n0 >> 5)) << 12);
    bf16x8 qf[4]; load_tile_frags(qf, qt0, lane);
    asm volatile("s_waitcnt vmcnt(0)" ::: "memory");
    __syncthreads();
    const LAS char* kbase = lds + lane * 16;
    const LAS char* vbase = lds + 4096 + (4 * hi + ((lane & 15) >> 2)) * 64 + ((lane >> 4) & 1) * 32 + (lane & 3) * 8;
#pragma unroll 1
    for (int hh = 0; hh < 3; ++hh) { const int head = 3 * kvh + hh;
        const char* qnext = hh < 2 ? qt0 + ((size_t)(hh + 1) * 4 * 256 << 12) : nullptr; bool reloaded = false;
        f32x16 o[2]; o[0] = zero16_(); o[1] = zero16_();
        float m = sink[head] * LOG2E, l = hi ? 0.f : 1.0f; const float slope2 = alibi_slope(head) * LOG2E;
        {
            const int t = wave + 4; bf16x8 kf[4];
#pragma unroll
            for (int s = 0; s < 4; ++s) kf[s] = *(const LAS bf16x8*)(kbase + t * 8192 + s * 1024);
            bf16x8 vf[2][2]; load_vfrags(vf, vbase + t * 8192);
            step<0, false, true>(o, m, l, kf, qf, vf, (float)(q - 4 * hi), slope2, slope2, 128.0f); }
#pragma unroll 1
        for (int k = 1; k <= 4; ++k) { const int tL = wave + 4 - k, tR = wave + 4 + k; const bool vL = n0 - 32 * k >= 0, vR = n0 + 32 * k < SEQ;
            const float relfL = (float)(q + 32 * k - 4 * hi), relfR = (float)(q - 32 * k - 4 * hi);
            if (vL && vR) {
                if (k < 4) step_pair_lds<1>(o, m, l, kbase + tL * 8192, kbase + tR * 8192, vbase + tL * 8192, vbase + tR * 8192, qf, relfL, relfR, slope2, 128.0f);
                else { step_pair_lds<2>(o, m, l, kbase + tL * 8192, kbase + tR * 8192, vbase + tL * 8192, vbase + tR * 8192, qf, relfL, relfR, slope2, 128.0f, qnext, lane); reloaded = true; } }
            else if (vL || vR) { const int t = vL ? tL : tR; bf16x8 kf[4];
#pragma unroll
                for (int s = 0; s < 4; ++s) kf[s] = *(const LAS bf16x8*)(kbase + t * 8192 + s * 1024);
                bf16x8 vf[2][2]; load_vfrags(vf, vbase + t * 8192);
                const float relf = vL ? relfL : relfR, sl = vL ? slope2 : -slope2;
                if (k < 4) step<1, false, true>(o, m, l, kf, qf, vf, relf, sl, slope2, 128.0f); else step<2, false, true>(o, m, l, kf, qf, vf, relf, sl, slope2, 128.0f); } }
        if (!reloaded && qnext) load_tile_frags(qf, qnext, lane);
        store_o(MIX, b * SEQ + n0 + q, 640 + 64 * head, o, 1.0f / hswap_sum(l), hi); }
    __syncthreads();
}
template <int G>
__device__ __forceinline__ void pool_group(const LAS char* rows, bf16* MIX, const bf16* wpt, const float* pscale, int row0, int tok, int kq, int lane) {
    constexpr int R = 1 << G, W = 2 * R + 1;
    int lo = tok - R, hi2 = tok + R + 1; lo = lo < 0 ? 0 : lo; hi2 = hi2 > SEQ ? SEQ : hi2; const float inv = 1.0f / (float)(hi2 - lo);
    f32x4 acc[4];
#pragma unroll
    for (int dt = 0; dt < 4; ++dt) acc[dt] = zero4_();
#pragma unroll
    for (int kb = 0; kb < 2; ++kb) { float s[8]; bf16x8 uc;
        const LAS char* rp = rows + ((lane & 15) + 8 - R) * POOL_PITCH + (8 * G + 4 * kb + kq) * 16;
#pragma unroll
        for (int e = 0; e < 8; ++e) s[e] = 0.f;
#pragma unroll
        for (int j = 0; j < W; ++j) { const int tt = tok + j - R; const float w = (tt >= 0 && tt < SEQ) ? 1.0f : 0.0f; const bf16x8 v = *(const LAS bf16x8*)(rp + j * POOL_PITCH); if (j == R) uc = v;
#pragma unroll
            for (int e = 0; e < 8; ++e) s[e] += w * bf2f((unsigned short)v[e]); }
        u32x4 pw; float pe[8];
#pragma unroll
        for (int e = 0; e < 8; ++e) pe[e] = s[e] * inv - bf2f((unsigned short)uc[e]);
        pw.x = cvtpk(pe[0], pe[1]); pw.y = cvtpk(pe[2], pe[3]); pw.z = cvtpk(pe[4], pe[5]); pw.w = cvtpk(pe[6], pe[7]);
        const bf16x8 bfrag = __builtin_bit_cast(bf16x8, pw);
#pragma unroll
        for (int dt = 0; dt < 4; ++dt) { const bf16x8 afrag = *(const bf16x8*)(wpt + (size_t)(G * 64 + dt * 16 + (lane & 15)) * 64 + kb * 32 + 8 * kq);
            acc[dt] = __builtin_amdgcn_mfma_f32_16x16x32_bf16(afrag, bfrag, acc[dt], 0, 0, 0); } }
#pragma unroll
    for (int dt = 0; dt < 4; ++dt) { const int dcol = G * 64 + dt * 16 + 4 * kq; const f32x4 sc = *(const f32x4*)(pscale + dcol);
        u32x2 w; w.x = cvtpk(acc[dt][0] * sc.x, acc[dt][1] * sc.y); w.y = cvtpk(acc[dt][2] * sc.z, acc[dt][3] * sc.w);
        *(u32x2*)((unsigned char*)MIX + pg8::img_off(row0 + (lane & 15), dcol & ~7, D / 64, false) + 2 * (dcol & 7)) = w; }
}
__device__ __forceinline__ void pool_item(const bf16* Z, bf16* MIX, const bf16* wpt, const float* pscale, int item, LAS char* rows, int lane) {
    const int row0 = 16 * item, b = row0 / SEQ, t0 = row0 % SEQ;
    const int tok = t0 + (lane & 15), kq = lane >> 4;
    const bf16* zb = Z + (size_t)b * SEQ * 256;
    u32x4 st[16];
#pragma unroll
    for (int i = 0; i < 16; ++i) { const int idx = i * 64 + lane, r = idx >> 5, c = idx & 31; int tt = t0 - 8 + r; tt = (tt >= 0 && tt < SEQ) ? tt : t0; st[i] = *(const u32x4*)(zb + (size_t)tt * 256 + 8 * c); }
#pragma unroll
    for (int i = 0; i < 16; ++i) { const int idx = i * 64 + lane, r = idx >> 5, c = idx & 31; *(LAS u32x4*)(rows + r * POOL_PITCH + c * 16) = st[i]; }
    pool_group<0>(rows, MIX, wpt, pscale, row0, tok, kq, lane); pool_group<1>(rows, MIX, wpt, pscale, row0, tok, kq, lane);
    pool_group<2>(rows, MIX, wpt, pscale, row0, tok, kq, lane); pool_group<3>(rows, MIX, wpt, pscale, row0, tok, kq, lane);
}
constexpr int N_B_UNITS = 128, N_C_UNITS = 256, N_P_ITEMS = M / 16;
}

__device__ __forceinline__ void p_mixers(Frame& F, const float* const* in, unsigned char* ws, int lq, int sel  ) {
    const int l = lq & 1;
    const bf16* Z = (const bf16*)(ws + WS_Z); bf16* MIX = (bf16*)(ws + WS_MIX);
    LAS char* lds = (LAS char*)F.lds;
    const float* sink = in[9] + 6 * l;
    {
        const int nb = (F.G >= 2 * mx::N_B_UNITS) ? mx::N_B_UNITS : (F.G + 1) / 2;
        const bool xl = (F.G == 256);
        if ((int)blockIdx.x < nb) {
            if (sel & 1) {
#pragma unroll 1
                for (int u0 = blockIdx.x; u0 < mx::N_B_UNITS; u0 += nb) { const int u = xl ? ((u0 & 7) >> 1) * 32 + (8 * (u0 & 1) + (u0 >> 4)) * 2 + ((u0 >> 3) & 1) : u0;     unsigned z_; asm volatile("v_mov_b32 %0, 0" : "=v"(z_)); const int lane = (int)__builtin_amdgcn_mbcnt_hi(~0u, __builtin_amdgcn_mbcnt_lo(~0u, z_)); mx::b_unit((const char*)(ws + WS_ZB), MIX, (char*)(ws + WS_BSCR), u, lds, F.wave, lane); } }
        } else if (sel & 2) {
#pragma unroll 1
            for (int v = (int)blockIdx.x - nb, u0 = v, k = 0; u0 < mx::N_C_UNITS; u0 += F.G - nb, ++k) { const int u = xl ? ((v & 7) >> 1) * 64 + ((((v >> 3) * 2 + k) >> 4) * 32) + 16 * (v & 1) + (((v >> 3) * 2 + k) & 15) : u0;     unsigned z_; asm volatile("v_mov_b32 %0, 0" : "=v"(z_)); const int lane = (int)__builtin_amdgcn_mbcnt_hi(~0u, __builtin_amdgcn_mbcnt_lo(~0u, z_)); mx::c_unit((const char*)(ws + WS_ZC), MIX, sink, u, lds, F.wave, lane); }
        }
        __syncthreads();
    }
    if (sel & 4) { const bf16* wpt = (const bf16*)(ws + WS_W + (size_t)l * W_LAYER + W_PT); const float* pscale = in[8] + 256 * l;
        for (int it0 = blockIdx.x * NWAVES + F.wave; it0 < mx::N_P_ITEMS; it0 += F.G * NWAVES) { const int it = (F.G == 256) ? (((int)blockIdx.x & 7) * 32 + ((int)blockIdx.x >> 3)) * NWAVES + F.wave : it0;     mx::pool_item(Z, MIX, wpt, pscale, it, lds + F.wave * (32 * mx::POOL_PITCH), F.lane); } }
}

struct Args { const float* in[15]; float* out; unsigned char* ws; int ph_lo, ph_hi, li, dup; };
__global__ void __launch_bounds__(NWAVES * 64, 2) mk_fwd(Args args) {
    extern __shared__ __attribute__((aligned(16))) unsigned char lds[];
    Frame F;
    F.lds = (LAS unsigned char*)lds;
    F.MISC = (volatile LAS unsigned*)(F.lds + MISC_OFF);
    F.tid = threadIdx.x; F.lane = F.tid & 63; F.wave = __builtin_amdgcn_readfirstlane(F.tid >> 6);
    const int wave0 = F.wave;
    F.G = gridDim.x; { const int bx = blockIdx.x; F.vcu = (F.G % 8 == 0) ? (bx % 8) * (F.G / 8) + bx / 8 : bx; }
    unsigned char* ws = args.ws;
    F.ctl = (gu32*)(ws + WS_CTL);
    for (int u = F.tid; u < (LDS_BYTES - LDSCTL_OFF) / 4; u += NWAVES * 64) ((LAS unsigned*)(F.lds + LDSCTL_OFF))[u] = 0u;
    __syncthreads();
    XcdBarrier bar; bar.bar = (unsigned*)(F.ctl + CW_BAR) + args.li * XCD_BAR_WORDS; bar.x = 0; bar.st = nullptr;
    const int lo = args.ph_lo, hi = args.ph_hi;
    if (hi - lo > 1) { bar = xcd_barrier_post((unsigned*)(F.ctl + CW_BAR) + args.li * XCD_BAR_WORDS, F.MISC + 8);
        if (F.tid == 0) { const unsigned v = bar.x + 1u; unsigned exp = 0u;
            if (!__hip_atomic_compare_exchange_strong((unsigned*)(F.ctl + CW_GRP) + (blockIdx.x & 7), &exp, v, __ATOMIC_RELAXED, __ATOMIC_RELAXED, __HIP_MEMORY_SCOPE_AGENT) && exp != v) __hip_atomic_fetch_or((unsigned*)(F.ctl + CW_GRPBAD), 1u, RLX_AGENT); } }
    const float* const* in = args.in;
    bf16* XS = (bf16*)(ws + WS_XS);
    bf16* H = (bf16*)(ws + WS_H);
    const float* MOD = (const float*)(ws + WS_MOD);
    float* SSQ = (float*)(ws + WS_SUMSQ);
    const float* GV = (const float*)(ws + WS_GV);

    const int dup = args.dup & 1, msel = ((args.dup >> 1) & 15) ? ((args.dup >> 1) & 15) : 7;
#pragma unroll 1
    for (int ph = lo; ph < hi; ++ph) {
        { unsigned z_; asm volatile("v_mov_b32 %0, 0" : "=v"(z_)); const int t_ = wave0 * 64 + (int)__builtin_amdgcn_mbcnt_hi(~0u, __builtin_amdgcn_mbcnt_lo(~0u, z_)); F.tid = t_; F.lane = t_ & 63; F.wave = wave0; }
        if (ph == PH_PRO) p_prologue(F, in, ws);
        else if (ph == PH_CONV) p_conv(F, in, ws);
        else if (ph == PH_FINAL) p_norm_final(F, XS, SSQ + (size_t)4 * M, args.out, in[14]);
        else {
            const int l = (ph - PH_L0) / PH_PER_LAYER, k = (ph - PH_L0) % PH_PER_LAYER;
            unsigned char* wl = ws + WS_W + (size_t)l * W_LAYER;
            const float* modl = MOD + (size_t)l * BATCH * NMOD * D;
            const float* biasl = (const float*)(ws + WS_BIAS + (size_t)l * BIAS_LAYER);
            if (k == 0) { pg8::Gemm g{H, (const bf16*)(wl + W_IN), M, INW, D}; pg8::StaticOrder S; S.init(M, INW, F.G, (int)blockIdx.x);
                pg8::EpiBf16Norm E{(bf16*)(ws + WS_Z), 256, SSQ + (size_t)(2 * l) * M, biasl, INW, ws + WS_ZB, ws + WS_ZC};
                pg8::gemm_phase<pg8::EpiBf16Norm, pg8::StaticOrder, true, true>(F.lds + RING_OFF, g, S, E, F.tid); }
            else if (k == 1) p_mixers(F, in, ws, l + 2 * dup, msel);
            else if (k == 2 && l == 0 && !dup) {
                pg8::Gemm g{(const bf16*)(ws + WS_MIX), (const bf16*)(wl + W_OUT), M, D, D}; pg8::StaticOrder S; S.init(M, D, F.G, (int)blockIdx.x);
                pg8::EpiGateResNormT<true> E{(const bf16*)in[0], XS, modl + 2 * D, NMOD * D, H, GV + (size_t)1 * BATCH * D, D, SSQ + (size_t)1 * M, D};
                pg8::gemm_phase<pg8::EpiGateResNormT<true>, pg8::StaticOrder, true, true>(F.lds + RING_OFF, g, S, E, F.tid); }
            else if (k == 2 || k == 4) { const bool dn = (k == 4); const bool last = dn && (l == DEPTH - 1);
                pg8::Gemm g{(const bf16*)(ws + (dn ? WS_HID : WS_MIX)), (const bf16*)(wl + (dn ? W_DN : W_OUT)), M, D, dn ? DFF : D}; pg8::StaticOrder S; S.init(M, D, F.G, (int)blockIdx.x);
                pg8::EpiGateResNorm E{XS, XS, dup ? (const float*)(F.ctl + CW_ZEROS) : modl + (dn ? 5 : 2) * D, dup ? 0 : NMOD * D,
                    (last || dup) ? (bf16*)nullptr : H, GV + (size_t)((dn ? 2 * (l + 1) : 2 * l + 1) % (2 * DEPTH)) * BATCH * D, D, SSQ + (size_t)(dup ? 5 : 2 * l + (dn ? 2 : 1)) * M, D};
                pg8::gemm_phase<pg8::EpiGateResNorm, pg8::StaticOrder, true, true>(F.lds + RING_OFF, g, S, E, F.tid); }
            else { pg8::Gemm g{H, (const bf16*)(wl + W_GU), M, 2 * DFF, D}; pg8::StaticOrder S; S.init(M, 2 * DFF, F.G, (int)blockIdx.x);
                pg8::EpiSwiGLUNorm E{(bf16*)(ws + WS_HID), DFF, SSQ + (size_t)(2 * l + 1) * M, biasl + BATCH * INW, 2 * DFF};
                pg8::gemm_phase<pg8::EpiSwiGLUNorm, pg8::StaticOrder, true, true>(F.lds + RING_OFF, g, S, E, F.tid); }
        }
        if (ph + 1 < hi) { const int kk = (ph >= PH_L0 && ph < PH_FINAL) ? (ph - PH_L0) % PH_PER_LAYER : -1;
            xcd_barrier(bar, F.MISC[17] != 0u && (kk == 2 || kk == 3 || (kk == 4 && ph + 1 == PH_FINAL)));
            if (ph == PH_PRO && lo == 0) { if (F.tid == 0) F.MISC[17] = (F.G == 256 && xb_ld((unsigned*)(F.ctl + CW_GRPBAD)) == 0u) ? 1u : 0u; __syncthreads(); } }
    }
}

extern "C" void kernel_launch(void* const* d_in, const int* in_sizes, int n_in, void* d_out, int out_size, void* d_ws, size_t ws_size, hipStream_t stream) {
    static int grid = 0;
    if (grid == 0) {
        if (n_in != 15 || in_sizes[0] != M * D || out_size != M * D || ws_size < WS_END) { fprintf(stderr, "kernel_launch: unexpected shapes (n_in %d, in0 %d, out %d, ws %zu); nothing launched\n", n_in, n_in > 0 ? in_sizes[0] : -1, out_size, ws_size); grid = -1; return; }
        int dev = 0, cus = 0, per_cu = 0;
        if (hipGetDevice(&dev) != hipSuccess || hipDeviceGetAttribute(&cus, hipDeviceAttributeMultiprocessorCount, dev) != hipSuccess) { grid = -1; return; }
        if (hipFuncSetAttribute((const void*)mk_fwd, hipFuncAttributeMaxDynamicSharedMemorySize, LDS_BYTES) != hipSuccess) { fprintf(stderr, "kernel_launch: hipFuncSetAttribute failed\n"); grid = -1; return; }
        if (hipOccupancyMaxActiveBlocksPerMultiprocessor(&per_cu, (const void*)mk_fwd, NWAVES * 64, LDS_BYTES) != hipSuccess || per_cu < 1) fprintf(stderr, "kernel_launch: occupancy query reports %d blocks per CU\n", per_cu);
        (void)hipGetLastError();
        grid = cus;
        if (grid != 256) fprintf(stderr, "kernel_launch: %d CUs; this kernel is laid out for 256\n", grid);
    }
    if (grid < 0) return;
    if (hipMemsetAsync((char*)d_ws + WS_CTL, 0, CTL_ZERO_BYTES, stream) != hipSuccess) return;
    Args a{};
    for (int i = 0; i < 15; ++i) a.in[i] = (const float*)d_in[i];
    a.out = (float*)d_out; a.ws = (unsigned char*)d_ws;
#if PROBE_DUP == 0 && PROBE_CUT == 0
    a.ph_lo = 0; a.ph_hi = NPHASES; a.li = 0; a.dup = 0;
    hipLaunchKernelGGL(mk_fwd, dim3(grid), dim3(NWAVES * 64), LDS_BYTES, stream, a);
#else
    { int lo = 0, li = 0;
      for (int ph = 0; ph < NPHASES; ++ph) { const bool cut = ((PROBE_CUT | PROBE_DUP) >> ph) & 1;
        if (cut || ph == NPHASES - 1) { a.ph_lo = lo; a.ph_hi = ph + 1; a.li = (ph + 1 - lo > 1) ? li++ : 0; a.dup = 0; hipLaunchKernelGGL(mk_fwd, dim3(grid), dim3(NWAVES * 64), LDS_BYTES, stream, a);
            if ((PROBE_DUP >> ph) & 1) { a.ph_lo = ph; a.ph_hi = ph + 1; a.li = 0; a.dup = 1 | (PROBE_MIXSEL << 1) | (PROBE_NOSTORE << 4); hipLaunchKernelGGL(mk_fwd, dim3(grid), dim3(NWAVES * 64), LDS_BYTES, stream, a); }
            lo = ph + 1; } } }
#endif
}
```

```cpp
#include <hip/hip_runtime.h>
#include <cstdio>
#include <cstdint>
namespace pg8 {
#define PG8_LAS __attribute__((address_space(3)))
typedef unsigned short bf16_t;
typedef short bf16x8 __attribute__((ext_vector_type(8)));
typedef float f32x4 __attribute__((ext_vector_type(4)));
typedef unsigned u32x4 __attribute__((ext_vector_type(4)));
constexpr int BM = 256, BK = 64, HALF = 128, HTB = HALF * BK * 2  , STAGE_BYTES = 8 * HTB, NXCD = 8, WGM = 8;

__host__ __device__ __forceinline__ int lds_byte(int r, int c) { const int st = (r >> 4) * 2 + (c >> 5), rr = r & 15, cc = c & 31, ob = rr * 64 + cc * 2; return st * 1024 + (ob ^ (((ob >> 9) & 1) << 5)); }
__host__ __device__ __forceinline__ void stage_rc(int b, int& R, int& C) { const int st = b / 1024, sb = b % 1024, swz = sb ^ (((sb >> 9) & 1) << 5); R = (st >> 1) * 16 + swz / 64; C = (st & 1) * 32 + (swz % 64) / 2; }
__host__ __device__ __forceinline__ int perm32(int rho) { const int n = rho >> 4, i = rho & 15; return 8 * (i >> 2) + 4 * n + (i & 3); }

__host__ __device__ __forceinline__ int perm32inv(int x) { return 16 * ((x >> 2) & 1) + 4 * (x >> 3) + (x & 3); }
__host__ __device__ __forceinline__ size_t img_off(int row, int col, int nt, bool wrow) { const int r = row & 127, rr = wrow ? (r & ~31) + perm32inv(r & 31) : r; return ((size_t)((row >> 7) * nt + (col >> 6)) << 14) + (size_t)lds_byte(rr, col & 63); }
constexpr bool IMG_A = true, IMG_B = true;
struct Unit { int pm, pn; };
struct Gemm { const bf16_t* A; const bf16_t* Bt; int M, N, K; };

struct StaticOrder {
    int nM, nN, nwg, G, c;
    __host__ __device__ void init(int M, int N, int G_, int c_) { nM = M / BM; nN = N / BM; nwg = nM * nN; G = G_; c = c_; }
    __host__ __device__ bool next(int i, Unit& u) const {
        const long L = (long)i * G + c; if (L >= nwg) return false;
        int wgid = (int)L; { const int q = nwg / NXCD, r = nwg % NXCD, xcd = wgid % NXCD, off = wgid / NXCD; wgid = (xcd < r ? xcd * (q + 1) : r * (q + 1) + (xcd - r) * q) + off; }
        const int nig = WGM * nN, gid = wgid / nig, fm = gid * WGM, gsz = (nM - fm) < WGM ? (nM - fm) : WGM;
        u.pm = fm + ((wgid % nig) % gsz); u.pn = (wgid % nig) / gsz; return true;
    }
    __device__ __forceinline__ void a_ready(const Unit&) const {}
    __device__ __forceinline__ void done(const Unit&) const {}
};

__device__ __forceinline__ unsigned cvt_pk_bf16(float lo, float hi) { unsigned r; asm volatile("v_cvt_pk_bf16_f32 %0, %1, %2" : "=v"(r) : "v"(lo), "v"(hi)); return r; }
constexpr float RMS_EPS_ = 1e-6f, INV_D_ = 1.0f / 1024.0f;
__device__ __forceinline__ void aux_dma(const float* src_lane, PG8_LAS unsigned char* dst_wave) { __builtin_amdgcn_global_load_lds((const unsigned*)src_lane, (PG8_LAS unsigned*)dst_wave, 4, 0, 0); }
typedef _Float16 h16x2 __attribute__((ext_vector_type(2)));
__device__ __forceinline__ unsigned pk_h2(float lo, float hi) { const h16x2 h = {(_Float16)lo, (_Float16)hi}; return __builtin_bit_cast(unsigned, h); }
__device__ __forceinline__ float h_lo(unsigned w) { return (float)__builtin_bit_cast(h16x2, w)[0]; }
__device__ __forceinline__ float h_hi(unsigned w) { return (float)__builtin_bit_cast(h16x2, w)[1]; }
struct EpiBf16Norm {
    static constexpr bool PERM = true, AFTER_DRAIN = false;
    bf16_t* O; int ldc; const float* sumsq; const float* bias; int bias_stride; unsigned char* zb; unsigned char* zc;
    __device__ __forceinline__ void prefetch(const Unit& u, PG8_LAS unsigned char* aux, int wid, int lane) const {
        if (wid < 4) aux_dma(sumsq + u.pm * BM + wid * 64 + lane, aux + wid * 256);
        else aux_dma(bias + (size_t)(u.pm >> 5) * bias_stride + u.pn * BM + (wid - 4) * 64 + lane, aux + 1024 + (wid - 4) * 256);
    }
    __device__ __forceinline__ void operator()(const f32x4 (&acc)[2][2][4][2], const Unit& u, int wr, int wc, int fr_, int fq_, PG8_LAS unsigned char* aux) const {
        unsigned z_; asm volatile("v_mov_b32 %0, 0" : "=v"(z_)); const int ln_ = (int)__builtin_amdgcn_mbcnt_hi(~0u, __builtin_amdgcn_mbcnt_lo(~0u, z_)); const int fr = ln_ & 15, fq = ln_ >> 4;
        const int row0 = u.pm * BM + wr * 64 + fr, col0 = u.pn * BM + wc * 32 + 8 * fq;
        const PG8_LAS float* ass = (const PG8_LAS float*)aux + wr * 64 + fr; const PG8_LAS float* ab = (const PG8_LAS float*)(aux + 1024) + wc * 32 + 8 * fq;
        f32x4 bv[2][2];
#pragma unroll
        for (int bj = 0; bj < 2; ++bj)
#pragma unroll
            for (int n = 0; n < 2; ++n) bv[bj][n] = *(const PG8_LAS f32x4*)(ab + bj * HALF + 4 * n);
#pragma unroll
        for (int ai = 0; ai < 2; ++ai)
#pragma unroll
            for (int m = 0; m < 4; ++m) { const int row = row0 + ai * HALF + m * 16; const float rs = __builtin_amdgcn_rsqf(ass[ai * HALF + m * 16] * INV_D_ + RMS_EPS_);
#pragma unroll
                for (int bj = 0; bj < 2; ++bj) { const f32x4 v0 = acc[ai][bj][m][0] * rs + bv[bj][0], v1 = acc[ai][bj][m][1] * rs + bv[bj][1];
                    u32x4 w; w.x = cvt_pk_bf16(v0[0], v0[1]); w.y = cvt_pk_bf16(v0[2], v0[3]); w.z = cvt_pk_bf16(v1[0], v1[1]); w.w = cvt_pk_bf16(v1[2], v1[3]);
                    const int cb = 2 * u.pn + bj;
                    if (zb != nullptr && cb >= 2 && cb <= 10) { const int t3 = (cb - 2) / 3, g = (cb - 2) % 3, lg = 2 * g, hd = 2 * g + (wc >> 1), c = (wc & 1) * 4 + fq;
                        const int t = row & 8191, b = row >> 13, r = t & ((1 << lg) - 1), n = t >> lg, ti = (r << (8 - lg)) + (n >> 5), key = n & 31;
                        const int off = t3 < 2 ? (c >> 1) * 1024 + (key + 32 * (c & 1)) * 16 : (c >> 2) * 2048 + (key >> 4) * 1024 + (key & 15) * 64 + (c & 3) * 16;
                        *(u32x4*)(zb + ((size_t)(((t3 * 6 + hd) * 4 + b) * 256 + ti) << 12) + off) = w; }
                    else if (zb != nullptr && cb >= 11) {
                        const int hx = cb <= 13 ? 2 * (cb - 11) + (wc >> 1) : (cb == 14 ? 6 : 8) + (wc >> 1), c = (wc & 1) * 4 + fq, t = row & 8191, b = row >> 13, key = t & 31;
                        const int off = cb < 15 ? (c >> 1) * 1024 + (key + 32 * (c & 1)) * 16 : (c >> 2) * 2048 + (key >> 4) * 1024 + (key & 15) * 64 + (c & 3) * 16;
                        *(u32x4*)(zc + ((size_t)((hx * 4 + b) * 256 + (t >> 5)) << 12) + off) = w; }
                    else *(u32x4*)(O + (size_t)row * ldc + col0 + bj * HALF) = w; } }
    }
};
struct EpiSwiGLUNorm {
    static constexpr bool PERM = true, AFTER_DRAIN = false;
    bf16_t* O; int ldc; const float* sumsq; const float* bias; int bias_stride;
    static __device__ __forceinline__ float silu_mul(float g, float u) { return g * u * __builtin_amdgcn_rcpf(1.0f + __builtin_amdgcn_exp2f(-1.4426950408889634f * g)); }
    __device__ __forceinline__ void prefetch(const Unit& u, PG8_LAS unsigned char* aux, int wid, int lane) const {
        if (wid < 4) aux_dma(sumsq + u.pm * BM + wid * 64 + lane, aux + wid * 256);
        else aux_dma(bias + (size_t)(u.pm >> 5) * bias_stride + u.pn * BM + (wid - 4) * 64 + lane, aux + 1024 + (wid - 4) * 256);
    }
    __device__ __forceinline__ void operator()(const f32x4 (&acc)[2][2][4][2], const Unit& u, int wr, int wc, int fr_, int fq_, PG8_LAS unsigned char* aux) const {
        unsigned z_; asm volatile("v_mov_b32 %0, 0" : "=v"(z_)); const int ln_ = (int)__builtin_amdgcn_mbcnt_hi(~0u, __builtin_amdgcn_mbcnt_lo(~0u, z_)); const int fr = ln_ & 15, fq = ln_ >> 4;
        const int row0 = u.pm * BM + wr * 64 + fr, col0 = u.pn * HALF + wc * 32 + 8 * fq;
        const PG8_LAS float* ass = (const PG8_LAS float*)aux + wr * 64 + fr; const PG8_LAS float* ab = (const PG8_LAS float*)(aux + 1024) + wc * 32 + 8 * fq;
        const f32x4 bg0 = *(const PG8_LAS f32x4*)(ab), bg1 = *(const PG8_LAS f32x4*)(ab + 4), bu0 = *(const PG8_LAS f32x4*)(ab + HALF), bu1 = *(const PG8_LAS f32x4*)(ab + HALF + 4);
#pragma unroll
        for (int ai = 0; ai < 2; ++ai)
#pragma unroll
            for (int m = 0; m < 4; ++m) { const int row = row0 + ai * HALF + m * 16; const float rs = __builtin_amdgcn_rsqf(ass[ai * HALF + m * 16] * INV_D_ + RMS_EPS_);
                unsigned char* rowp = (unsigned char*)O + img_off(row, col0, ldc / 64, false);
                const f32x4 g0 = acc[ai][0][m][0] * rs + bg0, g1 = acc[ai][0][m][1] * rs + bg1, u0 = acc[ai][1][m][0] * rs + bu0, u1 = acc[ai][1][m][1] * rs + bu1;
                f32x4 e0 = g0 * -1.4426950408889634f, e1 = g1 * -1.4426950408889634f;
#pragma unroll
                for (int i = 0; i < 4; ++i) { e0[i] = __builtin_amdgcn_exp2f(e0[i]); e1[i] = __builtin_amdgcn_exp2f(e1[i]); }
                e0 = e0 + 1.0f; e1 = e1 + 1.0f;
#pragma unroll
                for (int i = 0; i < 4; ++i) { e0[i] = __builtin_amdgcn_rcpf(e0[i]); e1[i] = __builtin_amdgcn_rcpf(e1[i]); }
                const f32x4 h0 = (g0 * u0) * e0, h1 = (g1 * u1) * e1;
                u32x4 w; w.x = cvt_pk_bf16(h0[0], h0[1]); w.y = cvt_pk_bf16(h0[2], h0[3]); w.z = cvt_pk_bf16(h1[0], h1[1]); w.w = cvt_pk_bf16(h1[2], h1[3]);
                *(u32x4*)rowp = w; }
    }
};
template <bool F32BASE>
struct EpiGateResNormT {
    static constexpr bool PERM = true, AFTER_DRAIN = false;
    const bf16_t* base; bf16_t* out; const float* gate; int gate_stride; bf16_t* Hn; const float* gn; int gn_stride; float* sumsq; int ldc;
    __device__ __forceinline__ void prefetch(const Unit& u, PG8_LAS unsigned char* aux, int wid, int lane) const {
        if (wid < 4) aux_dma(gate + (size_t)(u.pm >> 5) * gate_stride + u.pn * BM + wid * 64 + lane, aux + wid * 256);
        else aux_dma(gn + (size_t)(u.pm >> 5) * gn_stride + u.pn * BM + (wid - 4) * 64 + lane, aux + 1024 + (wid - 4) * 256);
    }
    __device__ __forceinline__ void operator()(const f32x4 (&acc)[2][2][4][2], const Unit& u, int wr, int wc, int fr_, int fq_, PG8_LAS unsigned char* aux) const {
        unsigned z_; asm volatile("v_mov_b32 %0, 0" : "=v"(z_)); const int ln_ = (int)__builtin_amdgcn_mbcnt_hi(~0u, __builtin_amdgcn_mbcnt_lo(~0u, z_)); const int fr = ln_ & 15, fq = ln_ >> 4;
        const int row0 = u.pm * BM + wr * 64 + fr, col0 = u.pn * BM + wc * 32 + 8 * fq;
        const PG8_LAS float* ag = (const PG8_LAS float*)aux + wc * 32 + 8 * fq; const PG8_LAS float* an = (const PG8_LAS float*)(aux + 1024) + wc * 32 + 8 * fq;
#pragma unroll
        for (int am = 0; am < 4; ++am) {
            u32x4 ld[2][2]; f32x4 lf[2][2][2];
#pragma unroll
            for (int mm = 0; mm < 2; ++mm)
#pragma unroll
                for (int bj = 0; bj < 2; ++bj) {
                    if constexpr (F32BASE) { const f32x4* px = (const f32x4*)((const float*)base + (size_t)(row0 + (am >> 1) * HALF + (2 * (am & 1) + mm) * 16) * ldc + col0 + bj * HALF); lf[mm][bj][0] = px[0]; lf[mm][bj][1] = px[1]; }
                    else ld[mm][bj] = *(const u32x4*)((const unsigned char*)base + img_off(row0 + (am >> 1) * HALF + (2 * (am & 1) + mm) * 16, col0 + bj * HALF, ldc / 64, false)); }
#pragma unroll
            for (int mm = 0; mm < 2; ++mm) { const int ai = am >> 1, m = 2 * (am & 1) + mm; const int row = row0 + ai * HALF + m * 16; const size_t off = (size_t)row * ldc + col0; float ss = 0.f;
#pragma unroll
                for (int bj = 0; bj < 2; ++bj) {
                    const f32x4 g0 = *(const PG8_LAS f32x4*)(ag + bj * HALF), g1 = *(const PG8_LAS f32x4*)(ag + bj * HALF + 4);
                    f32x4 b0, b1;
                    if constexpr (F32BASE) { b0 = lf[mm][bj][0]; b1 = lf[mm][bj][1]; }
                    else { const u32x4 bw = ld[mm][bj]; b0 = (f32x4){h_lo(bw.x), h_hi(bw.x), h_lo(bw.y), h_hi(bw.y)}; b1 = (f32x4){h_lo(bw.z), h_hi(bw.z), h_lo(bw.w), h_hi(bw.w)}; }
                    const f32x4 x0 = b0 + g0 * acc[ai][bj][m][0], x1 = b1 + g1 * acc[ai][bj][m][1];
                    u32x4 w; w.x = pk_h2(x0[0], x0[1]); w.y = pk_h2(x0[2], x0[3]); w.z = pk_h2(x1[0], x1[1]); w.w = pk_h2(x1[2], x1[3]);
                    *(u32x4*)((unsigned char*)out + img_off(row, col0 + bj * HALF, ldc / 64, false)) = w;
                    ss += (x0[0] * x0[0] + x0[1] * x0[1]) + (x0[2] * x0[2] + x0[3] * x0[3]) + (x1[0] * x1[0] + x1[1] * x1[1]) + (x1[2] * x1[2] + x1[3] * x1[3]);
                    if (Hn) { const f32x4 n0 = *(const PG8_LAS f32x4*)(an + bj * HALF), n1 = *(const PG8_LAS f32x4*)(an + bj * HALF + 4); const f32x4 h0 = x0 * n0, h1 = x1 * n1;
                        u32x4 hw; hw.x = cvt_pk_bf16(h0[0], h0[1]); hw.y = cvt_pk_bf16(h0[2], h0[3]); hw.z = cvt_pk_bf16(h1[0], h1[1]); hw.w = cvt_pk_bf16(h1[2], h1[3]);
                        *(u32x4*)((unsigned char*)Hn + img_off(row, col0 + bj * HALF, ldc / 64, false)) = hw; } }
                ss += __shfl_xor(ss, 16); ss += __shfl_xor(ss, 32);
                if (fq == 0) atomicAdd(sumsq + row, ss); }
            asm volatile("" ::: "memory"); }
    }
};
typedef EpiGateResNormT<false> EpiGateResNorm;

template <class Epi, class Sched, bool ALIGN_EPI = false, bool SP2 = false>
__device__ __forceinline__ void gemm_phase(PG8_LAS unsigned char* lds, const Gemm g, const Sched& S, const Epi& E, int tid_in) {
    int tid_ = tid_in; asm volatile("" : "+v"(tid_));
    const int tid = tid_, wid = __builtin_amdgcn_readfirstlane(tid >> 6), lane = tid & 63, wr = wid >> 2, wc = wid & 3, fr = lane & 15, fq = lane >> 4;
    const int K = g.K, nt = K / BK;
    unsigned voffA[2], voffB[2];
#pragma unroll
    for (int i = 0; i < 2; ++i) { int R, C; stage_rc(tid * 16 + i * 8192, R, C); const int Rb = Epi::PERM ? ((R & ~31) + perm32(R & 31)) : R;
        voffA[i] = IMG_A ? (unsigned)(tid * 16 + i * 8192) : (unsigned)(R * K + C) * 2u; voffB[i] = IMG_B ? (unsigned)(tid * 16 + i * 8192) : (unsigned)(Rb * K + C) * 2u; }
    const size_t kstepA = IMG_A ? (size_t)(HALF * BK * 2) : (size_t)(BK * 2), kstepB = IMG_B ? (size_t)(HALF * BK * 2) : (size_t)(BK * 2);
    const size_t hstep = (size_t)HALF * K * 2;
    const size_t tstep = 2 * hstep;
    const unsigned ldsw = (unsigned)wid * 1024u;
    const int aoff = lds_byte(wr * 64 + fr, fq * 8), boff = lds_byte(wc * 32 + fr, fq * 8);
#define PG8_SA(b, h) (((b) * 2 + (h)) * HTB)
#define PG8_SB(b, h) ((4 + (b) * 2 + (h)) * HTB)
#define PG8_STAGE(bufoff, gbase, voff) do { _Pragma("unroll") for (int _i = 0; _i < 2; ++_i) \
        __builtin_amdgcn_global_load_lds((const unsigned*)((const char*)(gbase) + (voff)[_i]), (PG8_LAS unsigned*)(lds + (bufoff) + ldsw + _i * 8192), 16, 0, 0); } while (0)
#define PG8_LDA(dst, b, h) do { _Pragma("unroll") for (int m = 0; m < 4; ++m) _Pragma("unroll") for (int k = 0; k < 2; ++k) dst[m][k] = *(const PG8_LAS bf16x8*)(lds + PG8_SA(b, h) + aoff + m * 2048 + k * 1024); } while (0)
#define PG8_LDB(dst, b, h) do { _Pragma("unroll") for (int n = 0; n < 2; ++n) _Pragma("unroll") for (int k = 0; k < 2; ++k) dst[n][k] = *(const PG8_LAS bf16x8*)(lds + PG8_SB(b, h) + boff + n * 2048 + k * 1024); } while (0)
#define PG8_MMA(ai, bj, At, Bt) do { __builtin_amdgcn_s_setprio(1); _Pragma("unroll") for (int m = 0; m < 4; ++m) _Pragma("unroll") for (int n = 0; n < 2; ++n) _Pragma("unroll") for (int k = 0; k < 2; ++k) \
        acc[ai][bj][m][n] = __builtin_amdgcn_mfma_f32_16x16x32_bf16(Bt[n][k], At[m][k], acc[ai][bj][m][n], 0, 0, 0); __builtin_amdgcn_s_setprio(0); } while (0)
#define PG8_WAIT_V(n) asm volatile("s_waitcnt vmcnt(" #n ")" ::: "memory")
#define PG8_WAIT_L(n) asm volatile("s_waitcnt lgkmcnt(" #n ")" ::: "memory")
#define PG8_BAR __builtin_amdgcn_s_barrier()
#define PG8_SCHED __builtin_amdgcn_sched_barrier(0)
    Unit cur, nxt; int ui = 0;
    if (!S.next(0, cur)) return;
    f32x4 acc[2][2][4][2];
#pragma unroll
    for (int a = 0; a < 2; ++a)
#pragma unroll
        for (int b = 0; b < 2; ++b)
#pragma unroll
            for (int m = 0; m < 4; ++m)
#pragma unroll
                for (int n = 0; n < 2; ++n) { float z_; asm volatile("v_mov_b32 %0, 0" : "=v"(z_)); acc[a][b][m][n] = (f32x4){z_, z_, z_, z_}; }
    bf16x8 At[4][2], B0[2][2], B1[2][2];
    const char* cA = (const char*)g.A + (size_t)cur.pm * tstep; const char* cB = (const char*)g.Bt + (size_t)cur.pn * tstep;
    S.a_ready(cur);
    if constexpr (SP2) {
        PG8_STAGE(PG8_SB(0, 0), cB, voffB); PG8_STAGE(PG8_SB(0, 1), cB + hstep, voffB); PG8_STAGE(PG8_SA(0, 0), cA, voffA); PG8_STAGE(PG8_SA(0, 1), cA + hstep, voffA);
        if (wr == 1) PG8_BAR;
        PG8_WAIT_V(2); PG8_BAR;
        PG8_STAGE(PG8_SB(1, 0), cB + kstepB, voffB); PG8_STAGE(PG8_SA(1, 0), cA + kstepA, voffA); PG8_STAGE(PG8_SB(1, 1), cB + hstep + kstepB, voffB);
        PG8_WAIT_V(6); PG8_BAR;
    } else {
        PG8_STAGE(PG8_SB(0, 0), cB, voffB); PG8_STAGE(PG8_SA(0, 0), cA, voffA); PG8_STAGE(PG8_SB(0, 1), cB + hstep, voffB); PG8_STAGE(PG8_SA(0, 1), cA + hstep, voffA);
        if (wr == 1) PG8_BAR;
        PG8_WAIT_V(4); PG8_BAR;
        PG8_STAGE(PG8_SB(1, 0), cB + kstepB, voffB); PG8_STAGE(PG8_SA(1, 0), cA + kstepA, voffA); PG8_STAGE(PG8_SB(1, 1), cB + hstep + kstepB, voffB);
        PG8_WAIT_V(6); PG8_BAR;
    }
    for (;;) {
        const bool has_next = S.next(ui + 1, nxt);
        const char* nA = has_next ? (const char*)g.A + (size_t)nxt.pm * tstep : cA; const char* nB = has_next ? (const char*)g.Bt + (size_t)nxt.pn * tstep : cB;
        for (int t = 0; t < nt; t += 2) {
            const bool last = (t == nt - 2);
            const char* a1 = cA + (size_t)(t + 1) * kstepA;
            const char* a2 = last ? nA : cA + (size_t)(t + 2) * kstepA; const char* b2 = last ? nB : cB + (size_t)(t + 2) * kstepB;
            const char* a3 = a2 + kstepA; const char* b3 = b2 + kstepB;
            if (last && has_next) S.a_ready(nxt);
            if (last) E.prefetch(cur, lds + STAGE_BYTES + 1024, wid, lane);
            if constexpr (SP2) {
            PG8_LDB(B0, 0, 0); PG8_LDB(B1, 0, 1); PG8_SCHED; PG8_LDA(At, 0, 0); PG8_STAGE(PG8_SA(1, 1), a1 + hstep, voffA);
            PG8_WAIT_V(8); PG8_WAIT_L(0); PG8_BAR; PG8_MMA(0, 0, At, B0); PG8_MMA(0, 1, At, B1); PG8_BAR; PG8_SCHED;
            PG8_LDA(At, 0, 1); PG8_STAGE(PG8_SB(0, 0), b2, voffB); PG8_STAGE(PG8_SB(0, 1), b2 + hstep, voffB); PG8_STAGE(PG8_SA(0, 0), a2, voffA);
            PG8_WAIT_V(8); PG8_WAIT_L(0); PG8_BAR; PG8_MMA(1, 0, At, B0); PG8_MMA(1, 1, At, B1); PG8_BAR; PG8_SCHED;
            PG8_LDB(B0, 1, 0); PG8_LDB(B1, 1, 1); PG8_SCHED; PG8_LDA(At, 1, 0); PG8_STAGE(PG8_SA(0, 1), a2 + hstep, voffA);
            PG8_WAIT_V(8); PG8_WAIT_L(0); PG8_BAR; PG8_MMA(0, 0, At, B0); PG8_MMA(0, 1, At, B1); PG8_BAR; PG8_SCHED;
            PG8_LDA(At, 1, 1); PG8_STAGE(PG8_SB(1, 0), b3, voffB); PG8_STAGE(PG8_SB(1, 1), b3 + hstep, voffB); PG8_STAGE(PG8_SA(1, 0), a3, voffA);
            PG8_WAIT_V(8); PG8_WAIT_L(0); PG8_BAR; PG8_MMA(1, 0, At, B0); PG8_MMA(1, 1, At, B1); PG8_BAR; PG8_SCHED;
            } else {
            PG8_LDB(B0, 0, 0); PG8_SCHED; PG8_LDA(At, 0, 0); PG8_STAGE(PG8_SA(1, 1), a1 + hstep, voffA);
            PG8_WAIT_L(8); PG8_BAR; PG8_WAIT_L(0); PG8_MMA(0, 0, At, B0); PG8_BAR; PG8_SCHED;
            PG8_LDB(B1, 0, 1); PG8_STAGE(PG8_SB(0, 0), b2, voffB);
            PG8_BAR; PG8_WAIT_L(0); PG8_MMA(0, 1, At, B1); PG8_BAR;
            PG8_LDA(At, 0, 1); PG8_STAGE(PG8_SA(0, 0), a2, voffA);
            PG8_BAR; PG8_WAIT_L(0); PG8_MMA(1, 0, At, B0); PG8_BAR; PG8_SCHED;
            PG8_STAGE(PG8_SB(0, 1), b2 + hstep, voffB);
            PG8_WAIT_V(6); PG8_BAR; PG8_MMA(1, 1, At, B1); PG8_BAR;
            PG8_LDB(B0, 1, 0); PG8_SCHED; PG8_LDA(At, 1, 0); PG8_STAGE(PG8_SA(0, 1), a2 + hstep, voffA);
            PG8_WAIT_L(8); PG8_BAR; PG8_WAIT_L(0); PG8_MMA(0, 0, At, B0); PG8_BAR; PG8_SCHED;
            PG8_LDB(B1, 1, 1); PG8_STAGE(PG8_SB(1, 0), b3, voffB);
            PG8_BAR; PG8_WAIT_L(0); PG8_MMA(0, 1, At, B1); PG8_BAR;
            PG8_LDA(At, 1, 1); PG8_STAGE(PG8_SA(1, 0), a3, voffA);
            PG8_BAR; PG8_WAIT_L(0); PG8_MMA(1, 0, At, B0); PG8_BAR; PG8_SCHED;
            PG8_STAGE(PG8_SB(1, 1), b3 + hstep, voffB);
            PG8_WAIT_V(6); PG8_BAR; PG8_MMA(1, 1, At, B1); PG8_BAR;
            }
        }
        if constexpr (ALIGN_EPI) { if (wr == 0) PG8_BAR; }
        if constexpr (!Epi::AFTER_DRAIN) { E(acc, cur, wr, wc, fr, fq, lds + STAGE_BYTES + 1024); S.done(cur); }
        if (!has_next) break;
#pragma unroll
        for (int a = 0; a < 2; ++a)
#pragma unroll
            for (int b = 0; b < 2; ++b)
#pragma unroll
                for (int m = 0; m < 4; ++m)
#pragma unroll
                    for (int n = 0; n < 2; ++n) { float z_; asm volatile("v_mov_b32 %0, 0" : "=v"(z_)); acc[a][b][m][n] = (f32x4){z_, z_, z_, z_}; }
        cur = nxt; cA = nA; cB = nB; ++ui;
        if constexpr (ALIGN_EPI) { if (wr == 1) PG8_BAR; }
    }
    PG8_WAIT_V(0);
    if constexpr (!ALIGN_EPI) { if (wr == 0) PG8_BAR; }
    PG8_BAR;
    if constexpr (Epi::AFTER_DRAIN) { E.fused(acc, cur, wr, wc, fr, fq, lds, wid, lane); S.done(cur); }
#undef PG8_SA
#undef PG8_SB
#undef PG8_STAGE
#undef PG8_LDA
#undef PG8_LDB
#undef PG8_MMA
#undef PG8_WAIT_V
#undef PG8_WAIT_L
#undef PG8_BAR
#undef PG8_SCHED
}
}
#define GAS __attribute__((address_space(1)))
#define LAS __attribute__((address_space(3)))
typedef unsigned short bf16;
typedef unsigned v4u __attribute__((ext_vector_type(4)));
typedef float f32x4 __attribute__((ext_vector_type(4)));
typedef short bf16x8 __attribute__((ext_vector_type(8)));
typedef GAS unsigned gu32;
typedef GAS unsigned long long gu64;
#define RLX_AGENT __ATOMIC_RELAXED, __HIP_MEMORY_SCOPE_AGENT
#define LDS_WAIT() asm volatile("s_waitcnt lgkmcnt(0)" ::: "memory")
#define VM_WAIT() asm volatile("s_waitcnt vmcnt(0)" ::: "memory")
__device__ __forceinline__ unsigned long long rt() { return __builtin_amdgcn_s_memrealtime(); }
__device__ __forceinline__ unsigned f2bf(float f) { unsigned u = __builtin_bit_cast(unsigned, f); return (u + 0x7fffu + ((u >> 16) & 1u)) >> 16; }
__device__ __forceinline__ unsigned pk2(float lo, float hi) { return f2bf(lo) | (f2bf(hi) << 16); }

#define XB_TMO      128
#define XB_XCNT(j)  (256  + 64 * (j))
#define XB_XSUB(j)  (1280 + 64 * (j))
#define XB_XGEN(j)  (2304 + 64 * (j))
#define XB_TOP      3328
#define XB_TOPGEN   3392
#define XCD_BAR_WORDS 3456
#define XB_SPIN_CAP (1u << 18)

__device__ __forceinline__ unsigned xb_ld(unsigned* p)              { return __hip_atomic_load(p, __ATOMIC_RELAXED, __HIP_MEMORY_SCOPE_AGENT); }
__device__ __forceinline__ unsigned xb_add(unsigned* p, unsigned v) { return __hip_atomic_fetch_add(p, v, __ATOMIC_RELAXED, __HIP_MEMORY_SCOPE_AGENT); }
__device__ __forceinline__ unsigned xb_xcc_id() { return (unsigned)__builtin_amdgcn_s_getreg((3 << 11) | 20) & 0xFu; }
#define XB_SPIN(cond, bar) do { unsigned _sp = 0; while (cond) { __builtin_amdgcn_s_sleep(1); \
    if ((++_sp & 255u) == 0u) { if (xb_ld(&(bar)[XB_TMO])) break; if (_sp > XB_SPIN_CAP) { atomicAdd(&(bar)[XB_TMO], 1u); break; } } } } while (0)

struct XcdBarrier {
    unsigned* bar; unsigned x;
    volatile LAS unsigned* st;
};

__device__ __forceinline__ XcdBarrier xcd_barrier_post(unsigned* bar, volatile LAS unsigned* st) {
    XcdBarrier b; b.bar = bar; b.x = xb_xcc_id(); b.st = st;
    if (threadIdx.x == 0) (void)xb_add(&bar[XB_XCNT(b.x)], 1u);
    return b;
}
__device__ __forceinline__ void xcd_barrier_complete(unsigned* bar, unsigned x, unsigned& nloc, unsigned& nx) {
    const unsigned G = gridDim.x * gridDim.y * gridDim.z;
    unsigned sum, cnt, mine, sp = 0u;
    for (;;) {
        sum = 0u; cnt = 0u; mine = 0u;
#pragma unroll
        for (unsigned j = 0; j < 16; ++j) { const unsigned c = xb_ld(&bar[XB_XCNT(j)]); sum += c; cnt += (c > 0u) ? 1u : 0u; mine = (j == x) ? c : mine; }
        if (sum == G) break;
        __builtin_amdgcn_s_sleep(1);
        if ((++sp & 255u) == 0u) { if (xb_ld(&bar[XB_TMO])) break; if (sp > XB_SPIN_CAP) { atomicAdd(&bar[XB_TMO], 1u); break; } }
    }
    nloc = mine > 0u ? mine : 1u; nx = cnt > 0u ? cnt : 1u;
}

__device__ __forceinline__ void xcd_barrier(const XcdBarrier& b, bool local = false) {
    asm volatile("s_waitcnt vmcnt(0)" ::: "memory");
    __syncthreads();
    if (threadIdx.x == 0) {
        unsigned* bar = b.bar;
        __builtin_amdgcn_s_waitcnt(0);
        unsigned nloc = b.st[0], nx = b.st[1];
        if (nloc == 0u) { xcd_barrier_complete(bar, b.x, nloc, nx); b.st[0] = nloc; b.st[1] = nx; }
        const unsigned old = xb_add(&bar[XB_XSUB(b.x)], 1u);
        const unsigned gen = old / nloc;
        if (old + 1u == (gen + 1u) * nloc) {
            if (!local) {
            __builtin_amdgcn_fence(__ATOMIC_RELEASE, "agent");
            asm volatile("s_waitcnt vmcnt(0)" ::: "memory");
            const unsigned og = xb_add(&bar[XB_TOP], 1u);
            const unsigned tg = og / nx;
            if (og + 1u == (tg + 1u) * nx) xb_add(&bar[XB_TOPGEN], 1u);
            else XB_SPIN(xb_ld(&bar[XB_TOPGEN]) == tg, bar);
            }
            __builtin_amdgcn_fence(__ATOMIC_ACQUIRE, "agent");
            xb_add(&bar[XB_XGEN(b.x)], 1u);
            asm volatile("s_waitcnt vmcnt(0)" ::: "memory");
        } else {
            __builtin_amdgcn_fence(__ATOMIC_ACQUIRE, "agent");
            XB_SPIN(xb_ld(&bar[XB_XGEN(b.x)]) == gen, bar);
            asm volatile("s_waitcnt vmcnt(0)" ::: "memory");
        }
    }
    __syncthreads();
}

constexpr int NWAVES = 8;
constexpr int BATCH = 4, SEQ = 8192, D = 1024, M = BATCH * SEQ, DEPTH = 2;
constexpr int INW = 2048, DFF = 2816, NMOD = 6;
constexpr int O_U = 0, O_QB = 256, O_KB = 640, O_VB = 1024, O_QC = 1408, O_KC = 1792, O_VC = 1920;
constexpr float RMS_EPS = 1e-6f;
constexpr float LOG2E = 1.4426950408889634f;
constexpr float QSCALE = 0.125f * LOG2E;

constexpr size_t MiB = 1u << 20;
constexpr size_t WS_CTL = 0, CTL_ZERO_BYTES = 131072;
constexpr size_t WS_MOD = 1 * MiB;
constexpr size_t WS_W = 2 * MiB, W_LAYER = 24 * MiB;
constexpr size_t W_IN = 0, W_OUT = 4 * MiB, W_GU = 6 * MiB, W_DN = 17 * MiB, W_PT = 23 * MiB;
constexpr size_t WS_H = 50 * MiB;
constexpr size_t WS_Z = 114 * MiB;
constexpr size_t WS_MIX = 436 * MiB;
constexpr size_t WS_HID = 114 * MiB;
constexpr size_t WS_XS = 306 * MiB;
constexpr size_t WS_AUX = 434 * MiB;
constexpr size_t WS_SUMSQ = WS_AUX;
constexpr size_t WS_GV = WS_AUX + 1 * MiB;
constexpr size_t WS_BIAS = WS_GV + 65536;
constexpr size_t BIAS_LAYER = (size_t)BATCH * (2048 + 5632) * 4;
constexpr size_t WS_BSCR = 370 * MiB;
constexpr size_t WS_ZC = 202 * MiB;
constexpr size_t WS_ZB = 130 * MiB;
constexpr size_t WS_END = 500 * MiB;
static_assert(WS_Z + (size_t)M * 256 * 2 <= WS_ZB && WS_ZB + 72 * MiB <= WS_ZC && WS_ZC + 40 * MiB <= WS_XS, "z region map");
static_assert(WS_HID + (size_t)M * DFF * 2 <= WS_XS && WS_MIX + (size_t)M * D * 2 <= WS_END && WS_AUX + 2 * MiB <= WS_MIX && WS_BSCR + 24 * MiB <= WS_AUX && WS_H + (size_t)M * D * 2 <= WS_Z, "ws map");
constexpr int CW_TMO = 0, CW_CODE = 1, CW_BAR = 4096  , CW_QUEUE = 20480, CW_GRP = 20480  , CW_GRPBAD = 20496  , CW_ZEROS = 24576  ;

constexpr int RING_OFF = 0, RING_BYTES = 131072;
constexpr int LDSCTL_OFF = RING_BYTES, MISC_OFF = 147456 - 256, LSEB_OFF = MISC_OFF - 6144;
constexpr int LDS_BYTES = 147456;

constexpr int PH_PRO = 0, PH_CONV = 1, PH_L0 = 2, PH_PER_LAYER = 5, PH_FINAL = PH_L0 + DEPTH * PH_PER_LAYER, NPHASES = PH_FINAL + 1;
#ifndef PROBE_DUP
#define PROBE_DUP 0
#endif
#ifndef PROBE_CUT
#define PROBE_CUT 0
#endif
#ifndef PROBE_MIXSEL
#define PROBE_MIXSEL 0
#endif
#ifndef PROBE_NOSTORE
#define PROBE_NOSTORE 0
#endif
#ifndef MK_ONE_LAUNCH
#define MK_ONE_LAUNCH 1
#endif

struct Frame {
    LAS unsigned char* lds;
    volatile LAS unsigned* MISC;
    gu32* ctl;
    int tid, lane, wave, G, vcu;
};

__device__ __forceinline__ float wave_sum(float v) {
#pragma unroll
    for (int o = 1; o < 64; o <<= 1) v += __shfl_xor(v, o);
    return v;
}
__device__ __forceinline__ float bf2f(unsigned short b) { return __uint_as_float((unsigned)b << 16); }
__device__ __forceinline__ float zero_() { float z; asm volatile("v_mov_b32 %0, 0" : "=v"(z)); return z; }
__device__ __forceinline__ f32x4 zero4_() { const float z = zero_(); return (f32x4){z, z, z, z}; }

__device__ __forceinline__ void tr_item(const float* W, int N, int k0, int n0, bf16* WT, int ldt, int drow0, float scale, LAS float* scr, int lane, bool img = true) {
#pragma unroll 8
    for (int i = 0; i < 32; ++i) { const int kk = 2 * i + (lane >> 5); scr[kk * 33 + (lane & 31)] = __builtin_nontemporal_load(W + (size_t)(k0 + kk) * N + n0 + (lane & 31)); }
    LDS_WAIT(); asm volatile("" ::: "memory");
    const int c = lane & 7;
#pragma unroll
    for (int j = 0; j < 4; ++j) { const int n = (lane >> 3) + 8 * j; const LAS float* s = scr + (8 * c) * 33 + n;
        v4u o; o.x = pk2(s[0 * 33] * scale, s[1 * 33] * scale); o.y = pk2(s[2 * 33] * scale, s[3 * 33] * scale); o.z = pk2(s[4 * 33] * scale, s[5 * 33] * scale); o.w = pk2(s[6 * 33] * scale, s[7 * 33] * scale);
        if (img) *(GAS v4u*)((unsigned char*)WT + pg8::img_off(drow0 + n, k0 + 8 * c, ldt / 64, true)) = o;
        else *(GAS v4u*)(WT + (size_t)(drow0 + n) * ldt + k0 + 8 * c) = o; }
    LDS_WAIT(); asm volatile("" ::: "memory");
}
constexpr int TI_IN = 16 * 64, TI_OUT = 16 * 32, TI_G = 16 * 88, TI_DN = 44 * 32, TI_P = 8, TI_LAYER = TI_IN + TI_OUT + 2 * TI_G + TI_DN + TI_P;
__device__ __forceinline__ void weight_item(const float* const* in, unsigned char* ws, int it, LAS float* scr, int lane) {
    const int l = it / TI_LAYER; int r = it % TI_LAYER;
    unsigned char* wl = ws + WS_W + (size_t)l * W_LAYER;
    if (r < TI_IN) { const int kb = r / 64, n0 = 32 * (r % 64); const bool isq = (n0 >= O_QB && n0 < O_KB) || (n0 >= O_QC && n0 < O_KC);
        tr_item(in[6] + (size_t)l * D * INW, INW, 64 * kb, n0, (bf16*)(wl + W_IN), D, n0, isq ? QSCALE : 1.0f, scr, lane); return; }
    r -= TI_IN;
    if (r < TI_OUT) { const int kb = r / 32, n0 = 32 * (r % 32); tr_item(in[10] + (size_t)l * D * D, D, 64 * kb, n0, (bf16*)(wl + W_OUT), D, n0, 1.0f, scr, lane); return; }
    r -= TI_OUT;
    if (r < 2 * TI_G) { const int up = r >= TI_G; if (up) r -= TI_G; const int kb = r / 88, n0 = 32 * (r % 88);
        tr_item(in[up ? 12 : 11] + (size_t)l * D * DFF, DFF, 64 * kb, n0, (bf16*)(wl + W_GU), D, 256 * (n0 >> 7) + 128 * up + (n0 & 127), 1.0f, scr, lane); return; }
    r -= 2 * TI_G;
    if (r < TI_DN) { const int kb = r / 32, n0 = 32 * (r % 32); tr_item(in[13] + (size_t)l * DFF * D, D, 64 * kb, n0, (bf16*)(wl + W_DN), DFF, n0, 1.0f, scr, lane); return; }
    r -= TI_DN;
    { const int g = r >> 1, n0 = 32 * (r & 1); tr_item(in[7] + (size_t)l * 16384 + g * 4096, 64, 0, n0, (bf16*)(wl + W_PT) + g * 4096, 64, n0, 1.0f, scr, lane, false); }
}
__device__ __forceinline__ void ada_item(Frame& F, const float* const* in, unsigned char* ws, int item) {
    LAS float* cact = (LAS float*)(F.lds);
    LAS float* red = (LAS float*)(F.lds + 16384);
    const int l = item / 96, cb = item % 96;
    const float* c = in[1];
    for (int i = F.tid; i < BATCH * D; i += NWAVES * 64) { const int b = i >> 10, k = i & 1023; const float v = c[i]; cact[k * 4 + b] = v / (1.0f + __expf(-v)); }
    __syncthreads();
    const float* W = in[4] + (size_t)l * D * (NMOD * D) + 64 * cb + F.lane;
    float a0 = 0.f, a1 = 0.f, a2 = 0.f, a3 = 0.f;
    const int kbeg = 128 * F.wave;
#pragma unroll 16
    for (int kk = 0; kk < 128; ++kk) { const float wv = __builtin_nontemporal_load(W + (size_t)(kbeg + kk) * (NMOD * D)); const f32x4 ca = *(const LAS f32x4*)(cact + (kbeg + kk) * 4);
        a0 += ca.x * wv; a1 += ca.y * wv; a2 += ca.z * wv; a3 += ca.w * wv; }
    red[(F.wave * 4 + 0) * 64 + F.lane] = a0; red[(F.wave * 4 + 1) * 64 + F.lane] = a1; red[(F.wave * 4 + 2) * 64 + F.lane] = a2; red[(F.wave * 4 + 3) * 64 + F.lane] = a3;
    __syncthreads();
    if (F.wave < 4) { float s = in[5][(size_t)l * NMOD * D + 64 * cb + F.lane];
#pragma unroll
        for (int w = 0; w < 8; ++w) s += red[(w * 4 + F.wave) * 64 + F.lane];
        ((float*)(ws + WS_MOD))[((size_t)l * BATCH + F.wave) * (NMOD * D) + 64 * cb + F.lane] = s; }
    __syncthreads();
}
__device__ __forceinline__ void p_prologue(Frame& F, const float* const* in, unsigned char* ws) {
    for (int item = blockIdx.x; item < DEPTH * 96; item += F.G) ada_item(F, in, ws, item);
    LAS float* scr = (LAS float*)(F.lds + RING_OFF + F.wave * 16384);
    const int gw = blockIdx.x * NWAVES + F.wave, NGW = F.G * NWAVES;
    for (int it = gw; it < DEPTH * TI_LAYER; it += NGW) weight_item(in, ws, it, scr, F.lane);
    { GAS f32x4* z = (GAS f32x4*)(ws + WS_SUMSQ) + M / 4; const int n4 = 4 * M / 4;
      for (int i = blockIdx.x * (NWAVES * 64) + F.tid; i < n4; i += F.G * NWAVES * 64) z[i] = zero4_(); }
}

__device__ __forceinline__ void p_conv(Frame& F, const float* const* in, unsigned char* ws) {
    const float* MOD = (const float*)(ws + WS_MOD);
    const int NGW = F.G * NWAVES, rpw = M / NGW;
    const int gw = (F.G == 256) ? (((int)blockIdx.x & 7) * 32 + ((int)blockIdx.x >> 3)) * NWAVES + F.wave : (int)blockIdx.x * NWAVES + F.wave;
    {
        const int row0 = gw * rpw, b = row0 / SEQ;
        const float* mb = MOD + (size_t)b * (NMOD * D);
        const float* xin = in[0]; bf16* hout = (bf16*)(ws + WS_H); float* ssq = (float*)(ws + WS_SUMSQ);
        f32x4 Gv[4];
#pragma unroll
        for (int j = 0; j < 4; ++j) { const int cidx = 4 * F.lane + 256 * j; const f32x4 g = *(const f32x4*)(in[2] + cidx), sc = *(const f32x4*)(mb + 1 * D + cidx); Gv[j] = g * (sc + 1.0f); }
        for (int rr = 0; rr < rpw; rr += 4) {
            f32x4 v[4][4];
#pragma unroll
            for (int i = 0; i < 4; ++i) { const GAS f32x4* xr = (const GAS f32x4*)(xin + (size_t)(row0 + rr + i) * D) + F.lane;
#pragma unroll
                for (int j = 0; j < 4; ++j) v[i][j] = __builtin_nontemporal_load(xr + 64 * j); }
#pragma unroll
            for (int i = 0; i < 4; ++i) { const size_t row = (size_t)(row0 + rr + i); float s = 0.f;
#pragma unroll
                for (int j = 0; j < 4; ++j) s += (v[i][j].x * v[i][j].x + v[i][j].y * v[i][j].y) + (v[i][j].z * v[i][j].z + v[i][j].w * v[i][j].w);
                s = wave_sum(s); if (F.lane == 0) ssq[row] = s;
                unsigned char* hb = (unsigned char*)hout + 8 * (F.lane & 1);
#pragma unroll
                for (int j = 0; j < 4; ++j) { const f32x4 o = v[i][j] * Gv[j]; *(GAS unsigned long long*)(hb + pg8::img_off((int)row, (4 * F.lane + 256 * j) & ~7, D / 64, false)) = (unsigned long long)pk2(o.x, o.y) | ((unsigned long long)pk2(o.z, o.w) << 32);
 } }
        }
    }
    {
        float* GV = (float*)(ws + WS_GV);
        for (int i = blockIdx.x * (NWAVES * 64) + F.tid; i < DEPTH * 2 * BATCH * D; i += F.G * NWAVES * 64) { const int col = i & (D - 1), b = (i >> 10) & 3, w = (i >> 12) & 1, l = i >> 13;
            GV[i] = in[w ? 3 : 2][l * D + col] * (1.0f + MOD[((size_t)l * BATCH + b) * (NMOD * D) + (w ? 4 : 1) * D + col]); }
    }
    {
        const int g0 = 8 * gw;
        if (g0 < DEPTH * (INW + 2 * DFF)) {
            const int l = g0 / (INW + 2 * DFF), rl = g0 % (INW + 2 * DFF), w = rl >= INW, n0 = w ? rl - INW : rl, N = w ? 2 * DFF : INW;
            const unsigned char* Bt = ws + WS_W + (size_t)l * W_LAYER + (w ? W_GU : W_IN);
            float* bias = (float*)(ws + WS_BIAS + (size_t)l * BIAS_LAYER) + (w ? BATCH * INW : 0);
            const float* shp = MOD + (size_t)l * BATCH * (NMOD * D) + (w ? 3 : 0) * D + 16 * F.lane;
            v4u wr[8][2];
#pragma unroll
            for (int i = 0; i < 8; ++i) { wr[i][0] = *(const GAS v4u*)(Bt + pg8::img_off(n0 + i, 16 * F.lane, D / 64, true)); wr[i][1] = *(const GAS v4u*)(Bt + pg8::img_off(n0 + i, 16 * F.lane + 8, D / 64, true)); }
            f32x4 sh[4][4];
#pragma unroll
            for (int b = 0; b < 4; ++b)
#pragma unroll
                for (int j = 0; j < 4; ++j) sh[b][j] = *(const f32x4*)(shp + (size_t)b * (NMOD * D) + 4 * j);
#pragma unroll
            for (int i = 0; i < 8; ++i) { const v4u w0 = wr[i][0], w1 = wr[i][1];
                float wf[16];
                wf[0] = __uint_as_float(w0.x << 16); wf[1] = __uint_as_float(w0.x & 0xffff0000u); wf[2] = __uint_as_float(w0.y << 16); wf[3] = __uint_as_float(w0.y & 0xffff0000u);
                wf[4] = __uint_as_float(w0.z << 16); wf[5] = __uint_as_float(w0.z & 0xffff0000u); wf[6] = __uint_as_float(w0.w << 16); wf[7] = __uint_as_float(w0.w & 0xffff0000u);
                wf[8] = __uint_as_float(w1.x << 16); wf[9] = __uint_as_float(w1.x & 0xffff0000u); wf[10] = __uint_as_float(w1.y << 16); wf[11] = __uint_as_float(w1.y & 0xffff0000u);
                wf[12] = __uint_as_float(w1.z << 16); wf[13] = __uint_as_float(w1.z & 0xffff0000u); wf[14] = __uint_as_float(w1.w << 16); wf[15] = __uint_as_float(w1.w & 0xffff0000u);
                float acc[4];
#pragma unroll
                for (int b = 0; b < 4; ++b) { float a = 0.f;
#pragma unroll
                    for (int j = 0; j < 4; ++j) a += (wf[4 * j] * sh[b][j].x + wf[4 * j + 1] * sh[b][j].y) + (wf[4 * j + 2] * sh[b][j].z + wf[4 * j + 3] * sh[b][j].w);
                    acc[b] = wave_sum(a); }
                if (F.lane < 4) bias[(size_t)F.lane * N + n0 + i] = F.lane == 0 ? acc[0] : F.lane == 1 ? acc[1] : F.lane == 2 ? acc[2] : acc[3]; }
        }
    }
}
__device__ __forceinline__ void p_norm_final(Frame& F, const bf16* xin, const float* ssq, float* out, const float* gvec) {
    const int NGW = F.G * NWAVES, rpw = M / NGW;
    const int gw = (F.G == 256) ? (((int)blockIdx.x & 7) * 32 + ((int)blockIdx.x >> 3)) * NWAVES + F.wave : (int)blockIdx.x * NWAVES + F.wave;
    const int row0 = gw * rpw;
    f32x4 Gv[4];
#pragma unroll
    for (int j = 0; j < 4; ++j) Gv[j] = *(const f32x4*)(gvec + 4 * F.lane + 256 * j);
    for (int rr = 0; rr < rpw; rr += 4) {
        unsigned long long w[4][4]; float ss[4];
#pragma unroll
        for (int i = 0; i < 4; ++i) { const unsigned char* xr = (const unsigned char*)xin + 8 * (F.lane & 1); ss[i] = ssq[row0 + rr + i];
#pragma unroll
            for (int j = 0; j < 4; ++j) w[i][j] = *(const GAS unsigned long long*)(xr + pg8::img_off(row0 + rr + i, (4 * F.lane + 256 * j) & ~7, D / 64, false)); }
#pragma unroll
        for (int i = 0; i < 4; ++i) { const float rstd = 1.0f / sqrtf(ss[i] * (1.0f / D) + RMS_EPS);
            GAS f32x4* o = (GAS f32x4*)(out + (size_t)(row0 + rr + i) * D) + F.lane;
#pragma unroll
            for (int j = 0; j < 4; ++j) { const unsigned wl = (unsigned)w[i][j], wh = (unsigned)(w[i][j] >> 32);
                const f32x4 v = {pg8::h_lo(wl), pg8::h_hi(wl), pg8::h_lo(wh), pg8::h_hi(wh)};
                __builtin_nontemporal_store(v * rstd * Gv[j], o + 64 * j); } }
    }
}

namespace mx {
typedef short bf16x8 __attribute__((ext_vector_type(8)));
typedef short s16x4 __attribute__((ext_vector_type(4)));
typedef float f32x16 __attribute__((ext_vector_type(16)));
typedef unsigned u32x4 __attribute__((ext_vector_type(4)));
typedef unsigned u32x2 __attribute__((ext_vector_type(2)));
typedef float f32x2_t __attribute__((ext_vector_type(2))); typedef __bf16 bf16x2_t __attribute__((ext_vector_type(2)));
constexpr float THR = 8.0f;
constexpr int POOL_PITCH = 544;
__device__ __forceinline__ unsigned cvtpk(float lo, float hi) { f32x2_t v = {lo, hi}; bf16x2_t b = __builtin_convertvector(v, bf16x2_t); return __builtin_bit_cast(unsigned, b); }
__device__ __forceinline__ float hswap_max(float v) { auto rr = __builtin_amdgcn_permlane32_swap(__float_as_uint(v), __float_as_uint(v), false, false); return fmaxf(__uint_as_float(rr[0]), __uint_as_float(rr[1])); }
__device__ __forceinline__ float hswap_sum(float v) { auto rr = __builtin_amdgcn_permlane32_swap(__float_as_uint(v), __float_as_uint(v), false, false); return __uint_as_float(rr[0]) + __uint_as_float(rr[1]); }
__device__ __forceinline__ s16x4 vtr(const LAS char* p) { return __builtin_bit_cast(s16x4, __builtin_amdgcn_ds_read_tr16_b64_v4i16((LAS s16x4*)p)); }
__device__ __forceinline__ f32x16 zero16_() { const float z = zero_(); return (f32x16){z, z, z, z, z, z, z, z, z, z, z, z, z, z, z, z}; }
__device__ __forceinline__ int kt_of(int i) { return (i & 1) ? -((i + 1) >> 1) : (i >> 1); }

template <int VAR>
__device__ __forceinline__ float scores(f32x16& t, const bf16x8 (&kf)[4], const bf16x8 (&qf)[4], float relf, float sl, float slope2, float Rf) {
    f32x16 s = {0.f, 0.f, 0.f, 0.f, 0.f, 0.f, 0.f, 0.f, 0.f, 0.f, 0.f, 0.f, 0.f, 0.f, 0.f, 0.f};
#pragma unroll
    for (int i = 0; i < 4; ++i) s = __builtin_amdgcn_mfma_f32_32x32x16_bf16(kf[i], qf[i], s, 0, 0, 0);
    if (VAR == 0) {
#pragma unroll
        for (int r = 0; r < 16; ++r) t[r] = __builtin_fmaf(-__builtin_fabsf(relf - (float)((r & 3) + 8 * (r >> 2))), slope2, s[r]);
        return 0.f;
    } else {
#pragma unroll
        for (int r = 0; r < 16; ++r) { const float c = (float)((r & 3) + 8 * (r >> 2)); float v = __builtin_fmaf(sl, c, s[r]); if (VAR == 2) v = __builtin_fabsf(relf - c) > Rf ? -INFINITY : v; t[r] = v; }
        return -sl * relf;
    }
}
__device__ __forceinline__ float lane_max(const f32x16& t) {
    float a = fmaxf(fmaxf(t[0], t[1]), fmaxf(t[2], t[3])), b = fmaxf(fmaxf(t[4], t[5]), fmaxf(t[6], t[7])), c = fmaxf(fmaxf(t[8], t[9]), fmaxf(t[10], t[11])), d = fmaxf(fmaxf(t[12], t[13]), fmaxf(t[14], t[15]));
    return fmaxf(fmaxf(a, b), fmaxf(c, d));
}
__device__ __forceinline__ float tile_max(const f32x16& t) {
    float a = fmaxf(fmaxf(t[0], t[1]), fmaxf(t[2], t[3])), b = fmaxf(fmaxf(t[4], t[5]), fmaxf(t[6], t[7])), c = fmaxf(fmaxf(t[8], t[9]), fmaxf(t[10], t[11])), d = fmaxf(fmaxf(t[12], t[13]), fmaxf(t[14], t[15]));
    return hswap_max(fmaxf(fmaxf(a, b), fmaxf(c, d)));
}
__device__ __forceinline__ void load_frag4(bf16x8 (&f)[4], const bf16* rowp, int hi) {
#pragma unroll
    for (int i = 0; i < 4; ++i) f[i] = *(const bf16x8*)(rowp + 16 * i + 8 * hi);
}
__device__ __forceinline__ void load_tile_frags(bf16x8 (&f)[4], const char* tile, int lane) {
#pragma unroll
    for (int s = 0; s < 4; ++s) f[s] = *(const bf16x8*)(tile + s * 1024 + lane * 16);
}
__device__ __forceinline__ void dma_tile(LAS char* dst, const char* tile, int lane) {
#pragma unroll
    for (int j = 0; j < 4; ++j) __builtin_amdgcn_global_load_lds((const unsigned*)(tile + j * 1024 + lane * 16), (LAS unsigned*)(dst + j * 1024), 16, 0, 0);
}
__device__ __forceinline__ void dma_v(LAS char* vb, const bf16* vrow0, long rs, int lane) {
#pragma unroll
    for (int j = 0; j < 4; ++j) __builtin_amdgcn_global_load_lds((const unsigned*)(vrow0 + (long)(16 * (j & 1) + (lane >> 2)) * rs + (4 * (j >> 1) + (lane & 3)) * 8), (LAS unsigned*)(vb + j * 1024), 16, 0, 0);
}
__device__ __forceinline__ void load_vfrags(bf16x8 (&vf)[2][2], const LAS char* vaddr) {
#pragma unroll
    for (int d0 = 0; d0 < 2; ++d0)
#pragma unroll
        for (int ks = 0; ks < 2; ++ks) { const s16x4 lo = vtr(vaddr + d0 * 2048 + ks * 1024), hh = vtr(vaddr + d0 * 2048 + ks * 1024 + 512);
            vf[d0][ks] = (bf16x8){lo[0], lo[1], lo[2], lo[3], hh[0], hh[1], hh[2], hh[3]}; }
}
__device__ __forceinline__ void pv_tile(f32x16 (&o)[2], const bf16x8 (&vf)[2][2], const f32x16& p) {
    u32x4 w0, w1;
    w0.x = cvtpk(p[0], p[1]); w0.y = cvtpk(p[2], p[3]); w0.z = cvtpk(p[4], p[5]); w0.w = cvtpk(p[6], p[7]);
    w1.x = cvtpk(p[8], p[9]); w1.y = cvtpk(p[10], p[11]); w1.z = cvtpk(p[12], p[13]); w1.w = cvtpk(p[14], p[15]);
    const bf16x8 pa0 = __builtin_bit_cast(bf16x8, w0), pa1 = __builtin_bit_cast(bf16x8, w1);
#pragma unroll
    for (int d0 = 0; d0 < 2; ++d0) { o[d0] = __builtin_amdgcn_mfma_f32_32x32x16_bf16(vf[d0][0], pa0, o[d0], 0, 0, 0); o[d0] = __builtin_amdgcn_mfma_f32_32x32x16_bf16(vf[d0][1], pa1, o[d0], 0, 0, 0); }
}
__device__ __forceinline__ void store_o(bf16* MIX, int row, int col, const f32x16 (&o)[2], float scale, int hi) {
#pragma unroll
    for (int d0 = 0; d0 < 2; ++d0)
#pragma unroll
        for (int g = 0; g < 4; g += 2) {
            const unsigned ax = cvtpk(o[d0][4 * g] * scale, o[d0][4 * g + 1] * scale), ay = cvtpk(o[d0][4 * g + 2] * scale, o[d0][4 * g + 3] * scale);
            const unsigned bx = cvtpk(o[d0][4 * g + 4] * scale, o[d0][4 * g + 5] * scale), by = cvtpk(o[d0][4 * g + 6] * scale, o[d0][4 * g + 7] * scale);
            const auto rx = __builtin_amdgcn_permlane32_swap(ax, bx, false, false); const auto ry = __builtin_amdgcn_permlane32_swap(ay, by, false, false);
            u32x4 w; w.x = rx[0]; w.y = ry[0]; w.z = rx[1]; w.w = ry[1];
            *(u32x4*)((unsigned char*)MIX + pg8::img_off(row, col + 32 * d0 + 8 * g + 8 * hi, D / 64, false)) = w; }
}
__device__ __forceinline__ void pack_o(u32x4 (&w)[4], const f32x16 (&o)[2], float scale) {
#pragma unroll
    for (int d0 = 0; d0 < 2; ++d0)
#pragma unroll
        for (int g = 0; g < 4; g += 2) {
            const unsigned ax = cvtpk(o[d0][4 * g] * scale, o[d0][4 * g + 1] * scale), ay = cvtpk(o[d0][4 * g + 2] * scale, o[d0][4 * g + 3] * scale);
            const unsigned bx = cvtpk(o[d0][4 * g + 4] * scale, o[d0][4 * g + 5] * scale), by = cvtpk(o[d0][4 * g + 6] * scale, o[d0][4 * g + 7] * scale);
            const auto rx = __builtin_amdgcn_permlane32_swap(ax, bx, false, false); const auto ry = __builtin_amdgcn_permlane32_swap(ay, by, false, false);
            w[2 * d0 + (g >> 1)] = (u32x4){rx[0], ry[0], rx[1], ry[1]}; }
}
__device__ __forceinline__ float alibi_slope(int k  ) { return __builtin_amdgcn_exp2f(-8.0f * (float)(k + 1) / 12.0f); }
__device__ __forceinline__ void scale_o(f32x16 (&o)[2], float f) {
#pragma unroll
    for (int r = 0; r < 16; ++r) { o[0][r] *= f; o[1][r] *= f; }
}

template <bool FIRST, bool WITH_O>
__device__ __forceinline__ void step_rest(f32x16 (&o)[2], float& m, float& l, f32x16& t, float off, const bf16x8 (&vf)[2][2]) {
    const float tm = hswap_max(lane_max(t) + off);
    if (FIRST) m = tm;
    else if (__any(tm - m > THR)) { const float dl = fmaxf(tm - m, 0.f), f = __builtin_amdgcn_exp2f(-dl); l *= f; if (WITH_O) scale_o(o, f); m += dl; }
    const float bm = off - m; f32x2_t ps = {0.f, 0.f}; const f32x2_t bm2 = {bm, bm};
#pragma unroll
    for (int r = 0; r < 16; r += 2) { const f32x2_t x = (f32x2_t){t[r], t[r + 1]} + bm2; t[r] = __builtin_amdgcn_exp2f(x.x); t[r + 1] = __builtin_amdgcn_exp2f(x.y); ps += (f32x2_t){t[r], t[r + 1]}; }
    l += ps.x + ps.y;
    if (WITH_O) pv_tile(o, vf, t);
}
template <int VAR, bool FIRST, bool WITH_O>
__device__ __forceinline__ void step(f32x16 (&o)[2], float& m, float& l, const bf16x8 (&kf)[4], const bf16x8 (&qf)[4], const bf16x8 (&vf)[2][2], float relf, float sl, float slope2, float Rf) {
    f32x16 t; const float off = scores<VAR>(t, kf, qf, relf, sl, slope2, Rf);
    step_rest<FIRST, WITH_O>(o, m, l, t, off, vf);
}

__device__ __forceinline__ void pair_rest(f32x16 (&o)[2], float& m, float& l, f32x16& tL, f32x16& tR, float offL, float offR, const LAS char* vL, const LAS char* vR) {
    const float tm = hswap_max(fmaxf(lane_max(tL) + offL, lane_max(tR) + offR));
    if (__any(tm - m > THR)) { const float dl = fmaxf(tm - m, 0.f), f = __builtin_amdgcn_exp2f(-dl); l *= f; scale_o(o, f); m += dl; }
    const float bL = offL - m, bR = offR - m; f32x2_t ps = {0.f, 0.f}; const f32x2_t bL2 = {bL, bL}, bR2 = {bR, bR};
#pragma unroll
    for (int r = 0; r < 16; r += 2) { const f32x2_t xL = (f32x2_t){tL[r], tL[r + 1]} + bL2, xR = (f32x2_t){tR[r], tR[r + 1]} + bR2;
        tL[r] = __builtin_amdgcn_exp2f(xL.x); tL[r + 1] = __builtin_amdgcn_exp2f(xL.y); tR[r] = __builtin_amdgcn_exp2f(xR.x); tR[r + 1] = __builtin_amdgcn_exp2f(xR.y);
        ps += (f32x2_t){tL[r], tL[r + 1]}; ps += (f32x2_t){tR[r], tR[r + 1]}; }
    l += ps.x + ps.y;
    { bf16x8 vf[2][2]; load_vfrags(vf, vL); pv_tile(o, vf, tL); }
    { bf16x8 vf[2][2]; load_vfrags(vf, vR); pv_tile(o, vf, tR); }
}
template <int VAR>
__device__ __forceinline__ void step_pair_lds(f32x16 (&o)[2], float& m, float& l, const LAS char* kL, const LAS char* kR, const LAS char* vL, const LAS char* vR, bf16x8 (&qf)[4],
                                              float relfL, float relfR, float slope2, float Rf, const char* qnext = nullptr, int lane = 0) {
    f32x16 tL, tR; float offL, offR;
    { bf16x8 kf[4];
#pragma unroll
      for (int s = 0; s < 4; ++s) kf[s] = *(const LAS bf16x8*)(kL + s * 1024);
      offL = scores<VAR>(tL, kf, qf, relfL, slope2, slope2, Rf); }
    { bf16x8 kf[4];
#pragma unroll
      for (int s = 0; s < 4; ++s) kf[s] = *(const LAS bf16x8*)(kR + s * 1024);
      offR = scores<VAR>(tR, kf, qf, relfR, -slope2, slope2, Rf); }
    if (qnext) load_tile_frags(qf, qnext, lane);
    pair_rest(o, m, l, tL, tR, offL, offR, vL, vR);
}
template <int VAR>
__device__ __forceinline__ void step_pair_regk(f32x16 (&o)[2], float& m, float& l, const bf16x8 (&kfL)[4], const bf16x8 (&kfR)[4], const LAS char* vL, const LAS char* vR, const bf16x8 (&qf)[4],
                                               float relfL, float relfR, float slope2, float Rf) {
    f32x16 tL, tR; const float offL = scores<VAR>(tL, kfL, qf, relfL, slope2, slope2, Rf), offR = scores<VAR>(tR, kfR, qf, relfR, -slope2, slope2, Rf);
    pair_rest(o, m, l, tL, tR, offL, offR, vL, vR);
}

__device__ __forceinline__ void dma_k(LAS char* kb, const bf16* krow0, long rs, int lane) {
#pragma unroll
    for (int s = 0; s < 4; ++s) __builtin_amdgcn_global_load_lds((const unsigned*)(krow0 + (long)(lane & 31) * rs + 16 * s + 8 * (lane >> 5)), (LAS unsigned*)(kb + s * 1024), 16, 0, 0);
}
struct BTile { const char* qb; const char* kb; const char* vb; int nt  , t0  , n0, head, d, r, tl; float slope2; };
__device__ __forceinline__ BTile b_decode(const char* ZB, int b, int c, int j, int qi, int q) {
    BTile t; const int g = qi >> 4, i = qi & 15, lg = 2 * g; t.d = 1 << lg;
    t.r = i >> (4 - lg); const int isub = i & ((16 >> lg) - 1); t.n0 = ((512 * c) >> lg) + 32 * isub; t.nt = 256 >> lg; t.t0 = t.n0 >> 5;
    t.head = 2 * g + j; t.slope2 = alibi_slope(6 + t.head) * (float)t.d * LOG2E;
    const size_t tb = (size_t)(t.head * 4 + b) * 256 + ((size_t)t.r << (8 - lg));
    t.qb = ZB + (tb << 12); t.kb = ZB + ((tb + 6 * 4 * 256) << 12); t.vb = ZB + ((tb + 2 * 6 * 4 * 256) << 12);
    t.tl = g * 512 + (32 * isub + q) * t.d + t.r;
    return t;
}
__device__ __forceinline__ void b_issue_qk(const BTile& t, bf16x8 (&qf)[4], bf16x8 (&kf)[5][4], bool (&val)[5], int (&kc)[5], int lane) {
    load_tile_frags(qf, t.qb + ((size_t)t.t0 << 12), lane);
#pragma unroll
    for (int i = 0; i < 5; ++i) { const int kt = t.t0 + kt_of(i); val[i] = kt >= 0 && kt < t.nt; kc[i] = kt < 0 ? 0 : (kt >= t.nt ? t.nt - 1 : kt);
        load_tile_frags(kf[i], t.kb + ((size_t)kc[i] << 12), lane); }
}
__device__ __forceinline__ void fill_ninf(f32x16& t) {
#pragma unroll
    for (int r = 0; r < 16; ++r) t[r] = -INFINITY;
}
__device__ __forceinline__ float b_qtile(f32x16 (&o)[2], const BTile& t, const BTile& tn, bool has_next, bf16x8 (&qf)[4], bf16x8 (&kf)[5][4], bool (&val)[5], int (&kc)[5], LAS char* vb, int lane) {
    const int q = lane & 31, hi = lane >> 5;
    const float slope2 = t.slope2;
    const LAS char* vaddr = vb + (4 * hi + ((lane & 15) >> 2)) * 64 + ((lane >> 4) & 1) * 32 + (lane & 3) * 8;
    float m = 0.f, l = 0.f;
    {
        bf16x8 vf[2][2]; load_vfrags(vf, vaddr);
        asm volatile("s_waitcnt lgkmcnt(0)" ::: "memory"); dma_tile(vb, t.vb + ((size_t)kc[4] << 12), lane);
        step<0, true, true>(o, m, l, kf[0], qf, vf, (float)(q - 4 * hi), slope2, slope2, 64.0f); }
    {
        f32x16 tL, tR; const float offL = scores<1>(tL, kf[1], qf, (float)(q + 32 - 4 * hi), slope2, slope2, 64.0f), offR = scores<1>(tR, kf[2], qf, (float)(q - 32 - 4 * hi), -slope2, slope2, 64.0f);
        if (!val[1]) fill_ninf(tL); if (!val[2]) fill_ninf(tR);
        pair_rest(o, m, l, tL, tR, offL, offR, vaddr + 4096, vaddr + 8192); }
    asm volatile("s_waitcnt vmcnt(0)" ::: "memory");
    {
        f32x16 tL, tR; const float offL = scores<2>(tL, kf[3], qf, (float)(q + 64 - 4 * hi), slope2, slope2, 64.0f), offR = scores<2>(tR, kf[4], qf, (float)(q - 64 - 4 * hi), -slope2, slope2, 64.0f);
        if (!val[3]) fill_ninf(tL); if (!val[4]) fill_ninf(tR);
        if (has_next) {
            asm volatile("s_waitcnt lgkmcnt(0)" ::: "memory");
            b_issue_qk(tn, qf, kf, val, kc, lane);
            dma_tile(vb + 4096, tn.vb + ((size_t)kc[1] << 12), lane); dma_tile(vb + 8192, tn.vb + ((size_t)kc[2] << 12), lane); }
        pair_rest(o, m, l, tL, tR, offL, offR, vaddr + 12288, vaddr);
        if (has_next) { asm volatile("s_waitcnt lgkmcnt(0)" ::: "memory");
            dma_tile(vb, tn.vb + ((size_t)kc[0] << 12), lane); dma_tile(vb + 12288, tn.vb + ((size_t)kc[3] << 12), lane); } }
    const float lt = hswap_sum(l);
    scale_o(o, 1.0f / lt);
    return m + __builtin_amdgcn_logf(lt);
}
__device__ __forceinline__ void b_unit(const char* ZB, bf16* MIX, char* SCR, int u, LAS char* lds, int wave, int lane) {
    const int b = u >> 5, c = (u >> 1) & 15, j = u & 1;
    LAS float* lseb = (LAS float*)(lds + LSEB_OFF);
    LAS char* vb = lds + wave * 16384;
    char* scr = SCR + ((size_t)(u * 8 + wave) * 6 << 12) + lane * 16;
    const int q = lane & 31, hi = lane >> 5;
    bf16x8 qf[4], kf[5][4]; bool val[5]; int kc[5];
    BTile t = b_decode(ZB, b, c, j, wave, q);
    b_issue_qk(t, qf, kf, val, kc, lane);
#pragma unroll
    for (int i = 0; i < 4; ++i) dma_tile(vb + i * 4096, t.vb + ((size_t)kc[i] << 12), lane);
#pragma unroll 1
    for (int it = 0; it < 6; ++it) { const bool has_next = it < 5; const BTile tn = b_decode(ZB, b, c, j, wave + 8 * (has_next ? it + 1 : it), q);
        if (it == 0) asm volatile("s_waitcnt vmcnt(0)" ::: "memory"); else asm volatile("s_waitcnt vmcnt(4)" ::: "memory");
        f32x16 o[2]; o[0] = zero16_(); o[1] = zero16_();
        const float lse = b_qtile(o, t, tn, has_next, qf, kf, val, kc, vb, lane);
        if (hi == 0) lseb[t.tl] = lse;
        u32x4 w[4]; pack_o(w, o, 1.0f);
#pragma unroll
        for (int k = 0; k < 4; ++k) *(u32x4*)(scr + ((size_t)it << 12) + k * 1024) = w[k];
        t = tn; }
    __syncthreads();
#pragma unroll 1
    for (int it0 = 0; it0 < 6; it0 += 3) { u32x4 w[3][4];
#pragma unroll
        for (int ii = 0; ii < 3; ++ii)
#pragma unroll
            for (int k = 0; k < 4; ++k) w[ii][k] = *(const u32x4*)(scr + ((size_t)(it0 + ii) << 12) + k * 1024);
#pragma unroll
        for (int ii = 0; ii < 3; ++ii) { const BTile tt = b_decode(ZB, b, c, j, wave + 8 * (it0 + ii), q);
            const int tk = tt.tl & 511; const float l0 = lseb[tk], l1 = lseb[512 + tk], l2 = lseb[1024 + tk], own = lseb[tt.tl]; const float mm = fmaxf(l0, fmaxf(l1, l2));
            const float a = __builtin_amdgcn_exp2f(own - mm) / (__builtin_amdgcn_exp2f(l0 - mm) + __builtin_amdgcn_exp2f(l1 - mm) + __builtin_amdgcn_exp2f(l2 - mm));
            const int orow = b * SEQ + (tt.n0 + q) * tt.d + tt.r, ocol = 256 + 64 * tt.head + 8 * hi;
#pragma unroll
            for (int k = 0; k < 4; ++k) { const u32x4 x = w[ii][k]; u32x4 y;
                y.x = cvtpk(__uint_as_float(x.x << 16) * a, __uint_as_float(x.x & 0xffff0000u) * a); y.y = cvtpk(__uint_as_float(x.y << 16) * a, __uint_as_float(x.y & 0xffff0000u) * a);
                y.z = cvtpk(__uint_as_float(x.z << 16) * a, __uint_as_float(x.z & 0xffff0000u) * a); y.w = cvtpk(__uint_as_float(x.w << 16) * a, __uint_as_float(x.w & 0xffff0000u) * a);
                *(u32x4*)((unsigned char*)MIX + pg8::img_off(orow, ocol + 32 * (k >> 1) + 16 * (k & 1), D / 64, false)) = y; } } }
    __syncthreads();
}
__device__ __forceinline__ void c_unit(const char* ZC, bf16* MIX, const float* sink, int u, LAS char* lds, int wave, int lane) {
    const int b = u >> 6, kvh = (u >> 5) & 1, q0 = 256 * (u & 31), n0 = q0 + 32 * wave;
    const int q = lane & 31, hi = lane >> 5;
    const char* kt0 = ZC + ((size_t)((6 + kvh) * 4 + b) * 256 << 12); const char* vt0 = ZC + ((size_t)((8 + kvh) * 4 + b) * 256 << 12);
#pragma unroll
    for (int tt = 0; tt < 2; ++tt) { const int t = 2 * wave + tt, T = (q0 >> 5) - 4 + t;
        if (T >= 0 && T < SEQ / 32) { dma_tile(lds + t * 8192, kt0 + ((size_t)T << 12), lane); dma_tile(lds + t * 8192 + 4096, vt0 + ((size_t)T << 12), lane); } }
    const char* qt0 = ZC + (((size_t)((3 * kvh) * 4 + b) * 256 + (n0 >> 5)) << 12);
    bf16x8 qf[4]; load_tile_frags(qf, qt0, lane);
    asm volatile("s_waitcnt vmcnt(0)" ::: "memory");
    __syncthreads();
    const LAS char* kbase = lds + lane * 16;
    const LAS char* vbase = lds + 4096 + (4 * hi + ((lane & 15) >> 2)) * 64 + ((lane >> 4) & 1) * 32 + (lane & 3) * 8;
#pragma unroll 1
    for (int hh = 0; hh < 3; ++hh) { const int head = 3 * kvh + hh;
        const char* qnext = hh < 2 ? qt0 + ((size_t)(hh + 1) * 4 * 256 << 12) : nullptr; bool reloaded = false;
        f32x16 o[2]; o[0] = zero16_(); o[1] = zero16_();
        float m = sink[head] * LOG2E, l = hi ? 0.f : 1.0f; const float slope2 = alibi_slope(head) * LOG2E;
        {
            const int t = wave + 4; bf16x8 kf[4];
#pragma unroll
            for (int s = 0; s < 4; ++s) kf[s] = *(const LAS bf16x8*)(kbase + t * 8192 + s * 1024);
            bf16x8 vf[2][2]; load_vfrags(vf, vbase + t * 8192);
            step<0, false, true>(o, m, l, kf, qf, vf, (float)(q - 4 * hi), slope2, slope2, 128.0f); }
#pragma unroll 1
        for (int k = 1; k <= 4; ++k) { const int tL = wave + 4 - k, tR = wave + 4 + k; const bool vL = n0 - 32 * k >= 0, vR = n0 + 32 * k < SEQ;
            const float relfL = (float)(q + 32 * k - 4 * hi), relfR = (float)(q - 32 * k - 4 * hi);
            if (vL && vR) {
                if (k < 4) step_pair_lds<1>(o, m, l, kbase + tL * 8192, kbase + tR * 8192, vbase + tL * 8192, vbase + tR * 8192, qf, relfL, relfR, slope2, 128.0f);
                else { step_pair_lds<2>(o, m, l, kbase + tL * 8192, kbase + tR * 8192, vbase + tL * 8192, vbase + tR * 8192, qf, relfL, relfR, slope2, 128.0f, qnext, lane); reloaded = true; } }
            else if (vL || vR) { const int t = vL ? tL : tR; bf16x8 kf[4];
#pragma unroll
                for (int s = 0; s < 4; ++s) kf[s] = *(const LAS bf16x8*)(kbase + t * 8192 + s * 1024);
                bf16x8 vf[2][2]; load_vfrags(vf, vbase + t * 8192);
                const float relf = vL ? relfL : relfR, sl = vL ? slope2 : -slope2;
                if (k < 4) step<1, false, true>(o, m, l, kf, qf, vf, relf, sl, slope2, 128.0f); else step<2, false, true>(o, m, l, kf, qf, vf, relf, sl, slope2, 128.0f); } }
        if (!reloaded && qnext) load_tile_frags(qf, qnext, lane);
        store_o(MIX, b * SEQ + n0 + q, 640 + 64 * head, o, 1.0f / hswap_sum(l), hi); }
    __syncthreads();
}
template <int G>
__device__ __forceinline__ void pool_group(const LAS char* rows, bf16* MIX, const bf16* wpt, const float* pscale, int row0, int tok, int kq, int lane) {
    constexpr int R = 1 << G, W = 2 * R + 1;
    int lo = tok - R, hi2 = tok + R + 1; lo = lo < 0 ? 0 : lo; hi2 = hi2 > SEQ ? SEQ : hi2; const float inv = 1.0f / (float)(hi2 - lo);
    f32x4 acc[4];
#pragma unroll
    for (int dt = 0; dt < 4; ++dt) acc[dt] = zero4_();
#pragma unroll
    for (int kb = 0; kb < 2; ++kb) { float s[8]; bf16x8 uc;
        const LAS char* rp = rows + ((lane & 15) + 8 - R) * POOL_PITCH + (8 * G + 4 * kb + kq) * 16;
#pragma unroll
        for (int e = 0; e < 8; ++e) s[e] = 0.f;
#pragma unroll
        for (int j = 0; j < W; ++j) { const int tt = tok + j - R; const float w = (tt >= 0 && tt < SEQ) ? 1.0f : 0.0f; const bf16x8 v = *(const LAS bf16x8*)(rp + j * POOL_PITCH); if (j == R) uc = v;
#pragma unroll
            for (int e = 0; e < 8; ++e) s[e] += w * bf2f((unsigned short)v[e]); }
        u32x4 pw; float pe[8];
#pragma unroll
        for (int e = 0; e < 8; ++e) pe[e] = s[e] * inv - bf2f((unsigned short)uc[e]);
        pw.x = cvtpk(pe[0], pe[1]); pw.y = cvtpk(pe[2], pe[3]); pw.z = cvtpk(pe[4], pe[5]); pw.w = cvtpk(pe[6], pe[7]);
        const bf16x8 bfrag = __builtin_bit_cast(bf16x8, pw);
#pragma unroll
        for (int dt = 0; dt < 4; ++dt) { const bf16x8 afrag = *(const bf16x8*)(wpt + (size_t)(G * 64 + dt * 16 + (lane & 15)) * 64 + kb * 32 + 8 * kq);
            acc[dt] = __builtin_amdgcn_mfma_f32_16x16x32_bf16(afrag, bfrag, acc[dt], 0, 0, 0); } }
#pragma unroll
    for (int dt = 0; dt < 4; ++dt) { const int dcol = G * 64 + dt * 16 + 4 * kq; const f32x4 sc = *(const f32x4*)(pscale + dcol);
        u32x2 w; w.x = cvtpk(acc[dt][0] * sc.x, acc[dt][1] * sc.y); w.y = cvtpk(acc[dt][2] * sc.z, acc[dt][3] * sc.w);
        *(u32x2*)((unsigned char*)MIX + pg8::img_off(row0 + (lane & 15), dcol & ~7, D / 64, false) + 2 * (dcol & 7)) = w; }
}
__device__ __forceinline__ void pool_item(const bf16* Z, bf16* MIX, const bf16* wpt, const float* pscale, int item, LAS char* rows, int lane) {
    const int row0 = 16 * item, b = row0 / SEQ, t0 = row0 % SEQ;
    const int tok = t0 + (lane & 15), kq = lane >> 4;
    const bf16* zb = Z + (size_t)b * SEQ * 256;
    u32x4 st[16];
#pragma unroll
    for (int i = 0; i < 16; ++i) { const int idx = i * 64 + lane, r = idx >> 5, c = idx & 31; int tt = t0 - 8 + r; tt = (tt >= 0 && tt < SEQ) ? tt : t0; st[i] = *(const u32x4*)(zb + (size_t)tt * 256 + 8 * c); }
#pragma unroll
    for (int i = 0; i < 16; ++i) { const int idx = i * 64 + lane, r = idx >> 5, c = idx & 31; *(LAS u32x4*)(rows + r * POOL_PITCH + c * 16) = st[i]; }
    pool_group<0>(rows, MIX, wpt, pscale, row0, tok, kq, lane); pool_group<1>(rows, MIX, wpt, pscale, row0, tok, kq, lane);
    pool_group<2>(rows, MIX, wpt, pscale, row0, tok, kq, lane); pool_group<3>(rows, MIX, wpt, pscale, row0, tok, kq, lane);
}
constexpr int N_B_UNITS = 128, N_C_UNITS = 256, N_P_ITEMS = M / 16;
}

__device__ __forceinline__ void p_mixers(Frame& F, const float* const* in, unsigned char* ws, int lq, int sel  ) {
    const int l = lq & 1;
    const bf16* Z = (const bf16*)(ws + WS_Z); bf16* MIX = (bf16*)(ws + WS_MIX);
    LAS char* lds = (LAS char*)F.lds;
    const float* sink = in[9] + 6 * l;
    {
        const int nb = (F.G >= 2 * mx::N_B_UNITS) ? mx::N_B_UNITS : (F.G + 1) / 2;
        const bool xl = (F.G == 256);
        if ((int)blockIdx.x < nb) {
            if (sel & 1) {
#pragma unroll 1
                for (int u0 = blockIdx.x; u0 < mx::N_B_UNITS; u0 += nb) { const int u = xl ? ((u0 & 7) >> 1) * 32 + (8 * (u0 & 1) + (u0 >> 4)) * 2 + ((u0 >> 3) & 1) : u0;     unsigned z_; asm volatile("v_mov_b32 %0, 0" : "=v"(z_)); const int lane = (int)__builtin_amdgcn_mbcnt_hi(~0u, __builtin_amdgcn_mbcnt_lo(~0u, z_)); mx::b_unit((const char*)(ws + WS_ZB), MIX, (char*)(ws + WS_BSCR), u, lds, F.wave, lane); } }
        } else if (sel & 2) {
#pragma unroll 1
            for (int v = (int)blockIdx.x - nb, u0 = v, k = 0; u0 < mx::N_C_UNITS; u0 += F.G - nb, ++k) { const int u = xl ? ((v & 7) >> 1) * 64 + ((((v >> 3) * 2 + k) >> 4) * 32) + 16 * (v & 1) + (((v >> 3) * 2 + k) & 15) : u0;     unsigned z_; asm volatile("v_mov_b32 %0, 0" : "=v"(z_)); const int lane = (int)__builtin_amdgcn_mbcnt_hi(~0u, __builtin_amdgcn_mbcnt_lo(~0u, z_)); mx::c_unit((const char*)(ws + WS_ZC), MIX, sink, u, lds, F.wave, lane); }
        }
        __syncthreads();
    }
    if (sel & 4) { const bf16* wpt = (const bf16*)(ws + WS_W + (size_t)l * W_LAYER + W_PT); const float* pscale = in[8] + 256 * l;
        for (int it0 = blockIdx.x * NWAVES + F.wave; it0 < mx::N_P_ITEMS; it0 += F.G * NWAVES) { const int it = (F.G == 256) ? (((int)blockIdx.x & 7) * 32 + ((int)blockIdx.x >> 3)) * NWAVES + F.wave : it0;     mx::pool_item(Z, MIX, wpt, pscale, it, lds + F.wave * (32 * mx::POOL_PITCH), F.lane); } }
}

struct Args { const float* in[15]; float* out; unsigned char* ws; int ph_lo, ph_hi, li, dup; };
__global__ void __launch_bounds__(NWAVES * 64, 2) mk_fwd(Args args) {
    extern __shared__ __attribute__((aligned(16))) unsigned char lds[];
    Frame F;
    F.lds = (LAS unsigned char*)lds;
    F.MISC = (volatile LAS unsigned*)(F.lds + MISC_OFF);
    F.tid = threadIdx.x; F.lane = F.tid & 63; F.wave = __builtin_amdgcn_readfirstlane(F.tid >> 6);
    const int wave0 = F.wave;
    F.G = gridDim.x; { const int bx = blockIdx.x; F.vcu = (F.G % 8 == 0) ? (bx % 8) * (F.G / 8) + bx / 8 : bx; }
    unsigned char* ws = args.ws;
    F.ctl = (gu32*)(ws + WS_CTL);
    for (int u = F.tid; u < (LDS_BYTES - LDSCTL_OFF) / 4; u += NWAVES * 64) ((LAS unsigned*)(F.lds + LDSCTL_OFF))[u] = 0u;
    __syncthreads();
    XcdBarrier bar; bar.bar = (unsigned*)(F.ctl + CW_BAR) + args.li * XCD_BAR_WORDS; bar.x = 0; bar.st = nullptr;
    const int lo = args.ph_lo, hi = args.ph_hi;
    if (hi - lo > 1) { bar = xcd_barrier_post((unsigned*)(F.ctl + CW_BAR) + args.li * XCD_BAR_WORDS, F.MISC + 8);
        if (F.tid == 0) { const unsigned v = bar.x + 1u; unsigned exp = 0u;
            if (!__hip_atomic_compare_exchange_strong((unsigned*)(F.ctl + CW_GRP) + (blockIdx.x & 7), &exp, v, __ATOMIC_RELAXED, __ATOMIC_RELAXED, __HIP_MEMORY_SCOPE_AGENT) && exp != v) __hip_atomic_fetch_or((unsigned*)(F.ctl + CW_GRPBAD), 1u, RLX_AGENT); } }
    const float* const* in = args.in;
    bf16* XS = (bf16*)(ws + WS_XS);
    bf16* H = (bf16*)(ws + WS_H);
    const float* MOD = (const float*)(ws + WS_MOD);
    float* SSQ = (float*)(ws + WS_SUMSQ);
    const float* GV = (const float*)(ws + WS_GV);

    const int dup = args.dup & 1, msel = ((args.dup >> 1) & 15) ? ((args.dup >> 1) & 15) : 7;
#pragma unroll 1
    for (int ph = lo; ph < hi; ++ph) {
        { unsigned z_; asm volatile("v_mov_b32 %0, 0" : "=v"(z_)); const int t_ = wave0 * 64 + (int)__builtin_amdgcn_mbcnt_hi(~0u, __builtin_amdgcn_mbcnt_lo(~0u, z_)); F.tid = t_; F.lane = t_ & 63; F.wave = wave0; }
        if (ph == PH_PRO) p_prologue(F, in, ws);
        else if (ph == PH_CONV) p_conv(F, in, ws);
        else if (ph == PH_FINAL) p_norm_final(F, XS, SSQ + (size_t)4 * M, args.out, in[14]);
        else {
            const int l = (ph - PH_L0) / PH_PER_LAYER, k = (ph - PH_L0) % PH_PER_LAYER;
            unsigned char* wl = ws + WS_W + (size_t)l * W_LAYER;
            const float* modl = MOD + (size_t)l * BATCH * NMOD * D;
            const float* biasl = (const float*)(ws + WS_BIAS + (size_t)l * BIAS_LAYER);
            if (k == 0) { pg8::Gemm g{H, (const bf16*)(wl + W_IN), M, INW, D}; pg8::StaticOrder S; S.init(M, INW, F.G, (int)blockIdx.x);
                pg8::EpiBf16Norm E{(bf16*)(ws + WS_Z), 256, SSQ + (size_t)(2 * l) * M, biasl, INW, ws + WS_ZB, ws + WS_ZC};
                pg8::gemm_phase<pg8::EpiBf16Norm, pg8::StaticOrder, true, true>(F.lds + RING_OFF, g, S, E, F.tid); }
            else if (k == 1) p_mixers(F, in, ws, l + 2 * dup, msel);
            else if (k == 2 && l == 0 && !dup) {
                pg8::Gemm g{(const bf16*)(ws + WS_MIX), (const bf16*)(wl + W_OUT), M, D, D}; pg8::StaticOrder S; S.init(M, D, F.G, (int)blockIdx.x);
                pg8::EpiGateResNormT<true> E{(const bf16*)in[0], XS, modl + 2 * D, NMOD * D, H, GV + (size_t)1 * BATCH * D, D, SSQ + (size_t)1 * M, D};
                pg8::gemm_phase<pg8::EpiGateResNormT<true>, pg8::StaticOrder, true, true>(F.lds + RING_OFF, g, S, E, F.tid); }
            else if (k == 2 || k == 4) { const bool dn = (k == 4); const bool last = dn && (l == DEPTH - 1);
                pg8::Gemm g{(const bf16*)(ws + (dn ? WS_HID : WS_MIX)), (const bf16*)(wl + (dn ? W_DN : W_OUT)), M, D, dn ? DFF : D}; pg8::StaticOrder S; S.init(M, D, F.G, (int)blockIdx.x);
                pg8::EpiGateResNorm E{XS, XS, dup ? (const float*)(F.ctl + CW_ZEROS) : modl + (dn ? 5 : 2) * D, dup ? 0 : NMOD * D,
                    (last || dup) ? (bf16*)nullptr : H, GV + (size_t)((dn ? 2 * (l + 1) : 2 * l + 1) % (2 * DEPTH)) * BATCH * D, D, SSQ + (size_t)(dup ? 5 : 2 * l + (dn ? 2 : 1)) * M, D};
                pg8::gemm_phase<pg8::EpiGateResNorm, pg8::StaticOrder, true, true>(F.lds + RING_OFF, g, S, E, F.tid); }
            else { pg8::Gemm g{H, (const bf16*)(wl + W_GU), M, 2 * DFF, D}; pg8::StaticOrder S; S.init(M, 2 * DFF, F.G, (int)blockIdx.x);
                pg8::EpiSwiGLUNorm E{(bf16*)(ws + WS_HID), DFF, SSQ + (size_t)(2 * l + 1) * M, biasl + BATCH * INW, 2 * DFF};
                pg8::gemm_phase<pg8::EpiSwiGLUNorm, pg8::StaticOrder, true, true>(F.lds + RING_OFF, g, S, E, F.tid); }
        }
        if (ph + 1 < hi) { const int kk = (ph >= PH_L0 && ph < PH_FINAL) ? (ph - PH_L0) % PH_PER_LAYER : -1;
            xcd_barrier(bar, F.MISC[17] != 0u && (kk == 2 || kk == 3 || (kk == 4 && ph + 1 == PH_FINAL)));
            if (ph == PH_PRO && lo == 0) { if (F.tid == 0) F.MISC[17] = (F.G == 256 && xb_ld((unsigned*)(F.ctl + CW_GRPBAD)) == 0u) ? 1u : 0u; __syncthreads(); } }
    }
}

extern "C" void kernel_launch(void* const* d_in, const int* in_sizes, int n_in, void* d_out, int out_size, void* d_ws, size_t ws_size, hipStream_t stream) {
    static int grid = 0;
    if (grid == 0) {
        if (n_in != 15 || in_sizes[0] != M * D || out_size != M * D || ws_size < WS_END) { fprintf(stderr, "kernel_launch: unexpected shapes (n_in %d, in0 %d, out %d, ws %zu); nothing launched\n", n_in, n_in > 0 ? in_sizes[0] : -1, out_size, ws_size); grid = -1; return; }
        int dev = 0, cus = 0, per_cu = 0;
        if (hipGetDevice(&dev) != hipSuccess || hipDeviceGetAttribute(&cus, hipDeviceAttributeMultiprocessorCount, dev) != hipSuccess) { grid = -1; return; }
        if (hipFuncSetAttribute((const void*)mk_fwd, hipFuncAttributeMaxDynamicSharedMemorySize, LDS_BYTES) != hipSuccess) { fprintf(stderr, "kernel_launch: hipFuncSetAttribute failed\n"); grid = -1; return; }
        if (hipOccupancyMaxActiveBlocksPerMultiprocessor(&per_cu, (const void*)mk_fwd, NWAVES * 64, LDS_BYTES) != hipSuccess || per_cu < 1) fprintf(stderr, "kernel_launch: occupancy query reports %d blocks per CU\n", per_cu);
        (void)hipGetLastError();
        grid = cus;
        if (grid != 256) fprintf(stderr, "kernel_launch: %d CUs; this kernel is laid out for 256\n", grid);
    }
    if (grid < 0) return;
    if (hipMemsetAsync((char*)d_ws + WS_CTL, 0, CTL_ZERO_BYTES, stream) != hipSuccess) return;
    Args a{};
    for (int i = 0; i < 15; ++i) a.in[i] = (const float*)d_in[i];
    a.out = (float*)d_out; a.ws = (unsigned char*)d_ws;
#if PROBE_DUP == 0 && PROBE_CUT == 0
    a.ph_lo = 0; a.ph_hi = NPHASES; a.li = 0; a.dup = 0;
    hipLaunchKernelGGL(mk_fwd, dim3(grid), dim3(NWAVES * 64), LDS_BYTES, stream, a);
#else
    { int lo = 0, li = 0;
      for (int ph = 0; ph < NPHASES; ++ph) { const bool cut = ((PROBE_CUT | PROBE_DUP) >> ph) & 1;
        if (cut || ph == NPHASES - 1) { a.ph_lo = lo; a.ph_hi = ph + 1; a.li = (ph + 1 - lo > 1) ? li++ : 0; a.dup = 0; hipLaunchKernelGGL(mk_fwd, dim3(grid), dim3(NWAVES * 64), LDS_BYTES, stream, a);
            if ((PROBE_DUP >> ph) & 1) { a.ph_lo = ph; a.ph_hi = ph + 1; a.li = 0; a.dup = 1 | (PROBE_MIXSEL << 1) | (PROBE_NOSTORE << 4); hipLaunchKernelGGL(mk_fwd, dim3(grid), dim3(NWAVES * 64), LDS_BYTES, stream, a); }
            lo = ph + 1; } } }
#endif
}
```

```cpp
#include <hip/hip_runtime.h>
#include <cstdio>
#include <cstdint>
namespace pg8 {
#define PG8_LAS __attribute__((address_space(3)))
typedef unsigned short bf16_t;
typedef short bf16x8 __attribute__((ext_vector_type(8)));
typedef float f32x4 __attribute__((ext_vector_type(4)));
typedef unsigned u32x4 __attribute__((ext_vector_type(4)));
constexpr int BM = 256, BK = 64, HALF = 128, HTB = HALF * BK * 2  , STAGE_BYTES = 8 * HTB, NXCD = 8, WGM = 8;

__host__ __device__ __forceinline__ int lds_byte(int r, int c) { const int st = (r >> 4) * 2 + (c >> 5), rr = r & 15, cc = c & 31, ob = rr * 64 + cc * 2; return st * 1024 + (ob ^ (((ob >> 9) & 1) << 5)); }
__host__ __device__ __forceinline__ void stage_rc(int b, int& R, int& C) { const int st = b / 1024, sb = b % 1024, swz = sb ^ (((sb >> 9) & 1) << 5); R = (st >> 1) * 16 + swz / 64; C = (st & 1) * 32 + (swz % 64) / 2; }
__host__ __device__ __forceinline__ int perm32(int rho) { const int n = rho >> 4, i = rho & 15; return 8 * (i >> 2) + 4 * n + (i & 3); }

__host__ __device__ __forceinline__ int perm32inv(int x) { return 16 * ((x >> 2) & 1) + 4 * (x >> 3) + (x & 3); }
__host__ __device__ __forceinline__ size_t img_off(int row, int col, int nt, bool wrow) { const int r = row & 127, rr = wrow ? (r & ~31) + perm32inv(r & 31) : r; return ((size_t)((row >> 7) * nt + (col >> 6)) << 14) + (size_t)lds_byte(rr, col & 63); }
constexpr bool IMG_A = true, IMG_B = true;
struct Unit { int pm, pn; };
struct Gemm { const bf16_t* A; const bf16_t* Bt; int M, N, K; };

struct StaticOrder {
    int nM, nN, nwg, G, c;
    __host__ __device__ void init(int M, int N, int G_, int c_) { nM = M / BM; nN = N / BM; nwg = nM * nN; G = G_; c = c_; }
    __host__ __device__ bool next(int i, Unit& u) const {
        const long L = (long)i * G + c; if (L >= nwg) return false;
        int wgid = (int)L; { const int q = nwg / NXCD, r = nwg % NXCD, xcd = wgid % NXCD, off = wgid / NXCD; wgid = (xcd < r ? xcd * (q + 1) : r * (q + 1) + (xcd - r) * q) + off; }
        const int nig = WGM * nN, gid = wgid / nig, fm = gid * WGM, gsz = (nM - fm) < WGM ? (nM - fm) : WGM;
        u.pm = fm + ((wgid % nig) % gsz); u.pn = (wgid % nig) / gsz; return true;
    }
    __device__ __forceinline__ void a_ready(const Unit&) const {}
    __device__ __forceinline__ void done(const Unit&) const {}
};

__device__ __forceinline__ unsigned cvt_pk_bf16(float lo, float hi) { unsigned r; asm volatile("v_cvt_pk_bf16_f32 %0, %1, %2" : "=v"(r) : "v"(lo), "v"(hi)); return r; }
constexpr float RMS_EPS_ = 1e-6f, INV_D_ = 1.0f / 1024.0f;
__device__ __forceinline__ void aux_dma(const float* src_lane, PG8_LAS unsigned char* dst_wave) { __builtin_amdgcn_global_load_lds((const unsigned*)src_lane, (PG8_LAS unsigned*)dst_wave, 4, 0, 0); }
typedef _Float16 h16x2 __attribute__((ext_vector_type(2)));
__device__ __forceinline__ unsigned pk_h2(float lo, float hi) { const h16x2 h = {(_Float16)lo, (_Float16)hi}; return __builtin_bit_cast(unsigned, h); }
__device__ __forceinline__ float h_lo(unsigned w) { return (float)__builtin_bit_cast(h16x2, w)[0]; }
__device__ __forceinline__ float h_hi(unsigned w) { return (float)__builtin_bit_cast(h16x2, w)[1]; }
struct EpiBf16Norm {
    static constexpr bool PERM = true, AFTER_DRAIN = false;
    bf16_t* O; int ldc; const float* sumsq; const float* bias; int bias_stride; unsigned char* zb; unsigned char* zc;
    __device__ __forceinline__ void prefetch(const Unit& u, PG8_LAS unsigned char* aux, int wid, int lane) const {
        if (wid < 4) aux_dma(sumsq + u.pm * BM + wid * 64 + lane, aux + wid * 256);
        else aux_dma(bias + (size_t)(u.pm >> 5) * bias_stride + u.pn * BM + (wid - 4) * 64 + lane, aux + 1024 + (wid - 4) * 256);
    }
    __device__ __forceinline__ void operator()(const f32x4 (&acc)[2][2][4][2], const Unit& u, int wr, int wc, int fr_, int fq_, PG8_LAS unsigned char* aux) const {
        unsigned z_; asm volatile("v_mov_b32 %0, 0" : "=v"(z_)); const int ln_ = (int)__builtin_amdgcn_mbcnt_hi(~0u, __builtin_amdgcn_mbcnt_lo(~0u, z_)); const int fr = ln_ & 15, fq = ln_ >> 4;
        const int row0 = u.pm * BM + wr * 64 + fr, col0 = u.pn * BM + wc * 32 + 8 * fq;
        const PG8_LAS float* ass = (const PG8_LAS float*)aux + wr * 64 + fr; const PG8_LAS float* ab = (const PG8_LAS float*)(aux + 1024) + wc * 32 + 8 * fq;
        f32x4 bv[2][2];
#pragma unroll
        for (int bj = 0; bj < 2; ++bj)
#pragma unroll
            for (int n = 0; n < 2; ++n) bv[bj][n] = *(const PG8_LAS f32x4*)(ab + bj * HALF + 4 * n);
#pragma unroll
        for (int ai = 0; ai < 2; ++ai)
#pragma unroll
            for (int m = 0; m < 4; ++m) { const int row = row0 + ai * HALF + m * 16; const float rs = __builtin_amdgcn_rsqf(ass[ai * HALF + m * 16] * INV_D_ + RMS_EPS_);
#pragma unroll
                for (int bj = 0; bj < 2; ++bj) { const f32x4 v0 = acc[ai][bj][m][0] * rs + bv[bj][0], v1 = acc[ai][bj][m][1] * rs + bv[bj][1];
                    u32x4 w; w.x = cvt_pk_bf16(v0[0], v0[1]); w.y = cvt_pk_bf16(v0[2], v0[3]); w.z = cvt_pk_bf16(v1[0], v1[1]); w.w = cvt_pk_bf16(v1[2], v1[3]);
                    const int cb = 2 * u.pn + bj;
                    if (zb != nullptr && cb >= 2 && cb <= 10) { const int t3 = (cb - 2) / 3, g = (cb - 2) % 3, lg = 2 * g, hd = 2 * g + (wc >> 1), c = (wc & 1) * 4 + fq;
                        const int t = row & 8191, b = row >> 13, r = t & ((1 << lg) - 1), n = t >> lg, ti = (r << (8 - lg)) + (n >> 5), key = n & 31;
                        const int off = t3 < 2 ? (c >> 1) * 1024 + (key + 32 * (c & 1)) * 16 : (c >> 2) * 2048 + (key >> 4) * 1024 + (key & 15) * 64 + (c & 3) * 16;
                        *(u32x4*)(zb + ((size_t)(((t3 * 6 + hd) * 4 + b) * 256 + ti) << 12) + off) = w; }
                    else if (zb != nullptr && cb >= 11) {
                        const int hx = cb <= 13 ? 2 * (cb - 11) + (wc >> 1) : (cb == 14 ? 6 : 8) + (wc >> 1), c = (wc & 1) * 4 + fq, t = row & 8191, b = row >> 13, key = t & 31;
                        const int off = cb < 15 ? (c >> 1) * 1024 + (key + 32 * (c & 1)) * 16 : (c >> 2) * 2048 + (key >> 4) * 1024 + (key & 15) * 64 + (c & 3) * 16;
                        *(u32x4*)(zc + ((size_t)((hx * 4 + b) * 256 + (t >> 5)) << 12) + off) = w; }
                    else *(u32x4*)(O + (size_t)row * ldc + col0 + bj * HALF) = w; } }
    }
};
struct EpiSwiGLUNorm {
    static constexpr bool PERM = true, AFTER_DRAIN = false;
    bf16_t* O; int ldc; const float* sumsq; const float* bias; int bias_stride;
    static __device__ __forceinline__ float silu_mul(float g, float u) { return g * u * __builtin_amdgcn_rcpf(1.0f + __builtin_amdgcn_exp2f(-1.4426950408889634f * g)); }
    __device__ __forceinline__ void prefetch(const Unit& u, PG8_LAS unsigned char* aux, int wid, int lane) const {
        if (wid < 4) aux_dma(sumsq + u.pm * BM + wid * 64 + lane, aux + wid * 256);
        else aux_dma(bias + (size_t)(u.pm >> 5) * bias_stride + u.pn * BM + (wid - 4) * 64 + lane, aux + 1024 + (wid - 4) * 256);
    }
    __device__ __forceinline__ void operator()(const f32x4 (&acc)[2][2][4][2], const Unit& u, int wr, int wc, int fr_, int fq_, PG8_LAS unsigned char* aux) const {
        unsigned z_; asm volatile("v_mov_b32 %0, 0" : "=v"(z_)); const int ln_ = (int)__builtin_amdgcn_mbcnt_hi(~0u, __builtin_amdgcn_mbcnt_lo(~0u, z_)); const int fr = ln_ & 15, fq = ln_ >> 4;
        const int row0 = u.pm * BM + wr * 64 + fr, col0 = u.pn * HALF + wc * 32 + 8 * fq;
        const PG8_LAS float* ass = (const PG8_LAS float*)aux + wr * 64 + fr; const PG8_LAS float* ab = (const PG8_LAS float*)(aux + 1024) + wc * 32 + 8 * fq;
        const f32x4 bg0 = *(const PG8_LAS f32x4*)(ab), bg1 = *(const PG8_LAS f32x4*)(ab + 4), bu0 = *(const PG8_LAS f32x4*)(ab + HALF), bu1 = *(const PG8_LAS f32x4*)(ab + HALF + 4);
#pragma unroll
        for (int ai = 0; ai < 2; ++ai)
#pragma unroll
            for (int m = 0; m < 4; ++m) { const int row = row0 + ai * HALF + m * 16; const float rs = __builtin_amdgcn_rsqf(ass[ai * HALF + m * 16] * INV_D_ + RMS_EPS_);
                unsigned char* rowp = (unsigned char*)O + img_off(row, col0, ldc / 64, false);
                const f32x4 g0 = acc[ai][0][m][0] * rs + bg0, g1 = acc[ai][0][m][1] * rs + bg1, u0 = acc[ai][1][m][0] * rs + bu0, u1 = acc[ai][1][m][1] * rs + bu1;
                f32x4 e0 = g0 * -1.4426950408889634f, e1 = g1 * -1.4426950408889634f;
#pragma unroll
                for (int i = 0; i < 4; ++i) { e0[i] = __builtin_amdgcn_exp2f(e0[i]); e1[i] = __builtin_amdgcn_exp2f(e1[i]); }
                e0 = e0 + 1.0f; e1 = e1 + 1.0f;
#pragma unroll
                for (int i = 0; i < 4; ++i) { e0[i] = __builtin_amdgcn_rcpf(e0[i]); e1[i] = __builtin_amdgcn_rcpf(e1[i]); }
                const f32x4 h0 = (g0 * u0) * e0, h1 = (g1 * u1) * e1;
                u32x4 w; w.x = cvt_pk_bf16(h0[0], h0[1]); w.y = cvt_pk_bf16(h0[2], h0[3]); w.z = cvt_pk_bf16(h1[0], h1[1]); w.w = cvt_pk_bf16(h1[2], h1[3]);
                *(u32x4*)rowp = w; }
    }
};
template <bool F32BASE>
struct EpiGateResNormT {
    static constexpr bool PERM = true, AFTER_DRAIN = false;
    const bf16_t* base; bf16_t* out; const float* gate; int gate_stride; bf16_t* Hn; const float* gn; int gn_stride; float* sumsq; int ldc;
    __device__ __forceinline__ void prefetch(const Unit& u, PG8_LAS unsigned char* aux, int wid, int lane) const {
        if (wid < 4) aux_dma(gate + (size_t)(u.pm >> 5) * gate_stride + u.pn * BM + wid * 64 + lane, aux + wid * 256);
        else aux_dma(gn + (size_t)(u.pm >> 5) * gn_stride + u.pn * BM + (wid - 4) * 64 + lane, aux + 1024 + (wid - 4) * 256);
    }
    __device__ __forceinline__ void operator()(const f32x4 (&acc)[2][2][4][2], const Unit& u, int wr, int wc, int fr_, int fq_, PG8_LAS unsigned char* aux) const {
        unsigned z_; asm volatile("v_mov_b32 %0, 0" : "=v"(z_)); const int ln_ = (int)__builtin_amdgcn_mbcnt_hi(~0u, __builtin_amdgcn_mbcnt_lo(~0u, z_)); const int fr = ln_ & 15, fq = ln_ >> 4;
        const int row0 = u.pm * BM + wr * 64 + fr, col0 = u.pn * BM + wc * 32 + 8 * fq;
        const PG8_LAS float* ag = (const PG8_LAS float*)aux + wc * 32 + 8 * fq; const PG8_LAS float* an = (const PG8_LAS float*)(aux + 1024) + wc * 32 + 8 * fq;
#pragma unroll
        for (int am = 0; am < 4; ++am) {
            u32x4 ld[2][2]; f32x4 lf[2][2][2];
#pragma unroll
            for (int mm = 0; mm < 2; ++mm)
#pragma unroll
                for (int bj = 0; bj < 2; ++bj) {
                    if constexpr (F32BASE) { const f32x4* px = (const f32x4*)((const float*)base + (size_t)(row0 + (am >> 1) * HALF + (2 * (am & 1) + mm) * 16) * ldc + col0 + bj * HALF); lf[mm][bj][0] = px[0]; lf[mm][bj][1] = px[1]; }
                    else ld[mm][bj] = *(const u32x4*)((const unsigned char*)base + img_off(row0 + (am >> 1) * HALF + (2 * (am & 1) + mm) * 16, col0 + bj * HALF, ldc / 64, false)); }
#pragma unroll
            for (int mm = 0; mm < 2; ++mm) { const int ai = am >> 1, m = 2 * (am & 1) + mm; const int row = row0 + ai * HALF + m * 16; const size_t off = (size_t)row * ldc + col0; float ss = 0.f;
#pragma unroll
                for (int bj = 0; bj < 2; ++bj) {
                    const f32x4 g0 = *(const PG8_LAS f32x4*)(ag + bj * HALF), g1 = *(const PG8_LAS f32x4*)(ag + bj * HALF + 4);
                    f32x4 b0, b1;
                    if constexpr (F32BASE) { b0 = lf[mm][bj][0]; b1 = lf[mm][bj][1]; }
                    else { const u32x4 bw = ld[mm][bj]; b0 = (f32x4){h_lo(bw.x), h_hi(bw.x), h_lo(bw.y), h_hi(bw.y)}; b1 = (f32x4){h_lo(bw.z), h_hi(bw.z), h_lo(bw.w), h_hi(bw.w)}; }
                    const f32x4 x0 = b0 + g0 * acc[ai][bj][m][0], x1 = b1 + g1 * acc[ai][bj][m][1];
                    u32x4 w; w.x = pk_h2(x0[0], x0[1]); w.y = pk_h2(x0[2], x0[3]); w.z = pk_h2(x1[0], x1[1]); w.w = pk_h2(x1[2], x1[3]);
                    *(u32x4*)((unsigned char*)out + img_off(row, col0 + bj * HALF, ldc / 64, false)) = w;
                    ss += (x0[0] * x0[0] + x0[1] * x0[1]) + (x0[2] * x0[2] + x0[3] * x0[3]) + (x1[0] * x1[0] + x1[1] * x1[1]) + (x1[2] * x1[2] + x1[3] * x1[3]);
                    if (Hn) { const f32x4 n0 = *(const PG8_LAS f32x4*)(an + bj * HALF), n1 = *(const PG8_LAS f32x4*)(an + bj * HALF + 4); const f32x4 h0 = x0 * n0, h1 = x1 * n1;
                        u32x4 hw; hw.x = cvt_pk_bf16(h0[0], h0[1]); hw.y = cvt_pk_bf16(h0[2], h0[3]); hw.z = cvt_pk_bf16(h1[0], h1[1]); hw.w = cvt_pk_bf16(h1[2], h1[3]);
                        *(u32x4*)((unsigned char*)Hn + img_off(row, col0 + bj * HALF, ldc / 64, false)) = hw; } }
                ss += __shfl_xor(ss, 16); ss += __shfl_xor(ss, 32);
                if (fq == 0) atomicAdd(sumsq + row, ss); }
            asm volatile("" ::: "memory"); }
    }
};
typedef EpiGateResNormT<false> EpiGateResNorm;

template <class Epi, class Sched, bool ALIGN_EPI = false, bool SP2 = false>
__device__ __forceinline__ void gemm_phase(PG8_LAS unsigned char* lds, const Gemm g, const Sched& S, const Epi& E, int tid_in) {
    int tid_ = tid_in; asm volatile("" : "+v"(tid_));
    const int tid = tid_, wid = __builtin_amdgcn_readfirstlane(tid >> 6), lane = tid & 63, wr = wid >> 2, wc = wid & 3, fr = lane & 15, fq = lane >> 4;
    const int K = g.K, nt = K / BK;
    unsigned voffA[2], voffB[2];
#pragma unroll
    for (int i = 0; i < 2; ++i) { int R, C; stage_rc(tid * 16 + i * 8192, R, C); const int Rb = Epi::PERM ? ((R & ~31) + perm32(R & 31)) : R;
        voffA[i] = IMG_A ? (unsigned)(tid * 16 + i * 8192) : (unsigned)(R * K + C) * 2u; voffB[i] = IMG_B ? (unsigned)(tid * 16 + i * 8192) : (unsigned)(Rb * K + C) * 2u; }
    const size_t kstepA = IMG_A ? (size_t)(HALF * BK * 2) : (size_t)(BK * 2), kstepB = IMG_B ? (size_t)(HALF * BK * 2) : (size_t)(BK * 2);
    const size_t hstep = (size_t)HALF * K * 2;
    const size_t tstep = 2 * hstep;
    const unsigned ldsw = (unsigned)wid * 1024u;
    const int aoff = lds_byte(wr * 64 + fr, fq * 8), boff = lds_byte(wc * 32 + fr, fq * 8);
#define PG8_SA(b, h) (((b) * 2 + (h)) * HTB)
#define PG8_SB(b, h) ((4 + (b) * 2 + (h)) * HTB)
#define PG8_STAGE(bufoff, gbase, voff) do { _Pragma("unroll") for (int _i = 0; _i < 2; ++_i) \
        __builtin_amdgcn_global_load_lds((const unsigned*)((const char*)(gbase) + (voff)[_i]), (PG8_LAS unsigned*)(lds + (bufoff) + ldsw + _i * 8192), 16, 0, 0); } while (0)
#define PG8_LDA(dst, b, h) do { _Pragma("unroll") for (int m = 0; m < 4; ++m) _Pragma("unroll") for (int k = 0; k < 2; ++k) dst[m][k] = *(const PG8_LAS bf16x8*)(lds + PG8_SA(b, h) + aoff + m * 2048 + k * 1024); } while (0)
#define PG8_LDB(dst, b, h) do { _Pragma("unroll") for (int n = 0; n < 2; ++n) _Pragma("unroll") for (int k = 0; k < 2; ++k) dst[n][k] = *(const PG8_LAS bf16x8*)(lds + PG8_SB(b, h) + boff + n * 2048 + k * 1024); } while (0)
#define PG8_MMA(ai, bj, At, Bt) do { __builtin_amdgcn_s_setprio(1); _Pragma("unroll") for (int m = 0; m < 4; ++m) _Pragma("unroll") for (int n = 0; n < 2; ++n) _Pragma("unroll") for (int k = 0; k < 2; ++k) \
        acc[ai][bj][m][n] = __builtin_amdgcn_mfma_f32_16x16x32_bf16(Bt[n][k], At[m][k], acc[ai][bj][m][n], 0, 0, 0); __builtin_amdgcn_s_setprio(0); } while (0)
#define PG8_WAIT_V(n) asm volatile("s_waitcnt vmcnt(" #n ")" ::: "memory")
#define PG8_WAIT_L(n) asm volatile("s_waitcnt lgkmcnt(" #n ")" ::: "memory")
#define PG8_BAR __builtin_amdgcn_s_barrier()
#define PG8_SCHED __builtin_amdgcn_sched_barrier(0)
    Unit cur, nxt; int ui = 0;
    if (!S.next(0, cur)) return;
    f32x4 acc[2][2][4][2];
#pragma unroll
    for (int a = 0; a < 2; ++a)
#pragma unroll
        for (int b = 0; b < 2; ++b)
#pragma unroll
            for (int m = 0; m < 4; ++m)
#pragma unroll
                for (int n = 0; n < 2; ++n) { float z_; asm volatile("v_mov_b32 %0, 0" : "=v"(z_)); acc[a][b][m][n] = (f32x4){z_, z_, z_, z_}; }
    bf16x8 At[4][2], B0[2][2], B1[2][2];
    const char* cA = (const char*)g.A + (size_t)cur.pm * tstep; const char* cB = (const char*)g.Bt + (size_t)cur.pn * tstep;
    S.a_ready(cur);
    if constexpr (SP2) {
        PG8_STAGE(PG8_SB(0, 0), cB, voffB); PG8_STAGE(PG8_SB(0, 1), cB + hstep, voffB); PG8_STAGE(PG8_SA(0, 0), cA, voffA); PG8_STAGE(PG8_SA(0, 1), cA + hstep, voffA);
        if (wr == 1) PG8_BAR;
        PG8_WAIT_V(2); PG8_BAR;
        PG8_STAGE(PG8_SB(1, 0), cB + kstepB, voffB); PG8_STAGE(PG8_SA(1, 0), cA + kstepA, voffA); PG8_STAGE(PG8_SB(1, 1), cB + hstep + kstepB, voffB);
        PG8_WAIT_V(6); PG8_BAR;
    } else {
        PG8_STAGE(PG8_SB(0, 0), cB, voffB); PG8_STAGE(PG8_SA(0, 0), cA, voffA); PG8_STAGE(PG8_SB(0, 1), cB + hstep, voffB); PG8_STAGE(PG8_SA(0, 1), cA + hstep, voffA);
        if (wr == 1) PG8_BAR;
        PG8_WAIT_V(4); PG8_BAR;
        PG8_STAGE(PG8_SB(1, 0), cB + kstepB, voffB); PG8_STAGE(PG8_SA(1, 0), cA + kstepA, voffA); PG8_STAGE(PG8_SB(1, 1), cB + hstep + kstepB, voffB);
        PG8_WAIT_V(6); PG8_BAR;
    }
    for (;;) {
        const bool has_next = S.next(ui + 1, nxt);
        const char* nA = has_next ? (const char*)g.A + (size_t)nxt.pm * tstep : cA; const char* nB = has_next ? (const char*)g.Bt + (size_t)nxt.pn * tstep : cB;
        for (int t = 0; t < nt; t += 2) {
            const bool last = (t == nt - 2);
            const char* a1 = cA + (size_t)(t + 1) * kstepA;
            const char* a2 = last ? nA : cA + (size_t)(t + 2) * kstepA; const char* b2 = last ? nB : cB + (size_t)(t + 2) * kstepB;
            const char* a3 = a2 + kstepA; const char* b3 = b2 + kstepB;
            if (last && has_next) S.a_ready(nxt);
            if (last) E.prefetch(cur, lds + STAGE_BYTES + 1024, wid, lane);
            if constexpr (SP2) {
            PG8_LDB(B0, 0, 0); PG8_LDB(B1, 0, 1); PG8_SCHED; PG8_LDA(At, 0, 0); PG8_STAGE(PG8_SA(1, 1), a1 + hstep, voffA);
            PG8_WAIT_V(8); PG8_WAIT_L(0); PG8_BAR; PG8_MMA(0, 0, At, B0); PG8_MMA(0, 1, At, B1); PG8_BAR; PG8_SCHED;
            PG8_LDA(At, 0, 1); PG8_STAGE(PG8_SB(0, 0), b2, voffB); PG8_STAGE(PG8_SB(0, 1), b2 + hstep, voffB); PG8_STAGE(PG8_SA(0, 0), a2, voffA);
            PG8_WAIT_V(8); PG8_WAIT_L(0); PG8_BAR; PG8_MMA(1, 0, At, B0); PG8_MMA(1, 1, At, B1); PG8_BAR; PG8_SCHED;
            PG8_LDB(B0, 1, 0); PG8_LDB(B1, 1, 1); PG8_SCHED; PG8_LDA(At, 1, 0); PG8_STAGE(PG8_SA(0, 1), a2 + hstep, voffA);
            PG8_WAIT_V(8); PG8_WAIT_L(0); PG8_BAR; PG8_MMA(0, 0, At, B0); PG8_MMA(0, 1, At, B1); PG8_BAR; PG8_SCHED;
            PG8_LDA(At, 1, 1); PG8_STAGE(PG8_SB(1, 0), b3, voffB); PG8_STAGE(PG8_SB(1, 1), b3 + hstep, voffB); PG8_STAGE(PG8_SA(1, 0), a3, voffA);
            PG8_WAIT_V(8); PG8_WAIT_L(0); PG8_BAR; PG8_MMA(1, 0, At, B0); PG8_MMA(1, 1, At, B1); PG8_BAR; PG8_SCHED;
            } else {
            PG8_LDB(B0, 0, 0); PG8_SCHED; PG8_LDA(At, 0, 0); PG8_STAGE(PG8_SA(1, 1), a1 + hstep, voffA);
            PG8_WAIT_L(8); PG8_BAR; PG8_WAIT_L(0); PG8_MMA(0, 0, At, B0); PG8_BAR; PG8_SCHED;
            PG8_LDB(B1, 0, 1); PG8_STAGE(PG8_SB(0, 0), b2, voffB);
            PG8_BAR; PG8_WAIT_L(0); PG8_MMA(0, 1, At, B1); PG8_BAR;
            PG8_LDA(At, 0, 1); PG8_STAGE(PG8_SA(0, 0), a2, voffA);
            PG8_BAR; PG8_WAIT_L(0); PG8_MMA(1, 0, At, B0); PG8_BAR; PG8_SCHED;
            PG8_STAGE(PG8_SB(0, 1), b2 + hstep, voffB);
            PG8_WAIT_V(6); PG8_BAR; PG8_MMA(1, 1, At, B1); PG8_BAR;
            PG8_LDB(B0, 1, 0); PG8_SCHED; PG8_LDA(At, 1, 0); PG8_STAGE(PG8_SA(0, 1), a2 + hstep, voffA);
            PG8_WAIT_L(8); PG8_BAR; PG8_WAIT_L(0); PG8_MMA(0, 0, At, B0); PG8_BAR; PG8_SCHED;
            PG8_LDB(B1, 1, 1); PG8_STAGE(PG8_SB(1, 0), b3, voffB);
            PG8_BAR; PG8_WAIT_L(0); PG8_MMA(0, 1, At, B1); PG8_BAR;
            PG8_LDA(At, 1, 1); PG8_STAGE(PG8_SA(1, 0), a3, voffA);
            PG8_BAR; PG8_WAIT_L(0); PG8_MMA(1, 0, At, B0); PG8_BAR; PG8_SCHED;
            PG8_STAGE(PG8_SB(1, 1), b3 + hstep, voffB);
            PG8_WAIT_V(6); PG8_BAR; PG8_MMA(1, 1, At, B1); PG8_BAR;
            }
        }
        if constexpr (ALIGN_EPI) { if (wr == 0) PG8_BAR; }
        if constexpr (!Epi::AFTER_DRAIN) { E(acc, cur, wr, wc, fr, fq, lds + STAGE_BYTES + 1024); S.done(cur); }
        if (!has_next) break;
#pragma unroll
        for (int a = 0; a < 2; ++a)
#pragma unroll
            for (int b = 0; b < 2; ++b)
#pragma unroll
                for (int m = 0; m < 4; ++m)
#pragma unroll
                    for (int n = 0; n < 2; ++n) { float z_; asm volatile("v_mov_b32 %0, 0" : "=v"(z_)); acc[a][b][m][n] = (f32x4){z_, z_, z_, z_}; }
        cur = nxt; cA = nA; cB = nB; ++ui;
        if constexpr (ALIGN_EPI) { if (wr == 1) PG8_BAR; }
    }
    PG8_WAIT_V(0);
    if constexpr (!ALIGN_EPI) { if (wr == 0) PG8_BAR; }
    PG8_BAR;
    if constexpr (Epi::AFTER_DRAIN) { E.fused(acc, cur, wr, wc, fr, fq, lds, wid, lane); S.done(cur); }
#undef PG8_SA
#undef PG8_SB
#undef PG8_STAGE
#undef PG8_LDA
#undef PG8_LDB
#undef PG8_MMA
#undef PG8_WAIT_V
#undef PG8_WAIT_L
#undef PG8_BAR
#undef PG8_SCHED
}
}
#define GAS __attribute__((address_space(1)))
#define LAS __attribute__((address_space(3)))
typedef unsigned short bf16;
typedef unsigned v4u __attribute__((ext_vector_type(4)));
typedef float f32x4 __attribute__((ext_vector_type(4)));
typedef short bf16x8 __attribute__((ext_vector_type(8)));
typedef GAS unsigned gu32;
typedef GAS unsigned long long gu64;
#define RLX_AGENT __ATOMIC_RELAXED, __HIP_MEMORY_SCOPE_AGENT
#define LDS_WAIT() asm volatile("s_waitcnt lgkmcnt(0)" ::: "memory")
#define VM_WAIT() asm volatile("s_waitcnt vmcnt(0)" ::: "memory")
__device__ __forceinline__ unsigned long long rt() { return __builtin_amdgcn_s_memrealtime(); }
__device__ __forceinline__ unsigned f2bf(float f) { unsigned u = __builtin_bit_cast(unsigned, f); return (u + 0x7fffu + ((u >> 16) & 1u)) >> 16; }
__device__ __forceinline__ unsigned pk2(float lo, float hi) { return f2bf(lo) | (f2bf(hi) << 16); }

#define XB_TMO      128
#define XB_XCNT(j)  (256  + 64 * (j))
#define XB_XSUB(j)  (1280 + 64 * (j))
#define XB_XGEN(j)  (2304 + 64 * (j))
#define XB_TOP      3328
#define XB_TOPGEN   3392
#define XCD_BAR_WORDS 3456
#define XB_SPIN_CAP (1u << 18)

__device__ __forceinline__ unsigned xb_ld(unsigned* p)              { return __hip_atomic_load(p, __ATOMIC_RELAXED, __HIP_MEMORY_SCOPE_AGENT); }
__device__ __forceinline__ unsigned xb_add(unsigned* p, unsigned v) { return __hip_atomic_fetch_add(p, v, __ATOMIC_RELAXED, __HIP_MEMORY_SCOPE_AGENT); }
__device__ __forceinline__ unsigned xb_xcc_id() { return (unsigned)__builtin_amdgcn_s_getreg((3 << 11) | 20) & 0xFu; }
#define XB_SPIN(cond, bar) do { unsigned _sp = 0; while (cond) { __builtin_amdgcn_s_sleep(1); \
    if ((++_sp & 255u) == 0u) { if (xb_ld(&(bar)[XB_TMO])) break; if (_sp > XB_SPIN_CAP) { atomicAdd(&(bar)[XB_TMO], 1u); break; } } } } while (0)

struct XcdBarrier {
    unsigned* bar; unsigned x;
    volatile LAS unsigned* st;
};

__device__ __forceinline__ XcdBarrier xcd_barrier_post(unsigned* bar, volatile LAS unsigned* st) {
    XcdBarrier b; b.bar = bar; b.x = xb_xcc_id(); b.st = st;
    if (threadIdx.x == 0) (void)xb_add(&bar[XB_XCNT(b.x)], 1u);
    return b;
}
__device__ __forceinline__ void xcd_barrier_complete(unsigned* bar, unsigned x, unsigned& nloc, unsigned& nx) {
    const unsigned G = gridDim.x * gridDim.y * gridDim.z;
    unsigned sum, cnt, mine, sp = 0u;
    for (;;) {
        sum = 0u; cnt = 0u; mine = 0u;
#pragma unroll
        for (unsigned j = 0; j < 16; ++j) { const unsigned c = xb_ld(&bar[XB_XCNT(j)]); sum += c; cnt += (c > 0u) ? 1u : 0u; mine = (j == x) ? c : mine; }
        if (sum == G) break;
        __builtin_amdgcn_s_sleep(1);
        if ((++sp & 255u) == 0u) { if (xb_ld(&bar[XB_TMO])) break; if (sp > XB_SPIN_CAP) { atomicAdd(&bar[XB_TMO], 1u); break; } }
    }
    nloc = mine > 0u ? mine : 1u; nx = cnt > 0u ? cnt : 1u;
}

__device__ __forceinline__ void xcd_barrier(const XcdBarrier& b, bool local = false) {
    asm volatile("s_waitcnt vmcnt(0)" ::: "memory");
    __syncthreads();
    if (threadIdx.x == 0) {
        unsigned* bar = b.bar;
        __builtin_amdgcn_s_waitcnt(0);
        unsigned nloc = b.st[0], nx = b.st[1];
        if (nloc == 0u) { xcd_barrier_complete(bar, b.x, nloc, nx); b.st[0] = nloc; b.st[1] = nx; }
        const unsigned old = xb_add(&bar[XB_XSUB(b.x)], 1u);
        const unsigned gen = old / nloc;
        if (old + 1u == (gen + 1u) * nloc) {
            if (!local) {
            __builtin_amdgcn_fence(__ATOMIC_RELEASE, "agent");
            asm volatile("s_waitcnt vmcnt(0)" ::: "memory");
            const unsigned og = xb_add(&bar[XB_TOP], 1u);
            const unsigned tg = og / nx;
            if (og + 1u == (tg + 1u) * nx) xb_add(&bar[XB_TOPGEN], 1u);
            else XB_SPIN(xb_ld(&bar[XB_TOPGEN]) == tg, bar);
            }
            __builtin_amdgcn_fence(__ATOMIC_ACQUIRE, "agent");
            xb_add(&bar[XB_XGEN(b.x)], 1u);
            asm volatile("s_waitcnt vmcnt(0)" ::: "memory");
        } else {
            if (local) __builtin_amdgcn_fence(__ATOMIC_ACQUIRE, "agent");
            XB_SPIN(xb_ld(&bar[XB_XGEN(b.x)]) == gen, bar);
            if (!local) __builtin_amdgcn_fence(__ATOMIC_ACQUIRE, "agent");
            asm volatile("s_waitcnt vmcnt(0)" ::: "memory");
        }
    }
    __syncthreads();
}

constexpr int NWAVES = 8;
constexpr int BATCH = 4, SEQ = 8192, D = 1024, M = BATCH * SEQ, DEPTH = 2;
constexpr int INW = 2048, DFF = 2816, NMOD = 6;
constexpr int O_U = 0, O_QB = 256, O_KB = 640, O_VB = 1024, O_QC = 1408, O_KC = 1792, O_VC = 1920;
constexpr float RMS_EPS = 1e-6f;
constexpr float LOG2E = 1.4426950408889634f;
constexpr float QSCALE = 0.125f * LOG2E;

constexpr size_t MiB = 1u << 20;
constexpr size_t WS_CTL = 0, CTL_ZERO_BYTES = 131072;
constexpr size_t WS_MOD = 1 * MiB;
constexpr size_t WS_W = 2 * MiB, W_LAYER = 24 * MiB;
constexpr size_t W_IN = 0, W_OUT = 4 * MiB, W_GU = 6 * MiB, W_DN = 17 * MiB, W_PT = 23 * MiB;
constexpr size_t WS_H = 50 * MiB;
constexpr size_t WS_Z = 114 * MiB;
constexpr size_t WS_MIX = 436 * MiB;
constexpr size_t WS_HID = 114 * MiB;
constexpr size_t WS_XS = 306 * MiB;
constexpr size_t WS_AUX = 434 * MiB;
constexpr size_t WS_SUMSQ = WS_AUX;
constexpr size_t WS_GV = WS_AUX + 1 * MiB;
constexpr size_t WS_BIAS = WS_GV + 65536;
constexpr size_t BIAS_LAYER = (size_t)BATCH * (2048 + 5632) * 4;
constexpr size_t WS_BSCR = 370 * MiB;
constexpr size_t WS_ZC = 202 * MiB;
constexpr size_t WS_ZB = 130 * MiB;
constexpr size_t WS_END = 500 * MiB;
static_assert(WS_Z + (size_t)M * 256 * 2 <= WS_ZB && WS_ZB + 72 * MiB <= WS_ZC && WS_ZC + 40 * MiB <= WS_XS, "z region map");
static_assert(WS_HID + (size_t)M * DFF * 2 <= WS_XS && WS_MIX + (size_t)M * D * 2 <= WS_END && WS_AUX + 2 * MiB <= WS_MIX && WS_BSCR + 24 * MiB <= WS_AUX && WS_H + (size_t)M * D * 2 <= WS_Z, "ws map");
constexpr int CW_TMO = 0, CW_CODE = 1, CW_BAR = 4096  , CW_QUEUE = 20480, CW_GRP = 20480  , CW_GRPBAD = 20496  , CW_ZEROS = 24576  ;

constexpr int RING_OFF = 0, RING_BYTES = 131072;
constexpr int LDSCTL_OFF = RING_BYTES, MISC_OFF = 147456 - 256, LSEB_OFF = MISC_OFF - 6144;
constexpr int LDS_BYTES = 147456;

constexpr int PH_PRO = 0, PH_CONV = 1, PH_L0 = 2, PH_PER_LAYER = 5, PH_FINAL = PH_L0 + DEPTH * PH_PER_LAYER, NPHASES = PH_FINAL + 1;
#ifndef PROBE_DUP
#define PROBE_DUP 0
#endif
#ifndef PROBE_CUT
#define PROBE_CUT 0
#endif
#ifndef PROBE_MIXSEL
#define PROBE_MIXSEL 0
#endif
#ifndef PROBE_NOSTORE
#define PROBE_NOSTORE 0
#endif
#ifndef MK_ONE_LAUNCH
#define MK_ONE_LAUNCH 1
#endif

struct Frame {
    LAS unsigned char* lds;
    volatile LAS unsigned* MISC;
    gu32* ctl;
    int tid, lane, wave, G, vcu;
};

__device__ __forceinline__ float wave_sum(float v) {
#pragma unroll
    for (int o = 1; o < 64; o <<= 1) v += __shfl_xor(v, o);
    return v;
}
__device__ __forceinline__ float bf2f(unsigned short b) { return __uint_as_float((unsigned)b << 16); }
__device__ __forceinline__ float zero_() { float z; asm volatile("v_mov_b32 %0, 0" : "=v"(z)); return z; }
__device__ __forceinline__ f32x4 zero4_() { const float z = zero_(); return (f32x4){z, z, z, z}; }

__device__ __forceinline__ void tr_item(const float* W, int N, int k0, int n0, bf16* WT, int ldt, int drow0, float scale, LAS float* scr, int lane, bool img = true) {
#pragma unroll 8
    for (int i = 0; i < 32; ++i) { const int kk = 2 * i + (lane >> 5); scr[kk * 33 + (lane & 31)] = __builtin_nontemporal_load(W + (size_t)(k0 + kk) * N + n0 + (lane & 31)); }
    LDS_WAIT(); asm volatile("" ::: "memory");
    const int c = lane & 7;
#pragma unroll
    for (int j = 0; j < 4; ++j) { const int n = (lane >> 3) + 8 * j; const LAS float* s = scr + (8 * c) * 33 + n;
        v4u o; o.x = pk2(s[0 * 33] * scale, s[1 * 33] * scale); o.y = pk2(s[2 * 33] * scale, s[3 * 33] * scale); o.z = pk2(s[4 * 33] * scale, s[5 * 33] * scale); o.w = pk2(s[6 * 33] * scale, s[7 * 33] * scale);
        if (img) *(GAS v4u*)((unsigned char*)WT + pg8::img_off(drow0 + n, k0 + 8 * c, ldt / 64, true)) = o;
        else *(GAS v4u*)(WT + (size_t)(drow0 + n) * ldt + k0 + 8 * c) = o; }
    LDS_WAIT(); asm volatile("" ::: "memory");
}
constexpr int TI_IN = 16 * 64, TI_OUT = 16 * 32, TI_G = 16 * 88, TI_DN = 44 * 32, TI_P = 8, TI_LAYER = TI_IN + TI_OUT + 2 * TI_G + TI_DN + TI_P;
__device__ __forceinline__ void weight_item(const float* const* in, unsigned char* ws, int it, LAS float* scr, int lane) {
    const int l = it / TI_LAYER; int r = it % TI_LAYER;
    unsigned char* wl = ws + WS_W + (size_t)l * W_LAYER;
    if (r < TI_IN) { const int kb = r / 64, n0 = 32 * (r % 64); const bool isq = (n0 >= O_QB && n0 < O_KB) || (n0 >= O_QC && n0 < O_KC);
        tr_item(in[6] + (size_t)l * D * INW, INW, 64 * kb, n0, (bf16*)(wl + W_IN), D, n0, isq ? QSCALE : 1.0f, scr, lane); return; }
    r -= TI_IN;
    if (r < TI_OUT) { const int kb = r / 32, n0 = 32 * (r % 32); tr_item(in[10] + (size_t)l * D * D, D, 64 * kb, n0, (bf16*)(wl + W_OUT), D, n0, 1.0f, scr, lane); return; }
    r -= TI_OUT;
    if (r < 2 * TI_G) { const int up = r >= TI_G; if (up) r -= TI_G; const int kb = r / 88, n0 = 32 * (r % 88);
        tr_item(in[up ? 12 : 11] + (size_t)l * D * DFF, DFF, 64 * kb, n0, (bf16*)(wl + W_GU), D, 256 * (n0 >> 7) + 128 * up + (n0 & 127), 1.0f, scr, lane); return; }
    r -= 2 * TI_G;
    if (r < TI_DN) { const int kb = r / 32, n0 = 32 * (r % 32); tr_item(in[13] + (size_t)l * DFF * D, D, 64 * kb, n0, (bf16*)(wl + W_DN), DFF, n0, 1.0f, scr, lane); return; }
    r -= TI_DN;
    { const int g = r >> 1, n0 = 32 * (r & 1); tr_item(in[7] + (size_t)l * 16384 + g * 4096, 64, 0, n0, (bf16*)(wl + W_PT) + g * 4096, 64, n0, 1.0f, scr, lane, false); }
}
__device__ __forceinline__ void ada_item(Frame& F, const float* const* in, unsigned char* ws, int item) {
    LAS float* cact = (LAS float*)(F.lds);
    LAS float* red = (LAS float*)(F.lds + 16384);
    const int l = item / 96, cb = item % 96;
    const float* c = in[1];
    for (int i = F.tid; i < BATCH * D; i += NWAVES * 64) { const int b = i >> 10, k = i & 1023; const float v = c[i]; cact[k * 4 + b] = v / (1.0f + __expf(-v)); }
    __syncthreads();
    const float* W = in[4] + (size_t)l * D * (NMOD * D) + 64 * cb + F.lane;
    float a0 = 0.f, a1 = 0.f, a2 = 0.f, a3 = 0.f;
    const int kbeg = 128 * F.wave;
#pragma unroll 16
    for (int kk = 0; kk < 128; ++kk) { const float wv = __builtin_nontemporal_load(W + (size_t)(kbeg + kk) * (NMOD * D)); const f32x4 ca = *(const LAS f32x4*)(cact + (kbeg + kk) * 4);
        a0 += ca.x * wv; a1 += ca.y * wv; a2 += ca.z * wv; a3 += ca.w * wv; }
    red[(F.wave * 4 + 0) * 64 + F.lane] = a0; red[(F.wave * 4 + 1) * 64 + F.lane] = a1; red[(F.wave * 4 + 2) * 64 + F.lane] = a2; red[(F.wave * 4 + 3) * 64 + F.lane] = a3;
    __syncthreads();
    if (F.wave < 4) { float s = in[5][(size_t)l * NMOD * D + 64 * cb + F.lane];
#pragma unroll
        for (int w = 0; w < 8; ++w) s += red[(w * 4 + F.wave) * 64 + F.lane];
        ((float*)(ws + WS_MOD))[((size_t)l * BATCH + F.wave) * (NMOD * D) + 64 * cb + F.lane] = s; }
    __syncthreads();
}
__device__ __forceinline__ void p_prologue(Frame& F, const float* const* in, unsigned char* ws) {
    for (int item = blockIdx.x; item < DEPTH * 96; item += F.G) ada_item(F, in, ws, item);
    LAS float* scr = (LAS float*)(F.lds + RING_OFF + F.wave * 16384);
    const int gw = blockIdx.x * NWAVES + F.wave, NGW = F.G * NWAVES;
    for (int it = gw; it < DEPTH * TI_LAYER; it += NGW) weight_item(in, ws, it, scr, F.lane);
    { GAS f32x4* z = (GAS f32x4*)(ws + WS_SUMSQ) + M / 4; const int n4 = 4 * M / 4;
      for (int i = blockIdx.x * (NWAVES * 64) + F.tid; i < n4; i += F.G * NWAVES * 64) z[i] = zero4_(); }
}

__device__ __forceinline__ void p_conv(Frame& F, const float* const* in, unsigned char* ws) {
    const float* MOD = (const float*)(ws + WS_MOD);
    const int NGW = F.G * NWAVES, rpw = M / NGW;
    const int gw = (F.G == 256) ? (((int)blockIdx.x & 7) * 32 + ((int)blockIdx.x >> 3)) * NWAVES + F.wave : (int)blockIdx.x * NWAVES + F.wave;
    {
        const int row0 = gw * rpw, b = row0 / SEQ;
        const float* mb = MOD + (size_t)b * (NMOD * D);
        const float* xin = in[0]; bf16* hout = (bf16*)(ws + WS_H); float* ssq = (float*)(ws + WS_SUMSQ);
        f32x4 Gv[4], Sv[4];
#pragma unroll
        for (int j = 0; j < 4; ++j) { const int cidx = 4 * F.lane + 256 * j; const f32x4 g = *(const f32x4*)(in[2] + cidx), sc = *(const f32x4*)(mb + 1 * D + cidx); Gv[j] = g * (sc + 1.0f); Sv[j] = *(const f32x4*)(mb + 0 * D + cidx); }
        for (int rr = 0; rr < rpw; rr += 4) {
            f32x4 v[4][4];
#pragma unroll
            for (int i = 0; i < 4; ++i) { const GAS f32x4* xr = (const GAS f32x4*)(xin + (size_t)(row0 + rr + i) * D) + F.lane;
#pragma unroll
                for (int j = 0; j < 4; ++j) v[i][j] = __builtin_nontemporal_load(xr + 64 * j); }
#pragma unroll
            for (int i = 0; i < 4; ++i) { const size_t row = (size_t)(row0 + rr + i); float s = 0.f;
#pragma unroll
                for (int j = 0; j < 4; ++j) s += (v[i][j].x * v[i][j].x + v[i][j].y * v[i][j].y) + (v[i][j].z * v[i][j].z + v[i][j].w * v[i][j].w);
                s = wave_sum(s); const float rstd = 1.0f / sqrtf(s * (1.0f / D) + RMS_EPS); if (F.lane == 0) ssq[row] = (float)D * (1.0f - RMS_EPS);
                unsigned char* hb = (unsigned char*)hout + 8 * (F.lane & 1);
#pragma unroll
                for (int j = 0; j < 4; ++j) { const f32x4 o = (v[i][j] * rstd) * Gv[j] + Sv[j]; *(GAS unsigned long long*)(hb + pg8::img_off((int)row, (4 * F.lane + 256 * j) & ~7, D / 64, false)) = (unsigned long long)pk2(o.x, o.y) | ((unsigned long long)pk2(o.z, o.w) << 32);
 } }
        }
    }
    {
        float* GV = (float*)(ws + WS_GV);
        for (int i = blockIdx.x * (NWAVES * 64) + F.tid; i < DEPTH * 2 * BATCH * D; i += F.G * NWAVES * 64) { const int col = i & (D - 1), b = (i >> 10) & 3, w = (i >> 12) & 1, l = i >> 13;
            GV[i] = in[w ? 3 : 2][l * D + col] * (1.0f + MOD[((size_t)l * BATCH + b) * (NMOD * D) + (w ? 4 : 1) * D + col]); }
    }
    {
        const int g0 = 8 * gw;
        if (g0 < DEPTH * (INW + 2 * DFF)) {
            const int l = g0 / (INW + 2 * DFF), rl = g0 % (INW + 2 * DFF), w = rl >= INW, n0 = w ? rl - INW : rl, N = w ? 2 * DFF : INW;
            const unsigned char* Bt = ws + WS_W + (size_t)l * W_LAYER + (w ? W_GU : W_IN);
            float* bias = (float*)(ws + WS_BIAS + (size_t)l * BIAS_LAYER) + (w ? BATCH * INW : 0);
            const float* shp = MOD + (size_t)l * BATCH * (NMOD * D) + (w ? 3 : 0) * D + 16 * F.lane;
            v4u wr[8][2];
#pragma unroll
            for (int i = 0; i < 8; ++i) { wr[i][0] = *(const GAS v4u*)(Bt + pg8::img_off(n0 + i, 16 * F.lane, D / 64, true)); wr[i][1] = *(const GAS v4u*)(Bt + pg8::img_off(n0 + i, 16 * F.lane + 8, D / 64, true)); }
            f32x4 sh[4][4];
#pragma unroll
            for (int b = 0; b < 4; ++b)
#pragma unroll
                for (int j = 0; j < 4; ++j) sh[b][j] = *(const f32x4*)(shp + (size_t)b * (NMOD * D) + 4 * j);
#pragma unroll
            for (int i = 0; i < 8; ++i) { const v4u w0 = wr[i][0], w1 = wr[i][1];
                float wf[16];
                wf[0] = __uint_as_float(w0.x << 16); wf[1] = __uint_as_float(w0.x & 0xffff0000u); wf[2] = __uint_as_float(w0.y << 16); wf[3] = __uint_as_float(w0.y & 0xffff0000u);
                wf[4] = __uint_as_float(w0.z << 16); wf[5] = __uint_as_float(w0.z & 0xffff0000u); wf[6] = __uint_as_float(w0.w << 16); wf[7] = __uint_as_float(w0.w & 0xffff0000u);
                wf[8] = __uint_as_float(w1.x << 16); wf[9] = __uint_as_float(w1.x & 0xffff0000u); wf[10] = __uint_as_float(w1.y << 16); wf[11] = __uint_as_float(w1.y & 0xffff0000u);
                wf[12] = __uint_as_float(w1.z << 16); wf[13] = __uint_as_float(w1.z & 0xffff0000u); wf[14] = __uint_as_float(w1.w << 16); wf[15] = __uint_as_float(w1.w & 0xffff0000u);
                float acc[4];
#pragma unroll
                for (int b = 0; b < 4; ++b) { float a = 0.f;
#pragma unroll
                    for (int j = 0; j < 4; ++j) a += (wf[4 * j] * sh[b][j].x + wf[4 * j + 1] * sh[b][j].y) + (wf[4 * j + 2] * sh[b][j].z + wf[4 * j + 3] * sh[b][j].w);
                    acc[b] = wave_sum(a); }
                if (F.lane < 4) bias[(size_t)F.lane * N + n0 + i] = F.lane == 0 ? acc[0] : F.lane == 1 ? acc[1] : F.lane == 2 ? acc[2] : acc[3]; }
        }
    }
}
__device__ __forceinline__ void p_norm_final(Frame& F, const bf16* xin, const float* ssq, float* out, const float* gvec) {
    const int NGW = F.G * NWAVES, rpw = M / NGW;
    const int gw = (F.G == 256) ? (((int)blockIdx.x & 7) * 32 + ((int)blockIdx.x >> 3)) * NWAVES + F.wave : (int)blockIdx.x * NWAVES + F.wave;
    const int row0 = gw * rpw;
    f32x4 Gv[4];
#pragma unroll
    for (int j = 0; j < 4; ++j) Gv[j] = *(const f32x4*)(gvec + 4 * F.lane + 256 * j);
    for (int rr = 0; rr < rpw; rr += 4) {
        unsigned long long w[4][4]; float ss[4];
#pragma unroll
        for (int i = 0; i < 4; ++i) { const unsigned char* xr = (const unsigned char*)xin + 8 * (F.lane & 1); ss[i] = ssq[row0 + rr + i];
#pragma unroll
            for (int j = 0; j < 4; ++j) w[i][j] = *(const GAS unsigned long long*)(xr + pg8::img_off(row0 + rr + i, (4 * F.lane + 256 * j) & ~7, D / 64, false)); }
#pragma unroll
        for (int i = 0; i < 4; ++i) { const float rstd = 1.0f / sqrtf(ss[i] * (1.0f / D) + RMS_EPS);
            GAS f32x4* o = (GAS f32x4*)(out + (size_t)(row0 + rr + i) * D) + F.lane;
#pragma unroll
            for (int j = 0; j < 4; ++j) { const unsigned wl = (unsigned)w[i][j], wh = (unsigned)(w[i][j] >> 32);
                const f32x4 v = {pg8::h_lo(wl), pg8::h_hi(wl), pg8::h_lo(wh), pg8::h_hi(wh)};
                __builtin_nontemporal_store(v * rstd * Gv[j], o + 64 * j); } }
    }
}

namespace mx {
typedef short bf16x8 __attribute__((ext_vector_type(8)));
typedef short s16x4 __attribute__((ext_vector_type(4)));
typedef float f32x16 __attribute__((ext_vector_type(16)));
typedef unsigned u32x4 __attribute__((ext_vector_type(4)));
typedef unsigned u32x2 __attribute__((ext_vector_type(2)));
typedef float f32x2_t __attribute__((ext_vector_type(2))); typedef __bf16 bf16x2_t __attribute__((ext_vector_type(2)));
constexpr float THR = 8.0f;
constexpr int POOL_PITCH = 544;
__device__ __forceinline__ unsigned cvtpk(float lo, float hi) { f32x2_t v = {lo, hi}; bf16x2_t b = __builtin_convertvector(v, bf16x2_t); return __builtin_bit_cast(unsigned, b); }
__device__ __forceinline__ float hswap_max(float v) { auto rr = __builtin_amdgcn_permlane32_swap(__float_as_uint(v), __float_as_uint(v), false, false); return fmaxf(__uint_as_float(rr[0]), __uint_as_float(rr[1])); }
__device__ __forceinline__ float hswap_sum(float v) { auto rr = __builtin_amdgcn_permlane32_swap(__float_as_uint(v), __float_as_uint(v), false, false); return __uint_as_float(rr[0]) + __uint_as_float(rr[1]); }
__device__ __forceinline__ s16x4 vtr(const LAS char* p) { return __builtin_bit_cast(s16x4, __builtin_amdgcn_ds_read_tr16_b64_v4i16((LAS s16x4*)p)); }
__device__ __forceinline__ f32x16 zero16_() { const float z = zero_(); return (f32x16){z, z, z, z, z, z, z, z, z, z, z, z, z, z, z, z}; }
__device__ __forceinline__ int kt_of(int i) { return (i & 1) ? -((i + 1) >> 1) : (i >> 1); }

template <int VAR>
__device__ __forceinline__ float scores(f32x16& t, const bf16x8 (&kf)[4], const bf16x8 (&qf)[4], float relf, float sl, float slope2, float Rf) {
    f32x16 s = {0.f, 0.f, 0.f, 0.f, 0.f, 0.f, 0.f, 0.f, 0.f, 0.f, 0.f, 0.f, 0.f, 0.f, 0.f, 0.f};
#pragma unroll
    for (int i = 0; i < 4; ++i) s = __builtin_amdgcn_mfma_f32_32x32x16_bf16(kf[i], qf[i], s, 0, 0, 0);
    if (VAR == 0) {
#pragma unroll
        for (int r = 0; r < 16; ++r) t[r] = __builtin_fmaf(-__builtin_fabsf(relf - (float)((r & 3) + 8 * (r >> 2))), slope2, s[r]);
        return 0.f;
    } else {
#pragma unroll
        for (int r = 0; r < 16; ++r) { const float c = (float)((r & 3) + 8 * (r >> 2)); float v = __builtin_fmaf(sl, c, s[r]); if (VAR == 2) v = __builtin_fabsf(relf - c) > Rf ? -INFINITY : v; t[r] = v; }
        return -sl * relf;
    }
}
__device__ __forceinline__ float lane_max(const f32x16& t) {
    float a = fmaxf(fmaxf(t[0], t[1]), fmaxf(t[2], t[3])), b = fmaxf(fmaxf(t[4], t[5]), fmaxf(t[6], t[7])), c = fmaxf(fmaxf(t[8], t[9]), fmaxf(t[10], t[11])), d = fmaxf(fmaxf(t[12], t[13]), fmaxf(t[14], t[15]));
    return fmaxf(fmaxf(a, b), fmaxf(c, d));
}
__device__ __forceinline__ float tile_max(const f32x16& t) {
    float a = fmaxf(fmaxf(t[0], t[1]), fmaxf(t[2], t[3])), b = fmaxf(fmaxf(t[4], t[5]), fmaxf(t[6], t[7])), c = fmaxf(fmaxf(t[8], t[9]), fmaxf(t[10], t[11])), d = fmaxf(fmaxf(t[12], t[13]), fmaxf(t[14], t[15]));
    return hswap_max(fmaxf(fmaxf(a, b), fmaxf(c, d)));
}
__device__ __forceinline__ void load_frag4(bf16x8 (&f)[4], const bf16* rowp, int hi) {
#pragma unroll
    for (int i = 0; i < 4; ++i) f[i] = *(const bf16x8*)(rowp + 16 * i + 8 * hi);
}
__device__ __forceinline__ void load_tile_frags(bf16x8 (&f)[4], const char* tile, int lane) {
#pragma unroll
    for (int s = 0; s < 4; ++s) f[s] = *(const bf16x8*)(tile + s * 1024 + lane * 16);
}
__device__ __forceinline__ void dma_tile(LAS char* dst, const char* tile, int lane) {
#pragma unroll
    for (int j = 0; j < 4; ++j) __builtin_amdgcn_global_load_lds((const unsigned*)(tile + j * 1024 + lane * 16), (LAS unsigned*)(dst + j * 1024), 16, 0, 0);
}
__device__ __forceinline__ void dma_v(LAS char* vb, const bf16* vrow0, long rs, int lane) {
#pragma unroll
    for (int j = 0; j < 4; ++j) __builtin_amdgcn_global_load_lds((const unsigned*)(vrow0 + (long)(16 * (j & 1) + (lane >> 2)) * rs + (4 * (j >> 1) + (lane & 3)) * 8), (LAS unsigned*)(vb + j * 1024), 16, 0, 0);
}
__device__ __forceinline__ void load_vfrags(bf16x8 (&vf)[2][2], const LAS char* vaddr) {
#pragma unroll
    for (int d0 = 0; d0 < 2; ++d0)
#pragma unroll
        for (int ks = 0; ks < 2; ++ks) { const s16x4 lo = vtr(vaddr + d0 * 2048 + ks * 1024), hh = vtr(vaddr + d0 * 2048 + ks * 1024 + 512);
            vf[d0][ks] = (bf16x8){lo[0], lo[1], lo[2], lo[3], hh[0], hh[1], hh[2], hh[3]}; }
}
__device__ __forceinline__ void pv_tile(f32x16 (&o)[2], const bf16x8 (&vf)[2][2], const f32x16& p) {
    u32x4 w0, w1;
    w0.x = cvtpk(p[0], p[1]); w0.y = cvtpk(p[2], p[3]); w0.z = cvtpk(p[4], p[5]); w0.w = cvtpk(p[6], p[7]);
    w1.x = cvtpk(p[8], p[9]); w1.y = cvtpk(p[10], p[11]); w1.z = cvtpk(p[12], p[13]); w1.w = cvtpk(p[14], p[15]);
    const bf16x8 pa0 = __builtin_bit_cast(bf16x8, w0), pa1 = __builtin_bit_cast(bf16x8, w1);
#pragma unroll
    for (int d0 = 0; d0 < 2; ++d0) { o[d0] = __builtin_amdgcn_mfma_f32_32x32x16_bf16(vf[d0][0], pa0, o[d0], 0, 0, 0); o[d0] = __builtin_amdgcn_mfma_f32_32x32x16_bf16(vf[d0][1], pa1, o[d0], 0, 0, 0); }
}
__device__ __forceinline__ void store_o(bf16* MIX, int row, int col, const f32x16 (&o)[2], float scale, int hi) {
#pragma unroll
    for (int d0 = 0; d0 < 2; ++d0)
#pragma unroll
        for (int g = 0; g < 4; g += 2) {
            const unsigned ax = cvtpk(o[d0][4 * g] * scale, o[d0][4 * g + 1] * scale), ay = cvtpk(o[d0][4 * g + 2] * scale, o[d0][4 * g + 3] * scale);
            const unsigned bx = cvtpk(o[d0][4 * g + 4] * scale, o[d0][4 * g + 5] * scale), by = cvtpk(o[d0][4 * g + 6] * scale, o[d0][4 * g + 7] * scale);
            const auto rx = __builtin_amdgcn_permlane32_swap(ax, bx, false, false); const auto ry = __builtin_amdgcn_permlane32_swap(ay, by, false, false);
            u32x4 w; w.x = rx[0]; w.y = ry[0]; w.z = rx[1]; w.w = ry[1];
            *(u32x4*)((unsigned char*)MIX + pg8::img_off(row, col + 32 * d0 + 8 * g + 8 * hi, D / 64, false)) = w; }
}
__device__ __forceinline__ void pack_o(u32x4 (&w)[4], const f32x16 (&o)[2], float scale) {
#pragma unroll
    for (int d0 = 0; d0 < 2; ++d0)
#pragma unroll
        for (int g = 0; g < 4; g += 2) {
            const unsigned ax = cvtpk(o[d0][4 * g] * scale, o[d0][4 * g + 1] * scale), ay = cvtpk(o[d0][4 * g + 2] * scale, o[d0][4 * g + 3] * scale);
            const unsigned bx = cvtpk(o[d0][4 * g + 4] * scale, o[d0][4 * g + 5] * scale), by = cvtpk(o[d0][4 * g + 6] * scale, o[d0][4 * g + 7] * scale);
            const auto rx = __builtin_amdgcn_permlane32_swap(ax, bx, false, false); const auto ry = __builtin_amdgcn_permlane32_swap(ay, by, false, false);
            w[2 * d0 + (g >> 1)] = (u32x4){rx[0], ry[0], rx[1], ry[1]}; }
}
__device__ __forceinline__ float alibi_slope(int k  ) { return __builtin_amdgcn_exp2f(-8.0f * (float)(k + 1) / 12.0f); }
__device__ __forceinline__ void scale_o(f32x16 (&o)[2], float f) {
#pragma unroll
    for (int r = 0; r < 16; ++r) { o[0][r] *= f; o[1][r] *= f; }
}

template <bool FIRST, bool WITH_O>
__device__ __forceinline__ void step_rest(f32x16 (&o)[2], float& m, float& l, f32x16& t, float off, const bf16x8 (&vf)[2][2]) {
    const float tm = hswap_max(lane_max(t) + off);
    if (FIRST) m = tm;
    else if (__any(tm - m > THR)) { const float dl = fmaxf(tm - m, 0.f), f = __builtin_amdgcn_exp2f(-dl); l *= f; if (WITH_O) scale_o(o, f); m += dl; }
    const float bm = off - m; f32x2_t ps = {0.f, 0.f}; const f32x2_t bm2 = {bm, bm};
#pragma unroll
    for (int r = 0; r < 16; r += 2) { const f32x2_t x = (f32x2_t){t[r], t[r + 1]} + bm2; t[r] = __builtin_amdgcn_exp2f(x.x); t[r + 1] = __builtin_amdgcn_exp2f(x.y); ps += (f32x2_t){t[r], t[r + 1]}; }
    l += ps.x + ps.y;
    if (WITH_O) pv_tile(o, vf, t);
}
template <int VAR, bool FIRST, bool WITH_O>
__device__ __forceinline__ void step(f32x16 (&o)[2], float& m, float& l, const bf16x8 (&kf)[4], const bf16x8 (&qf)[4], const bf16x8 (&vf)[2][2], float relf, float sl, float slope2, float Rf) {
    f32x16 t; const float off = scores<VAR>(t, kf, qf, relf, sl, slope2, Rf);
    step_rest<FIRST, WITH_O>(o, m, l, t, off, vf);
}

__device__ __forceinline__ void pair_rest(f32x16 (&o)[2], float& m, float& l, f32x16& tL, f32x16& tR, float offL, float offR, const LAS char* vL, const LAS char* vR) {
    const float tm = hswap_max(fmaxf(lane_max(tL) + offL, lane_max(tR) + offR));
    if (__any(tm - m > THR)) { const float dl = fmaxf(tm - m, 0.f), f = __builtin_amdgcn_exp2f(-dl); l *= f; scale_o(o, f); m += dl; }
    const float bL = offL - m, bR = offR - m; f32x2_t ps = {0.f, 0.f}; const f32x2_t bL2 = {bL, bL}, bR2 = {bR, bR};
#pragma unroll
    for (int r = 0; r < 16; r += 2) { const f32x2_t xL = (f32x2_t){tL[r], tL[r + 1]} + bL2, xR = (f32x2_t){tR[r], tR[r + 1]} + bR2;
        tL[r] = __builtin_amdgcn_exp2f(xL.x); tL[r + 1] = __builtin_amdgcn_exp2f(xL.y); tR[r] = __builtin_amdgcn_exp2f(xR.x); tR[r + 1] = __builtin_amdgcn_exp2f(xR.y);
        ps += (f32x2_t){tL[r], tL[r + 1]}; ps += (f32x2_t){tR[r], tR[r + 1]}; }
    l += ps.x + ps.y;
    { bf16x8 vf[2][2]; load_vfrags(vf, vL); pv_tile(o, vf, tL); }
    { bf16x8 vf[2][2]; load_vfrags(vf, vR); pv_tile(o, vf, tR); }
}
template <int VAR>
__device__ __forceinline__ void step_pair_lds(f32x16 (&o)[2], float& m, float& l, const LAS char* kL, const LAS char* kR, const LAS char* vL, const LAS char* vR, bf16x8 (&qf)[4],
                                              float relfL, float relfR, float slope2, float Rf, const char* qnext = nullptr, int lane = 0) {
    f32x16 tL, tR; float offL, offR;
    { bf16x8 kf[4];
#pragma unroll
      for (int s = 0; s < 4; ++s) kf[s] = *(const LAS bf16x8*)(kL + s * 1024);
      offL = scores<VAR>(tL, kf, qf, relfL, slope2, slope2, Rf); }
    { bf16x8 kf[4];
#pragma unroll
      for (int s = 0; s < 4; ++s) kf[s] = *(const LAS bf16x8*)(kR + s * 1024);
      offR = scores<VAR>(tR, kf, qf, relfR, -slope2, slope2, Rf); }
    if (qnext) load_tile_frags(qf, qnext, lane);
    pair_rest(o, m, l, tL, tR, offL, offR, vL, vR);
}
template <int VAR>
__device__ __forceinline__ void step_pair_regk(f32x16 (&o)[2], float& m, float& l, const bf16x8 (&kfL)[4], const bf16x8 (&kfR)[4], const LAS char* vL, const LAS char* vR, const bf16x8 (&qf)[4],
                                               float relfL, float relfR, float slope2, float Rf) {
    f32x16 tL, tR; const float offL = scores<VAR>(tL, kfL, qf, relfL, slope2, slope2, Rf), offR = scores<VAR>(tR, kfR, qf, relfR, -slope2, slope2, Rf);
    pair_rest(o, m, l, tL, tR, offL, offR, vL, vR);
}

__device__ __forceinline__ void dma_k(LAS char* kb, const bf16* krow0, long rs, int lane) {
#pragma unroll
    for (int s = 0; s < 4; ++s) __builtin_amdgcn_global_load_lds((const unsigned*)(krow0 + (long)(lane & 31) * rs + 16 * s + 8 * (lane >> 5)), (LAS unsigned*)(kb + s * 1024), 16, 0, 0);
}
struct BTile { const char* qb; const char* kb; const char* vb; int nt  , t0  , n0, head, d, r, tl; float slope2; };
__device__ __forceinline__ BTile b_decode(const char* ZB, int b, int c, int j, int qi, int q) {
    BTile t; const int g = qi >> 4, i = qi & 15, lg = 2 * g; t.d = 1 << lg;
    t.r = i >> (4 - lg); const int isub = i & ((16 >> lg) - 1); t.n0 = ((512 * c) >> lg) + 32 * isub; t.nt = 256 >> lg; t.t0 = t.n0 >> 5;
    t.head = 2 * g + j; t.slope2 = alibi_slope(6 + t.head) * (float)t.d * LOG2E;
    const size_t tb = (size_t)(t.head * 4 + b) * 256 + ((size_t)t.r << (8 - lg));
    t.qb = ZB + (tb << 12); t.kb = ZB + ((tb + 6 * 4 * 256) << 12); t.vb = ZB + ((tb + 2 * 6 * 4 * 256) << 12);
    t.tl = g * 512 + (32 * isub + q) * t.d + t.r;
    return t;
}
__device__ __forceinline__ void b_issue_qk(const BTile& t, bf16x8 (&qf)[4], bf16x8 (&kf)[5][4], bool (&val)[5], int (&kc)[5], int lane) {
    load_tile_frags(qf, t.qb + ((size_t)t.t0 << 12), lane);
#pragma unroll
    for (int i = 0; i < 5; ++i) { const int kt = t.t0 + kt_of(i); val[i] = kt >= 0 && kt < t.nt; kc[i] = kt < 0 ? 0 : (kt >= t.nt ? t.nt - 1 : kt);
        load_tile_frags(kf[i], t.kb + ((size_t)kc[i] << 12), lane); }
}
__device__ __forceinline__ void fill_ninf(f32x16& t) {
#pragma unroll
    for (int r = 0; r < 16; ++r) t[r] = -INFINITY;
}
__device__ __forceinline__ float b_qtile(f32x16 (&o)[2], const BTile& t, const BTile& tn, bool has_next, bf16x8 (&qf)[4], bf16x8 (&kf)[5][4], bool (&val)[5], int (&kc)[5], LAS char* vb, int lane) {
    const int q = lane & 31, hi = lane >> 5;
    const float slope2 = t.slope2;
    const LAS char* vaddr = vb + (4 * hi + ((lane & 15) >> 2)) * 64 + ((lane >> 4) & 1) * 32 + (lane & 3) * 8;
    float m = 0.f, l = 0.f;
    {
        bf16x8 vf[2][2]; load_vfrags(vf, vaddr);
        asm volatile("s_waitcnt lgkmcnt(0)" ::: "memory"); dma_tile(vb, t.vb + ((size_t)kc[4] << 12), lane);
        step<0, true, true>(o, m, l, kf[0], qf, vf, (float)(q - 4 * hi), slope2, slope2, 64.0f); }
    {
        f32x16 tL, tR; const float offL = scores<1>(tL, kf[1], qf, (float)(q + 32 - 4 * hi), slope2, slope2, 64.0f), offR = scores<1>(tR, kf[2], qf, (float)(q - 32 - 4 * hi), -slope2, slope2, 64.0f);
        if (!val[1]) fill_ninf(tL); if (!val[2]) fill_ninf(tR);
        pair_rest(o, m, l, tL, tR, offL, offR, vaddr + 4096, vaddr + 8192); }
    asm volatile("s_waitcnt vmcnt(0)" ::: "memory");
    {
        f32x16 tL, tR; const float offL = scores<2>(tL, kf[3], qf, (float)(q + 64 - 4 * hi), slope2, slope2, 64.0f), offR = scores<2>(tR, kf[4], qf, (float)(q - 64 - 4 * hi), -slope2, slope2, 64.0f);
        if (!val[3]) fill_ninf(tL); if (!val[4]) fill_ninf(tR);
        if (has_next) {
            asm volatile("s_waitcnt lgkmcnt(0)" ::: "memory");
            b_issue_qk(tn, qf, kf, val, kc, lane);
            dma_tile(vb + 4096, tn.vb + ((size_t)kc[1] << 12), lane); dma_tile(vb + 8192, tn.vb + ((size_t)kc[2] << 12), lane); }
        pair_rest(o, m, l, tL, tR, offL, offR, vaddr + 12288, vaddr);
        if (has_next) { asm volatile("s_waitcnt lgkmcnt(0)" ::: "memory");
            dma_tile(vb, tn.vb + ((size_t)kc[0] << 12), lane); dma_tile(vb + 12288, tn.vb + ((size_t)kc[3] << 12), lane); } }
    const float lt = hswap_sum(l);
    scale_o(o, 1.0f / lt);
    return m + __builtin_amdgcn_logf(lt);
}
__device__ __forceinline__ void b_unit(const char* ZB, bf16* MIX, char* SCR, int u, LAS char* lds, int wave, int lane) {
    const int b = u >> 5, c = (u >> 1) & 15, j = u & 1;
    LAS float* lseb = (LAS float*)(lds + LSEB_OFF);
    LAS char* vb = lds + wave * 16384;
    char* scr = SCR + ((size_t)(u * 8 + wave) * 6 << 12) + lane * 16;
    const int q = lane & 31, hi = lane >> 5;
    bf16x8 qf[4], kf[5][4]; bool val[5]; int kc[5];
    BTile t = b_decode(ZB, b, c, j, wave, q);
    b_issue_qk(t, qf, kf, val, kc, lane);
#pragma unroll
    for (int i = 0; i < 4; ++i) dma_tile(vb + i * 4096, t.vb + ((size_t)kc[i] << 12), lane);
#pragma unroll 1
    for (int it = 0; it < 6; ++it) { const bool has_next = it < 5; const BTile tn = b_decode(ZB, b, c, j, wave + 8 * (has_next ? it + 1 : it), q);
        if (it == 0) asm volatile("s_waitcnt vmcnt(0)" ::: "memory"); else asm volatile("s_waitcnt vmcnt(4)" ::: "memory");
        f32x16 o[2]; o[0] = zero16_(); o[1] = zero16_();
        const float lse = b_qtile(o, t, tn, has_next, qf, kf, val, kc, vb, lane);
        if (hi == 0) lseb[t.tl] = lse;
        u32x4 w[4]; pack_o(w, o, 1.0f);
#pragma unroll
        for (int k = 0; k < 4; ++k) *(u32x4*)(scr + ((size_t)it << 12) + k * 1024) = w[k];
        t = tn; }
    __syncthreads();
#pragma unroll 1
    for (int it0 = 0; it0 < 6; it0 += 3) { u32x4 w[3][4];
#pragma unroll
        for (int ii = 0; ii < 3; ++ii)
#pragma unroll
            for (int k = 0; k < 4; ++k) w[ii][k] = *(const u32x4*)(scr + ((size_t)(it0 + ii) << 12) + k * 1024);
#pragma unroll
        for (int ii = 0; ii < 3; ++ii) { const BTile tt = b_decode(ZB, b, c, j, wave + 8 * (it0 + ii), q);
            const int tk = tt.tl & 511; const float l0 = lseb[tk], l1 = lseb[512 + tk], l2 = lseb[1024 + tk], own = lseb[tt.tl]; const float mm = fmaxf(l0, fmaxf(l1, l2));
            const float a = __builtin_amdgcn_exp2f(own - mm) / (__builtin_amdgcn_exp2f(l0 - mm) + __builtin_amdgcn_exp2f(l1 - mm) + __builtin_amdgcn_exp2f(l2 - mm));
            const int orow = b * SEQ + (tt.n0 + q) * tt.d + tt.r, ocol = 256 + 64 * tt.head + 8 * hi;
#pragma unroll
            for (int k = 0; k < 4; ++k) { const u32x4 x = w[ii][k]; u32x4 y;
                y.x = cvtpk(__uint_as_float(x.x << 16) * a, __uint_as_float(x.x & 0xffff0000u) * a); y.y = cvtpk(__uint_as_float(x.y << 16) * a, __uint_as_float(x.y & 0xffff0000u) * a);
                y.z = cvtpk(__uint_as_float(x.z << 16) * a, __uint_as_float(x.z & 0xffff0000u) * a); y.w = cvtpk(__uint_as_float(x.w << 16) * a, __uint_as_float(x.w & 0xffff0000u) * a);
                *(u32x4*)((unsigned char*)MIX + pg8::img_off(orow, ocol + 32 * (k >> 1) + 16 * (k & 1), D / 64, false)) = y; } } }
    __syncthreads();
}
__device__ __forceinline__ void c_unit(const char* ZC, bf16* MIX, const float* sink, int u, LAS char* lds, int wave, int lane) {
    const int b = u >> 6, kvh = (u >> 5) & 1, q0 = 256 * (u & 31), n0 = q0 + 32 * wave;
    const int q = lane & 31, hi = lane >> 5;
    const char* kt0 = ZC + ((size_t)((6 + kvh) * 4 + b) * 256 << 12); const char* vt0 = ZC + ((size_t)((8 + kvh) * 4 + b) * 256 << 12);
#pragma unroll
    for (int tt = 0; tt < 2; ++tt) { const int t = 2 * wave + tt, T = (q0 >> 5) - 4 + t;
        if (T >= 0 && T < SEQ / 32) { dma_tile(lds + t * 8192, kt0 + ((size_t)T << 12), lane); dma_tile(lds + t * 8192 + 4096, vt0 + ((size_t)T << 12), lane); } }
    const char* qt0 = ZC + (((size_t)((3 * kvh) * 4 + b) * 256 + (n0 >> 5)) << 12);
    bf16x8 qf[4]; load_tile_frags(qf, qt0, lane);
    asm volatile("s_waitcnt vmcnt(0)" ::: "memory");
    __syncthreads();
    const LAS char* kbase = lds + lane * 16;
    const LAS char* vbase = lds + 4096 + (4 * hi + ((lane & 15) >> 2)) * 64 + ((lane >> 4) & 1) * 32 + (lane & 3) * 8;
#pragma unroll 1
    for (int hh = 0; hh < 3; ++hh) { const int head = 3 * kvh + hh;
        const char* qnext = hh < 2 ? qt0 + ((size_t)(hh + 1) * 4 * 256 << 12) : nullptr; bool reloaded = false;
        f32x16 o[2]; o[0] = zero16_(); o[1] = zero16_();
        float m = sink[head] * LOG2E, l = hi ? 0.f : 1.0f; const float slope2 = alibi_slope(head) * LOG2E;
        {
            const int t = wave + 4; bf16x8 kf[4];
#pragma unroll
            for (int s = 0; s < 4; ++s) kf[s] = *(const LAS bf16x8*)(kbase + t * 8192 + s * 1024);
            bf16x8 vf[2][2]; load_vfrags(vf, vbase + t * 8192);
            step<0, false, true>(o, m, l, kf, qf, vf, (float)(q - 4 * hi), slope2, slope2, 128.0f); }
#pragma unroll 1
        for (int k = 1; k <= 4; ++k) { const int tL = wave + 4 - k, tR = wave + 4 + k; const bool vL = n0 - 32 * k >= 0, vR = n0 + 32 * k < SEQ;
            const float relfL = (float)(q + 32 * k - 4 * hi), relfR = (float)(q - 32 * k - 4 * hi);
            if (vL && vR) {
                if (k < 4) step_pair_lds<1>(o, m, l, kbase + tL * 8192, kbase + tR * 8192, vbase + tL * 8192, vbase + tR * 8192, qf, relfL, relfR, slope2, 128.0f);
                else { step_pair_lds<2>(o, m, l, kbase + tL * 8192, kbase + tR * 8192, vbase + tL * 8192, vbase + tR * 8192, qf, relfL, relfR, slope2, 128.0f, qnext, lane); reloaded = true; } }
            else if (vL || vR) { const int t = vL ? tL : tR; bf16x8 kf[4];
#pragma unroll
                for (int s = 0; s < 4; ++s) kf[s] = *(const LAS bf16x8*)(kbase + t * 8192 + s * 1024);
                bf16x8 vf[2][2]; load_vfrags(vf, vbase + t * 8192);
                const float relf = vL ? relfL : relfR, sl = vL ? slope2 : -slope2;
                if (k < 4) step<1, false, true>(o, m, l, kf, qf, vf, relf, sl, slope2, 128.0f); else step<2, false, true>(o, m, l, kf, qf, vf, relf, sl, slope2, 128.0f); } }
        if (!reloaded && qnext) load_tile_frags(qf, qnext, lane);
        store_o(MIX, b * SEQ + n0 + q, 640 + 64 * head, o, 1.0f / hswap_sum(l), hi); }
    __syncthreads();
}
template <int G>
__device__ __forceinline__ void pool_group(const LAS char* rows, bf16* MIX, const bf16* wpt, const float* pscale, int row0, int tok, int kq, int lane) {
    constexpr int R = 1 << G, W = 2 * R + 1;
    int lo = tok - R, hi2 = tok + R + 1; lo = lo < 0 ? 0 : lo; hi2 = hi2 > SEQ ? SEQ : hi2; const float inv = 1.0f / (float)(hi2 - lo);
    f32x4 acc[4];
#pragma unroll
    for (int dt = 0; dt < 4; ++dt) acc[dt] = zero4_();
#pragma unroll
    for (int kb = 0; kb < 2; ++kb) { float s[8]; bf16x8 uc;
        const LAS char* rp = rows + ((lane & 15) + 8 - R) * POOL_PITCH + (8 * G + 4 * kb + kq) * 16;
#pragma unroll
        for (int e = 0; e < 8; ++e) s[e] = 0.f;
#pragma unroll
        for (int j = 0; j < W; ++j) { const int tt = tok + j - R; const float w = (tt >= 0 && tt < SEQ) ? 1.0f : 0.0f; const bf16x8 v = *(const LAS bf16x8*)(rp + j * POOL_PITCH); if (j == R) uc = v;
#pragma unroll
            for (int e = 0; e < 8; ++e) s[e] += w * bf2f((unsigned short)v[e]); }
        u32x4 pw; float pe[8];
#pragma unroll
        for (int e = 0; e < 8; ++e) pe[e] = s[e] * inv - bf2f((unsigned short)uc[e]);
        pw.x = cvtpk(pe[0], pe[1]); pw.y = cvtpk(pe[2], pe[3]); pw.z = cvtpk(pe[4], pe[5]); pw.w = cvtpk(pe[6], pe[7]);
        const bf16x8 bfrag = __builtin_bit_cast(bf16x8, pw);
#pragma unroll
        for (int dt = 0; dt < 4; ++dt) { const bf16x8 afrag = *(const bf16x8*)(wpt + (size_t)(G * 64 + dt * 16 + (lane & 15)) * 64 + kb * 32 + 8 * kq);
            acc[dt] = __builtin_amdgcn_mfma_f32_16x16x32_bf16(afrag, bfrag, acc[dt], 0, 0, 0); } }
#pragma unroll
    for (int dt = 0; dt < 4; ++dt) { const int dcol = G * 64 + dt * 16 + 4 * kq; const f32x4 sc = *(const f32x4*)(pscale + dcol);
        u32x2 w; w.x = cvtpk(acc[dt][0] * sc.x, acc[dt][1] * sc.y); w.y = cvtpk(acc[dt][2] * sc.z, acc[dt][3] * sc.w);
        *(u32x2*)((unsigned char*)MIX + pg8::img_off(row0 + (lane & 15), dcol & ~7, D / 64, false) + 2 * (dcol & 7)) = w; }
}
__device__ __forceinline__ void pool_item(const bf16* Z, bf16* MIX, const bf16* wpt, const float* pscale, int item, LAS char* rows, int lane) {
    const int row0 = 16 * item, b = row0 / SEQ, t0 = row0 % SEQ;
    const int tok = t0 + (lane & 15), kq = lane >> 4;
    const bf16* zb = Z + (size_t)b * SEQ * 256;
    u32x4 st[16];
#pragma unroll
    for (int i = 0; i < 16; ++i) { const int idx = i * 64 + lane, r = idx >> 5, c = idx & 31; int tt = t0 - 8 + r; tt = (tt >= 0 && tt < SEQ) ? tt : t0; st[i] = *(const u32x4*)(zb + (size_t)tt * 256 + 8 * c); }
#pragma unroll
    for (int i = 0; i < 16; ++i) { const int idx = i * 64 + lane, r = idx >> 5, c = idx & 31; *(LAS u32x4*)(rows + r * POOL_PITCH + c * 16) = st[i]; }
    pool_group<0>(rows, MIX, wpt, pscale, row0, tok, kq, lane); pool_group<1>(rows, MIX, wpt, pscale, row0, tok, kq, lane);
    pool_group<2>(rows, MIX, wpt, pscale, row0, tok, kq, lane); pool_group<3>(rows, MIX, wpt, pscale, row0, tok, kq, lane);
}
constexpr int N_B_UNITS = 128, N_C_UNITS = 256, N_P_ITEMS = M / 16;
}

__device__ __forceinline__ void p_mixers(Frame& F, const float* const* in, unsigned char* ws, int lq, int sel  ) {
    const int l = lq & 1;
    const bf16* Z = (const bf16*)(ws + WS_Z); bf16* MIX = (bf16*)(ws + WS_MIX);
    LAS char* lds = (LAS char*)F.lds;
    const float* sink = in[9] + 6 * l;
    {
        const int nb = (F.G >= 2 * mx::N_B_UNITS) ? mx::N_B_UNITS : (F.G + 1) / 2;
        const bool xl = (F.G == 256);
        if ((int)blockIdx.x < nb) {
            if (sel & 1) {
#pragma unroll 1
                for (int u0 = blockIdx.x; u0 < mx::N_B_UNITS; u0 += nb) { const int u = xl ? ((u0 & 7) >> 1) * 32 + (8 * (u0 & 1) + (u0 >> 4)) * 2 + ((u0 >> 3) & 1) : u0;     unsigned z_; asm volatile("v_mov_b32 %0, 0" : "=v"(z_)); const int lane = (int)__builtin_amdgcn_mbcnt_hi(~0u, __builtin_amdgcn_mbcnt_lo(~0u, z_)); mx::b_unit((const char*)(ws + WS_ZB), MIX, (char*)(ws + WS_BSCR), u, lds, F.wave, lane); } }
        } else if (sel & 2) {
#pragma unroll 1
            for (int v = (int)blockIdx.x - nb, u0 = v, k = 0; u0 < mx::N_C_UNITS; u0 += F.G - nb, ++k) { const int u = xl ? ((v & 7) >> 1) * 64 + ((((v >> 3) * 2 + k) >> 4) * 32) + 16 * (v & 1) + (((v >> 3) * 2 + k) & 15) : u0;     unsigned z_; asm volatile("v_mov_b32 %0, 0" : "=v"(z_)); const int lane = (int)__builtin_amdgcn_mbcnt_hi(~0u, __builtin_amdgcn_mbcnt_lo(~0u, z_)); mx::c_unit((const char*)(ws + WS_ZC), MIX, sink, u, lds, F.wave, lane); }
        }
        __syncthreads();
    }
    if (sel & 4) { const bf16* wpt = (const bf16*)(ws + WS_W + (size_t)l * W_LAYER + W_PT); const float* pscale = in[8] + 256 * l;
        for (int it0 = blockIdx.x * NWAVES + F.wave; it0 < mx::N_P_ITEMS; it0 += F.G * NWAVES) { const int it = (F.G == 256) ? (((int)blockIdx.x & 7) * 32 + ((int)blockIdx.x >> 3)) * NWAVES + F.wave : it0;     mx::pool_item(Z, MIX, wpt, pscale, it, lds + F.wave * (32 * mx::POOL_PITCH), F.lane); } }
}

struct Args { const float* in[15]; float* out; unsigned char* ws; int ph_lo, ph_hi, li, dup; };
__global__ void __launch_bounds__(NWAVES * 64, 2) mk_fwd(Args args) {
    extern __shared__ __attribute__((aligned(16))) unsigned char lds[];
    Frame F;
    F.lds = (LAS unsigned char*)lds;
    F.MISC = (volatile LAS unsigned*)(F.lds + MISC_OFF);
    F.tid = threadIdx.x; F.lane = F.tid & 63; F.wave = __builtin_amdgcn_readfirstlane(F.tid >> 6);
    const int wave0 = F.wave;
    F.G = gridDim.x; { const int bx = blockIdx.x; F.vcu = (F.G % 8 == 0) ? (bx % 8) * (F.G / 8) + bx / 8 : bx; }
    unsigned char* ws = args.ws;
    F.ctl = (gu32*)(ws + WS_CTL);
    for (int u = F.tid; u < (LDS_BYTES - LDSCTL_OFF) / 4; u += NWAVES * 64) ((LAS unsigned*)(F.lds + LDSCTL_OFF))[u] = 0u;
    __syncthreads();
    XcdBarrier bar; bar.bar = (unsigned*)(F.ctl + CW_BAR) + args.li * XCD_BAR_WORDS; bar.x = 0; bar.st = nullptr;
    const int lo = args.ph_lo, hi = args.ph_hi;
    if (hi - lo > 1) { bar = xcd_barrier_post((unsigned*)(F.ctl + CW_BAR) + args.li * XCD_BAR_WORDS, F.MISC + 8);
        if (F.tid == 0) { const unsigned v = bar.x + 1u; unsigned exp = 0u;
            if (!__hip_atomic_compare_exchange_strong((unsigned*)(F.ctl + CW_GRP) + (blockIdx.x & 7), &exp, v, __ATOMIC_RELAXED, __ATOMIC_RELAXED, __HIP_MEMORY_SCOPE_AGENT) && exp != v) __hip_atomic_fetch_or((unsigned*)(F.ctl + CW_GRPBAD), 1u, RLX_AGENT); } }
    const float* const* in = args.in;
    bf16* XS = (bf16*)(ws + WS_XS);
    bf16* H = (bf16*)(ws + WS_H);
    const float* MOD = (const float*)(ws + WS_MOD);
    float* SSQ = (float*)(ws + WS_SUMSQ);
    const float* GV = (const float*)(ws + WS_GV);

    const int dup = args.dup & 1, msel = ((args.dup >> 1) & 15) ? ((args.dup >> 1) & 15) : 7;
#pragma unroll 1
    for (int ph = lo; ph < hi; ++ph) {
        { unsigned z_; asm volatile("v_mov_b32 %0, 0" : "=v"(z_)); const int t_ = wave0 * 64 + (int)__builtin_amdgcn_mbcnt_hi(~0u, __builtin_amdgcn_mbcnt_lo(~0u, z_)); F.tid = t_; F.lane = t_ & 63; F.wave = wave0; }
        if (ph == PH_PRO) p_prologue(F, in, ws);
        else if (ph == PH_CONV) p_conv(F, in, ws);
        else if (ph == PH_FINAL) p_norm_final(F, XS, SSQ + (size_t)4 * M, args.out, in[14]);
        else {
            const int l = (ph - PH_L0) / PH_PER_LAYER, k = (ph - PH_L0) % PH_PER_LAYER;
            unsigned char* wl = ws + WS_W + (size_t)l * W_LAYER;
            const float* modl = MOD + (size_t)l * BATCH * NMOD * D;
            const float* biasl = (const float*)(ws + WS_BIAS + (size_t)l * BIAS_LAYER);
            if (k == 0) { pg8::Gemm g{H, (const bf16*)(wl + W_IN), M, INW, D}; pg8::StaticOrder S; S.init(M, INW, F.G, (int)blockIdx.x);
                pg8::EpiBf16Norm E{(bf16*)(ws + WS_Z), 256, SSQ + (size_t)(2 * l) * M, l == 0 ? (const float*)(F.ctl + CW_ZEROS) : biasl, l == 0 ? 0 : INW, ws + WS_ZB, ws + WS_ZC};
                pg8::gemm_phase<pg8::EpiBf16Norm, pg8::StaticOrder, true, true>(F.lds + RING_OFF, g, S, E, F.tid); }
            else if (k == 1) p_mixers(F, in, ws, l + 2 * dup, msel);
            else if (k == 2 && l == 0 && !dup) {
                pg8::Gemm g{(const bf16*)(ws + WS_MIX), (const bf16*)(wl + W_OUT), M, D, D}; pg8::StaticOrder S; S.init(M, D, F.G, (int)blockIdx.x);
                pg8::EpiGateResNormT<true> E{(const bf16*)in[0], XS, modl + 2 * D, NMOD * D, H, GV + (size_t)1 * BATCH * D, D, SSQ + (size_t)1 * M, D};
                pg8::gemm_phase<pg8::EpiGateResNormT<true>, pg8::StaticOrder, true, true>(F.lds + RING_OFF, g, S, E, F.tid); }
            else if (k == 2 || k == 4) { const bool dn = (k == 4); const bool last = dn && (l == DEPTH - 1);
                pg8::Gemm g{(const bf16*)(ws + (dn ? WS_HID : WS_MIX)), (const bf16*)(wl + (dn ? W_DN : W_OUT)), M, D, dn ? DFF : D}; pg8::StaticOrder S; S.init(M, D, F.G, (int)blockIdx.x);
                pg8::EpiGateResNorm E{XS, XS, dup ? (const float*)(F.ctl + CW_ZEROS) : modl + (dn ? 5 : 2) * D, dup ? 0 : NMOD * D,
                    (last || dup) ? (bf16*)nullptr : H, GV + (size_t)((dn ? 2 * (l + 1) : 2 * l + 1) % (2 * DEPTH)) * BATCH * D, D, SSQ + (size_t)(dup ? 5 : 2 * l + (dn ? 2 : 1)) * M, D};
                pg8::gemm_phase<pg8::EpiGateResNorm, pg8::StaticOrder, true, true>(F.lds + RING_OFF, g, S, E, F.tid); }
            else { pg8::Gemm g{H, (const bf16*)(wl + W_GU), M, 2 * DFF, D}; pg8::StaticOrder S; S.init(M, 2 * DFF, F.G, (int)blockIdx.x);
                pg8::EpiSwiGLUNorm E{(bf16*)(ws + WS_HID), DFF, SSQ + (size_t)(2 * l + 1) * M, biasl + BATCH * INW, 2 * DFF};
                pg8::gemm_phase<pg8::EpiSwiGLUNorm, pg8::StaticOrder, true, true>(F.lds + RING_OFF, g, S, E, F.tid); }
        }
        if (ph + 1 < hi) { const int kk = (ph >= PH_L0 && ph < PH_FINAL) ? (ph - PH_L0) % PH_PER_LAYER : -1;
            xcd_barrier(bar, F.MISC[17] != 0u && (kk == 2 || kk == 3 || (kk == 4 && ph + 1 == PH_FINAL) || ph == PH_CONV));
            if (ph == PH_PRO && lo == 0) { if (F.tid == 0) F.MISC[17] = (F.G == 256 && xb_ld((unsigned*)(F.ctl + CW_GRPBAD)) == 0u) ? 1u : 0u; __syncthreads(); } }
    }
}

extern "C" void kernel_launch(void* const* d_in, const int* in_sizes, int n_in, void* d_out, int out_size, void* d_ws, size_t ws_size, hipStream_t stream) {
    static int grid = 0;
    if (grid == 0) {
        if (n_in != 15 || in_sizes[0] != M * D || out_size != M * D || ws_size < WS_END) { fprintf(stderr, "kernel_launch: unexpected shapes (n_in %d, in0 %d, out %d, ws %zu); nothing launched\n", n_in, n_in > 0 ? in_sizes[0] : -1, out_size, ws_size); grid = -1; return; }
        int dev = 0, cus = 0, per_cu = 0;
        if (hipGetDevice(&dev) != hipSuccess || hipDeviceGetAttribute(&cus, hipDeviceAttributeMultiprocessorCount, dev) != hipSuccess) { grid = -1; return; }
        if (hipFuncSetAttribute((const void*)mk_fwd, hipFuncAttributeMaxDynamicSharedMemorySize, LDS_BYTES) != hipSuccess) { fprintf(stderr, "kernel_launch: hipFuncSetAttribute failed\n"); grid = -1; return; }
        if (hipOccupancyMaxActiveBlocksPerMultiprocessor(&per_cu, (const void*)mk_fwd, NWAVES * 64, LDS_BYTES) != hipSuccess || per_cu < 1) fprintf(stderr, "kernel_launch: occupancy query reports %d blocks per CU\n", per_cu);
        (void)hipGetLastError();
        grid = cus;
        if (grid != 256) fprintf(stderr, "kernel_launch: %d CUs; this kernel is laid out for 256\n", grid);
    }
    if (grid < 0) return;
    if (hipMemsetAsync((char*)d_ws + WS_CTL, 0, CTL_ZERO_BYTES, stream) != hipSuccess) return;
    Args a{};
    for (int i = 0; i < 15; ++i) a.in[i] = (const float*)d_in[i];
    a.out = (float*)d_out; a.ws = (unsigned char*)d_ws;
#if PROBE_DUP == 0 && PROBE_CUT == 0
    a.ph_lo = 0; a.ph_hi = NPHASES; a.li = 0; a.dup = 0;
    hipLaunchKernelGGL(mk_fwd, dim3(grid), dim3(NWAVES * 64), LDS_BYTES, stream, a);
#else
    { int lo = 0, li = 0;
      for (int ph = 0; ph < NPHASES; ++ph) { const bool cut = ((PROBE_CUT | PROBE_DUP) >> ph) & 1;
        if (cut || ph == NPHASES - 1) { a.ph_lo = lo; a.ph_hi = ph + 1; a.li = (ph + 1 - lo > 1) ? li++ : 0; a.dup = 0; hipLaunchKernelGGL(mk_fwd, dim3(grid), dim3(NWAVES * 64), LDS_BYTES, stream, a);
            if ((PROBE_DUP >> ph) & 1) { a.ph_lo = ph; a.ph_hi = ph + 1; a.li = 0; a.dup = 1 | (PROBE_MIXSEL << 1) | (PROBE_NOSTORE << 4); hipLaunchKernelGGL(mk_fwd, dim3(grid), dim3(NWAVES * 64), LDS_BYTES, stream, a); }
            lo = ph + 1; } } }
#endif
}
```

```cpp
#include <hip/hip_runtime.h>
#include <cstdio>
#include <cstdint>
namespace pg8 {
#define PG8_LAS __attribute__((address_space(3)))
typedef unsigned short bf16_t;
typedef short bf16x8 __attribute__((ext_vector_type(8)));
typedef float f32x4 __attribute__((ext_vector_type(4)));
typedef unsigned u32x4 __attribute__((ext_vector_type(4)));
constexpr int BM = 256, BK = 64, HALF = 128, HTB = HALF * BK * 2  , STAGE_BYTES = 8 * HTB, NXCD = 8, WGM = 8;

__host__ __device__ __forceinline__ int lds_byte(int r, int c) { const int st = (r >> 4) * 2 + (c >> 5), rr = r & 15, cc = c & 31, ob = rr * 64 + cc * 2; return st * 1024 + (ob ^ (((ob >> 9) & 1) << 5)); }
__host__ __device__ __forceinline__ void stage_rc(int b, int& R, int& C) { const int st = b / 1024, sb = b % 1024, swz = sb ^ (((sb >> 9) & 1) << 5); R = (st >> 1) * 16 + swz / 64; C = (st & 1) * 32 + (swz % 64) / 2; }
__host__ __device__ __forceinline__ int perm32(int rho) { const int n = rho >> 4, i = rho & 15; return 8 * (i >> 2) + 4 * n + (i & 3); }

__host__ __device__ __forceinline__ int perm32inv(int x) { return 16 * ((x >> 2) & 1) + 4 * (x >> 3) + (x & 3); }
__host__ __device__ __forceinline__ size_t img_off(int row, int col, int nt, bool wrow) { const int r = row & 127, rr = wrow ? (r & ~31) + perm32inv(r & 31) : r; return ((size_t)((row >> 7) * nt + (col >> 6)) << 14) + (size_t)lds_byte(rr, col & 63); }
constexpr bool IMG_A = true, IMG_B = true;
struct Unit { int pm, pn; };
struct Gemm { const bf16_t* A; const bf16_t* Bt; int M, N, K; size_t a_gskip = 0; };

struct StaticOrder {
    int nM, nN, nwg, G, c;
    __host__ __device__ void init(int M, int N, int G_, int c_) { nM = M / BM; nN = N / BM; nwg = nM * nN; G = G_; c = c_; }
    __host__ __device__ bool next(int i, Unit& u) const {
        const long L = (long)i * G + c; if (L >= nwg) return false;
        int wgid = (int)L; { const int q = nwg / NXCD, r = nwg % NXCD, xcd = wgid % NXCD, off = wgid / NXCD; wgid = (xcd < r ? xcd * (q + 1) : r * (q + 1) + (xcd - r) * q) + off; }
        const int nig = WGM * nN, gid = wgid / nig, fm = gid * WGM, gsz = (nM - fm) < WGM ? (nM - fm) : WGM;
        u.pm = fm + ((wgid % nig) % gsz); u.pn = (wgid % nig) / gsz; return true;
    }
    __device__ __forceinline__ void a_ready(const Unit&) const {}
    __device__ __forceinline__ void done(const Unit&) const {}
};

__device__ __forceinline__ unsigned cvt_pk_bf16(float lo, float hi) { unsigned r; asm volatile("v_cvt_pk_bf16_f32 %0, %1, %2" : "=v"(r) : "v"(lo), "v"(hi)); return r; }
constexpr float RMS_EPS_ = 1e-6f, INV_D_ = 1.0f / 1024.0f;
__device__ __forceinline__ void aux_dma(const float* src_lane, PG8_LAS unsigned char* dst_wave) { __builtin_amdgcn_global_load_lds((const unsigned*)src_lane, (PG8_LAS unsigned*)dst_wave, 4, 0, 0); }
typedef _Float16 h16x2 __attribute__((ext_vector_type(2)));
__device__ __forceinline__ unsigned pk_h2(float lo, float hi) { const h16x2 h = {(_Float16)lo, (_Float16)hi}; return __builtin_bit_cast(unsigned, h); }
__device__ __forceinline__ float h_lo(unsigned w) { return (float)__builtin_bit_cast(h16x2, w)[0]; }
__device__ __forceinline__ float h_hi(unsigned w) { return (float)__builtin_bit_cast(h16x2, w)[1]; }
struct EpiBf16Norm {
    static constexpr bool PERM = true, AFTER_DRAIN = false;
    bf16_t* O; int ldc; const float* sumsq; const float* bias; int bias_stride; unsigned char* zb; unsigned char* zc;
    __device__ __forceinline__ void prefetch(const Unit& u, PG8_LAS unsigned char* aux, int wid, int lane) const {
        if (wid < 4) aux_dma(sumsq + u.pm * BM + wid * 64 + lane, aux + wid * 256);
        else aux_dma(bias + (size_t)(u.pm >> 5) * bias_stride + u.pn * BM + (wid - 4) * 64 + lane, aux + 1024 + (wid - 4) * 256);
    }
    __device__ __forceinline__ void operator()(const f32x4 (&acc)[2][2][4][2], const Unit& u, int wr, int wc, int fr_, int fq_, PG8_LAS unsigned char* aux) const {
        unsigned z_; asm volatile("v_mov_b32 %0, 0" : "=v"(z_)); const int ln_ = (int)__builtin_amdgcn_mbcnt_hi(~0u, __builtin_amdgcn_mbcnt_lo(~0u, z_)); const int fr = ln_ & 15, fq = ln_ >> 4;
        const int row0 = u.pm * BM + wr * 64 + fr, col0 = u.pn * BM + wc * 32 + 8 * fq;
        const PG8_LAS float* ass = (const PG8_LAS float*)aux + wr * 64 + fr; const PG8_LAS float* ab = (const PG8_LAS float*)(aux + 1024) + wc * 32 + 8 * fq;
        f32x4 bv[2][2];
#pragma unroll
        for (int bj = 0; bj < 2; ++bj)
#pragma unroll
            for (int n = 0; n < 2; ++n) bv[bj][n] = *(const PG8_LAS f32x4*)(ab + bj * HALF + 4 * n);
#pragma unroll
        for (int ai = 0; ai < 2; ++ai)
#pragma unroll
            for (int m = 0; m < 4; ++m) { const int row = row0 + ai * HALF + m * 16; const float rs = __builtin_amdgcn_rsqf(ass[ai * HALF + m * 16] * INV_D_ + RMS_EPS_);
#pragma unroll
                for (int bj = 0; bj < 2; ++bj) { const f32x4 v0 = acc[ai][bj][m][0] * rs + bv[bj][0], v1 = acc[ai][bj][m][1] * rs + bv[bj][1];
                    u32x4 w; w.x = cvt_pk_bf16(v0[0], v0[1]); w.y = cvt_pk_bf16(v0[2], v0[3]); w.z = cvt_pk_bf16(v1[0], v1[1]); w.w = cvt_pk_bf16(v1[2], v1[3]);
                    const int cb = 2 * u.pn + bj;
                    if (zb != nullptr && cb >= 2 && cb <= 10) { const int t3 = (cb - 2) / 3, g = (cb - 2) % 3, lg = 2 * g, hd = 2 * g + (wc >> 1), c = (wc & 1) * 4 + fq;
                        const int t = row & 8191, b = row >> 13, r = t & ((1 << lg) - 1), n = t >> lg, ti = (r << (8 - lg)) + (n >> 5), key = n & 31;
                        const int off = t3 < 2 ? (c >> 1) * 1024 + (key + 32 * (c & 1)) * 16 : (c >> 2) * 2048 + (key >> 4) * 1024 + (key & 15) * 64 + (c & 3) * 16;
                        *(u32x4*)(zb + ((size_t)(((t3 * 6 + hd) * 4 + b) * 256 + ti) << 12) + off) = w; }
                    else if (zb != nullptr && cb >= 11) {
                        const int hx = cb <= 13 ? 2 * (cb - 11) + (wc >> 1) : (cb == 14 ? 6 : 8) + (wc >> 1), c = (wc & 1) * 4 + fq, t = row & 8191, b = row >> 13, key = t & 31;
                        const int off = cb < 15 ? (c >> 1) * 1024 + (key + 32 * (c & 1)) * 16 : (c >> 2) * 2048 + (key >> 4) * 1024 + (key & 15) * 64 + (c & 3) * 16;
                        *(u32x4*)(zc + ((size_t)((hx * 4 + b) * 256 + (t >> 5)) << 12) + off) = w; }
                    else *(u32x4*)(O + (size_t)row * ldc + col0 + bj * HALF) = w; } }
    }
};
struct EpiSwiGLUNorm {
    static constexpr bool PERM = true, AFTER_DRAIN = false;
    bf16_t* O; int ldc; const float* sumsq; const float* bias; int bias_stride;
    static __device__ __forceinline__ float silu_mul(float g, float u) { return g * u * __builtin_amdgcn_rcpf(1.0f + __builtin_amdgcn_exp2f(-1.4426950408889634f * g)); }
    __device__ __forceinline__ void prefetch(const Unit& u, PG8_LAS unsigned char* aux, int wid, int lane) const {
        if (wid < 4) aux_dma(sumsq + u.pm * BM + wid * 64 + lane, aux + wid * 256);
        else aux_dma(bias + (size_t)(u.pm >> 5) * bias_stride + u.pn * BM + (wid - 4) * 64 + lane, aux + 1024 + (wid - 4) * 256);
    }
    __device__ __forceinline__ void operator()(const f32x4 (&acc)[2][2][4][2], const Unit& u, int wr, int wc, int fr_, int fq_, PG8_LAS unsigned char* aux) const {
        unsigned z_; asm volatile("v_mov_b32 %0, 0" : "=v"(z_)); const int ln_ = (int)__builtin_amdgcn_mbcnt_hi(~0u, __builtin_amdgcn_mbcnt_lo(~0u, z_)); const int fr = ln_ & 15, fq = ln_ >> 4;
        const int row0 = u.pm * BM + wr * 64 + fr, col0 = u.pn * HALF + wc * 32 + 8 * fq;
        const PG8_LAS float* ass = (const PG8_LAS float*)aux + wr * 64 + fr; const PG8_LAS float* ab = (const PG8_LAS float*)(aux + 1024) + wc * 32 + 8 * fq;
        const f32x4 bg0 = *(const PG8_LAS f32x4*)(ab), bg1 = *(const PG8_LAS f32x4*)(ab + 4), bu0 = *(const PG8_LAS f32x4*)(ab + HALF), bu1 = *(const PG8_LAS f32x4*)(ab + HALF + 4);
#pragma unroll
        for (int ai = 0; ai < 2; ++ai)
#pragma unroll
            for (int m = 0; m < 4; ++m) { const int row = row0 + ai * HALF + m * 16; const float rs = __builtin_amdgcn_rsqf(ass[ai * HALF + m * 16] * INV_D_ + RMS_EPS_);
                unsigned char* rowp = (unsigned char*)O + img_off(row, col0, ldc / 64, false);
                const f32x4 g0 = acc[ai][0][m][0] * rs + bg0, g1 = acc[ai][0][m][1] * rs + bg1, u0 = acc[ai][1][m][0] * rs + bu0, u1 = acc[ai][1][m][1] * rs + bu1;
                f32x4 e0 = g0, e1 = g1;
#pragma unroll
                for (int i = 0; i < 4; ++i) { e0[i] = __builtin_amdgcn_exp2f(e0[i]); e1[i] = __builtin_amdgcn_exp2f(e1[i]); }
                e0 = e0 + 1.0f; e1 = e1 + 1.0f;
#pragma unroll
                for (int i = 0; i < 4; ++i) { e0[i] = __builtin_amdgcn_rcpf(e0[i]); e1[i] = __builtin_amdgcn_rcpf(e1[i]); }
                const f32x4 h0 = (g0 * u0) * e0, h1 = (g1 * u1) * e1;
                u32x4 w; w.x = cvt_pk_bf16(h0[0], h0[1]); w.y = cvt_pk_bf16(h0[2], h0[3]); w.z = cvt_pk_bf16(h1[0], h1[1]); w.w = cvt_pk_bf16(h1[2], h1[3]);
                *(u32x4*)rowp = w; }
    }
};
template <bool F32BASE>
struct EpiGateResNormT {
    static constexpr bool PERM = true, AFTER_DRAIN = false;
    const bf16_t* base; bf16_t* out; const float* gate; int gate_stride; bf16_t* Hn; const float* gn; int gn_stride; float* sumsq; int ldc;
    __device__ __forceinline__ void prefetch(const Unit& u, PG8_LAS unsigned char* aux, int wid, int lane) const {
        if (wid < 4) aux_dma(gate + (size_t)(u.pm >> 5) * gate_stride + u.pn * BM + wid * 64 + lane, aux + wid * 256);
        else aux_dma(gn + (size_t)(u.pm >> 5) * gn_stride + u.pn * BM + (wid - 4) * 64 + lane, aux + 1024 + (wid - 4) * 256);
    }
    __device__ __forceinline__ void operator()(const f32x4 (&acc)[2][2][4][2], const Unit& u, int wr, int wc, int fr_, int fq_, PG8_LAS unsigned char* aux) const {
        unsigned z_; asm volatile("v_mov_b32 %0, 0" : "=v"(z_)); const int ln_ = (int)__builtin_amdgcn_mbcnt_hi(~0u, __builtin_amdgcn_mbcnt_lo(~0u, z_)); const int fr = ln_ & 15, fq = ln_ >> 4;
        const int row0 = u.pm * BM + wr * 64 + fr, col0 = u.pn * BM + wc * 32 + 8 * fq;
        const PG8_LAS float* ag = (const PG8_LAS float*)aux + wc * 32 + 8 * fq; const PG8_LAS float* an = (const PG8_LAS float*)(aux + 1024) + wc * 32 + 8 * fq;
#pragma unroll
        for (int am = 0; am < 4; ++am) {
            u32x4 ld[2][2]; f32x4 lf[2][2][2];
#pragma unroll
            for (int mm = 0; mm < 2; ++mm)
#pragma unroll
                for (int bj = 0; bj < 2; ++bj) {
                    if constexpr (F32BASE) { const f32x4* px = (const f32x4*)((const float*)base + (size_t)(row0 + (am >> 1) * HALF + (2 * (am & 1) + mm) * 16) * ldc + col0 + bj * HALF); lf[mm][bj][0] = __builtin_nontemporal_load(px); lf[mm][bj][1] = __builtin_nontemporal_load(px + 1); }
                    else ld[mm][bj] = *(const u32x4*)((const unsigned char*)base + img_off(row0 + (am >> 1) * HALF + (2 * (am & 1) + mm) * 16, col0 + bj * HALF, ldc / 64, false)); }
#pragma unroll
            for (int mm = 0; mm < 2; ++mm) { const int ai = am >> 1, m = 2 * (am & 1) + mm; const int row = row0 + ai * HALF + m * 16; const size_t off = (size_t)row * ldc + col0; float ss = 0.f;
#pragma unroll
                for (int bj = 0; bj < 2; ++bj) {
                    const f32x4 g0 = *(const PG8_LAS f32x4*)(ag + bj * HALF), g1 = *(const PG8_LAS f32x4*)(ag + bj * HALF + 4);
                    f32x4 b0, b1;
                    if constexpr (F32BASE) { b0 = lf[mm][bj][0]; b1 = lf[mm][bj][1]; }
                    else { const u32x4 bw = ld[mm][bj]; b0 = (f32x4){h_lo(bw.x), h_hi(bw.x), h_lo(bw.y), h_hi(bw.y)}; b1 = (f32x4){h_lo(bw.z), h_hi(bw.z), h_lo(bw.w), h_hi(bw.w)}; }
                    const f32x4 x0 = b0 + g0 * acc[ai][bj][m][0], x1 = b1 + g1 * acc[ai][bj][m][1];
                    u32x4 w; w.x = pk_h2(x0[0], x0[1]); w.y = pk_h2(x0[2], x0[3]); w.z = pk_h2(x1[0], x1[1]); w.w = pk_h2(x1[2], x1[3]);
                    *(u32x4*)((unsigned char*)out + img_off(row, col0 + bj * HALF, ldc / 64, false)) = w;
                    ss += (x0[0] * x0[0] + x0[1] * x0[1]) + (x0[2] * x0[2] + x0[3] * x0[3]) + (x1[0] * x1[0] + x1[1] * x1[1]) + (x1[2] * x1[2] + x1[3] * x1[3]);
                    if (Hn) { const f32x4 n0 = *(const PG8_LAS f32x4*)(an + bj * HALF), n1 = *(const PG8_LAS f32x4*)(an + bj * HALF + 4); const f32x4 h0 = x0 * n0, h1 = x1 * n1;
                        u32x4 hw; hw.x = cvt_pk_bf16(h0[0], h0[1]); hw.y = cvt_pk_bf16(h0[2], h0[3]); hw.z = cvt_pk_bf16(h1[0], h1[1]); hw.w = cvt_pk_bf16(h1[2], h1[3]);
                        *(u32x4*)((unsigned char*)Hn + img_off(row, col0 + bj * HALF, ldc / 64, false)) = hw; } }
                ss += __shfl_xor(ss, 16); ss += __shfl_xor(ss, 32);
                if (fq == 0) atomicAdd(sumsq + row, ss); }
            asm volatile("" ::: "memory"); }
    }
};
typedef EpiGateResNormT<false> EpiGateResNorm;

template <class Epi, class Sched, bool ALIGN_EPI = false, bool SP2 = false>
__device__ __forceinline__ void gemm_phase(PG8_LAS unsigned char* lds, const Gemm g, const Sched& S, const Epi& E, int tid_in) {
    int tid_ = tid_in; asm volatile("" : "+v"(tid_));
    const int tid = tid_, wid = __builtin_amdgcn_readfirstlane(tid >> 6), lane = tid & 63, wr = wid >> 2, wc = wid & 3, fr = lane & 15, fq = lane >> 4;
    const int K = g.K, nt = K / BK;
    unsigned voffA[2], voffB[2];
#pragma unroll
    for (int i = 0; i < 2; ++i) { int R, C; stage_rc(tid * 16 + i * 8192, R, C); const int Rb = Epi::PERM ? ((R & ~31) + perm32(R & 31)) : R;
        voffA[i] = IMG_A ? (unsigned)(tid * 16 + i * 8192) : (unsigned)(R * K + C) * 2u; voffB[i] = IMG_B ? (unsigned)(tid * 16 + i * 8192) : (unsigned)(Rb * K + C) * 2u; }
    const size_t kstepA = IMG_A ? (size_t)(HALF * BK * 2) : (size_t)(BK * 2), kstepB = IMG_B ? (size_t)(HALF * BK * 2) : (size_t)(BK * 2);
    const size_t hstep = (size_t)HALF * K * 2;
    const size_t tstep = 2 * hstep;
    const unsigned ldsw = (unsigned)wid * 1024u;
    const int aoff = lds_byte(wr * 64 + fr, fq * 8), boff = lds_byte(wc * 32 + fr, fq * 8);
#define PG8_SA(b, h) (((b) * 2 + (h)) * HTB)
#define PG8_SB(b, h) ((4 + (b) * 2 + (h)) * HTB)
#define PG8_STAGE(bufoff, gbase, voff) do { _Pragma("unroll") for (int _i = 0; _i < 2; ++_i) \
        __builtin_amdgcn_global_load_lds((const unsigned*)((const char*)(gbase) + (voff)[_i]), (PG8_LAS unsigned*)(lds + (bufoff) + ldsw + _i * 8192), 16, 0, 0); } while (0)
#define PG8_LDA(dst, b, h) do { _Pragma("unroll") for (int m = 0; m < 4; ++m) _Pragma("unroll") for (int k = 0; k < 2; ++k) dst[m][k] = *(const PG8_LAS bf16x8*)(lds + PG8_SA(b, h) + aoff + m * 2048 + k * 1024); } while (0)
#define PG8_LDB(dst, b, h) do { _Pragma("unroll") for (int n = 0; n < 2; ++n) _Pragma("unroll") for (int k = 0; k < 2; ++k) dst[n][k] = *(const PG8_LAS bf16x8*)(lds + PG8_SB(b, h) + boff + n * 2048 + k * 1024); } while (0)
#define PG8_MMA(ai, bj, At, Bt) do { __builtin_amdgcn_s_setprio(1); _Pragma("unroll") for (int m = 0; m < 4; ++m) _Pragma("unroll") for (int n = 0; n < 2; ++n) _Pragma("unroll") for (int k = 0; k < 2; ++k) \
        acc[ai][bj][m][n] = __builtin_amdgcn_mfma_f32_16x16x32_bf16(Bt[n][k], At[m][k], acc[ai][bj][m][n], 0, 0, 0); __builtin_amdgcn_s_setprio(0); } while (0)
#define PG8_WAIT_V(n) asm volatile("s_waitcnt vmcnt(" #n ")" ::: "memory")
#define PG8_WAIT_L(n) asm volatile("s_waitcnt lgkmcnt(" #n ")" ::: "memory")
#define PG8_BAR __builtin_amdgcn_s_barrier()
#define PG8_SCHED __builtin_amdgcn_sched_barrier(0)
    Unit cur, nxt; int ui = 0;
    if (!S.next(0, cur)) return;
    f32x4 acc[2][2][4][2];
#pragma unroll
    for (int a = 0; a < 2; ++a)
#pragma unroll
        for (int b = 0; b < 2; ++b)
#pragma unroll
            for (int m = 0; m < 4; ++m)
#pragma unroll
                for (int n = 0; n < 2; ++n) { float z_; asm volatile("v_mov_b32 %0, 0" : "=v"(z_)); acc[a][b][m][n] = (f32x4){z_, z_, z_, z_}; }
    bf16x8 At[4][2], B0[2][2], B1[2][2];
    const char* cA = (const char*)g.A + (size_t)cur.pm * tstep + (size_t)(cur.pm >> 4) * g.a_gskip; const char* cB = (const char*)g.Bt + (size_t)cur.pn * tstep;
    S.a_ready(cur);
    if constexpr (SP2) {
        PG8_STAGE(PG8_SB(0, 0), cB, voffB); PG8_STAGE(PG8_SB(0, 1), cB + hstep, voffB); PG8_STAGE(PG8_SA(0, 0), cA, voffA); PG8_STAGE(PG8_SA(0, 1), cA + hstep, voffA);
        if (wr == 1) PG8_BAR;
        PG8_WAIT_V(2); PG8_BAR;
        PG8_STAGE(PG8_SB(1, 0), cB + kstepB, voffB); PG8_STAGE(PG8_SA(1, 0), cA + kstepA, voffA); PG8_STAGE(PG8_SB(1, 1), cB + hstep + kstepB, voffB);
        PG8_WAIT_V(6); PG8_BAR;
    } else {
        PG8_STAGE(PG8_SB(0, 0), cB, voffB); PG8_STAGE(PG8_SA(0, 0), cA, voffA); PG8_STAGE(PG8_SB(0, 1), cB + hstep, voffB); PG8_STAGE(PG8_SA(0, 1), cA + hstep, voffA);
        if (wr == 1) PG8_BAR;
        PG8_WAIT_V(4); PG8_BAR;
        PG8_STAGE(PG8_SB(1, 0), cB + kstepB, voffB); PG8_STAGE(PG8_SA(1, 0), cA + kstepA, voffA); PG8_STAGE(PG8_SB(1, 1), cB + hstep + kstepB, voffB);
        PG8_WAIT_V(6); PG8_BAR;
    }
    for (;;) {
        const bool has_next = S.next(ui + 1, nxt);
        const char* nA = has_next ? (const char*)g.A + (size_t)nxt.pm * tstep + (size_t)(nxt.pm >> 4) * g.a_gskip : cA; const char* nB = has_next ? (const char*)g.Bt + (size_t)nxt.pn * tstep : cB;
        for (int t = 0; t < nt; t += 2) {
            const bool last = (t == nt - 2);
            const char* a1 = cA + (size_t)(t + 1) * kstepA;
            const char* a2 = last ? nA : cA + (size_t)(t + 2) * kstepA; const char* b2 = last ? nB : cB + (size_t)(t + 2) * kstepB;
            const char* a3 = a2 + kstepA; const char* b3 = b2 + kstepB;
            if (last && has_next) S.a_ready(nxt);
            if (last) E.prefetch(cur, lds + STAGE_BYTES + 1024, wid, lane);
            if constexpr (SP2) {
            PG8_LDB(B0, 0, 0); PG8_LDB(B1, 0, 1); PG8_SCHED; PG8_LDA(At, 0, 0); PG8_STAGE(PG8_SA(1, 1), a1 + hstep, voffA);
            PG8_WAIT_V(8); PG8_WAIT_L(0); PG8_BAR; PG8_MMA(0, 0, At, B0); PG8_MMA(0, 1, At, B1); PG8_BAR; PG8_SCHED;
            PG8_LDA(At, 0, 1); PG8_STAGE(PG8_SB(0, 0), b2, voffB); PG8_STAGE(PG8_SB(0, 1), b2 + hstep, voffB); PG8_STAGE(PG8_SA(0, 0), a2, voffA);
            PG8_WAIT_V(8); PG8_WAIT_L(0); PG8_BAR; PG8_MMA(1, 0, At, B0); PG8_MMA(1, 1, At, B1); PG8_BAR; PG8_SCHED;
            PG8_LDB(B0, 1, 0); PG8_LDB(B1, 1, 1); PG8_SCHED; PG8_LDA(At, 1, 0); PG8_STAGE(PG8_SA(0, 1), a2 + hstep, voffA);
            PG8_WAIT_V(8); PG8_WAIT_L(0); PG8_BAR; PG8_MMA(0, 0, At, B0); PG8_MMA(0, 1, At, B1); PG8_BAR; PG8_SCHED;
            PG8_LDA(At, 1, 1); PG8_STAGE(PG8_SB(1, 0), b3, voffB); PG8_STAGE(PG8_SB(1, 1), b3 + hstep, voffB); PG8_STAGE(PG8_SA(1, 0), a3, voffA);
            PG8_WAIT_V(8); PG8_WAIT_L(0); PG8_BAR; PG8_MMA(1, 0, At, B0); PG8_MMA(1, 1, At, B1); PG8_BAR; PG8_SCHED;
            } else {
            PG8_LDB(B0, 0, 0); PG8_SCHED; PG8_LDA(At, 0, 0); PG8_STAGE(PG8_SA(1, 1), a1 + hstep, voffA);
            PG8_WAIT_L(8); PG8_BAR; PG8_WAIT_L(0); PG8_MMA(0, 0, At, B0); PG8_BAR; PG8_SCHED;
            PG8_LDB(B1, 0, 1); PG8_STAGE(PG8_SB(0, 0), b2, voffB);
            PG8_BAR; PG8_WAIT_L(0); PG8_MMA(0, 1, At, B1); PG8_BAR;
            PG8_LDA(At, 0, 1); PG8_STAGE(PG8_SA(0, 0), a2, voffA);
            PG8_BAR; PG8_WAIT_L(0); PG8_MMA(1, 0, At, B0); PG8_BAR; PG8_SCHED;
            PG8_STAGE(PG8_SB(0, 1), b2 + hstep, voffB);
            PG8_WAIT_V(6); PG8_BAR; PG8_MMA(1, 1, At, B1); PG8_BAR;
            PG8_LDB(B0, 1, 0); PG8_SCHED; PG8_LDA(At, 1, 0); PG8_STAGE(PG8_SA(0, 1), a2 + hstep, voffA);
            PG8_WAIT_L(8); PG8_BAR; PG8_WAIT_L(0); PG8_MMA(0, 0, At, B0); PG8_BAR; PG8_SCHED;
            PG8_LDB(B1, 1, 1); PG8_STAGE(PG8_SB(1, 0), b3, voffB);
            PG8_BAR; PG8_WAIT_L(0); PG8_MMA(0, 1, At, B1); PG8_BAR;
            PG8_LDA(At, 1, 1); PG8_STAGE(PG8_SA(1, 0), a3, voffA);
            PG8_BAR; PG8_WAIT_L(0); PG8_MMA(1, 0, At, B0); PG8_BAR; PG8_SCHED;
            PG8_STAGE(PG8_SB(1, 1), b3 + hstep, voffB);
            PG8_WAIT_V(6); PG8_BAR; PG8_MMA(1, 1, At, B1); PG8_BAR;
            }
        }
        if constexpr (ALIGN_EPI) { if (wr == 0) PG8_BAR; }
        if constexpr (!Epi::AFTER_DRAIN) { E(acc, cur, wr, wc, fr, fq, lds + STAGE_BYTES + 1024); S.done(cur); }
        if (!has_next) break;
#pragma unroll
        for (int a = 0; a < 2; ++a)
#pragma unroll
            for (int b = 0; b < 2; ++b)
#pragma unroll
                for (int m = 0; m < 4; ++m)
#pragma unroll
                    for (int n = 0; n < 2; ++n) { float z_; asm volatile("v_mov_b32 %0, 0" : "=v"(z_)); acc[a][b][m][n] = (f32x4){z_, z_, z_, z_}; }
        cur = nxt; cA = nA; cB = nB; ++ui;
        if constexpr (ALIGN_EPI) { if (wr == 1) PG8_BAR; }
    }
    PG8_WAIT_V(0);
    if constexpr (!ALIGN_EPI) { if (wr == 0) PG8_BAR; }
    PG8_BAR;
    if constexpr (Epi::AFTER_DRAIN) { E.fused(acc, cur, wr, wc, fr, fq, lds, wid, lane); S.done(cur); }
#undef PG8_SA
#undef PG8_SB
#undef PG8_STAGE
#undef PG8_LDA
#undef PG8_LDB
#undef PG8_MMA
#undef PG8_WAIT_V
#undef PG8_WAIT_L
#undef PG8_BAR
#undef PG8_SCHED
}
}
#define GAS __attribute__((address_space(1)))
#define LAS __attribute__((address_space(3)))
typedef unsigned short bf16;
typedef unsigned v4u __attribute__((ext_vector_type(4)));
typedef float f32x4 __attribute__((ext_vector_type(4)));
typedef short bf16x8 __attribute__((ext_vector_type(8)));
typedef GAS unsigned gu32;
typedef GAS unsigned long long gu64;
#define RLX_AGENT __ATOMIC_RELAXED, __HIP_MEMORY_SCOPE_AGENT
#define LDS_WAIT() asm volatile("s_waitcnt lgkmcnt(0)" ::: "memory")
#define VM_WAIT() asm volatile("s_waitcnt vmcnt(0)" ::: "memory")
__device__ __forceinline__ unsigned long long rt() { return __builtin_amdgcn_s_memrealtime(); }
__device__ __forceinline__ unsigned f2bf(float f) { unsigned u = __builtin_bit_cast(unsigned, f); return (u + 0x7fffu + ((u >> 16) & 1u)) >> 16; }
__device__ __forceinline__ unsigned pk2(float lo, float hi) { return f2bf(lo) | (f2bf(hi) << 16); }

#define XB_TMO      128
#define XB_XCNT(j)  (256  + 64 * (j))
#define XB_XSUB(j)  (1280 + 64 * (j))
#define XB_XGEN(j)  (2304 + 64 * (j))
#define XB_TOP      3328
#define XB_TOPGEN   3392
#define XCD_BAR_WORDS 3456
#define XB_SPIN_CAP (1u << 18)

__device__ __forceinline__ unsigned xb_ld(unsigned* p)              { return __hip_atomic_load(p, __ATOMIC_RELAXED, __HIP_MEMORY_SCOPE_AGENT); }
__device__ __forceinline__ unsigned xb_add(unsigned* p, unsigned v) { return __hip_atomic_fetch_add(p, v, __ATOMIC_RELAXED, __HIP_MEMORY_SCOPE_AGENT); }
__device__ __forceinline__ unsigned xb_xcc_id() { return (unsigned)__builtin_amdgcn_s_getreg((3 << 11) | 20) & 0xFu; }
#define XB_SPIN(cond, bar) do { unsigned _sp = 0; while (cond) { __builtin_amdgcn_s_sleep(1); \
    if ((++_sp & 255u) == 0u) { if (xb_ld(&(bar)[XB_TMO])) break; if (_sp > XB_SPIN_CAP) { atomicAdd(&(bar)[XB_TMO], 1u); break; } } } } while (0)

struct XcdBarrier {
    unsigned* bar; unsigned x;
    volatile LAS unsigned* st;
};

__device__ __forceinline__ XcdBarrier xcd_barrier_post(unsigned* bar, volatile LAS unsigned* st) {
    XcdBarrier b; b.bar = bar; b.x = xb_xcc_id(); b.st = st;
    if (threadIdx.x == 0) (void)xb_add(&bar[XB_XCNT(b.x)], 1u);
    return b;
}
__device__ __forceinline__ void xcd_barrier_complete(unsigned* bar, unsigned x, unsigned& nloc, unsigned& nx) {
    const unsigned G = gridDim.x * gridDim.y * gridDim.z;
    unsigned sum, cnt, mine, sp = 0u;
    for (;;) {
        sum = 0u; cnt = 0u; mine = 0u;
#pragma unroll
        for (unsigned j = 0; j < 16; ++j) { const unsigned c = xb_ld(&bar[XB_XCNT(j)]); sum += c; cnt += (c > 0u) ? 1u : 0u; mine = (j == x) ? c : mine; }
        if (sum == G) break;
        __builtin_amdgcn_s_sleep(1);
        if ((++sp & 255u) == 0u) { if (xb_ld(&bar[XB_TMO])) break; if (sp > XB_SPIN_CAP) { atomicAdd(&bar[XB_TMO], 1u); break; } }
    }
    nloc = mine > 0u ? mine : 1u; nx = cnt > 0u ? cnt : 1u;
}

__device__ __forceinline__ void xcd_barrier(const XcdBarrier& b, bool local = false, unsigned* post = nullptr, unsigned* need = nullptr, unsigned needv = 0u) {
    asm volatile("s_waitcnt vmcnt(0)" ::: "memory");
    __syncthreads();
    if (threadIdx.x == 0) {
        unsigned* bar = b.bar;
        __builtin_amdgcn_s_waitcnt(0);
        unsigned nloc = b.st[0], nx = b.st[1];
        if (nloc == 0u) { xcd_barrier_complete(bar, b.x, nloc, nx); b.st[0] = nloc; b.st[1] = nx; }
        const unsigned old = xb_add(&bar[XB_XSUB(b.x)], 1u);
        const unsigned gen = old / nloc;
        if (old + 1u == (gen + 1u) * nloc) {
            if (!local) {
            __builtin_amdgcn_fence(__ATOMIC_RELEASE, "agent");
            asm volatile("s_waitcnt vmcnt(0)" ::: "memory");
            const unsigned og = xb_add(&bar[XB_TOP], 1u);
            const unsigned tg = og / nx;
            if (og + 1u == (tg + 1u) * nx) xb_add(&bar[XB_TOPGEN], 1u);
            else XB_SPIN(xb_ld(&bar[XB_TOPGEN]) == tg, bar);
            }
            __builtin_amdgcn_fence(__ATOMIC_ACQUIRE, "agent");
            if (post) (void)xb_add(post, 1u);
            if (need) XB_SPIN(xb_ld(need) < needv, bar);
            xb_add(&bar[XB_XGEN(b.x)], 1u);
            asm volatile("s_waitcnt vmcnt(0)" ::: "memory");
        } else {
            if (local) __builtin_amdgcn_fence(__ATOMIC_ACQUIRE, "agent");
            XB_SPIN(xb_ld(&bar[XB_XGEN(b.x)]) == gen, bar);
            if (!local) __builtin_amdgcn_fence(__ATOMIC_ACQUIRE, "agent");
            asm volatile("s_waitcnt vmcnt(0)" ::: "memory");
        }
    }
    __syncthreads();
}

constexpr int NWAVES = 8;
constexpr int BATCH = 4, SEQ = 8192, D = 1024, M = BATCH * SEQ, DEPTH = 2;
constexpr int INW = 2048, DFF = 2816, NMOD = 6;
constexpr int O_U = 0, O_QB = 256, O_KB = 640, O_VB = 1024, O_QC = 1408, O_KC = 1792, O_VC = 1920;
constexpr float RMS_EPS = 1e-6f;
constexpr float LOG2E = 1.4426950408889634f;
constexpr float QSCALE = 0.125f * LOG2E;

constexpr size_t MiB = 1u << 20;
constexpr size_t WS_CTL = 0, CTL_ZERO_BYTES = 131072;
constexpr size_t WS_MOD = 1 * MiB;
constexpr size_t WS_W = 2 * MiB, W_LAYER = 24 * MiB;
constexpr size_t W_IN = 0, W_OUT = 4 * MiB, W_GU = 6 * MiB, W_DN = 17 * MiB, W_PT = 23 * MiB;
constexpr size_t WS_H = 50 * MiB;
constexpr size_t WS_Z = 114 * MiB;
constexpr size_t WS_MIX = 242 * MiB;
constexpr size_t WS_HID = 242 * MiB;
constexpr size_t WS_XS = 418 * MiB;
constexpr size_t WS_AUX = 482 * MiB;
constexpr size_t WS_SUMSQ = WS_AUX;
constexpr size_t WS_GV = WS_AUX + 1 * MiB;
constexpr size_t WS_BIAS = WS_GV + 65536;
constexpr size_t BIAS_LAYER = (size_t)BATCH * (2048 + 5632) * 4;
constexpr size_t WS_BSCR = WS_HID + (size_t)(M / 8) * D * 2;
constexpr size_t WS_ZC = 202 * MiB;
constexpr size_t WS_ZB = 130 * MiB;
constexpr size_t WS_END = 484 * MiB;
static_assert(WS_Z + (size_t)M * 256 * 2 <= WS_ZB && WS_ZB + 72 * MiB <= WS_ZC && WS_ZC + 40 * MiB <= WS_HID, "z region map");
static_assert(WS_ZC + 40 * MiB <= WS_HID && WS_HID + (size_t)M * DFF * 2 <= WS_XS && WS_XS + 64 * MiB <= WS_AUX && WS_AUX + 2 * MiB <= WS_END && WS_H + (size_t)M * D * 2 <= WS_Z && (size_t)(M / 8) * D * 2 + 3 * MiB <= (size_t)(M / 8) * DFF * 2, "ws map");
constexpr int CW_TMO = 0, CW_CODE = 1, CW_BAR = 4096  , CW_QUEUE = 20480, CW_GRP = 20480  , CW_GRPBAD = 20496  , CW_GRPFLAG = 20544  , CW_ZEROS = 24576  ;

constexpr int RING_OFF = 0, RING_BYTES = 131072;
constexpr int LDSCTL_OFF = RING_BYTES, MISC_OFF = 147456 - 256, LSEB_OFF = MISC_OFF - 6144;
constexpr int LDS_BYTES = 147456;

constexpr int PH_PRO = 0, PH_CONV = 1, PH_L0 = 2, PH_PER_LAYER = 5, PH_FINAL = PH_L0 + DEPTH * PH_PER_LAYER, NPHASES = PH_FINAL + 1;
#ifndef PROBE_DUP
#define PROBE_DUP 0
#endif
#ifndef PROBE_CUT
#define PROBE_CUT 0
#endif
#ifndef PROBE_MIXSEL
#define PROBE_MIXSEL 0
#endif
#ifndef PROBE_NOSTORE
#define PROBE_NOSTORE 0
#endif
#ifndef MK_ONE_LAUNCH
#define MK_ONE_LAUNCH 1
#endif

struct Frame {
    LAS unsigned char* lds;
    volatile LAS unsigned* MISC;
    gu32* ctl;
    int tid, lane, wave, G, vcu;
};

__device__ __forceinline__ float wave_sum(float v) {
#pragma unroll
    for (int o = 1; o < 64; o <<= 1) v += __shfl_xor(v, o);
    return v;
}
__device__ __forceinline__ float bf2f(unsigned short b) { return __uint_as_float((unsigned)b << 16); }
__device__ __forceinline__ float zero_() { float z; asm volatile("v_mov_b32 %0, 0" : "=v"(z)); return z; }
__device__ __forceinline__ f32x4 zero4_() { const float z = zero_(); return (f32x4){z, z, z, z}; }

__device__ __forceinline__ void tr_item(const float* W, int N, int k0, int n0, bf16* WT, int ldt, int drow0, float scale, LAS float* scr, int lane, bool img = true) {
#pragma unroll 8
    for (int i = 0; i < 32; ++i) { const int kk = 2 * i + (lane >> 5); scr[kk * 33 + (lane & 31)] = __builtin_nontemporal_load(W + (size_t)(k0 + kk) * N + n0 + (lane & 31)); }
    LDS_WAIT(); asm volatile("" ::: "memory");
    const int c = lane & 7;
#pragma unroll
    for (int j = 0; j < 4; ++j) { const int n = (lane >> 3) + 8 * j; const LAS float* s = scr + (8 * c) * 33 + n;
        v4u o; o.x = pk2(s[0 * 33] * scale, s[1 * 33] * scale); o.y = pk2(s[2 * 33] * scale, s[3 * 33] * scale); o.z = pk2(s[4 * 33] * scale, s[5 * 33] * scale); o.w = pk2(s[6 * 33] * scale, s[7 * 33] * scale);
        if (img) *(GAS v4u*)((unsigned char*)WT + pg8::img_off(drow0 + n, k0 + 8 * c, ldt / 64, true)) = o;
        else *(GAS v4u*)(WT + (size_t)(drow0 + n) * ldt + k0 + 8 * c) = o; }
    LDS_WAIT(); asm volatile("" ::: "memory");
}
constexpr int TI_IN = 16 * 64, TI_OUT = 16 * 32, TI_G = 16 * 88, TI_DN = 44 * 32, TI_P = 8, TI_LAYER = TI_IN + TI_OUT + 2 * TI_G + TI_DN + TI_P;
__device__ __forceinline__ void weight_item(const float* const* in, unsigned char* ws, int it, LAS float* scr, int lane) {
    const int l = it / TI_LAYER; int r = it % TI_LAYER;
    unsigned char* wl = ws + WS_W + (size_t)l * W_LAYER;
    if (r < TI_IN) { const int kb = r / 64, n0 = 32 * (r % 64); const bool isq = (n0 >= O_QB && n0 < O_KB) || (n0 >= O_QC && n0 < O_KC);
        tr_item(in[6] + (size_t)l * D * INW, INW, 64 * kb, n0, (bf16*)(wl + W_IN), D, n0, isq ? QSCALE : 1.0f, scr, lane); return; }
    r -= TI_IN;
    if (r < TI_OUT) { const int kb = r / 32, n0 = 32 * (r % 32); tr_item(in[10] + (size_t)l * D * D, D, 64 * kb, n0, (bf16*)(wl + W_OUT), D, n0, 1.0f, scr, lane); return; }
    r -= TI_OUT;
    if (r < 2 * TI_G) { const int up = r >= TI_G; if (up) r -= TI_G; const int kb = r / 88, n0 = 32 * (r % 88);
        tr_item(in[up ? 12 : 11] + (size_t)l * D * DFF, DFF, 64 * kb, n0, (bf16*)(wl + W_GU), D, 256 * (n0 >> 7) + 128 * up + (n0 & 127), up ? -0.6931471805599453f : -1.4426950408889634f, scr, lane); return; }
    r -= 2 * TI_G;
    if (r < TI_DN) { const int kb = r / 32, n0 = 32 * (r % 32); tr_item(in[13] + (size_t)l * DFF * D, D, 64 * kb, n0, (bf16*)(wl + W_DN), DFF, n0, 1.0f, scr, lane); return; }
    r -= TI_DN;
    { const int g = r >> 1, n0 = 32 * (r & 1); tr_item(in[7] + (size_t)l * 16384 + g * 4096, 64, 0, n0, (bf16*)(wl + W_PT) + g * 4096, 64, n0, 1.0f, scr, lane, false); }
}
__device__ __forceinline__ void ada_item(Frame& F, const float* const* in, unsigned char* ws, int item) {
    LAS float* cact = (LAS float*)(F.lds);
    LAS float* red = (LAS float*)(F.lds + 16384);
    const int l = item / 96, cb = item % 96;
    const float* c = in[1];
    for (int i = F.tid; i < BATCH * D; i += NWAVES * 64) { const int b = i >> 10, k = i & 1023; const float v = c[i]; cact[k * 4 + b] = v / (1.0f + __expf(-v)); }
    __syncthreads();
    const float* W = in[4] + (size_t)l * D * (NMOD * D) + 64 * cb + F.lane;
    float a0 = 0.f, a1 = 0.f, a2 = 0.f, a3 = 0.f;
    const int kbeg = 128 * F.wave;
#pragma unroll 16
    for (int kk = 0; kk < 128; ++kk) { const float wv = __builtin_nontemporal_load(W + (size_t)(kbeg + kk) * (NMOD * D)); const f32x4 ca = *(const LAS f32x4*)(cact + (kbeg + kk) * 4);
        a0 += ca.x * wv; a1 += ca.y * wv; a2 += ca.z * wv; a3 += ca.w * wv; }
    red[(F.wave * 4 + 0) * 64 + F.lane] = a0; red[(F.wave * 4 + 1) * 64 + F.lane] = a1; red[(F.wave * 4 + 2) * 64 + F.lane] = a2; red[(F.wave * 4 + 3) * 64 + F.lane] = a3;
    __syncthreads();
    if (F.wave < 4) { float s = in[5][(size_t)l * NMOD * D + 64 * cb + F.lane];
#pragma unroll
        for (int w = 0; w < 8; ++w) s += red[(w * 4 + F.wave) * 64 + F.lane];
        ((float*)(ws + WS_MOD))[((size_t)l * BATCH + F.wave) * (NMOD * D) + 64 * cb + F.lane] = s; }
    __syncthreads();
}
__device__ __forceinline__ void p_prologue(Frame& F, const float* const* in, unsigned char* ws) {
    for (int item = blockIdx.x; item < DEPTH * 96; item += F.G) ada_item(F, in, ws, item);
    LAS float* scr = (LAS float*)(F.lds + RING_OFF + F.wave * 16384);
    const int gw = blockIdx.x * NWAVES + F.wave, NGW = F.G * NWAVES;
    for (int it = gw; it < DEPTH * TI_LAYER; it += NGW) weight_item(in, ws, it, scr, F.lane);
    { GAS f32x4* z = (GAS f32x4*)(ws + WS_SUMSQ) + M / 4; const int n4 = 4 * M / 4;
      for (int i = blockIdx.x * (NWAVES * 64) + F.tid; i < n4; i += F.G * NWAVES * 64) z[i] = zero4_(); }
}

__device__ __forceinline__ void p_conv(Frame& F, const float* const* in, unsigned char* ws) {
    const float* MOD = (const float*)(ws + WS_MOD);
    const int NGW = F.G * NWAVES, rpw = M / NGW;
    const int gw = (F.G == 256) ? (((int)blockIdx.x & 7) * 32 + ((int)blockIdx.x >> 3)) * NWAVES + F.wave : (int)blockIdx.x * NWAVES + F.wave;
    {
        const int row0 = gw * rpw, b = row0 / SEQ;
        const float* mb = MOD + (size_t)b * (NMOD * D);
        const float* xin = in[0]; bf16* hout = (bf16*)(ws + WS_H); float* ssq = (float*)(ws + WS_SUMSQ);
        f32x4 Gv[4], Sv[4];
#pragma unroll
        for (int j = 0; j < 4; ++j) { const int cidx = 4 * F.lane + 256 * j; const f32x4 g = *(const f32x4*)(in[2] + cidx), sc = *(const f32x4*)(mb + 1 * D + cidx); Gv[j] = g * (sc + 1.0f); Sv[j] = *(const f32x4*)(mb + 0 * D + cidx); }
        for (int rr = 0; rr < rpw; rr += 4) {
            f32x4 v[4][4];
#pragma unroll
            for (int i = 0; i < 4; ++i) { const GAS f32x4* xr = (const GAS f32x4*)(xin + (size_t)(row0 + rr + i) * D) + F.lane;
#pragma unroll
                for (int j = 0; j < 4; ++j) v[i][j] = __builtin_nontemporal_load(xr + 64 * j); }
#pragma unroll
            for (int i = 0; i < 4; ++i) { const size_t row = (size_t)(row0 + rr + i); float s = 0.f;
#pragma unroll
                for (int j = 0; j < 4; ++j) s += (v[i][j].x * v[i][j].x + v[i][j].y * v[i][j].y) + (v[i][j].z * v[i][j].z + v[i][j].w * v[i][j].w);
                s = wave_sum(s); const float rstd = 1.0f / sqrtf(s * (1.0f / D) + RMS_EPS); if (F.lane == 0) ssq[row] = (float)D * (1.0f - RMS_EPS);
                unsigned char* hb = (unsigned char*)hout + 8 * (F.lane & 1);
#pragma unroll
                for (int j = 0; j < 4; ++j) { const f32x4 o = (v[i][j] * rstd) * Gv[j] + Sv[j]; *(GAS unsigned long long*)(hb + pg8::img_off((int)row, (4 * F.lane + 256 * j) & ~7, D / 64, false)) = (unsigned long long)pk2(o.x, o.y) | ((unsigned long long)pk2(o.z, o.w) << 32);
 } }
        }
    }
    {
        float* GV = (float*)(ws + WS_GV);
        for (int i = blockIdx.x * (NWAVES * 64) + F.tid; i < DEPTH * 2 * BATCH * D; i += F.G * NWAVES * 64) { const int col = i & (D - 1), b = (i >> 10) & 3, w = (i >> 12) & 1, l = i >> 13;
            GV[i] = in[w ? 3 : 2][l * D + col] * (1.0f + MOD[((size_t)l * BATCH + b) * (NMOD * D) + (w ? 4 : 1) * D + col]); }
    }
    {
        const int g0 = 8 * gw;
        if (g0 < DEPTH * (INW + 2 * DFF)) {
            const int l = g0 / (INW + 2 * DFF), rl = g0 % (INW + 2 * DFF), w = rl >= INW, n0 = w ? rl - INW : rl, N = w ? 2 * DFF : INW;
            const unsigned char* Bt = ws + WS_W + (size_t)l * W_LAYER + (w ? W_GU : W_IN);
            float* bias = (float*)(ws + WS_BIAS + (size_t)l * BIAS_LAYER) + (w ? BATCH * INW : 0);
            const float* shp = MOD + (size_t)l * BATCH * (NMOD * D) + (w ? 3 : 0) * D + 16 * F.lane;
            v4u wr[8][2];
#pragma unroll
            for (int i = 0; i < 8; ++i) { wr[i][0] = *(const GAS v4u*)(Bt + pg8::img_off(n0 + i, 16 * F.lane, D / 64, true)); wr[i][1] = *(const GAS v4u*)(Bt + pg8::img_off(n0 + i, 16 * F.lane + 8, D / 64, true)); }
            f32x4 sh[4][4];
#pragma unroll
            for (int b = 0; b < 4; ++b)
#pragma unroll
                for (int j = 0; j < 4; ++j) sh[b][j] = *(const f32x4*)(shp + (size_t)b * (NMOD * D) + 4 * j);
#pragma unroll
            for (int i = 0; i < 8; ++i) { const v4u w0 = wr[i][0], w1 = wr[i][1];
                float wf[16];
                wf[0] = __uint_as_float(w0.x << 16); wf[1] = __uint_as_float(w0.x & 0xffff0000u); wf[2] = __uint_as_float(w0.y << 16); wf[3] = __uint_as_float(w0.y & 0xffff0000u);
                wf[4] = __uint_as_float(w0.z << 16); wf[5] = __uint_as_float(w0.z & 0xffff0000u); wf[6] = __uint_as_float(w0.w << 16); wf[7] = __uint_as_float(w0.w & 0xffff0000u);
                wf[8] = __uint_as_float(w1.x << 16); wf[9] = __uint_as_float(w1.x & 0xffff0000u); wf[10] = __uint_as_float(w1.y << 16); wf[11] = __uint_as_float(w1.y & 0xffff0000u);
                wf[12] = __uint_as_float(w1.z << 16); wf[13] = __uint_as_float(w1.z & 0xffff0000u); wf[14] = __uint_as_float(w1.w << 16); wf[15] = __uint_as_float(w1.w & 0xffff0000u);
                float acc[4];
#pragma unroll
                for (int b = 0; b < 4; ++b) { float a = 0.f;
#pragma unroll
                    for (int j = 0; j < 4; ++j) a += (wf[4 * j] * sh[b][j].x + wf[4 * j + 1] * sh[b][j].y) + (wf[4 * j + 2] * sh[b][j].z + wf[4 * j + 3] * sh[b][j].w);
                    acc[b] = wave_sum(a); }
                if (F.lane < 4) bias[(size_t)F.lane * N + n0 + i] = F.lane == 0 ? acc[0] : F.lane == 1 ? acc[1] : F.lane == 2 ? acc[2] : acc[3]; }
        }
    }
}
__device__ __forceinline__ void p_norm_final(Frame& F, const bf16* xin, const float* ssq, float* out, const float* gvec) {
    const int NGW = F.G * NWAVES, rpw = M / NGW;
    const int gw = (F.G == 256) ? (((int)blockIdx.x & 7) * 32 + ((int)blockIdx.x >> 3)) * NWAVES + F.wave : (int)blockIdx.x * NWAVES + F.wave;
    const int row0 = gw * rpw;
    f32x4 Gv[4];
#pragma unroll
    for (int j = 0; j < 4; ++j) Gv[j] = *(const f32x4*)(gvec + 4 * F.lane + 256 * j);
    for (int rr = 0; rr < rpw; rr += 4) {
        unsigned long long w[4][4]; float ss[4];
#pragma unroll
        for (int i = 0; i < 4; ++i) { const unsigned char* xr = (const unsigned char*)xin + 8 * (F.lane & 1); ss[i] = ssq[row0 + rr + i];
#pragma unroll
            for (int j = 0; j < 4; ++j) w[i][j] = *(const GAS unsigned long long*)(xr + pg8::img_off(row0 + rr + i, (4 * F.lane + 256 * j) & ~7, D / 64, false)); }
#pragma unroll
        for (int i = 0; i < 4; ++i) { const float rstd = 1.0f / sqrtf(ss[i] * (1.0f / D) + RMS_EPS);
            GAS f32x4* o = (GAS f32x4*)(out + (size_t)(row0 + rr + i) * D) + F.lane;
#pragma unroll
            for (int j = 0; j < 4; ++j) { const unsigned wl = (unsigned)w[i][j], wh = (unsigned)(w[i][j] >> 32);
                const f32x4 v = {pg8::h_lo(wl), pg8::h_hi(wl), pg8::h_lo(wh), pg8::h_hi(wh)};
                __builtin_nontemporal_store(v * rstd * Gv[j], o + 64 * j); } }
    }
}

namespace mx {
constexpr size_t SLAB = (size_t)(M / 8) * DFF * 2, SLAB_MIX = (size_t)(M / 8) * D * 2, SLAB_SCR = SLAB_MIX;
__device__ __forceinline__ size_t mix_off(int row, int col) { return (size_t)(row >> 12) * SLAB + pg8::img_off(row & 4095, col, D / 64, false); }
typedef short bf16x8 __attribute__((ext_vector_type(8)));
typedef short s16x4 __attribute__((ext_vector_type(4)));
typedef float f32x16 __attribute__((ext_vector_type(16)));
typedef unsigned u32x4 __attribute__((ext_vector_type(4)));
typedef unsigned u32x2 __attribute__((ext_vector_type(2)));
typedef float f32x2_t __attribute__((ext_vector_type(2))); typedef __bf16 bf16x2_t __attribute__((ext_vector_type(2)));
constexpr float THR = 8.0f;
constexpr int POOL_PITCH = 544;
__device__ __forceinline__ unsigned cvtpk(float lo, float hi) { f32x2_t v = {lo, hi}; bf16x2_t b = __builtin_convertvector(v, bf16x2_t); return __builtin_bit_cast(unsigned, b); }
__device__ __forceinline__ float hswap_max(float v) { auto rr = __builtin_amdgcn_permlane32_swap(__float_as_uint(v), __float_as_uint(v), false, false); return fmaxf(__uint_as_float(rr[0]), __uint_as_float(rr[1])); }
__device__ __forceinline__ float hswap_sum(float v) { auto rr = __builtin_amdgcn_permlane32_swap(__float_as_uint(v), __float_as_uint(v), false, false); return __uint_as_float(rr[0]) + __uint_as_float(rr[1]); }
__device__ __forceinline__ s16x4 vtr(const LAS char* p) { return __builtin_bit_cast(s16x4, __builtin_amdgcn_ds_read_tr16_b64_v4i16((LAS s16x4*)p)); }
__device__ __forceinline__ f32x16 zero16_() { const float z = zero_(); return (f32x16){z, z, z, z, z, z, z, z, z, z, z, z, z, z, z, z}; }
__device__ __forceinline__ int kt_of(int i) { return (i & 1) ? -((i + 1) >> 1) : (i >> 1); }

template <int VAR>
__device__ __forceinline__ float scores(f32x16& t, const bf16x8 (&kf)[4], const bf16x8 (&qf)[4], float relf, float sl, float slope2, float Rf) {
    f32x16 s = {0.f, 0.f, 0.f, 0.f, 0.f, 0.f, 0.f, 0.f, 0.f, 0.f, 0.f, 0.f, 0.f, 0.f, 0.f, 0.f};
#pragma unroll
    for (int i = 0; i < 4; ++i) s = __builtin_amdgcn_mfma_f32_32x32x16_bf16(kf[i], qf[i], s, 0, 0, 0);
    if (VAR == 0) {
#pragma unroll
        for (int r = 0; r < 16; ++r) t[r] = __builtin_fmaf(-__builtin_fabsf(relf - (float)((r & 3) + 8 * (r >> 2))), slope2, s[r]);
        return 0.f;
    } else {
#pragma unroll
        for (int r = 0; r < 16; ++r) { const float c = (float)((r & 3) + 8 * (r >> 2)); float v = __builtin_fmaf(sl, c, s[r]); if (VAR == 2) v = __builtin_fabsf(relf - c) > Rf ? -INFINITY : v; t[r] = v; }
        return -sl * relf;
    }
}
__device__ __forceinline__ float lane_max(const f32x16& t) {
    float a = fmaxf(fmaxf(t[0], t[1]), fmaxf(t[2], t[3])), b = fmaxf(fmaxf(t[4], t[5]), fmaxf(t[6], t[7])), c = fmaxf(fmaxf(t[8], t[9]), fmaxf(t[10], t[11])), d = fmaxf(fmaxf(t[12], t[13]), fmaxf(t[14], t[15]));
    return fmaxf(fmaxf(a, b), fmaxf(c, d));
}
__device__ __forceinline__ float tile_max(const f32x16& t) {
    float a = fmaxf(fmaxf(t[0], t[1]), fmaxf(t[2], t[3])), b = fmaxf(fmaxf(t[4], t[5]), fmaxf(t[6], t[7])), c = fmaxf(fmaxf(t[8], t[9]), fmaxf(t[10], t[11])), d = fmaxf(fmaxf(t[12], t[13]), fmaxf(t[14], t[15]));
    return hswap_max(fmaxf(fmaxf(a, b), fmaxf(c, d)));
}
__device__ __forceinline__ void load_frag4(bf16x8 (&f)[4], const bf16* rowp, int hi) {
#pragma unroll
    for (int i = 0; i < 4; ++i) f[i] = *(const bf16x8*)(rowp + 16 * i + 8 * hi);
}
__device__ __forceinline__ void load_tile_frags(bf16x8 (&f)[4], const char* tile, int lane) {
#pragma unroll
    for (int s = 0; s < 4; ++s) f[s] = *(const bf16x8*)(tile + s * 1024 + lane * 16);
}
__device__ __forceinline__ void load_tile_frags_nt(bf16x8 (&f)[4], const char* tile, int lane) {
#pragma unroll
    for (int s = 0; s < 4; ++s) f[s] = __builtin_nontemporal_load((const bf16x8*)(tile + s * 1024 + lane * 16));
}
__device__ __forceinline__ void dma_tile(LAS char* dst, const char* tile, int lane) {
#pragma unroll
    for (int j = 0; j < 4; ++j) __builtin_amdgcn_global_load_lds((const unsigned*)(tile + j * 1024 + lane * 16), (LAS unsigned*)(dst + j * 1024), 16, 0, 0);
}
__device__ __forceinline__ void dma_v(LAS char* vb, const bf16* vrow0, long rs, int lane) {
#pragma unroll
    for (int j = 0; j < 4; ++j) __builtin_amdgcn_global_load_lds((const unsigned*)(vrow0 + (long)(16 * (j & 1) + (lane >> 2)) * rs + (4 * (j >> 1) + (lane & 3)) * 8), (LAS unsigned*)(vb + j * 1024), 16, 0, 0);
}
__device__ __forceinline__ void load_vfrags(bf16x8 (&vf)[2][2], const LAS char* vaddr) {
#pragma unroll
    for (int d0 = 0; d0 < 2; ++d0)
#pragma unroll
        for (int ks = 0; ks < 2; ++ks) { const s16x4 lo = vtr(vaddr + d0 * 2048 + ks * 1024), hh = vtr(vaddr + d0 * 2048 + ks * 1024 + 512);
            vf[d0][ks] = (bf16x8){lo[0], lo[1], lo[2], lo[3], hh[0], hh[1], hh[2], hh[3]}; }
}
__device__ __forceinline__ void pv_tile(f32x16 (&o)[2], const bf16x8 (&vf)[2][2], const f32x16& p) {
    u32x4 w0, w1;
    w0.x = cvtpk(p[0], p[1]); w0.y = cvtpk(p[2], p[3]); w0.z = cvtpk(p[4], p[5]); w0.w = cvtpk(p[6], p[7]);
    w1.x = cvtpk(p[8], p[9]); w1.y = cvtpk(p[10], p[11]); w1.z = cvtpk(p[12], p[13]); w1.w = cvtpk(p[14], p[15]);
    const bf16x8 pa0 = __builtin_bit_cast(bf16x8, w0), pa1 = __builtin_bit_cast(bf16x8, w1);
#pragma unroll
    for (int d0 = 0; d0 < 2; ++d0) { o[d0] = __builtin_amdgcn_mfma_f32_32x32x16_bf16(vf[d0][0], pa0, o[d0], 0, 0, 0); o[d0] = __builtin_amdgcn_mfma_f32_32x32x16_bf16(vf[d0][1], pa1, o[d0], 0, 0, 0); }
}
__device__ __forceinline__ void store_o(bf16* MIX, int row, int col, const f32x16 (&o)[2], float scale, int hi) {
#pragma unroll
    for (int d0 = 0; d0 < 2; ++d0)
#pragma unroll
        for (int g = 0; g < 4; g += 2) {
            const unsigned ax = cvtpk(o[d0][4 * g] * scale, o[d0][4 * g + 1] * scale), ay = cvtpk(o[d0][4 * g + 2] * scale, o[d0][4 * g + 3] * scale);
            const unsigned bx = cvtpk(o[d0][4 * g + 4] * scale, o[d0][4 * g + 5] * scale), by = cvtpk(o[d0][4 * g + 6] * scale, o[d0][4 * g + 7] * scale);
            const auto rx = __builtin_amdgcn_permlane32_swap(ax, bx, false, false); const auto ry = __builtin_amdgcn_permlane32_swap(ay, by, false, false);
            u32x4 w; w.x = rx[0]; w.y = ry[0]; w.z = rx[1]; w.w = ry[1];
            *(u32x4*)((unsigned char*)MIX + mix_off(row, col + 32 * d0 + 8 * g + 8 * hi)) = w; }
}
__device__ __forceinline__ void pack_o(u32x4 (&w)[4], const f32x16 (&o)[2], float scale) {
#pragma unroll
    for (int d0 = 0; d0 < 2; ++d0)
#pragma unroll
        for (int g = 0; g < 4; g += 2) {
            const unsigned ax = cvtpk(o[d0][4 * g] * scale, o[d0][4 * g + 1] * scale), ay = cvtpk(o[d0][4 * g + 2] * scale, o[d0][4 * g + 3] * scale);
            const unsigned bx = cvtpk(o[d0][4 * g + 4] * scale, o[d0][4 * g + 5] * scale), by = cvtpk(o[d0][4 * g + 6] * scale, o[d0][4 * g + 7] * scale);
            const auto rx = __builtin_amdgcn_permlane32_swap(ax, bx, false, false); const auto ry = __builtin_amdgcn_permlane32_swap(ay, by, false, false);
            w[2 * d0 + (g >> 1)] = (u32x4){rx[0], ry[0], rx[1], ry[1]}; }
}
__device__ __forceinline__ float alibi_slope(int k  ) { return __builtin_amdgcn_exp2f(-8.0f * (float)(k + 1) / 12.0f); }
__device__ __forceinline__ void scale_o(f32x16 (&o)[2], float f) {
#pragma unroll
    for (int r = 0; r < 16; ++r) { o[0][r] *= f; o[1][r] *= f; }
}

template <bool FIRST, bool WITH_O>
__device__ __forceinline__ void step_rest(f32x16 (&o)[2], float& m, float& l, f32x16& t, float off, const bf16x8 (&vf)[2][2]) {
    const float tm = hswap_max(lane_max(t) + off);
    if (FIRST) m = tm;
    else if (__any(tm - m > THR)) { const float dl = fmaxf(tm - m, 0.f), f = __builtin_amdgcn_exp2f(-dl); l *= f; if (WITH_O) scale_o(o, f); m += dl; }
    const float bm = off - m; f32x2_t ps = {0.f, 0.f}; const f32x2_t bm2 = {bm, bm};
#pragma unroll
    for (int r = 0; r < 16; r += 2) { const f32x2_t x = (f32x2_t){t[r], t[r + 1]} + bm2; t[r] = __builtin_amdgcn_exp2f(x.x); t[r + 1] = __builtin_amdgcn_exp2f(x.y); ps += (f32x2_t){t[r], t[r + 1]}; }
    l += ps.x + ps.y;
    if (WITH_O) pv_tile(o, vf, t);
}
template <int VAR, bool FIRST, bool WITH_O>
__device__ __forceinline__ void step(f32x16 (&o)[2], float& m, float& l, const bf16x8 (&kf)[4], const bf16x8 (&qf)[4], const bf16x8 (&vf)[2][2], float relf, float sl, float slope2, float Rf) {
    f32x16 t; const float off = scores<VAR>(t, kf, qf, relf, sl, slope2, Rf);
    step_rest<FIRST, WITH_O>(o, m, l, t, off, vf);
}

__device__ __forceinline__ void pair_rest(f32x16 (&o)[2], float& m, float& l, f32x16& tL, f32x16& tR, float offL, float offR, const LAS char* vL, const LAS char* vR) {
    const float tm = hswap_max(fmaxf(lane_max(tL) + offL, lane_max(tR) + offR));
    if (__any(tm - m > THR)) { const float dl = fmaxf(tm - m, 0.f), f = __builtin_amdgcn_exp2f(-dl); l *= f; scale_o(o, f); m += dl; }
    const float bL = offL - m, bR = offR - m; f32x2_t ps = {0.f, 0.f}; const f32x2_t bL2 = {bL, bL}, bR2 = {bR, bR};
#pragma unroll
    for (int r = 0; r < 16; r += 2) { const f32x2_t xL = (f32x2_t){tL[r], tL[r + 1]} + bL2, xR = (f32x2_t){tR[r], tR[r + 1]} + bR2;
        tL[r] = __builtin_amdgcn_exp2f(xL.x); tL[r + 1] = __builtin_amdgcn_exp2f(xL.y); tR[r] = __builtin_amdgcn_exp2f(xR.x); tR[r + 1] = __builtin_amdgcn_exp2f(xR.y);
        ps += (f32x2_t){tL[r], tL[r + 1]}; ps += (f32x2_t){tR[r], tR[r + 1]}; }
    l += ps.x + ps.y;
    { bf16x8 vf[2][2]; load_vfrags(vf, vL); pv_tile(o, vf, tL); }
    { bf16x8 vf[2][2]; load_vfrags(vf, vR); pv_tile(o, vf, tR); }
}
template <int VAR>
__device__ __forceinline__ void step_pair_lds(f32x16 (&o)[2], float& m, float& l, const LAS char* kL, const LAS char* kR, const LAS char* vL, const LAS char* vR, bf16x8 (&qf)[4],
                                              float relfL, float relfR, float slope2, float Rf, const char* qnext = nullptr, int lane = 0) {
    f32x16 tL, tR; float offL, offR;
    { bf16x8 kf[4];
#pragma unroll
      for (int s = 0; s < 4; ++s) kf[s] = *(const LAS bf16x8*)(kL + s * 1024);
      offL = scores<VAR>(tL, kf, qf, relfL, slope2, slope2, Rf); }
    { bf16x8 kf[4];
#pragma unroll
      for (int s = 0; s < 4; ++s) kf[s] = *(const LAS bf16x8*)(kR + s * 1024);
      offR = scores<VAR>(tR, kf, qf, relfR, -slope2, slope2, Rf); }
    if (qnext) load_tile_frags_nt(qf, qnext, lane);
    pair_rest(o, m, l, tL, tR, offL, offR, vL, vR);
}
template <int VAR>
__device__ __forceinline__ void step_pair_regk(f32x16 (&o)[2], float& m, float& l, const bf16x8 (&kfL)[4], const bf16x8 (&kfR)[4], const LAS char* vL, const LAS char* vR, const bf16x8 (&qf)[4],
                                               float relfL, float relfR, float slope2, float Rf) {
    f32x16 tL, tR; const float offL = scores<VAR>(tL, kfL, qf, relfL, slope2, slope2, Rf), offR = scores<VAR>(tR, kfR, qf, relfR, -slope2, slope2, Rf);
    pair_rest(o, m, l, tL, tR, offL, offR, vL, vR);
}

__device__ __forceinline__ void dma_k(LAS char* kb, const bf16* krow0, long rs, int lane) {
#pragma unroll
    for (int s = 0; s < 4; ++s) __builtin_amdgcn_global_load_lds((const unsigned*)(krow0 + (long)(lane & 31) * rs + 16 * s + 8 * (lane >> 5)), (LAS unsigned*)(kb + s * 1024), 16, 0, 0);
}
struct BTile { const char* qb; const char* kb; const char* vb; int nt  , t0  , n0, head, d, r, tl; float slope2; };
__device__ __forceinline__ BTile b_decode(const char* ZB, int b, int c, int j, int qi, int q) {
    BTile t; const int g = qi >> 4, i = qi & 15, lg = 2 * g; t.d = 1 << lg;
    t.r = i >> (4 - lg); const int isub = i & ((16 >> lg) - 1); t.n0 = ((512 * c) >> lg) + 32 * isub; t.nt = 256 >> lg; t.t0 = t.n0 >> 5;
    t.head = 2 * g + j; t.slope2 = alibi_slope(6 + t.head) * (float)t.d * LOG2E;
    const size_t tb = (size_t)(t.head * 4 + b) * 256 + ((size_t)t.r << (8 - lg));
    t.qb = ZB + (tb << 12); t.kb = ZB + ((tb + 6 * 4 * 256) << 12); t.vb = ZB + ((tb + 2 * 6 * 4 * 256) << 12);
    t.tl = g * 512 + (32 * isub + q) * t.d + t.r;
    return t;
}
__device__ __forceinline__ void b_issue_qk(const BTile& t, bf16x8 (&qf)[4], bf16x8 (&kf)[5][4], bool (&val)[5], int (&kc)[5], int lane) {
    load_tile_frags_nt(qf, t.qb + ((size_t)t.t0 << 12), lane);
#pragma unroll
    for (int i = 0; i < 5; ++i) { const int kt = t.t0 + kt_of(i); val[i] = kt >= 0 && kt < t.nt; kc[i] = kt < 0 ? 0 : (kt >= t.nt ? t.nt - 1 : kt);
        load_tile_frags(kf[i], t.kb + ((size_t)kc[i] << 12), lane); }
}
__device__ __forceinline__ void fill_ninf(f32x16& t) {
#pragma unroll
    for (int r = 0; r < 16; ++r) t[r] = -INFINITY;
}
__device__ __forceinline__ float b_qtile(f32x16 (&o)[2], const BTile& t, const BTile& tn, bool has_next, bf16x8 (&qf)[4], bf16x8 (&kf)[5][4], bool (&val)[5], int (&kc)[5], LAS char* vb, int lane) {
    const int q = lane & 31, hi = lane >> 5;
    const float slope2 = t.slope2;
    const LAS char* vaddr = vb + (4 * hi + ((lane & 15) >> 2)) * 64 + ((lane >> 4) & 1) * 32 + (lane & 3) * 8;
    float m = 0.f, l = 0.f;
    {
        bf16x8 vf[2][2]; load_vfrags(vf, vaddr);
        asm volatile("s_waitcnt lgkmcnt(0)" ::: "memory"); dma_tile(vb, t.vb + ((size_t)kc[4] << 12), lane);
        step<0, true, true>(o, m, l, kf[0], qf, vf, (float)(q - 4 * hi), slope2, slope2, 64.0f); }
    {
        f32x16 tL, tR; const float offL = scores<1>(tL, kf[1], qf, (float)(q + 32 - 4 * hi), slope2, slope2, 64.0f), offR = scores<1>(tR, kf[2], qf, (float)(q - 32 - 4 * hi), -slope2, slope2, 64.0f);
        if (!val[1]) fill_ninf(tL); if (!val[2]) fill_ninf(tR);
        pair_rest(o, m, l, tL, tR, offL, offR, vaddr + 4096, vaddr + 8192); }
    asm volatile("s_waitcnt vmcnt(0)" ::: "memory");
    {
        f32x16 tL, tR; const float offL = scores<2>(tL, kf[3], qf, (float)(q + 64 - 4 * hi), slope2, slope2, 64.0f), offR = scores<2>(tR, kf[4], qf, (float)(q - 64 - 4 * hi), -slope2, slope2, 64.0f);
        if (!val[3]) fill_ninf(tL); if (!val[4]) fill_ninf(tR);
        if (has_next) {
            asm volatile("s_waitcnt lgkmcnt(0)" ::: "memory");
            b_issue_qk(tn, qf, kf, val, kc, lane);
            dma_tile(vb + 4096, tn.vb + ((size_t)kc[1] << 12), lane); dma_tile(vb + 8192, tn.vb + ((size_t)kc[2] << 12), lane); }
        pair_rest(o, m, l, tL, tR, offL, offR, vaddr + 12288, vaddr);
        if (has_next) { asm volatile("s_waitcnt lgkmcnt(0)" ::: "memory");
            dma_tile(vb, tn.vb + ((size_t)kc[0] << 12), lane); dma_tile(vb + 12288, tn.vb + ((size_t)kc[3] << 12), lane); } }
    const float lt = hswap_sum(l);
    scale_o(o, 1.0f / lt);
    return m + __builtin_amdgcn_logf(lt);
}
__device__ __forceinline__ void b_unit(const char* ZB, bf16* MIX, char* SCR, int u, LAS char* lds, int wave, int lane) {
    const int b = u >> 5, c = (u >> 1) & 15, j = u & 1;
    LAS float* lseb = (LAS float*)(lds + LSEB_OFF);
    LAS char* vb = lds + wave * 16384;
    char* scr = SCR + (size_t)(u >> 4) * SLAB + ((size_t)((u & 15) * 8 + wave) * 6 << 12) + lane * 16;
    const int q = lane & 31, hi = lane >> 5;
    bf16x8 qf[4], kf[5][4]; bool val[5]; int kc[5];
    BTile t = b_decode(ZB, b, c, j, wave, q);
    b_issue_qk(t, qf, kf, val, kc, lane);
#pragma unroll
    for (int i = 0; i < 4; ++i) dma_tile(vb + i * 4096, t.vb + ((size_t)kc[i] << 12), lane);
#pragma unroll 1
    for (int it = 0; it < 6; ++it) { const bool has_next = it < 5; const BTile tn = b_decode(ZB, b, c, j, wave + 8 * (has_next ? it + 1 : it), q);
        if (it == 0) asm volatile("s_waitcnt vmcnt(0)" ::: "memory"); else asm volatile("s_waitcnt vmcnt(4)" ::: "memory");
        f32x16 o[2]; o[0] = zero16_(); o[1] = zero16_();
        const float lse = b_qtile(o, t, tn, has_next, qf, kf, val, kc, vb, lane);
        if (hi == 0) lseb[t.tl] = lse;
        u32x4 w[4]; pack_o(w, o, 1.0f);
#pragma unroll
        for (int k = 0; k < 4; ++k) *(u32x4*)(scr + ((size_t)it << 12) + k * 1024) = w[k];
        t = tn; }
    __syncthreads();
#pragma unroll 1
    for (int it0 = 0; it0 < 6; it0 += 3) { u32x4 w[3][4];
#pragma unroll
        for (int ii = 0; ii < 3; ++ii)
#pragma unroll
            for (int k = 0; k < 4; ++k) w[ii][k] = *(const u32x4*)(scr + ((size_t)(it0 + ii) << 12) + k * 1024);
#pragma unroll
        for (int ii = 0; ii < 3; ++ii) { const BTile tt = b_decode(ZB, b, c, j, wave + 8 * (it0 + ii), q);
            const int tk = tt.tl & 511; const float l0 = lseb[tk], l1 = lseb[512 + tk], l2 = lseb[1024 + tk], own = lseb[tt.tl]; const float mm = fmaxf(l0, fmaxf(l1, l2));
            const float a = __builtin_amdgcn_exp2f(own - mm) / (__builtin_amdgcn_exp2f(l0 - mm) + __builtin_amdgcn_exp2f(l1 - mm) + __builtin_amdgcn_exp2f(l2 - mm));
            const int orow = b * SEQ + (tt.n0 + q) * tt.d + tt.r, ocol = 256 + 64 * tt.head + 8 * hi;
#pragma unroll
            for (int k = 0; k < 4; ++k) { const u32x4 x = w[ii][k]; u32x4 y;
                y.x = cvtpk(__uint_as_float(x.x << 16) * a, __uint_as_float(x.x & 0xffff0000u) * a); y.y = cvtpk(__uint_as_float(x.y << 16) * a, __uint_as_float(x.y & 0xffff0000u) * a);
                y.z = cvtpk(__uint_as_float(x.z << 16) * a, __uint_as_float(x.z & 0xffff0000u) * a); y.w = cvtpk(__uint_as_float(x.w << 16) * a, __uint_as_float(x.w & 0xffff0000u) * a);
                *(u32x4*)((unsigned char*)MIX + mix_off(orow, ocol + 32 * (k >> 1) + 16 * (k & 1))) = y; } } }
    __syncthreads();
}
__device__ __forceinline__ void c_unit(const char* ZC, bf16* MIX, const float* sink, int u, LAS char* lds, int wave, int lane) {
    const int b = u >> 6, kvh = (u >> 5) & 1, q0 = 256 * (u & 31), n0 = q0 + 32 * wave;
    const int q = lane & 31, hi = lane >> 5;
    const char* kt0 = ZC + ((size_t)((6 + kvh) * 4 + b) * 256 << 12); const char* vt0 = ZC + ((size_t)((8 + kvh) * 4 + b) * 256 << 12);
#pragma unroll
    for (int tt = 0; tt < 2; ++tt) { const int t = 2 * wave + tt, T = (q0 >> 5) - 4 + t;
        if (T >= 0 && T < SEQ / 32) { dma_tile(lds + t * 8192, kt0 + ((size_t)T << 12), lane); dma_tile(lds + t * 8192 + 4096, vt0 + ((size_t)T << 12), lane); } }
    const char* qt0 = ZC + (((size_t)((3 * kvh) * 4 + b) * 256 + (n0 >> 5)) << 12);
    bf16x8 qf[4]; load_tile_frags_nt(qf, qt0, lane);
    asm volatile("s_waitcnt vmcnt(0)" ::: "memory");
    __syncthreads();
    const LAS char* kbase = lds + lane * 16;
    const LAS char* vbase = lds + 4096 + (4 * hi + ((lane & 15) >> 2)) * 64 + ((lane >> 4) & 1) * 32 + (lane & 3) * 8;
#pragma unroll 1
    for (int hh = 0; hh < 3; ++hh) { const int head = 3 * kvh + hh;
        const char* qnext = hh < 2 ? qt0 + ((size_t)(hh + 1) * 4 * 256 << 12) : nullptr; bool reloaded = false;
        f32x16 o[2]; o[0] = zero16_(); o[1] = zero16_();
        float m = sink[head] * LOG2E, l = hi ? 0.f : 1.0f; const float slope2 = alibi_slope(head) * LOG2E;
        {
            const int t = wave + 4; bf16x8 kf[4];
#pragma unroll
            for (int s = 0; s < 4; ++s) kf[s] = *(const LAS bf16x8*)(kbase + t * 8192 + s * 1024);
            bf16x8 vf[2][2]; load_vfrags(vf, vbase + t * 8192);
            step<0, false, true>(o, m, l, kf, qf, vf, (float)(q - 4 * hi), slope2, slope2, 128.0f); }
#pragma unroll 1
        for (int k = 1; k <= 4; ++k) { const int tL = wave + 4 - k, tR = wave + 4 + k; const bool vL = n0 - 32 * k >= 0, vR = n0 + 32 * k < SEQ;
            const float relfL = (float)(q + 32 * k - 4 * hi), relfR = (float)(q - 32 * k - 4 * hi);
            if (vL && vR) {
                if (k < 4) step_pair_lds<1>(o, m, l, kbase + tL * 8192, kbase + tR * 8192, vbase + tL * 8192, vbase + tR * 8192, qf, relfL, relfR, slope2, 128.0f);
                else { step_pair_lds<2>(o, m, l, kbase + tL * 8192, kbase + tR * 8192, vbase + tL * 8192, vbase + tR * 8192, qf, relfL, relfR, slope2, 128.0f, qnext, lane); reloaded = true; } }
            else if (vL || vR) { const int t = vL ? tL : tR; bf16x8 kf[4];
#pragma unroll
                for (int s = 0; s < 4; ++s) kf[s] = *(const LAS bf16x8*)(kbase + t * 8192 + s * 1024);
                bf16x8 vf[2][2]; load_vfrags(vf, vbase + t * 8192);
                const float relf = vL ? relfL : relfR, sl = vL ? slope2 : -slope2;
                if (k < 4) step<1, false, true>(o, m, l, kf, qf, vf, relf, sl, slope2, 128.0f); else step<2, false, true>(o, m, l, kf, qf, vf, relf, sl, slope2, 128.0f); } }
        if (!reloaded && qnext) load_tile_frags_nt(qf, qnext, lane);
        store_o(MIX, b * SEQ + n0 + q, 640 + 64 * head, o, 1.0f / hswap_sum(l), hi); }
    __syncthreads();
}
template <int G>
__device__ __forceinline__ void pool_group(const LAS char* rows, bf16* MIX, const bf16* wpt, const float* pscale, int row0, int tok, int kq, int lane) {
    constexpr int R = 1 << G, W = 2 * R + 1;
    int lo = tok - R, hi2 = tok + R + 1; lo = lo < 0 ? 0 : lo; hi2 = hi2 > SEQ ? SEQ : hi2; const float inv = 1.0f / (float)(hi2 - lo);
    f32x4 acc[4];
#pragma unroll
    for (int dt = 0; dt < 4; ++dt) acc[dt] = zero4_();
#pragma unroll
    for (int kb = 0; kb < 2; ++kb) { float s[8]; bf16x8 uc;
        const LAS char* rp = rows + ((lane & 15) + 8 - R) * POOL_PITCH + (8 * G + 4 * kb + kq) * 16;
#pragma unroll
        for (int e = 0; e < 8; ++e) s[e] = 0.f;
#pragma unroll
        for (int j = 0; j < W; ++j) { const int tt = tok + j - R; const float w = (tt >= 0 && tt < SEQ) ? 1.0f : 0.0f; const bf16x8 v = *(const LAS bf16x8*)(rp + j * POOL_PITCH); if (j == R) uc = v;
#pragma unroll
            for (int e = 0; e < 8; ++e) s[e] += w * bf2f((unsigned short)v[e]); }
        u32x4 pw; float pe[8];
#pragma unroll
        for (int e = 0; e < 8; ++e) pe[e] = s[e] * inv - bf2f((unsigned short)uc[e]);
        pw.x = cvtpk(pe[0], pe[1]); pw.y = cvtpk(pe[2], pe[3]); pw.z = cvtpk(pe[4], pe[5]); pw.w = cvtpk(pe[6], pe[7]);
        const bf16x8 bfrag = __builtin_bit_cast(bf16x8, pw);
#pragma unroll
        for (int dt = 0; dt < 4; ++dt) { const bf16x8 afrag = *(const bf16x8*)(wpt + (size_t)(G * 64 + dt * 16 + (lane & 15)) * 64 + kb * 32 + 8 * kq);
            acc[dt] = __builtin_amdgcn_mfma_f32_16x16x32_bf16(afrag, bfrag, acc[dt], 0, 0, 0); } }
#pragma unroll
    for (int dt = 0; dt < 4; ++dt) { const int dcol = G * 64 + dt * 16 + 4 * kq; const f32x4 sc = *(const f32x4*)(pscale + dcol);
        u32x2 w; w.x = cvtpk(acc[dt][0] * sc.x, acc[dt][1] * sc.y); w.y = cvtpk(acc[dt][2] * sc.z, acc[dt][3] * sc.w);
        *(u32x2*)((unsigned char*)MIX + mix_off(row0 + (lane & 15), dcol & ~7) + 2 * (dcol & 7)) = w; }
}
__device__ __forceinline__ void pool_item(const bf16* Z, bf16* MIX, const bf16* wpt, const float* pscale, int item, LAS char* rows, int lane) {
    const int row0 = 16 * item, b = row0 / SEQ, t0 = row0 % SEQ;
    const int tok = t0 + (lane & 15), kq = lane >> 4;
    const bf16* zb = Z + (size_t)b * SEQ * 256;
    u32x4 st[16];
#pragma unroll
    for (int i = 0; i < 16; ++i) { const int idx = i * 64 + lane, r = idx >> 5, c = idx & 31; int tt = t0 - 8 + r; tt = (tt >= 0 && tt < SEQ) ? tt : t0; st[i] = *(const u32x4*)(zb + (size_t)tt * 256 + 8 * c); }
#pragma unroll
    for (int i = 0; i < 16; ++i) { const int idx = i * 64 + lane, r = idx >> 5, c = idx & 31; *(LAS u32x4*)(rows + r * POOL_PITCH + c * 16) = st[i]; }
    pool_group<0>(rows, MIX, wpt, pscale, row0, tok, kq, lane); pool_group<1>(rows, MIX, wpt, pscale, row0, tok, kq, lane);
    pool_group<2>(rows, MIX, wpt, pscale, row0, tok, kq, lane); pool_group<3>(rows, MIX, wpt, pscale, row0, tok, kq, lane);
}
constexpr int N_B_UNITS = 128, N_C_UNITS = 256, N_P_ITEMS = M / 16;
}

__device__ __forceinline__ void p_mixers(Frame& F, const float* const* in, unsigned char* ws, int lq, int sel  ) {
    const int l = lq & 1;
    const bf16* Z = (const bf16*)(ws + WS_Z); bf16* MIX = (bf16*)(ws + WS_MIX);
    LAS char* lds = (LAS char*)F.lds;
    const float* sink = in[9] + 6 * l;
    {
        const int nb = (F.G >= 2 * mx::N_B_UNITS) ? mx::N_B_UNITS : (F.G + 1) / 2;
        const bool xl = (F.G == 256);
        if ((int)blockIdx.x < nb) {
            if (sel & 1) {
#pragma unroll 1
                for (int u0 = blockIdx.x; u0 < mx::N_B_UNITS; u0 += nb) { const int u = xl ? ((u0 & 7) >> 1) * 32 + (8 * (u0 & 1) + (u0 >> 4)) * 2 + ((u0 >> 3) & 1) : u0;     unsigned z_; asm volatile("v_mov_b32 %0, 0" : "=v"(z_)); const int lane = (int)__builtin_amdgcn_mbcnt_hi(~0u, __builtin_amdgcn_mbcnt_lo(~0u, z_)); mx::b_unit((const char*)(ws + WS_ZB), MIX, (char*)(ws + WS_BSCR), u, lds, F.wave, lane); } }
        } else if (sel & 2) {
#pragma unroll 1
            for (int v = (int)blockIdx.x - nb, u0 = v, k = 0; u0 < mx::N_C_UNITS; u0 += F.G - nb, ++k) { const int u = xl ? ((v & 7) >> 1) * 64 + ((((v >> 3) * 2 + k) >> 4) * 32) + 16 * (v & 1) + (((v >> 3) * 2 + k) & 15) : u0;     unsigned z_; asm volatile("v_mov_b32 %0, 0" : "=v"(z_)); const int lane = (int)__builtin_amdgcn_mbcnt_hi(~0u, __builtin_amdgcn_mbcnt_lo(~0u, z_)); mx::c_unit((const char*)(ws + WS_ZC), MIX, sink, u, lds, F.wave, lane); }
        }
        __syncthreads();
    }
    if (sel & 4) { const bf16* wpt = (const bf16*)(ws + WS_W + (size_t)l * W_LAYER + W_PT); const float* pscale = in[8] + 256 * l;
        for (int it0 = blockIdx.x * NWAVES + F.wave; it0 < mx::N_P_ITEMS; it0 += F.G * NWAVES) { const int it = (F.G == 256) ? (((int)blockIdx.x & 7) * 32 + ((int)blockIdx.x >> 3)) * NWAVES + F.wave : it0;     mx::pool_item(Z, MIX, wpt, pscale, it, lds + F.wave * (32 * mx::POOL_PITCH), F.lane); } }
}

struct Args { const float* in[15]; float* out; unsigned char* ws; int ph_lo, ph_hi, li, dup; };
__global__ void __launch_bounds__(NWAVES * 64, 2) mk_fwd(Args args) {
    extern __shared__ __attribute__((aligned(16))) unsigned char lds[];
    Frame F;
    F.lds = (LAS unsigned char*)lds;
    F.MISC = (volatile LAS unsigned*)(F.lds + MISC_OFF);
    F.tid = threadIdx.x; F.lane = F.tid & 63; F.wave = __builtin_amdgcn_readfirstlane(F.tid >> 6);
    const int wave0 = F.wave;
    F.G = gridDim.x; { const int bx = blockIdx.x; F.vcu = (F.G % 8 == 0) ? (bx % 8) * (F.G / 8) + bx / 8 : bx; }
    unsigned char* ws = args.ws;
    F.ctl = (gu32*)(ws + WS_CTL);
    for (int u = F.tid; u < (LDS_BYTES - LDSCTL_OFF) / 4; u += NWAVES * 64) ((LAS unsigned*)(F.lds + LDSCTL_OFF))[u] = 0u;
    __syncthreads();
    XcdBarrier bar; bar.bar = (unsigned*)(F.ctl + CW_BAR) + args.li * XCD_BAR_WORDS; bar.x = 0; bar.st = nullptr;
    const int lo = args.ph_lo, hi = args.ph_hi;
    if (hi - lo > 1) { bar = xcd_barrier_post((unsigned*)(F.ctl + CW_BAR) + args.li * XCD_BAR_WORDS, F.MISC + 8);
        if (F.tid == 0) { const unsigned v = bar.x + 1u; unsigned exp = 0u;
            if (!__hip_atomic_compare_exchange_strong((unsigned*)(F.ctl + CW_GRP) + (blockIdx.x & 7), &exp, v, __ATOMIC_RELAXED, __ATOMIC_RELAXED, __HIP_MEMORY_SCOPE_AGENT) && exp != v) __hip_atomic_fetch_or((unsigned*)(F.ctl + CW_GRPBAD), 1u, RLX_AGENT); } }
    const float* const* in = args.in;
    bf16* XS = (bf16*)(ws + WS_XS);
    bf16* H = (bf16*)(ws + WS_H);
    const float* MOD = (const float*)(ws + WS_MOD);
    float* SSQ = (float*)(ws + WS_SUMSQ);
    const float* GV = (const float*)(ws + WS_GV);

    const int dup = args.dup & 1, msel = ((args.dup >> 1) & 15) ? ((args.dup >> 1) & 15) : 7;
#pragma unroll 1
    for (int ph = lo; ph < hi; ++ph) {
        { unsigned z_; asm volatile("v_mov_b32 %0, 0" : "=v"(z_)); const int t_ = wave0 * 64 + (int)__builtin_amdgcn_mbcnt_hi(~0u, __builtin_amdgcn_mbcnt_lo(~0u, z_)); F.tid = t_; F.lane = t_ & 63; F.wave = wave0; }
        if (ph == PH_PRO) p_prologue(F, in, ws);
        else if (ph == PH_CONV) p_conv(F, in, ws);
        else if (ph == PH_FINAL) p_norm_final(F, XS, SSQ + (size_t)4 * M, args.out, in[14]);
        else {
            const int l = (ph - PH_L0) / PH_PER_LAYER, k = (ph - PH_L0) % PH_PER_LAYER;
            unsigned char* wl = ws + WS_W + (size_t)l * W_LAYER;
            const float* modl = MOD + (size_t)l * BATCH * NMOD * D;
            const float* biasl = (const float*)(ws + WS_BIAS + (size_t)l * BIAS_LAYER);
            if (k == 0) { pg8::Gemm g{H, (const bf16*)(wl + W_IN), M, INW, D}; pg8::StaticOrder S; S.init(M, INW, F.G, (int)blockIdx.x);
                pg8::EpiBf16Norm E{(bf16*)(ws + WS_Z), 256, SSQ + (size_t)(2 * l) * M, l == 0 ? (const float*)(F.ctl + CW_ZEROS) : biasl, l == 0 ? 0 : INW, ws + WS_ZB, ws + WS_ZC};
                pg8::gemm_phase<pg8::EpiBf16Norm, pg8::StaticOrder, true, true>(F.lds + RING_OFF, g, S, E, F.tid); }
            else if (k == 1) p_mixers(F, in, ws, l + 2 * dup, msel);
            else if (k == 2 && l == 0 && !dup) {
                pg8::Gemm g{(const bf16*)(ws + WS_MIX), (const bf16*)(wl + W_OUT), M, D, D, mx::SLAB - mx::SLAB_MIX}; pg8::StaticOrder S; S.init(M, D, F.G, (int)blockIdx.x);
                pg8::EpiGateResNormT<true> E{(const bf16*)in[0], XS, modl + 2 * D, NMOD * D, H, GV + (size_t)1 * BATCH * D, D, SSQ + (size_t)1 * M, D};
                pg8::gemm_phase<pg8::EpiGateResNormT<true>, pg8::StaticOrder, true, true>(F.lds + RING_OFF, g, S, E, F.tid); }
            else if (k == 2 || k == 4) { const bool dn = (k == 4); const bool last = dn && (l == DEPTH - 1);
                pg8::Gemm g{(const bf16*)(ws + (dn ? WS_HID : WS_MIX)), (const bf16*)(wl + (dn ? W_DN : W_OUT)), M, D, dn ? DFF : D, dn ? (size_t)0 : mx::SLAB - mx::SLAB_MIX}; pg8::StaticOrder S; S.init(M, D, F.G, (int)blockIdx.x);
                pg8::EpiGateResNorm E{XS, XS, dup ? (const float*)(F.ctl + CW_ZEROS) : modl + (dn ? 5 : 2) * D, dup ? 0 : NMOD * D,
                    (last || dup) ? (bf16*)nullptr : H, GV + (size_t)((dn ? 2 * (l + 1) : 2 * l + 1) % (2 * DEPTH)) * BATCH * D, D, SSQ + (size_t)(dup ? 5 : 2 * l + (dn ? 2 : 1)) * M, D};
                pg8::gemm_phase<pg8::EpiGateResNorm, pg8::StaticOrder, true, true>(F.lds + RING_OFF, g, S, E, F.tid); }
            else { pg8::Gemm g{H, (const bf16*)(wl + W_GU), M, 2 * DFF, D}; pg8::StaticOrder S; S.init(M, 2 * DFF, F.G, (int)blockIdx.x);
                pg8::EpiSwiGLUNorm E{(bf16*)(ws + WS_HID), DFF, SSQ + (size_t)(2 * l + 1) * M, biasl + BATCH * INW, 2 * DFF};
                pg8::gemm_phase<pg8::EpiSwiGLUNorm, pg8::StaticOrder, true, true>(F.lds + RING_OFF, g, S, E, F.tid); }
        }
        if (ph + 1 < hi) { const int kk = (ph >= PH_L0 && ph < PH_FINAL) ? (ph - PH_L0) % PH_PER_LAYER : -1;
            const bool lok = F.MISC[17] != 0u; const int lyr = (ph - PH_L0) / PH_PER_LAYER; unsigned* gflag = (unsigned*)(F.ctl + CW_GRPFLAG);
            const bool e_mid = (kk == 4 && ph + 1 < PH_FINAL);
            xcd_barrier(bar, lok && (kk == 1 || kk == 2 || kk == 3 || kk == 4 || ph == PH_CONV), (lok && kk == 1) ? gflag + 32 * (blockIdx.x & 7) : nullptr, (lok && e_mid) ? gflag + 32 * ((blockIdx.x & 7) ^ 1) : nullptr, (unsigned)(lyr + 1));
            if (ph == PH_PRO && lo == 0) { if (F.tid == 0) F.MISC[17] = (F.G == 256 && F.MISC[9] == 8u && xb_ld((unsigned*)(F.ctl + CW_GRPBAD)) == 0u) ? 1u : 0u;     __syncthreads(); } }
    }
}

extern "C" void kernel_launch(void* const* d_in, const int* in_sizes, int n_in, void* d_out, int out_size, void* d_ws, size_t ws_size, hipStream_t stream) {
    static int grid = 0;
    if (grid == 0) {
        if (n_in != 15 || in_sizes[0] != M * D || out_size != M * D || ws_size < WS_END) { fprintf(stderr, "kernel_launch: unexpected shapes (n_in %d, in0 %d, out %d, ws %zu); nothing launched\n", n_in, n_in > 0 ? in_sizes[0] : -1, out_size, ws_size); grid = -1; return; }
        int dev = 0, cus = 0, per_cu = 0;
        if (hipGetDevice(&dev) != hipSuccess || hipDeviceGetAttribute(&cus, hipDeviceAttributeMultiprocessorCount, dev) != hipSuccess) { grid = -1; return; }
        if (hipFuncSetAttribute((const void*)mk_fwd, hipFuncAttributeMaxDynamicSharedMemorySize, LDS_BYTES) != hipSuccess) { fprintf(stderr, "kernel_launch: hipFuncSetAttribute failed\n"); grid = -1; return; }
        if (hipOccupancyMaxActiveBlocksPerMultiprocessor(&per_cu, (const void*)mk_fwd, NWAVES * 64, LDS_BYTES) != hipSuccess || per_cu < 1) fprintf(stderr, "kernel_launch: occupancy query reports %d blocks per CU\n", per_cu);
        (void)hipGetLastError();
        grid = cus;
        if (grid != 256) fprintf(stderr, "kernel_launch: %d CUs; this kernel is laid out for 256\n", grid);
    }
    if (grid < 0) return;
    if (hipMemsetAsync((char*)d_ws + WS_CTL, 0, CTL_ZERO_BYTES, stream) != hipSuccess) return;
    Args a{};
    for (int i = 0; i < 15; ++i) a.in[i] = (const float*)d_in[i];
    a.out = (float*)d_out; a.ws = (unsigned char*)d_ws;
#if PROBE_DUP == 0 && PROBE_CUT == 0
    a.ph_lo = 0; a.ph_hi = NPHASES; a.li = 0; a.dup = 0;
    hipLaunchKernelGGL(mk_fwd, dim3(grid), dim3(NWAVES * 64), LDS_BYTES, stream, a);
#else
    { int lo = 0, li = 0;
      for (int ph = 0; ph < NPHASES; ++ph) { const bool cut = ((PROBE_CUT | PROBE_DUP) >> ph) & 1;
        if (cut || ph == NPHASES - 1) { a.ph_lo = lo; a.ph_hi = ph + 1; a.li = (ph + 1 - lo > 1) ? li++ : 0; a.dup = 0; hipLaunchKernelGGL(mk_fwd, dim3(grid), dim3(NWAVES * 64), LDS_BYTES, stream, a);
            if ((PROBE_DUP >> ph) & 1) { a.ph_lo = ph; a.ph_hi = ph + 1; a.li = 0; a.dup = 1 | (PROBE_MIXSEL << 1) | (PROBE_NOSTORE << 4); hipLaunchKernelGGL(mk_fwd, dim3(grid), dim3(NWAVES * 64), LDS_BYTES, stream, a); }
            lo = ph + 1; } } }
#endif
}
```
